# Optimizing an MI355X kernel written in HIP

```python
import math
import jax, jax.numpy as jnp
from jax import lax
import numpy as np

D_MODEL = 1024
BATCH = 16
SEQ = 4096
DEPTH = 1
DEC_BATCH = 32
DEC_SEQ = 32
PAST_LEN = 1024

CHUNK = 64
QBLOCK = 128
EPS = 1e-6
NEG_INF = -1e30

A_HEADS = 8
A_HEAD_DIM = 64
A_WIDTH = A_HEADS * A_HEAD_DIM
DECAY_LORA = 64
AAA_LORA = 64
GATE_LORA = 160
A_COLS = 3 * A_WIDTH + DECAY_LORA + AAA_LORA + GATE_LORA
GN_EPS = 64e-5
SPLIT_A = (A_WIDTH, 2 * A_WIDTH, 3 * A_WIDTH, 3 * A_WIDTH + DECAY_LORA,
           3 * A_WIDTH + DECAY_LORA + AAA_LORA)

B_HEADS = 4
B_HEAD_DIM = 64
B_VDIM = 2 * B_HEAD_DIM
B_QK_WIDTH = B_HEADS * 2 * B_HEAD_DIM
B_V_WIDTH = B_HEADS * B_VDIM
B_COLS = 2 * B_QK_WIDTH + B_V_WIDTH

GATE_COLS = 2 * D_MODEL
N_IN = A_COLS + B_COLS + GATE_COLS
SPLIT_IN = (A_COLS, A_COLS + B_QK_WIDTH, A_COLS + 2 * B_QK_WIDTH, A_COLS + B_COLS)

D_FF = ((8 * D_MODEL + 3 * 256 - 1) // (3 * 256)) * 256

kernel_name = 'rwkv7_diffattn_gated_streaming_encoder'


def _rmsnorm(x, g):
    xf = x.astype(jnp.float32)
    xf = xf * lax.rsqrt(jnp.mean(xf * xf, axis=-1, keepdims=True) + EPS)
    return (xf * g.astype(jnp.float32)).astype(x.dtype)


def _head_layernorm(y, w, b):
    mu = jnp.mean(y, axis=-1, keepdims=True)
    var = jnp.mean(jnp.square(y - mu), axis=-1, keepdims=True)
    yn = ((y - mu) * lax.rsqrt(var + GN_EPS)).reshape(y.shape[0], y.shape[1], -1)
    return yn * w.astype(jnp.float32) + b.astype(jnp.float32)


def _wkv_scan(r, decay, k, v, kk, b, s0):
    xs = tuple(jnp.moveaxis(z.astype(jnp.float32), 1, 0) for z in (r, decay, k, v, kk, b))

    def step(s, inp):
        r_t, d_t, k_t, v_t, kk_t, b_t = inp
        sa = jnp.einsum('bhvk,bhk->bhv', s, -kk_t)
        s = (s * d_t[:, :, None, :] + sa[..., None] * b_t[:, :, None, :]
             + v_t[..., None] * k_t[:, :, None, :])
        return s, jnp.einsum('bhvk,bhk->bhv', s, r_t)

    s_fin, ys = lax.scan(step, s0.astype(jnp.float32), xs)
    return jnp.moveaxis(ys, 0, 1), s_fin


def _rwkv7(c, shift_prev, s0, mu, w0, w2, a0, a2, g2, k_k, k_a, r_k, ln_w, ln_b):
    bsz, t = c.shape[0], c.shape[1]
    prev = jnp.concatenate([shift_prev.astype(c.dtype), c[:, :-1]], axis=1)
    xs = c + (prev - c) * mu
    r, k, v, wd, ad, gd = jnp.split(xs, SPLIT_A, axis=-1)
    w = -jax.nn.softplus(-(w0 + jnp.tanh(wd) @ w2)) - 0.5
    decay = jnp.exp(-jnp.exp(w.astype(jnp.float32)))
    a = jax.nn.sigmoid(a0 + ad @ a2)
    g = jax.nn.sigmoid(gd) @ g2
    hs = lambda z: z.reshape(bsz, t, A_HEADS, A_HEAD_DIM)
    kk = hs((k * k_k).astype(jnp.float32))
    kk = kk * lax.rsqrt(jnp.maximum(jnp.sum(kk * kk, axis=-1, keepdims=True), 1e-24))
    k = k * (1.0 + (a - 1.0) * k_a)
    r4, k4, v4, a4 = hs(r), hs(k), hs(v), hs(a)
    y, s_fin = _wkv_scan(r4, hs(decay), k4, v4, kk, kk * a4, s0)
    bonus = jnp.sum(r4 * k4 * r_k, axis=-1, keepdims=True) * v4
    y = _head_layernorm(y, ln_w, ln_b) + bonus.reshape(bsz, t, A_WIDTH).astype(jnp.float32)
    return (y * g.astype(jnp.float32)).astype(c.dtype), s_fin.astype(s0.dtype), c[:, -1:]


def _diff_core(q, k, v, lam, mask):
    s = jnp.einsum('bqhnd,bkhnd->bnhqk', q, k).astype(jnp.float32) * (B_HEAD_DIM ** -0.5)
    if mask is not None:
        s = jnp.where(mask, s, NEG_INF)
    p = jax.nn.softmax(s, axis=-1)
    attn = p[:, 0] - lam * p[:, 1]
    return jnp.einsum('bhqk,bkhe->bqhe', attn.astype(v.dtype), v)


def _diff_attn_chunk_causal(q, k, v, lam):
    bsz, t = q.shape[0], q.shape[1]
    nb = t // QBLOCK
    qb = jnp.moveaxis(q.reshape(bsz, nb, QBLOCK, B_HEADS, 2, B_HEAD_DIM), 1, 0)
    key_chunk = jnp.arange(t) // CHUNK

    def one_block(args):
        q_blk, blk = args
        q_chunk = (blk * QBLOCK + jnp.arange(QBLOCK)) // CHUNK
        mask = key_chunk[None, :] <= q_chunk[:, None]
        return _diff_core(q_blk, k, v, lam, mask)

    out = lax.map(one_block, (qb, jnp.arange(nb)))
    return jnp.moveaxis(out, 0, 1).reshape(bsz, t, B_HEADS, B_VDIM)


def _layer(x, shift_prev, s0, k_past, v_past, p, lam_init):
    bsz, t = x.shape[0], x.shape[1]
    h = _rmsnorm(x, p['norm_mix_pre'])
    c = h @ p['w_in']
    c_a, q, k, v, g_in = jnp.split(c, SPLIT_IN, axis=-1)
    y_a, s_new, shift_new = _rwkv7(c_a, shift_prev, s0, p['rwkv_mu'], p['rwkv_w0'], p['rwkv_w2'],
                                   p['rwkv_a0'], p['rwkv_a2'], p['rwkv_g2'], p['rwkv_k_k'],
                                   p['rwkv_k_a'], p['rwkv_r_k'], p['rwkv_ln_w'], p['rwkv_ln_b'])
    q = q.reshape(bsz, t, B_HEADS, 2, B_HEAD_DIM)
    k = k.reshape(bsz, t, B_HEADS, 2, B_HEAD_DIM)
    v = v.reshape(bsz, t, B_HEADS, B_VDIM)
    f32 = jnp.float32
    lam = (jnp.exp(jnp.sum(p['lq1'].astype(f32) * p['lk1'].astype(f32)))
           - jnp.exp(jnp.sum(p['lq2'].astype(f32) * p['lk2'].astype(f32))) + lam_init)
    if k_past is None:
        o = _diff_attn_chunk_causal(q, k, v, lam)
    else:
        k_all = jnp.concatenate([k_past.astype(k.dtype), k], axis=1)
        v_all = jnp.concatenate([v_past.astype(v.dtype), v], axis=1)
        o = _diff_core(q, k_all, v_all, lam, None)
    o = (_rmsnorm(o, p['subln']) * (1.0 - lam_init)).reshape(bsz, t, B_V_WIDTH)
    g_a, g_b = jnp.split(jax.nn.sigmoid(g_in + p['b_gate']), 2, axis=-1)
    mix = g_a * (y_a @ p['w_out_a']) + g_b * (o @ p['w_out_b'])
    x = x + _rmsnorm(mix @ p['w_o'], p['norm_mix_post'])
    u_g, u_v = jnp.split(_rmsnorm(x, p['norm_ffn_pre']) @ p['w_ffn_in'], 2, axis=-1)
    x = x + _rmsnorm((jax.nn.silu(u_g) * u_v) @ p['w_ffn_out'], p['norm_ffn_post'])
    return x, k, v, s_new, shift_new


def _nrm(k, shape, scale):
    return jax.random.normal(k, shape, jnp.float32) * scale


def setup_inputs(seed: int = 0) -> dict:
    key = jax.random.key(seed)
    ks = jax.random.split(key, 40)
    L = DEPTH
    return {
        'x_prompt': _nrm(ks[0], (BATCH, SEQ, D_MODEL), 1.0),
        'x_sample': _nrm(ks[1], (DEC_BATCH, DEC_SEQ, D_MODEL), 1.0),
        'cache_k': _nrm(ks[2], (L, DEC_BATCH, PAST_LEN, B_HEADS, 2, B_HEAD_DIM), 1.0),
        'cache_v': _nrm(ks[3], (L, DEC_BATCH, PAST_LEN, B_HEADS, B_VDIM), 1.0),
        'state_wkv': _nrm(ks[4], (L, DEC_BATCH, A_HEADS, A_HEAD_DIM, A_HEAD_DIM), 1.0),
        'state_shift': _nrm(ks[5], (L, DEC_BATCH, 1, A_COLS), 1.0),
        'norm_mix_pre': 1.0 + _nrm(ks[6], (L, D_MODEL), 0.05),
        'norm_mix_post': 1.0 + _nrm(ks[7], (L, D_MODEL), 0.05),
        'norm_ffn_pre': 1.0 + _nrm(ks[8], (L, D_MODEL), 0.05),
        'norm_ffn_post': 1.0 + _nrm(ks[9], (L, D_MODEL), 0.05),
        'w_in': _nrm(ks[10], (L, D_MODEL, N_IN), D_MODEL ** -0.5),
        'b_gate': _nrm(ks[11], (L, GATE_COLS), 0.1),
        'rwkv_mu': jax.random.uniform(ks[12], (L, A_COLS), jnp.float32, 0.0, 1.0),
        'rwkv_w0': jax.random.uniform(ks[13], (L, A_WIDTH), jnp.float32, -6.0, -1.0),
        'rwkv_w2': _nrm(ks[14], (L, DECAY_LORA, A_WIDTH), 0.5 * DECAY_LORA ** -0.5),
        'rwkv_a0': _nrm(ks[15], (L, A_WIDTH), 0.1),
        'rwkv_a2': _nrm(ks[16], (L, AAA_LORA, A_WIDTH), AAA_LORA ** -0.5),
        'rwkv_g2': _nrm(ks[17], (L, GATE_LORA, A_WIDTH), GATE_LORA ** -0.5),
        'rwkv_k_k': 0.85 + _nrm(ks[18], (L, A_WIDTH), 0.05),
        'rwkv_k_a': 1.0 + _nrm(ks[19], (L, A_WIDTH), 0.05),
        'rwkv_r_k': _nrm(ks[20], (L, A_HEADS, A_HEAD_DIM), 0.1),
        'rwkv_ln_w': 1.0 + _nrm(ks[21], (L, A_WIDTH), 0.05),
        'rwkv_ln_b': _nrm(ks[22], (L, A_WIDTH), 0.05),
        'diff_lq1': _nrm(ks[23], (L, B_HEAD_DIM), 0.1),
        'diff_lk1': _nrm(ks[24], (L, B_HEAD_DIM), 0.1),
        'diff_lq2': _nrm(ks[25], (L, B_HEAD_DIM), 0.1),
        'diff_lk2': _nrm(ks[26], (L, B_HEAD_DIM), 0.1),
        'diff_subln': 1.0 + _nrm(ks[27], (L, B_VDIM), 0.05),
        'w_out_a': _nrm(ks[28], (L, A_WIDTH, D_MODEL), A_WIDTH ** -0.5),
        'w_out_b': _nrm(ks[29], (L, B_V_WIDTH, D_MODEL), B_V_WIDTH ** -0.5),
        'w_o': _nrm(ks[30], (L, D_MODEL, D_MODEL), D_MODEL ** -0.5),
        'w_ffn_in': _nrm(ks[31], (L, D_MODEL, 2 * D_FF), D_MODEL ** -0.5),
        'w_ffn_out': _nrm(ks[32], (L, D_FF, D_MODEL), D_FF ** -0.5),
    }


def reference(x_prompt, x_sample, cache_k, cache_v, state_wkv, state_shift,
              norm_mix_pre, norm_mix_post, norm_ffn_pre, norm_ffn_post, w_in, b_gate,
              rwkv_mu, rwkv_w0, rwkv_w2, rwkv_a0, rwkv_a2, rwkv_g2, rwkv_k_k, rwkv_k_a,
              rwkv_r_k, rwkv_ln_w, rwkv_ln_b, diff_lq1, diff_lk1, diff_lq2, diff_lk2,
              diff_subln, w_out_a, w_out_b, w_o, w_ffn_in, w_ffn_out):
    yp, ys = x_prompt, x_sample
    bsz_p = x_prompt.shape[0]
    kp_l, vp_l, sp_l, hp_l = [], [], [], []
    ks_l, vs_l, ss_l, hs_l = [], [], [], []
    for l in range(DEPTH):
        lam_init = 0.8 - 0.6 * math.exp(-0.3 * l)
        p = dict(norm_mix_pre=norm_mix_pre[l], norm_mix_post=norm_mix_post[l],
                 norm_ffn_pre=norm_ffn_pre[l], norm_ffn_post=norm_ffn_post[l],
                 w_in=w_in[l], b_gate=b_gate[l], rwkv_mu=rwkv_mu[l], rwkv_w0=rwkv_w0[l],
                 rwkv_w2=rwkv_w2[l], rwkv_a0=rwkv_a0[l], rwkv_a2=rwkv_a2[l], rwkv_g2=rwkv_g2[l],
                 rwkv_k_k=rwkv_k_k[l], rwkv_k_a=rwkv_k_a[l], rwkv_r_k=rwkv_r_k[l],
                 rwkv_ln_w=rwkv_ln_w[l], rwkv_ln_b=rwkv_ln_b[l], lq1=diff_lq1[l], lk1=diff_lk1[l],
                 lq2=diff_lq2[l], lk2=diff_lk2[l], subln=diff_subln[l], w_out_a=w_out_a[l],
                 w_out_b=w_out_b[l], w_o=w_o[l], w_ffn_in=w_ffn_in[l], w_ffn_out=w_ffn_out[l])
        shift0 = jnp.zeros((bsz_p, 1, A_COLS), x_prompt.dtype)
        s0 = jnp.zeros((bsz_p, A_HEADS, A_HEAD_DIM, A_HEAD_DIM), x_prompt.dtype)
        yp, kp, vp, sp, hp = _layer(yp, shift0, s0, None, None, p, lam_init)
        ys, kn, vn, sn, hn = _layer(ys, state_shift[l], state_wkv[l], cache_k[l], cache_v[l], p, lam_init)
        kp_l.append(kp); vp_l.append(vp); sp_l.append(sp); hp_l.append(hp)
        ks_l.append(kn); vs_l.append(vn); ss_l.append(sn); hs_l.append(hn)
    return (yp, ys, jnp.stack(kp_l), jnp.stack(vp_l), jnp.stack(sp_l), jnp.stack(hp_l),
            jnp.stack(ks_l), jnp.stack(vs_l), jnp.stack(ss_l), jnp.stack(hs_l))
```

```cpp
#include <hip/hip_runtime.h>
#include <hip/hip_cooperative_groups.h>
#include <cstdio>
#include <cstdint>
namespace cg = cooperative_groups;

typedef unsigned short u16;
typedef __attribute__((ext_vector_type(8))) short bf16x8;
typedef __attribute__((ext_vector_type(4))) float f32x4;

constexpr int TP = 65536, TS = 1024, T = TP + TS;
constexpr int ACOLS = 1824;
constexpr int LKS = 1088;
constexpr int LDS_BYTES = 73728;
constexpr float EPS = 1e-6f;

constexpr size_t OFF_YS = 67108864ull, OFF_KP = 68157440ull, OFF_VP = 101711872ull, OFF_WP = 135266304ull,
                 OFF_SHP = 135790592ull, OFF_KS = 135819776ull, OFF_VS = 136344064ull, OFF_WS = 136868352ull,
                 OFF_SHS = 137916928ull;

constexpr size_t al(size_t x) { return (x + 255) & ~(size_t)255; }
constexpr size_t O_WIN = 0;
constexpr size_t O_WOA = O_WIN + al(5504ull * 1024 * 2);
constexpr size_t O_WOB = O_WOA + al(1024ull * 512 * 2);
constexpr size_t O_WO = O_WOB + al(1024ull * 512 * 2);
constexpr size_t O_WFI = O_WO + al(1024ull * 1024 * 2);
constexpr size_t O_WFO = O_WFI + al(5632ull * 1024 * 2);
constexpr size_t O_W2 = O_WFO + al(1024ull * 2816 * 2);
constexpr size_t O_A2 = O_W2 + al(512 * 64 * 2);
constexpr size_t O_G2 = O_A2 + al(512 * 64 * 2);
constexpr size_t O_RS1 = O_G2 + al(512 * 160 * 2);
constexpr size_t O_SS2 = O_RS1 + al((size_t)T * 4);
constexpr size_t O_SS4 = O_SS2 + al((size_t)T * 16 * 4);
constexpr size_t O_RS3 = O_SS4 + al((size_t)T * 16 * 4);
constexpr size_t O_RK = O_RS3 + al((size_t)T * 4);
constexpr size_t O_SCAL = O_RK + al((size_t)T * 8 * 4);
constexpr size_t O_REGA = O_SCAL + 256;
constexpr size_t O_CA = O_REGA;
constexpr size_t O_YA = O_REGA;
constexpr size_t O_OB = O_YA + al((size_t)T * 512 * 2);
constexpr size_t O_HB = O_REGA;
constexpr size_t O_REGB = O_REGA + al((size_t)(T + 48) * 1824 * 2);
constexpr size_t O_QB = O_REGB;
constexpr size_t O_KP = O_QB + al((size_t)T * 512 * 2);
constexpr size_t O_KS = O_KP + al((size_t)TP * 512 * 2);
constexpr size_t O_VTP = O_KS + al(32ull * LKS * 512 * 2);
constexpr size_t O_VTS = O_VTP + al(16ull * 512 * 4096 * 2);
constexpr size_t O_REGC = O_VTS + al(32ull * 512 * LKS * 2);
constexpr size_t O_GATE = O_REGB;
static_assert(O_GATE + (size_t)T * 2048 * 2 <= O_REGC, "gate overlaps region C");
constexpr size_t O_SI = O_REGC;
constexpr size_t O_G = O_SI + al((size_t)T * 8 * 384 * 2);
constexpr size_t O_XB = O_REGC;
constexpr size_t O_MIX = O_REGC;
constexpr size_t O_M2 = O_MIX + al((size_t)T * 1024 * 2);
constexpr size_t O_X1B = O_M2 + al((size_t)T * 1024 * 2);
constexpr size_t O_FB = O_REGC;
constexpr size_t WS_END = O_G + al((size_t)T * 512 * 2);
static_assert(O_HB + (size_t)T * 2816 * 2 <= O_REGC, "hb overlaps region C");
static_assert(O_X1B + (size_t)T * 1024 * 2 <= WS_END, "x1b beyond end");
static_assert(WS_END <= 1073741824ull, "workspace too large");

struct Params {
    const float *x_prompt, *x_sample, *cache_k, *cache_v, *state_wkv, *state_shift;
    const float *n_mix_pre, *n_mix_post, *n_ffn_pre, *n_ffn_post, *w_in, *b_gate;
    const float *mu, *w0, *w2, *a0, *a2, *g2, *k_k, *k_a, *r_k, *ln_w, *ln_b;
    const float *lq1, *lk1, *lq2, *lk2, *subln, *w_out_a, *w_out_b, *w_o, *w_ffn_in, *w_ffn_out;
    float* out;
    unsigned char* ws;
    int ph_lo, ph_hi;
};

__device__ __forceinline__ u16 f2bf(float f) {
    unsigned u = __float_as_uint(f);
    u += 0x7fffu + ((u >> 16) & 1u);
    return (u16)(u >> 16);
}
__device__ __forceinline__ unsigned pk2(float a, float b) { return (unsigned)f2bf(a) | ((unsigned)f2bf(b) << 16); }
__device__ __forceinline__ float bflo(unsigned u) { return __uint_as_float(u << 16); }
__device__ __forceinline__ float bfhi(unsigned u) { return __uint_as_float(u & 0xffff0000u); }
__device__ __forceinline__ uint2 pk4(float a, float b, float c, float d) { return make_uint2(pk2(a, b), pk2(c, d)); }
__device__ __forceinline__ float sigmoidf_(float x) { return 1.f / (1.f + __expf(-x)); }

template <int CTRL>
__device__ __forceinline__ float dppf(float x) {
    return __int_as_float(__builtin_amdgcn_update_dpp(0, __float_as_int(x), CTRL, 0xF, 0xF, true));
}
__device__ __forceinline__ float red8(float x) {
    x += dppf<0xB1>(x);
    x += dppf<0x4E>(x);
    x += dppf<0x141>(x);
    return x;
}
__device__ __forceinline__ float red16(float x) {
    x = red8(x);
    x += dppf<0x140>(x);
    return x;
}
__device__ __forceinline__ float red_g(float x) {
    x += __shfl_xor(x, 16);
    x += __shfl_xor(x, 32);
    return x;
}
__device__ __forceinline__ float wave_sum(float x) {
    x = red16(x);
    return red_g(x);
}
__device__ __forceinline__ bf16x8 as_frag(uint4 v) {
    union { uint4 u; bf16x8 f; } c;
    c.u = v;
    return c.f;
}
#define MFMA(a, b, c) __builtin_amdgcn_mfma_f32_16x16x32_bf16((a), (b), (c), 0, 0, 0)

constexpr int LDT = 72;
constexpr int STG = 128 * LDT;
__device__ __forceinline__ void gemm_loop(const u16* __restrict__ A, int lda, const u16* __restrict__ B, int ldb,
                                          int nkt, u16* smem, f32x4 (&acc)[4][4]) {
    const int tid = threadIdx.x, lane = tid & 63, wid = tid >> 6, wm = wid >> 1, wn = wid & 1, l16 = lane & 15, g = lane >> 4;
    const int lr = tid >> 3, lc = (tid & 7) * 8;
    u16* sA = smem;
    u16* sB = smem + 2 * STG;
    const u16* ap = A + (size_t)lr * lda + lc;
    const u16* bp = B + (size_t)lr * ldb + lc;
    uint4 ra0, ra1, ra2, ra3, rb0, rb1, rb2, rb3;
#define G_LOAD(ko)                                                   \
    ra0 = *(const uint4*)(ap + (ko));                                \
    ra1 = *(const uint4*)(ap + (size_t)32 * lda + (ko));             \
    ra2 = *(const uint4*)(ap + (size_t)64 * lda + (ko));             \
    ra3 = *(const uint4*)(ap + (size_t)96 * lda + (ko));             \
    rb0 = *(const uint4*)(bp + (ko));                                \
    rb1 = *(const uint4*)(bp + (size_t)32 * ldb + (ko));             \
    rb2 = *(const uint4*)(bp + (size_t)64 * ldb + (ko));             \
    rb3 = *(const uint4*)(bp + (size_t)96 * ldb + (ko));
#define G_STORE(bo)                                                  \
    *(uint4*)(sA + (bo) + (lr + 0) * LDT + lc) = ra0;                \
    *(uint4*)(sA + (bo) + (lr + 32) * LDT + lc) = ra1;               \
    *(uint4*)(sA + (bo) + (lr + 64) * LDT + lc) = ra2;               \
    *(uint4*)(sA + (bo) + (lr + 96) * LDT + lc) = ra3;               \
    *(uint4*)(sB + (bo) + (lr + 0) * LDT + lc) = rb0;                \
    *(uint4*)(sB + (bo) + (lr + 32) * LDT + lc) = rb1;               \
    *(uint4*)(sB + (bo) + (lr + 64) * LDT + lc) = rb2;               \
    *(uint4*)(sB + (bo) + (lr + 96) * LDT + lc) = rb3;
    G_LOAD(0)
    G_STORE(0)
    __syncthreads();
    for (int kt = 0; kt < nkt; ++kt) {
        const int buf = kt & 1;
        if (kt + 1 < nkt) { G_LOAD((kt + 1) * 64) }
        const u16* cA = sA + buf * STG + (wm * 64 + l16) * LDT + g * 8;
        const u16* cB = sB + buf * STG + (wn * 64 + l16) * LDT + g * 8;
#pragma unroll
        for (int ks = 0; ks < 2; ++ks) {
            bf16x8 xf[4], wf[4];
#pragma unroll
            for (int i = 0; i < 4; ++i) {
                xf[i] = *(const bf16x8*)(cA + i * 16 * LDT + ks * 32);
                wf[i] = *(const bf16x8*)(cB + i * 16 * LDT + ks * 32);
            }
#pragma unroll
            for (int nt = 0; nt < 4; ++nt)
#pragma unroll
                for (int mt = 0; mt < 4; ++mt) acc[nt][mt] = MFMA(wf[nt], xf[mt], acc[nt][mt]);
        }
        if (kt + 1 < nkt) { G_STORE((buf ^ 1) * STG) }
        __syncthreads();
    }
}
__device__ __forceinline__ void gemm_loop_xf32(const float* __restrict__ A, const u16* __restrict__ B, int ldb, int nkt, u16* smem,
                                               f32x4 (&acc)[4][4]) {
    const int tid = threadIdx.x, lane = tid & 63, wid = tid >> 6, wm = wid >> 1, wn = wid & 1, l16 = lane & 15, g = lane >> 4;
    const int lr = tid >> 3, lc = (tid & 7) * 8;
    u16* sA = smem;
    u16* sB = smem + 2 * STG;
    const float* ap = A + (size_t)lr * 1024 + lc;
    const u16* bp = B + (size_t)lr * ldb + lc;
    float4 fa0, fa1, fa2, fa3, fa4, fa5, fa6, fa7;
    uint4 rb0, rb1, rb2, rb3;
#define GX_LOAD(ko)                                                  \
    fa0 = *(const float4*)(ap + (ko));                               \
    fa1 = *(const float4*)(ap + (ko) + 4);                           \
    fa2 = *(const float4*)(ap + 32 * 1024 + (ko));                   \
    fa3 = *(const float4*)(ap + 32 * 1024 + (ko) + 4);               \
    fa4 = *(const float4*)(ap + 64 * 1024 + (ko));                   \
    fa5 = *(const float4*)(ap + 64 * 1024 + (ko) + 4);               \
    fa6 = *(const float4*)(ap + 96 * 1024 + (ko));                   \
    fa7 = *(const float4*)(ap + 96 * 1024 + (ko) + 4);               \
    rb0 = *(const uint4*)(bp + (ko));                                \
    rb1 = *(const uint4*)(bp + (size_t)32 * ldb + (ko));             \
    rb2 = *(const uint4*)(bp + (size_t)64 * ldb + (ko));             \
    rb3 = *(const uint4*)(bp + (size_t)96 * ldb + (ko));
#define PKF(a, b) make_uint4(pk2(a.x, a.y), pk2(a.z, a.w), pk2(b.x, b.y), pk2(b.z, b.w))
#define GX_STORE(bo)                                                 \
    *(uint4*)(sA + (bo) + (lr + 0) * LDT + lc) = PKF(fa0, fa1);      \
    *(uint4*)(sA + (bo) + (lr + 32) * LDT + lc) = PKF(fa2, fa3);     \
    *(uint4*)(sA + (bo) + (lr + 64) * LDT + lc) = PKF(fa4, fa5);     \
    *(uint4*)(sA + (bo) + (lr + 96) * LDT + lc) = PKF(fa6, fa7);     \
    *(uint4*)(sB + (bo) + (lr + 0) * LDT + lc) = rb0;                \
    *(uint4*)(sB + (bo) + (lr + 32) * LDT + lc) = rb1;               \
    *(uint4*)(sB + (bo) + (lr + 64) * LDT + lc) = rb2;               \
    *(uint4*)(sB + (bo) + (lr + 96) * LDT + lc) = rb3;
    GX_LOAD(0)
    GX_STORE(0)
    __syncthreads();
    for (int kt = 0; kt < nkt; ++kt) {
        const int buf = kt & 1;
        if (kt + 1 < nkt) { GX_LOAD((kt + 1) * 64) }
        const u16* cA = sA + buf * STG + (wm * 64 + l16) * LDT + g * 8;
        const u16* cB = sB + buf * STG + (wn * 64 + l16) * LDT + g * 8;
#pragma unroll
        for (int ks = 0; ks < 2; ++ks) {
            bf16x8 xf[4], wf[4];
#pragma unroll
            for (int i = 0; i < 4; ++i) {
                xf[i] = *(const bf16x8*)(cA + i * 16 * LDT + ks * 32);
                wf[i] = *(const bf16x8*)(cB + i * 16 * LDT + ks * 32);
            }
#pragma unroll
            for (int nt = 0; nt < 4; ++nt)
#pragma unroll
                for (int mt = 0; mt < 4; ++mt) acc[nt][mt] = MFMA(wf[nt], xf[mt], acc[nt][mt]);
        }
        if (kt + 1 < nkt) { GX_STORE((buf ^ 1) * STG) }
        __syncthreads();
    }
}
__device__ __forceinline__ void zero_acc(f32x4 (&acc)[4][4]) {
#pragma unroll
    for (int i = 0; i < 4; ++i)
#pragma unroll
        for (int j = 0; j < 4; ++j) acc[i][j] = (f32x4){0.f, 0.f, 0.f, 0.f};
}
__device__ __forceinline__ void tile_map(int t, int NT, int& mt, int& nt) {
    const int grp = t / (8 * NT), r = t - grp * 8 * NT;
    mt = grp * 8 + (r & 7);
    nt = r >> 3;
}

__device__ __forceinline__ void tr_tile(const float* __restrict__ in, int R, int C, int ldin, u16* __restrict__ out, int ldout,
                        const float* __restrict__ scale, int r0, int c0, int Cout, bool perm, float* tile) {
    const int tid = threadIdx.x;
    {
        const int tx = tid & 63, ty = tid >> 6;
        const int c = c0 + tx;
        for (int rr = ty; rr < 64; rr += 4) {
            const int r = r0 + rr;
            float v = 0.f;
            if (r < R && c < C) {
                v = in[(size_t)r * ldin + c];
                if (scale) v *= scale[r];
            }
            tile[rr * 65 + tx] = v;
        }
    }
    __syncthreads();
    {
        const int rch = (tid & 7) * 8;
#pragma unroll
        for (int pass = 0; pass < 2; ++pass) {
            const int cc = (tid >> 3) + pass * 32;
            const int c = c0 + cc;
            if (c < Cout && r0 + rch < R) {
                float v[8];
#pragma unroll
                for (int k = 0; k < 8; ++k) v[k] = tile[(rch + k) * 65 + cc];
                int orow = c;
                if (perm) {
                    const int type = c >= 2816 ? 1 : 0;
                    const int j = c - type * 2816;
                    orow = (j >> 4) * 32 + type * 16 + (j & 15);
                }
                uint4 o = make_uint4(pk2(v[0], v[1]), pk2(v[2], v[3]), pk2(v[4], v[5]), pk2(v[6], v[7]));
                *(uint4*)(out + (size_t)orow * ldout + r0 + rch) = o;
            }
        }
    }
    __syncthreads();
}

__device__ __forceinline__ void phase0(const Params& p, unsigned char* smem) {
    float* tile = (float*)smem;
    const int tid = threadIdx.x, lane = tid & 63, wid = tid >> 6;
    unsigned char* ws = p.ws;
    const int G = gridDim.x;
    for (int u = blockIdx.x; u < 8136; u += G) {
        const float* in;
        int R, C, Cout, ldout, tl;
        u16* out;
        const float* scale = nullptr;
        bool perm = false;
        if (u < 1376) { tl = u; in = p.w_in; R = 1024; C = 5408; Cout = 5504; out = (u16*)(ws + O_WIN); ldout = 1024; scale = p.n_mix_pre; }
        else if (u < 1504) { tl = u - 1376; in = p.w_out_a; R = 512; C = 1024; Cout = 1024; out = (u16*)(ws + O_WOA); ldout = 512; }
        else if (u < 1632) { tl = u - 1504; in = p.w_out_b; R = 512; C = 1024; Cout = 1024; out = (u16*)(ws + O_WOB); ldout = 512; }
        else if (u < 1888) { tl = u - 1632; in = p.w_o; R = 1024; C = 1024; Cout = 1024; out = (u16*)(ws + O_WO); ldout = 1024; }
        else if (u < 3296) { tl = u - 1888; in = p.w_ffn_in; R = 1024; C = 5632; Cout = 5632; out = (u16*)(ws + O_WFI); ldout = 1024; scale = p.n_ffn_pre; perm = true; }
        else if (u < 4000) { tl = u - 3296; in = p.w_ffn_out; R = 2816; C = 1024; Cout = 1024; out = (u16*)(ws + O_WFO); ldout = 2816; }
        else if (u < 4008) { tl = u - 4000; in = p.w2; R = 64; C = 512; Cout = 512; out = (u16*)(ws + O_W2); ldout = 64; }
        else if (u < 4016) { tl = u - 4008; in = p.a2; R = 64; C = 512; Cout = 512; out = (u16*)(ws + O_A2); ldout = 64; }
        else if (u < 4040) { tl = u - 4016; in = p.g2; R = 160; C = 512; Cout = 512; out = (u16*)(ws + O_G2); ldout = 160; }
        else {
            tl = u - 4040;
            const int b = tl >> 7;
            tl &= 127;
            in = p.cache_v + (size_t)b * 1024 * 512; R = 1024; C = 512; Cout = 512;
            out = (u16*)(ws + O_VTS) + (size_t)b * 512 * LKS; ldout = LKS;
        }
        const int ctiles = (Cout + 63) >> 6;
        const int rt = tl / ctiles, ct = tl - rt * ctiles;
        tr_tile(in, R, C, C, out, ldout, scale, rt * 64, ct * 64, Cout, perm, tile);
    }
    {
        u16* xb = (u16*)(ws + O_XB);
        float* rs1 = (float*)(ws + O_RS1);
        for (int m = blockIdx.x * 4 + wid; m < T; m += G * 4) {
            const float* xr = (m < TP) ? p.x_prompt + (size_t)m * 1024 : p.x_sample + (size_t)(m - TP) * 1024;
            float ss = 0.f;
#pragma unroll
            for (int i = 0; i < 4; ++i) {
                const float4 v = *(const float4*)(xr + i * 256 + lane * 4);
                ss += v.x * v.x + v.y * v.y + v.z * v.z + v.w * v.w;
                *(uint2*)(xb + (size_t)m * 1024 + i * 256 + lane * 4) = pk4(v.x, v.y, v.z, v.w);
            }
            ss = wave_sum(ss);
            if (lane == 0) rs1[m] = rsqrtf(ss * (1.f / 1024.f) + EPS);
        }
    }
    {
        u16* kS = (u16*)(ws + O_KS);
        const int n8 = 32 * 1024 * 64;
        for (int i = blockIdx.x * 256 + tid; i < n8; i += G * 256) {
            const int b = i >> 16, rem = i & 65535, key = rem >> 6, c8 = rem & 63;
            const float4 v0 = *(const float4*)(p.cache_k + (size_t)i * 8);
            const float4 v1 = *(const float4*)(p.cache_k + (size_t)i * 8 + 4);
            *(uint4*)(kS + ((size_t)b * LKS + key) * 512 + c8 * 8) =
                make_uint4(pk2(v0.x, v0.y), pk2(v0.z, v0.w), pk2(v1.x, v1.y), pk2(v1.z, v1.w));
        }
        for (int i = blockIdx.x * 256 + tid; i < 32 * 32 * 64; i += G * 256) {
            const int b = i >> 11, rem = i & 2047, row = rem >> 6, c8 = rem & 63;
            *(uint4*)(kS + ((size_t)b * LKS + 1056 + row) * 512 + c8 * 8) = make_uint4(0, 0, 0, 0);
        }
        u16* vtS = (u16*)(ws + O_VTS);
        for (int i = blockIdx.x * 256 + tid; i < 32 * 512 * 4; i += G * 256) {
            const int row = i >> 2, c8 = i & 3;
            *(uint4*)(vtS + (size_t)row * LKS + 1056 + c8 * 8) = make_uint4(0, 0, 0, 0);
        }
    }
    {
        u16* cA = (u16*)(ws + O_CA);
        for (int i = blockIdx.x * 256 + tid; i < 48 * ACOLS; i += G * 256) {
            const int s = i / ACOLS, c = i - s * ACOLS;
            float v = 0.f;
            size_t row;
            if (s < 16) row = (size_t)s * 4097;
            else { row = (size_t)16 * 4097 + (size_t)(s - 16) * 33; v = p.state_shift[(size_t)(s - 16) * ACOLS + c]; }
            cA[row * ACOLS + c] = f2bf(v);
        }
        if (blockIdx.x == 0 && tid == 0) {
            float d1 = 0.f, d2 = 0.f;
            for (int i = 0; i < 64; ++i) { d1 += p.lq1[i] * p.lk1[i]; d2 += p.lq2[i] * p.lk2[i]; }
            float* sc = (float*)(ws + O_SCAL);
            sc[0] = __expf(d1) - __expf(d2) + 0.2f;
            ((unsigned*)sc)[1] = 0u;
        }
    }
}

__device__ __forceinline__ void phase1(const Params& p, unsigned char* smem) {
    unsigned char* ws = p.ws;
    const u16* xb = (const u16*)(ws + O_XB);
    const u16* W = (const u16*)(ws + O_WIN);
    const float* rs1 = (const float*)(ws + O_RS1);
    u16* cA = (u16*)(ws + O_CA);
    u16* qb = (u16*)(ws + O_QB);
    u16* kP = (u16*)(ws + O_KP);
    u16* kS = (u16*)(ws + O_KS);
    u16* vtP = (u16*)(ws + O_VTP);
    u16* vtS = (u16*)(ws + O_VTS);
    float* out = p.out;
    const int tid = threadIdx.x, lane = tid & 63, wid = tid >> 6, wm = wid >> 1, wn = wid & 1, l16 = lane & 15, g = lane >> 4;
    constexpr int NT = 27;
    for (int t = blockIdx.x; t < 520 * NT; t += gridDim.x) {
        int mtile, ntile;
        tile_map(t, NT, mtile, ntile);
        const int m0 = mtile * 128, n0 = ntile * 128;
        f32x4 acc[4][4];
        zero_acc(acc);
        gemm_loop(xb + (size_t)m0 * 1024, 1024, W + (size_t)n0 * 1024, 1024, 16, (u16*)smem, acc);
#pragma unroll
        for (int mt = 0; mt < 4; ++mt) {
            const int m = m0 + wm * 64 + mt * 16 + l16;
            const float rs = rs1[m];
            const bool isP = m < TP;
            int seq, tt;
            if (isP) { seq = m >> 12; tt = m & 4095; }
            else { const int ms = m - TP; seq = 16 + (ms >> 5); tt = ms & 31; }
            const size_t carow = (size_t)m + seq + 1;
            const bool last = isP ? (tt == 4095) : (tt == 31);
#pragma unroll
            for (int nt = 0; nt < 4; ++nt) {
                const int n = n0 + wn * 64 + nt * 16 + g * 4;
                if (n >= 3360) continue;
                f32x4 v = acc[nt][mt];
                v[0] *= rs; v[1] *= rs; v[2] *= rs; v[3] *= rs;
                if (n < 1824) {
                    *(uint2*)(cA + carow * ACOLS + n) = pk4(v[0], v[1], v[2], v[3]);
                    if (last) {
                        float* so = isP ? out + OFF_SHP + (size_t)seq * ACOLS + n : out + OFF_SHS + (size_t)(seq - 16) * ACOLS + n;
                        *(float4*)so = make_float4(v[0], v[1], v[2], v[3]);
                    }
                } else if (n < 2336) {
                    *(uint2*)(qb + (size_t)m * 512 + (n - 1824)) = pk4(v[0], v[1], v[2], v[3]);
                } else if (n < 2848) {
                    const int c = n - 2336;
                    if (isP) {
                        *(uint2*)(kP + (size_t)m * 512 + c) = pk4(v[0], v[1], v[2], v[3]);
                        *(float4*)(out + OFF_KP + (size_t)m * 512 + c) = make_float4(v[0], v[1], v[2], v[3]);
                    } else {
                        *(uint2*)(kS + ((size_t)(seq - 16) * LKS + 1024 + tt) * 512 + c) = pk4(v[0], v[1], v[2], v[3]);
                        *(float4*)(out + OFF_KS + (size_t)(m - TP) * 512 + c) = make_float4(v[0], v[1], v[2], v[3]);
                    }
                } else {
                    const int c = n - 2848;
                    if (isP) {
                        *(float4*)(out + OFF_VP + (size_t)m * 512 + c) = make_float4(v[0], v[1], v[2], v[3]);
                        u16* d = vtP + ((size_t)seq * 512 + c) * 4096 + tt;
                        d[0] = f2bf(v[0]); d[4096] = f2bf(v[1]); d[2 * 4096] = f2bf(v[2]); d[3 * 4096] = f2bf(v[3]);
                    } else {
                        *(float4*)(out + OFF_VS + (size_t)(m - TP) * 512 + c) = make_float4(v[0], v[1], v[2], v[3]);
                        u16* d = vtS + ((size_t)(seq - 16) * 512 + c) * LKS + 1024 + tt;
                        d[0] = f2bf(v[0]); d[LKS] = f2bf(v[1]); d[2 * LKS] = f2bf(v[2]); d[3 * LKS] = f2bf(v[3]);
                    }
                }
            }
        }
    }
}

__device__ __forceinline__ void lerp8(const u16* cur, const u16* prv, const float* mu, int col, float (&xs)[8]) {
    const uint4 cu = *(const uint4*)(cur + col);
    const uint4 pv = *(const uint4*)(prv + col);
    const float4 m0 = *(const float4*)(mu + col);
    const float4 m1 = *(const float4*)(mu + col + 4);
    const unsigned cw[4] = {cu.x, cu.y, cu.z, cu.w}, pw[4] = {pv.x, pv.y, pv.z, pv.w};
    const float mm[8] = {m0.x, m0.y, m0.z, m0.w, m1.x, m1.y, m1.z, m1.w};
#pragma unroll
    for (int i = 0; i < 4; ++i) {
        const float c0 = bflo(cw[i]), c1 = bfhi(cw[i]), p0 = bflo(pw[i]), p1 = bfhi(pw[i]);
        xs[2 * i] = c0 + (p0 - c0) * mm[2 * i];
        xs[2 * i + 1] = c1 + (p1 - c1) * mm[2 * i + 1];
    }
}
__device__ __forceinline__ void lerp4(const u16* cur, const u16* prv, const float* mu, int col, float (&xs)[4]) {
    const uint2 cu = *(const uint2*)(cur + col);
    const uint2 pv = *(const uint2*)(prv + col);
    const float4 m0 = *(const float4*)(mu + col);
    float c0 = bflo(cu.x), c1 = bfhi(cu.x), c2 = bflo(cu.y), c3 = bfhi(cu.y);
    xs[0] = c0 + (bflo(pv.x) - c0) * m0.x;
    xs[1] = c1 + (bfhi(pv.x) - c1) * m0.y;
    xs[2] = c2 + (bflo(pv.y) - c2) * m0.z;
    xs[3] = c3 + (bfhi(pv.y) - c3) * m0.w;
}
__device__ __forceinline__ bf16x8 packfrag(const float (&v)[8]) {
    return as_frag(make_uint4(pk2(v[0], v[1]), pk2(v[2], v[3]), pk2(v[4], v[5]), pk2(v[6], v[7])));
}

__device__ __forceinline__ void phase2(const Params& p) {
    unsigned char* ws = p.ws;
    const u16* cA = (const u16*)(ws + O_CA);
    const u16* w2t = (const u16*)(ws + O_W2);
    const u16* a2t = (const u16*)(ws + O_A2);
    const u16* g2t = (const u16*)(ws + O_G2);
    u16* SI = (u16*)(ws + O_SI);
    u16* Gb = (u16*)(ws + O_G);
    float* rk = (float*)(ws + O_RK);
    const int tid = threadIdx.x, lane = tid & 63, wid = tid >> 6, l16 = lane & 15, g = lane >> 4;
    for (int u = blockIdx.x; u < T / 64; u += gridDim.x) {
        const int mw = u * 64 + wid * 16;
        const int m = mw + l16;
        const bool isP = mw < TP;
        int seq, tt;
        if (isP) { seq = m >> 12; tt = m & 4095; }
        else { const int ms = m - TP; seq = 16 + (ms >> 5); tt = ms & 31; }
        const u16* cur = cA + ((size_t)m + seq + 1) * ACOLS;
        const u16* prv = cur - ACOLS;
        bf16x8 xw[2], xa[2], xg[5];
#pragma unroll
        for (int s = 0; s < 9; ++s) {
            float xs[8];
            lerp8(cur, prv, p.mu, 1536 + s * 32 + g * 8, xs);
            if (s < 2) {
#pragma unroll
                for (int i = 0; i < 8; ++i) xs[i] = 1.f - 2.f / (__expf(2.f * xs[i]) + 1.f);
                xw[s] = packfrag(xs);
            } else if (s < 4) {
                xa[s - 2] = packfrag(xs);
            } else {
#pragma unroll
                for (int i = 0; i < 8; ++i) xs[i] = sigmoidf_(xs[i]);
                xg[s - 4] = packfrag(xs);
            }
        }
        for (int h = 0; h < 8; ++h) {
            float kkr[16], av[16];
            float ssq = 0.f, rkacc = 0.f;
            const size_t sirow = isP ? ((size_t)(seq * 8 + h) * 4096 + tt) : ((size_t)128 * 4096 + (size_t)((seq - 16) * 8 + h) * 32 + tt);
            u16* sib = SI + sirow * 384;
#pragma unroll
            for (int nt = 0; nt < 4; ++nt) {
                const int wrow = h * 64 + nt * 16 + l16;
                f32x4 accw = {0.f, 0.f, 0.f, 0.f}, acca = accw, accg = accw;
#pragma unroll
                for (int s = 0; s < 2; ++s) {
                    accw = MFMA(*(const bf16x8*)(w2t + wrow * 64 + s * 32 + g * 8), xw[s], accw);
                    acca = MFMA(*(const bf16x8*)(a2t + wrow * 64 + s * 32 + g * 8), xa[s], acca);
                }
#pragma unroll
                for (int s = 0; s < 5; ++s) accg = MFMA(*(const bf16x8*)(g2t + wrow * 160 + s * 32 + g * 8), xg[s], accg);
                const int ch = h * 64 + nt * 16 + g * 4;
                float xr[4], xk[4], xv[4];
                lerp4(cur, prv, p.mu, ch, xr);
                lerp4(cur, prv, p.mu, 512 + ch, xk);
                lerp4(cur, prv, p.mu, 1024 + ch, xv);
                const float4 w0 = *(const float4*)(p.w0 + ch), a0 = *(const float4*)(p.a0 + ch), kk4 = *(const float4*)(p.k_k + ch),
                             ka4 = *(const float4*)(p.k_a + ch), rk4 = *(const float4*)(p.r_k + ch);
                const float w0a[4] = {w0.x, w0.y, w0.z, w0.w}, a0a[4] = {a0.x, a0.y, a0.z, a0.w}, kka[4] = {kk4.x, kk4.y, kk4.z, kk4.w},
                            kaa[4] = {ka4.x, ka4.y, ka4.z, ka4.w}, rka[4] = {rk4.x, rk4.y, rk4.z, rk4.w};
                float ev[4], kp[4];
#pragma unroll
                for (int r = 0; r < 4; ++r) {
                    const float z = -(w0a[r] + accw[r]);
                    const float sp = (z > 20.f) ? z : __logf(1.f + __expf(z));
                    ev[r] = __expf(-sp - 0.5f);
                    const float a = sigmoidf_(a0a[r] + acca[r]);
                    const float kraw = xk[r] * kka[r];
                    ssq += kraw * kraw;
                    kp[r] = xk[r] * (1.f + (a - 1.f) * kaa[r]);
                    rkacc += xr[r] * kp[r] * rka[r];
                    kkr[nt * 4 + r] = kraw;
                    av[nt * 4 + r] = a;
                }
                const int co = nt * 16 + g * 4;
                *(uint2*)(sib + 0 * 64 + co) = pk4(xr[0], xr[1], xr[2], xr[3]);
                *(uint2*)(sib + 1 * 64 + co) = pk4(ev[0], ev[1], ev[2], ev[3]);
                *(uint2*)(sib + 2 * 64 + co) = pk4(kp[0], kp[1], kp[2], kp[3]);
                *(uint2*)(sib + 3 * 64 + co) = pk4(xv[0], xv[1], xv[2], xv[3]);
                *(uint2*)(Gb + (size_t)m * 512 + ch) = pk4(accg[0], accg[1], accg[2], accg[3]);
            }
            ssq = red_g(ssq);
            rkacc = red_g(rkacc);
            const float inv = rsqrtf(fmaxf(ssq, 1e-24f));
#pragma unroll
            for (int nt = 0; nt < 4; ++nt) {
                const int co = nt * 16 + g * 4;
                float k0 = kkr[nt * 4 + 0] * inv, k1 = kkr[nt * 4 + 1] * inv, k2 = kkr[nt * 4 + 2] * inv, k3 = kkr[nt * 4 + 3] * inv;
                *(uint2*)(sib + 4 * 64 + co) = pk4(k0, k1, k2, k3);
                *(uint2*)(sib + 5 * 64 + co) = pk4(k0 * av[nt * 4 + 0], k1 * av[nt * 4 + 1], k2 * av[nt * 4 + 2], k3 * av[nt * 4 + 3]);
            }
            if (g == 0) rk[(size_t)m * 8 + h] = rkacc;
        }
    }
}

__device__ __forceinline__ void scan_item(const Params& p, const u16* __restrict__ si, int nch, const float* __restrict__ s0, float* __restrict__ sout,
                          size_t m0, int h, unsigned char* smem) {
    float* inb = (float*)smem;
    float* ybuf = (float*)(smem + 49152);
    unsigned char* ws = p.ws;
    const u16* Gb = (const u16*)(ws + O_G);
    const float* rk = (const float*)(ws + O_RK);
    u16* ya = (u16*)(ws + O_YA);
    const int tid = threadIdx.x;
    const int vp = tid >> 3, kq = tid & 7;
    float S0[8], S1[8];
    if (s0) {
        const float4 a = *(const float4*)(s0 + (vp * 2) * 64 + kq * 8), b = *(const float4*)(s0 + (vp * 2) * 64 + kq * 8 + 4);
        const float4 c = *(const float4*)(s0 + (vp * 2 + 1) * 64 + kq * 8), d = *(const float4*)(s0 + (vp * 2 + 1) * 64 + kq * 8 + 4);
        S0[0] = a.x; S0[1] = a.y; S0[2] = a.z; S0[3] = a.w; S0[4] = b.x; S0[5] = b.y; S0[6] = b.z; S0[7] = b.w;
        S1[0] = c.x; S1[1] = c.y; S1[2] = c.z; S1[3] = c.w; S1[4] = d.x; S1[5] = d.y; S1[6] = d.z; S1[7] = d.w;
    } else {
#pragma unroll
        for (int j = 0; j < 8; ++j) { S0[j] = 0.f; S1[j] = 0.f; }
    }
    uint4 st0, st1, st2;
    st0 = *(const uint4*)(si + (size_t)(0 * 256 + tid) * 8);
    st1 = *(const uint4*)(si + (size_t)(1 * 256 + tid) * 8);
    st2 = *(const uint4*)(si + (size_t)(2 * 256 + tid) * 8);
#define S_WRITE1(sv, i, buf)                                                                                          \
    {                                                                                                                 \
        const int idx = (i) * 256 + tid;                                                                              \
        const int vec = (idx % 48) >> 3;                                                                              \
        float v[8] = {bflo(sv.x), bfhi(sv.x), bflo(sv.y), bfhi(sv.y), bflo(sv.z), bfhi(sv.z), bflo(sv.w), bfhi(sv.w)}; \
        if (vec == 1) {                                                                                               \
            _Pragma("unroll") for (int k = 0; k < 8; ++k) v[k] = __expf(-v[k]);                                       \
        }                                                                                                             \
        float* d = inb + (buf) * 6144 + idx * 8;                                                                      \
        *(float4*)d = make_float4(v[0], v[1], v[2], v[3]);                                                            \
        *(float4*)(d + 4) = make_float4(v[4], v[5], v[6], v[7]);                                                      \
    }
#define stage_write(buf) S_WRITE1(st0, 0, buf) S_WRITE1(st1, 1, buf) S_WRITE1(st2, 2, buf)
    stage_write(0)
    __syncthreads();
    for (int c = 0; c < nch; ++c) {
        const int buf = c & 1;
        if (c + 1 < nch) {
            const u16* sn = si + (size_t)(c + 1) * 6144 + (size_t)tid * 8;
            st0 = *(const uint4*)(sn);
            st1 = *(const uint4*)(sn + 2048);
            st2 = *(const uint4*)(sn + 4096);
        }
        const float* cb = inb + buf * 6144;
#pragma unroll 2
        for (int tt = 0; tt < 16; ++tt) {
            const float* base = cb + tt * 384;
            float kk[8], dd[8], bb[8], kv[8], rr[8];
#define LD8(dst, off)                                                      \
    {                                                                      \
        const float4 q0 = *(const float4*)(base + (off) + kq * 8);         \
        const float4 q1 = *(const float4*)(base + (off) + kq * 8 + 4);     \
        dst[0] = q0.x; dst[1] = q0.y; dst[2] = q0.z; dst[3] = q0.w;        \
        dst[4] = q1.x; dst[5] = q1.y; dst[6] = q1.z; dst[7] = q1.w;        \
    }
            LD8(kk, 256) LD8(dd, 64) LD8(bb, 320) LD8(kv, 128) LD8(rr, 0)
            const float2 vv = *(const float2*)(base + 192 + vp * 2);
            float sa0 = 0.f, sa1 = 0.f;
#pragma unroll
            for (int j = 0; j < 8; ++j) { sa0 += S0[j] * kk[j]; sa1 += S1[j] * kk[j]; }
            sa0 = -red8(sa0);
            sa1 = -red8(sa1);
            float y0 = 0.f, y1 = 0.f;
#pragma unroll
            for (int j = 0; j < 8; ++j) {
                S0[j] = S0[j] * dd[j] + (sa0 * bb[j] + vv.x * kv[j]);
                S1[j] = S1[j] * dd[j] + (sa1 * bb[j] + vv.y * kv[j]);
                y0 += S0[j] * rr[j];
                y1 += S1[j] * rr[j];
            }
            y0 = red8(y0);
            y1 = red8(y1);
            if (kq == 0) *(float2*)(ybuf + tt * 64 + vp * 2) = make_float2(y0, y1);
        }
        __syncthreads();
        {
            const int tt = tid >> 4, cq = (tid & 15) * 4;
            const float4 y = *(const float4*)(ybuf + tt * 64 + cq);
            const float mean = red16(y.x + y.y + y.z + y.w) * (1.f / 64.f);
            const float d0 = y.x - mean, d1 = y.y - mean, d2 = y.z - mean, d3 = y.w - mean;
            const float var = red16(d0 * d0 + d1 * d1 + d2 * d2 + d3 * d3) * (1.f / 64.f);
            const float rstd = rsqrtf(var + 64e-5f);
            const size_t m = m0 + (size_t)c * 16 + tt;
            const float rkv = rk[m * 8 + h];
            const float4 v4 = *(const float4*)(cb + tt * 384 + 192 + cq);
            const uint2 gg = *(const uint2*)(Gb + m * 512 + h * 64 + cq);
            const float4 lw = *(const float4*)(p.ln_w + h * 64 + cq), lb = *(const float4*)(p.ln_b + h * 64 + cq);
            const float o0 = (d0 * rstd * lw.x + lb.x + rkv * v4.x) * bflo(gg.x);
            const float o1 = (d1 * rstd * lw.y + lb.y + rkv * v4.y) * bfhi(gg.x);
            const float o2 = (d2 * rstd * lw.z + lb.z + rkv * v4.z) * bflo(gg.y);
            const float o3 = (d3 * rstd * lw.w + lb.w + rkv * v4.w) * bfhi(gg.y);
            *(uint2*)(ya + m * 512 + h * 64 + cq) = pk4(o0, o1, o2, o3);
        }
        if (c + 1 < nch) { stage_write(buf ^ 1) }
        __syncthreads();
    }
    {
        float* d0 = sout + (vp * 2) * 64 + kq * 8;
        float* d1 = sout + (vp * 2 + 1) * 64 + kq * 8;
        *(float4*)d0 = make_float4(S0[0], S0[1], S0[2], S0[3]);
        *(float4*)(d0 + 4) = make_float4(S0[4], S0[5], S0[6], S0[7]);
        *(float4*)d1 = make_float4(S1[0], S1[1], S1[2], S1[3]);
        *(float4*)(d1 + 4) = make_float4(S1[4], S1[5], S1[6], S1[7]);
    }
}

constexpr int KLD = 136, VLD = 72;
__device__ __forceinline__ void attn_item(const u16* __restrict__ Q, int nq, const u16* __restrict__ K, const u16* __restrict__ Vt, int ldv, int nkt,
                          int lastvalid, u16* __restrict__ O, float lam, const float* __restrict__ subln, unsigned char* smem) {
    u16* sK = (u16*)smem;
    u16* sV = (u16*)(smem + 2 * 64 * KLD * 2);
    float* ex = (float*)smem;
    const int tid = threadIdx.x, lane = tid & 63, wid = tid >> 6, l16 = lane & 15, g = lane >> 4;
    const int n = wid >> 1, qh = wid & 1;
    const bool active = (qh * 32) < nq;
    bf16x8 qf[2][2];
#pragma unroll
    for (int qt = 0; qt < 2; ++qt)
#pragma unroll
        for (int s = 0; s < 2; ++s) {
            const int row = qh * 32 + qt * 16 + l16;
            uint4 v = make_uint4(0, 0, 0, 0);
            if (row < nq) v = *(const uint4*)(Q + (size_t)row * 512 + n * 64 + s * 32 + g * 8);
            qf[qt][s] = as_frag(v);
        }
    f32x4 o[2][8];
#pragma unroll
    for (int qt = 0; qt < 2; ++qt)
#pragma unroll
        for (int et = 0; et < 8; ++et) o[qt][et] = (f32x4){0.f, 0.f, 0.f, 0.f};
    float mrow[2] = {-1e30f, -1e30f}, lrow[2] = {0.f, 0.f};
    uint4 kr0, kr1, kr2, kr3, vr0, vr1, vr2, vr3;
    const int krow = tid >> 4, kch = (tid & 15) * 8;
    const int vrow = tid >> 3, vch = (tid & 7) * 8;
    const u16* kp_ = K + (size_t)krow * 512 + kch;
    const u16* vp_ = Vt + (size_t)vrow * ldv + vch;
#define A_LOAD(key0)                                                      \
    kr0 = *(const uint4*)(kp_ + (size_t)((key0) + 0) * 512);              \
    kr1 = *(const uint4*)(kp_ + (size_t)((key0) + 16) * 512);             \
    kr2 = *(const uint4*)(kp_ + (size_t)((key0) + 32) * 512);             \
    kr3 = *(const uint4*)(kp_ + (size_t)((key0) + 48) * 512);             \
    vr0 = *(const uint4*)(vp_ + (key0));                                  \
    vr1 = *(const uint4*)(vp_ + (size_t)32 * ldv + (key0));               \
    vr2 = *(const uint4*)(vp_ + (size_t)64 * ldv + (key0));               \
    vr3 = *(const uint4*)(vp_ + (size_t)96 * ldv + (key0));
#define A_STORE(nb)                                                       \
    *(uint4*)(sK + (nb) * 64 * KLD + (krow + 0) * KLD + kch) = kr0;       \
    *(uint4*)(sK + (nb) * 64 * KLD + (krow + 16) * KLD + kch) = kr1;      \
    *(uint4*)(sK + (nb) * 64 * KLD + (krow + 32) * KLD + kch) = kr2;      \
    *(uint4*)(sK + (nb) * 64 * KLD + (krow + 48) * KLD + kch) = kr3;      \
    *(uint4*)(sV + (nb) * 128 * VLD + (vrow + 0) * VLD + vch) = vr0;      \
    *(uint4*)(sV + (nb) * 128 * VLD + (vrow + 32) * VLD + vch) = vr1;     \
    *(uint4*)(sV + (nb) * 128 * VLD + (vrow + 64) * VLD + vch) = vr2;     \
    *(uint4*)(sV + (nb) * 128 * VLD + (vrow + 96) * VLD + vch) = vr3;
    A_LOAD(0)
    A_STORE(0)
    __syncthreads();
    constexpr float SC = 0.125f * 1.4426950408889634f;
    for (int kt = 0; kt < nkt; ++kt) {
        const int buf = kt & 1;
        if (kt + 1 < nkt) { A_LOAD((kt + 1) * 64) }
        if (active) {
            const int valid = (kt == nkt - 1) ? lastvalid : 64;
            const u16* cK = sK + buf * 64 * KLD + l16 * KLD + n * 64 + g * 8;
            const u16* cV = sV + buf * 128 * VLD + l16 * VLD + g * 4;
            f32x4 s[4][2];
#pragma unroll
            for (int k16 = 0; k16 < 4; ++k16) {
                const bf16x8 kf0 = *(const bf16x8*)(cK + k16 * 16 * KLD);
                const bf16x8 kf1 = *(const bf16x8*)(cK + k16 * 16 * KLD + 32);
#pragma unroll
                for (int qt = 0; qt < 2; ++qt) {
                    f32x4 z = {0.f, 0.f, 0.f, 0.f};
                    z = MFMA(kf0, qf[qt][0], z);
                    s[k16][qt] = MFMA(kf1, qf[qt][1], z);
                }
            }
            bf16x8 pf[2][2];
#pragma unroll
            for (int qt = 0; qt < 2; ++qt) {
                float mx = -1e30f;
#pragma unroll
                for (int k16 = 0; k16 < 4; ++k16)
#pragma unroll
                    for (int r = 0; r < 4; ++r) {
                        float v = s[k16][qt][r] * SC;
                        if (k16 * 16 >= valid) v = -1e30f;
                        s[k16][qt][r] = v;
                        mx = fmaxf(mx, v);
                    }
                mx = fmaxf(mx, __shfl_xor(mx, 16));
                mx = fmaxf(mx, __shfl_xor(mx, 32));
                const float mnew = fmaxf(mrow[qt], mx);
                const float alpha = exp2f(mrow[qt] - mnew);
                mrow[qt] = mnew;
                float psum = 0.f;
#pragma unroll
                for (int k16 = 0; k16 < 4; ++k16)
#pragma unroll
                    for (int r = 0; r < 4; ++r) {
                        const float pv = exp2f(s[k16][qt][r] - mnew);
                        s[k16][qt][r] = pv;
                        psum += pv;
                    }
                lrow[qt] = lrow[qt] * alpha + psum;
#pragma unroll
                for (int et = 0; et < 8; ++et) {
                    o[qt][et][0] *= alpha; o[qt][et][1] *= alpha; o[qt][et][2] *= alpha; o[qt][et][3] *= alpha;
                }
#pragma unroll
                for (int kb = 0; kb < 2; ++kb)
                    pf[qt][kb] = as_frag(make_uint4(pk2(s[2 * kb][qt][0], s[2 * kb][qt][1]), pk2(s[2 * kb][qt][2], s[2 * kb][qt][3]),
                                                    pk2(s[2 * kb + 1][qt][0], s[2 * kb + 1][qt][1]), pk2(s[2 * kb + 1][qt][2], s[2 * kb + 1][qt][3])));
            }
#pragma unroll
            for (int et = 0; et < 8; ++et)
#pragma unroll
                for (int kb = 0; kb < 2; ++kb) {
                    const uint2 lo = *(const uint2*)(cV + et * 16 * VLD + kb * 32);
                    const uint2 hi = *(const uint2*)(cV + et * 16 * VLD + kb * 32 + 16);
                    const bf16x8 vf = as_frag(make_uint4(lo.x, lo.y, hi.x, hi.y));
#pragma unroll
                    for (int qt = 0; qt < 2; ++qt) o[qt][et] = MFMA(vf, pf[qt][kb], o[qt][et]);
                }
        }
        if (kt + 1 < nkt) { A_STORE(buf ^ 1) }
        __syncthreads();
    }
    float inv[2];
#pragma unroll
    for (int qt = 0; qt < 2; ++qt) {
        const float l = red_g(lrow[qt]);
        inv[qt] = 1.f / fmaxf(l, 1e-30f);
    }
    if (active && n == 1) {
#pragma unroll
        for (int qt = 0; qt < 2; ++qt)
#pragma unroll
            for (int et = 0; et < 8; ++et) {
                const f32x4 v = o[qt][et];
                *(float4*)(ex + (qh * 32 + qt * 16 + l16) * 132 + et * 16 + g * 4) =
                    make_float4(v[0] * inv[qt], v[1] * inv[qt], v[2] * inv[qt], v[3] * inv[qt]);
            }
    }
    __syncthreads();
    if (active && n == 0) {
#pragma unroll
        for (int qt = 0; qt < 2; ++qt) {
            const int row = qh * 32 + qt * 16 + l16;
            float ss = 0.f;
#pragma unroll
            for (int et = 0; et < 8; ++et) {
                const float4 o2 = *(const float4*)(ex + row * 132 + et * 16 + g * 4);
                f32x4 v = o[qt][et];
                v[0] = v[0] * inv[qt] - lam * o2.x;
                v[1] = v[1] * inv[qt] - lam * o2.y;
                v[2] = v[2] * inv[qt] - lam * o2.z;
                v[3] = v[3] * inv[qt] - lam * o2.w;
                o[qt][et] = v;
                ss += v[0] * v[0] + v[1] * v[1] + v[2] * v[2] + v[3] * v[3];
            }
            ss = red_g(ss);
            const float rn = rsqrtf(ss * (1.f / 128.f) + EPS) * 0.8f;
            if (row < nq) {
#pragma unroll
                for (int et = 0; et < 8; ++et) {
                    const float4 sl = *(const float4*)(subln + et * 16 + g * 4);
                    const f32x4 v = o[qt][et];
                    *(uint2*)(O + (size_t)row * 512 + et * 16 + g * 4) = pk4(v[0] * rn * sl.x, v[1] * rn * sl.y, v[2] * rn * sl.z, v[3] * rn * sl.w);
                }
            }
        }
    }
    __syncthreads();
}

__device__ __forceinline__ void phase3(const Params& p, unsigned char* smem) {
    unsigned char* ws = p.ws;
    int* s_item = (int*)(smem + LDS_BYTES - 16);
    unsigned* ctr = (unsigned*)(ws + O_SCAL) + 1;
    const float lam = ((const float*)(ws + O_SCAL))[0];
    const u16* SI = (const u16*)(ws + O_SI);
    const u16* qb = (const u16*)(ws + O_QB);
    const u16* kP = (const u16*)(ws + O_KP);
    const u16* kS = (const u16*)(ws + O_KS);
    const u16* vtP = (const u16*)(ws + O_VTP);
    const u16* vtS = (const u16*)(ws + O_VTS);
    u16* ob = (u16*)(ws + O_OB);
    constexpr int NITEMS = 128 + 4096 + 128 + 256;
    int stage = 0;
    for (;;) {
        if (threadIdx.x == 0) {
            int it;
            if (stage == 0) it = (blockIdx.x < 128) ? (int)blockIdx.x : ((blockIdx.x < 384) ? (int)blockIdx.x - 128 + (128 + 4096 + 128) : -1);
            else { it = (int)atomicAdd(ctr, 1u) + 128; if (it >= 128 + 4096 + 128) it = 1 << 30; }
            *s_item = it;
        }
        __syncthreads();
        const int item = *s_item;
        __syncthreads();
        if (item >= NITEMS) break;
        if (item < 0) {
        } else if (item < 128 || item >= 128 + 4096 + 128) {
            const u16* si; int nch; const float* s0; float* sout; size_t m0; int h;
            if (item < 128) {
                h = item & 7;
                si = SI + (size_t)item * 4096 * 384; nch = 256; s0 = nullptr;
                sout = p.out + OFF_WP + (size_t)item * 4096; m0 = (size_t)(item >> 3) * 4096;
            } else {
                const int idx = item - (128 + 4096 + 128);
                h = idx & 7;
                si = SI + ((size_t)128 * 4096 + (size_t)idx * 32) * 384; nch = 2; s0 = p.state_wkv + (size_t)idx * 4096;
                sout = p.out + OFF_WS + (size_t)idx * 4096; m0 = (size_t)TP + (size_t)(idx >> 3) * 32;
            }
            scan_item(p, si, nch, s0, sout, m0, h, smem);
        } else {
            const u16 *Q, *K, *Vt; u16* O; int nq, ldv, nkt, lastvalid;
            if (item < 128 + 4096) {
                const int idx = item - 128;
                const int c = 63 - (idx >> 6), bh = idx & 63, b = bh >> 2, h = bh & 3;
                const size_t m0 = (size_t)b * 4096 + (size_t)c * 64;
                Q = qb + m0 * 512 + h * 128; nq = 64; K = kP + (size_t)b * 4096 * 512 + h * 128;
                Vt = vtP + ((size_t)b * 512 + h * 128) * 4096; ldv = 4096; nkt = c + 1; lastvalid = 64; O = ob + m0 * 512 + h * 128;
            } else {
                const int idx = item - (128 + 4096);
                const int b = idx >> 2, h = idx & 3;
                const size_t m0 = (size_t)TP + (size_t)b * 32;
                Q = qb + m0 * 512 + h * 128; nq = 32; K = kS + (size_t)b * LKS * 512 + h * 128;
                Vt = vtS + ((size_t)b * 512 + h * 128) * LKS; ldv = LKS; nkt = 17; lastvalid = 32; O = ob + m0 * 512 + h * 128;
            }
            attn_item(Q, nq, K, Vt, ldv, nkt, lastvalid, O, lam, p.subln, smem);
        }
        if (stage == 0) {
            __builtin_amdgcn_fence(__ATOMIC_RELEASE, "agent");
            cg::this_grid().sync();
            __builtin_amdgcn_fence(__ATOMIC_ACQUIRE, "agent");
            stage = 1;
        }
    }
}

__device__ __forceinline__ void phase4g(const Params& p, unsigned char* smem) {
    unsigned char* ws = p.ws;
    const u16* Wg = (const u16*)(ws + O_WIN) + (size_t)3360 * 1024;
    const float* rs1 = (const float*)(ws + O_RS1);
    u16* gate = (u16*)(ws + O_GATE);
    const int tid = threadIdx.x, lane = tid & 63, wid = tid >> 6, wm = wid >> 1, wn = wid & 1, l16 = lane & 15, g = lane >> 4;
    constexpr int NT = 16;
    for (int t = blockIdx.x; t < 520 * NT; t += gridDim.x) {
        int mtile, ntile;
        tile_map(t, NT, mtile, ntile);
        const int m0 = mtile * 128, n0 = ntile * 128;
        const float* xs = (m0 < TP) ? p.x_prompt + (size_t)m0 * 1024 : p.x_sample + (size_t)(m0 - TP) * 1024;
        f32x4 acc[4][4];
        zero_acc(acc);
        gemm_loop_xf32(xs, Wg + (size_t)n0 * 1024, 1024, 16, (u16*)smem, acc);
#pragma unroll
        for (int mt = 0; mt < 4; ++mt) {
            const int m = m0 + wm * 64 + mt * 16 + l16;
            const float rs = rs1[m];
#pragma unroll
            for (int nt = 0; nt < 4; ++nt) {
                const int n = n0 + wn * 64 + nt * 16 + g * 4;
                const float4 bg = *(const float4*)(p.b_gate + n);
                const f32x4 v = acc[nt][mt];
                *(uint2*)(gate + (size_t)m * 2048 + n) =
                    pk4(sigmoidf_(v[0] * rs + bg.x), sigmoidf_(v[1] * rs + bg.y), sigmoidf_(v[2] * rs + bg.z), sigmoidf_(v[3] * rs + bg.w));
            }
        }
    }
}

__device__ __forceinline__ void phase4(const Params& p, unsigned char* smem) {
    unsigned char* ws = p.ws;
    const u16* ya = (const u16*)(ws + O_YA);
    const u16* ob = (const u16*)(ws + O_OB);
    const u16* Wa = (const u16*)(ws + O_WOA);
    const u16* Wb = (const u16*)(ws + O_WOB);
    const u16* gate = (const u16*)(ws + O_GATE);
    u16* mix = (u16*)(ws + O_MIX);
    const int tid = threadIdx.x, lane = tid & 63, wid = tid >> 6, wm = wid >> 1, wn = wid & 1, l16 = lane & 15, g = lane >> 4;
    constexpr int NT = 8;
    for (int t = blockIdx.x; t < 520 * NT; t += gridDim.x) {
        int mtile, ntile;
        tile_map(t, NT, mtile, ntile);
        const int m0 = mtile * 128, n0 = ntile * 128;
        f32x4 acc[4][4], acc2[4][4];
        zero_acc(acc);
        zero_acc(acc2);
        gemm_loop(ya + (size_t)m0 * 512, 512, Wa + (size_t)n0 * 512, 512, 8, (u16*)smem, acc);
        gemm_loop(ob + (size_t)m0 * 512, 512, Wb + (size_t)n0 * 512, 512, 8, (u16*)smem, acc2);
#pragma unroll
        for (int mt = 0; mt < 4; ++mt) {
            const int m = m0 + wm * 64 + mt * 16 + l16;
#pragma unroll
            for (int nt = 0; nt < 4; ++nt) {
                const int n = n0 + wn * 64 + nt * 16 + g * 4;
                const uint2 ga = *(const uint2*)(gate + (size_t)m * 2048 + n);
                const uint2 gb = *(const uint2*)(gate + (size_t)m * 2048 + 1024 + n);
                const f32x4 a = acc[nt][mt], b = acc2[nt][mt];
                *(uint2*)(mix + (size_t)m * 1024 + n) =
                    pk4(bflo(ga.x) * a[0] + bflo(gb.x) * b[0], bfhi(ga.x) * a[1] + bfhi(gb.x) * b[1],
                        bflo(ga.y) * a[2] + bflo(gb.y) * b[2], bfhi(ga.y) * a[3] + bfhi(gb.y) * b[3]);
            }
        }
    }
}

__device__ __forceinline__ void gemm_rowss(const u16* A, int K, const u16* W, u16* outb, float* ssq, unsigned char* smem) {
    const int tid = threadIdx.x, lane = tid & 63, wid = tid >> 6, wm = wid >> 1, wn = wid & 1, l16 = lane & 15, g = lane >> 4;
    constexpr int NT = 8;
    for (int t = blockIdx.x; t < 520 * NT; t += gridDim.x) {
        int mtile, ntile;
        tile_map(t, NT, mtile, ntile);
        const int m0 = mtile * 128, n0 = ntile * 128;
        f32x4 acc[4][4];
        zero_acc(acc);
        gemm_loop(A + (size_t)m0 * K, K, W + (size_t)n0 * K, K, K / 64, (u16*)smem, acc);
#pragma unroll
        for (int mt = 0; mt < 4; ++mt) {
            const int m = m0 + wm * 64 + mt * 16 + l16;
#pragma unroll
            for (int nt = 0; nt < 4; ++nt) {
                const int n = n0 + wn * 64 + nt * 16 + g * 4;
                const f32x4 a = acc[nt][mt];
                *(uint2*)(outb + (size_t)m * 1024 + n) = pk4(a[0], a[1], a[2], a[3]);
            }
        }
    }
}

__device__ __forceinline__ float sum16(const float* q) {
    const float4 a = *(const float4*)q, b = *(const float4*)(q + 4), c = *(const float4*)(q + 8), d = *(const float4*)(q + 12);
    return ((a.x + a.y) + (a.z + a.w)) + ((b.x + b.y) + (b.z + b.w)) + (((c.x + c.y) + (c.z + c.w)) + ((d.x + d.y) + (d.z + d.w)));
}
__device__ __forceinline__ void phase6(const Params& p) {
    unsigned char* ws = p.ws;
    const u16* m2 = (const u16*)(ws + O_M2);
    u16* x1b = (u16*)(ws + O_X1B);
    float* rs3 = (float*)(ws + O_RS3);
    const int lane = threadIdx.x & 63, wid = threadIdx.x >> 6;
    for (int m = blockIdx.x * 4 + wid; m < T; m += gridDim.x * 4) {
        const float* xr = (m < TP) ? p.x_prompt + (size_t)m * 1024 : p.x_sample + (size_t)(m - TP) * 1024;
        uint2 mvv[4];
        float s2 = 0.f;
#pragma unroll
        for (int i = 0; i < 4; ++i) {
            mvv[i] = *(const uint2*)(m2 + (size_t)m * 1024 + i * 256 + lane * 4);
            const float a = bflo(mvv[i].x), b = bfhi(mvv[i].x), c = bflo(mvv[i].y), d = bfhi(mvv[i].y);
            s2 += a * a + b * b + c * c + d * d;
        }
        s2 = wave_sum(s2);
        const float rs = rsqrtf(s2 * (1.f / 1024.f) + EPS);
        float ss = 0.f;
#pragma unroll
        for (int i = 0; i < 4; ++i) {
            const int col = i * 256 + lane * 4;
            const float4 xv = *(const float4*)(xr + col);
            const uint2 mv = mvv[i];
            const float4 gp = *(const float4*)(p.n_mix_post + col);
            float4 r;
            r.x = xv.x + bflo(mv.x) * rs * gp.x;
            r.y = xv.y + bfhi(mv.x) * rs * gp.y;
            r.z = xv.z + bflo(mv.y) * rs * gp.z;
            r.w = xv.w + bfhi(mv.y) * rs * gp.w;
            ss += r.x * r.x + r.y * r.y + r.z * r.z + r.w * r.w;
            *(float4*)(p.out + (size_t)m * 1024 + col) = r;
            *(uint2*)(x1b + (size_t)m * 1024 + col) = pk4(r.x, r.y, r.z, r.w);
        }
        ss = wave_sum(ss);
        if (lane == 0) rs3[m] = rsqrtf(ss * (1.f / 1024.f) + EPS);
    }
}

__device__ __forceinline__ void phase7(const Params& p, unsigned char* smem) {
    unsigned char* ws = p.ws;
    const u16* x1b = (const u16*)(ws + O_X1B);
    const u16* W = (const u16*)(ws + O_WFI);
    const float* rs3 = (const float*)(ws + O_RS3);
    u16* hb = (u16*)(ws + O_HB);
    const int tid = threadIdx.x, lane = tid & 63, wid = tid >> 6, wm = wid >> 1, wn = wid & 1, l16 = lane & 15, g = lane >> 4;
    constexpr int NT = 44;
    for (int t = blockIdx.x; t < 520 * NT; t += gridDim.x) {
        int mtile, ntile;
        tile_map(t, NT, mtile, ntile);
        const int m0 = mtile * 128, n0 = ntile * 128;
        f32x4 acc[4][4];
        zero_acc(acc);
        gemm_loop(x1b + (size_t)m0 * 1024, 1024, W + (size_t)n0 * 1024, 1024, 16, (u16*)smem, acc);
#pragma unroll
        for (int mt = 0; mt < 4; ++mt) {
            const int m = m0 + wm * 64 + mt * 16 + l16;
            const float rs = rs3[m];
#pragma unroll
            for (int pr = 0; pr < 2; ++pr) {
                const f32x4 ug = acc[2 * pr][mt], uv = acc[2 * pr + 1][mt];
                const int j = ((n0 + wn * 64) >> 5) * 16 + pr * 16 + g * 4;
                float hv[4];
#pragma unroll
                for (int r = 0; r < 4; ++r) {
                    const float a = ug[r] * rs, b = uv[r] * rs;
                    hv[r] = a * sigmoidf_(a) * b;
                }
                *(uint2*)(hb + (size_t)m * 2816 + j) = pk4(hv[0], hv[1], hv[2], hv[3]);
            }
        }
    }
}

__device__ __forceinline__ void phase9(const Params& p) {
    unsigned char* ws = p.ws;
    const u16* fb = (const u16*)(ws + O_FB);
    const int lane = threadIdx.x & 63, wid = threadIdx.x >> 6;
    for (int m = blockIdx.x * 4 + wid; m < T; m += gridDim.x * 4) {
        uint2 fvv[4];
        float s2 = 0.f;
#pragma unroll
        for (int i = 0; i < 4; ++i) {
            fvv[i] = *(const uint2*)(fb + (size_t)m * 1024 + i * 256 + lane * 4);
            const float a = bflo(fvv[i].x), b = bfhi(fvv[i].x), c = bflo(fvv[i].y), d = bfhi(fvv[i].y);
            s2 += a * a + b * b + c * c + d * d;
        }
        s2 = wave_sum(s2);
        const float rs = rsqrtf(s2 * (1.f / 1024.f) + EPS);
#pragma unroll
        for (int i = 0; i < 4; ++i) {
            const int col = i * 256 + lane * 4;
            float4 r = *(const float4*)(p.out + (size_t)m * 1024 + col);
            const uint2 fv = fvv[i];
            const float4 gp = *(const float4*)(p.n_ffn_post + col);
            r.x += bflo(fv.x) * rs * gp.x;
            r.y += bfhi(fv.x) * rs * gp.y;
            r.z += bflo(fv.y) * rs * gp.z;
            r.w += bfhi(fv.y) * rs * gp.w;
            *(float4*)(p.out + (size_t)m * 1024 + col) = r;
        }
    }
}

__global__ void __launch_bounds__(256, 2) mega(Params p) {
    extern __shared__ __attribute__((aligned(16))) unsigned char smem[];
    cg::grid_group grid = cg::this_grid();
#define IN(k) (p.ph_lo <= (k) && (k) < p.ph_hi)
#define SEAM(k) if (IN(k) && IN((k) + 1)) { __builtin_amdgcn_fence(__ATOMIC_RELEASE, "agent"); asm volatile("s_waitcnt vmcnt(0) lgkmcnt(0)" ::: "memory"); grid.sync(); __builtin_amdgcn_fence(__ATOMIC_ACQUIRE, "agent"); }
    unsigned char* ws = p.ws;
    if (IN(0)) phase0(p, smem);
    SEAM(0)
    if (IN(1)) phase1(p, smem);
    SEAM(1)
    if (IN(2)) phase2(p);
    SEAM(2)
    if (IN(3)) phase3(p, smem);
    SEAM(3)
    if (IN(4)) phase4g(p, smem);
    SEAM(4)
    if (IN(5)) phase4(p, smem);
    SEAM(5)
    if (IN(6)) gemm_rowss((const u16*)(ws + O_MIX), 1024, (const u16*)(ws + O_WO), (u16*)(ws + O_M2), (float*)(ws + O_SS2), smem);
    SEAM(6)
    if (IN(7)) phase6(p);
    SEAM(7)
    if (IN(8)) phase7(p, smem);
    SEAM(8)
    if (IN(9)) gemm_rowss((const u16*)(ws + O_HB), 2816, (const u16*)(ws + O_WFO), (u16*)(ws + O_FB), (float*)(ws + O_SS4), smem);
    SEAM(9)
    if (IN(10)) phase9(p);
}

extern "C" void kernel_launch(void* const* d_in, const int* in_sizes, int n_in, void* d_out, int out_size, void* d_ws, size_t ws_size,
                              hipStream_t stream) {
    static int grid_blocks = 0;
    if (!grid_blocks) {
        int dev = 0, cus = 0, per_cu = 0;
        hipGetDevice(&dev);
        hipDeviceGetAttribute(&cus, hipDeviceAttributeMultiprocessorCount, dev);
        hipFuncSetAttribute((const void*)mega, hipFuncAttributeMaxDynamicSharedMemorySize, LDS_BYTES);
        hipOccupancyMaxActiveBlocksPerMultiprocessor(&per_cu, (const void*)mega, 256, LDS_BYTES);
        if (per_cu < 1) per_cu = 1;
        if (per_cu > 2) per_cu = 2;
        grid_blocks = cus * per_cu;
        if (ws_size < WS_END) fprintf(stderr, "kernel_launch: workspace too small: %zu < %zu\n", ws_size, (size_t)WS_END);
    }
    Params p{};
    const float** pp = (const float**)&p;
    for (int i = 0; i < 33; ++i) pp[i] = (const float*)d_in[i];
    p.out = (float*)d_out;
    p.ws = (unsigned char*)d_ws;
#ifndef MULTI_LAUNCH
    p.ph_lo = 0;
    p.ph_hi = 11;
    void* args[] = {&p};
    hipError_t e = hipLaunchCooperativeKernel((const void*)mega, dim3(grid_blocks), dim3(256), args, LDS_BYTES, stream);
    if (e != hipSuccess) fprintf(stderr, "cooperative launch failed: %s (grid %d)\n", hipGetErrorString(e), grid_blocks);
#else
    for (int k = 0; k < 11; ++k) {
        p.ph_lo = k;
        p.ph_hi = k + 1;
        hipLaunchKernelGGL(mega, dim3(grid_blocks), dim3(256), LDS_BYTES, stream, p);
    }
#endif
}
```

```cpp
#include <hip/hip_runtime.h>
#include <hip/hip_cooperative_groups.h>
#include <cstdio>
#include <cstdint>
namespace cg = cooperative_groups;

typedef unsigned short u16;
typedef __attribute__((ext_vector_type(8))) short bf16x8;
typedef __attribute__((ext_vector_type(4))) float f32x4;

constexpr int TP = 65536, TS = 1024, T = TP + TS;
constexpr int ACOLS = 1824;
constexpr int LKS = 1088;
constexpr int LDS_BYTES = 73728;
constexpr float EPS = 1e-6f;

constexpr size_t OFF_YS = 67108864ull, OFF_KP = 68157440ull, OFF_VP = 101711872ull, OFF_WP = 135266304ull,
                 OFF_SHP = 135790592ull, OFF_KS = 135819776ull, OFF_VS = 136344064ull, OFF_WS = 136868352ull,
                 OFF_SHS = 137916928ull;

constexpr size_t al(size_t x) { return (x + 255) & ~(size_t)255; }
constexpr size_t O_WIN = 0;
constexpr size_t O_WOA = O_WIN + al(5504ull * 1024 * 2);
constexpr size_t O_WOB = O_WOA + al(1024ull * 512 * 2);
constexpr size_t O_WO = O_WOB + al(1024ull * 512 * 2);
constexpr size_t O_WFI = O_WO + al(1024ull * 1024 * 2);
constexpr size_t O_WFO = O_WFI + al(5632ull * 1024 * 2);
constexpr size_t O_W2 = O_WFO + al(1024ull * 2816 * 2);
constexpr size_t O_A2 = O_W2 + al(512 * 64 * 2);
constexpr size_t O_G2 = O_A2 + al(512 * 64 * 2);
constexpr size_t O_RS1 = O_G2 + al(512 * 160 * 2);
constexpr size_t O_SS2 = O_RS1 + al((size_t)T * 4);
constexpr size_t O_SS4 = O_SS2 + al((size_t)T * 16 * 4);
constexpr size_t O_RS3 = O_SS4 + al((size_t)T * 16 * 4);
constexpr size_t O_RK = O_RS3 + al((size_t)T * 4);
constexpr size_t O_SCAL = O_RK + al((size_t)T * 8 * 4);
constexpr size_t O_REGA = O_SCAL + 256;
constexpr size_t O_CA = O_REGA;
constexpr size_t O_YA = O_REGA;
constexpr size_t O_OB = O_YA + al((size_t)T * 512 * 2);
constexpr size_t O_HB = O_REGA;
constexpr size_t O_REGB = O_REGA + al((size_t)(T + 48) * 1824 * 2);
constexpr size_t O_QB = O_REGB;
constexpr size_t O_KP = O_QB + al((size_t)T * 512 * 2);
constexpr size_t O_KS = O_KP + al((size_t)TP * 512 * 2);
constexpr size_t O_VTP = O_KS + al(32ull * LKS * 512 * 2);
constexpr size_t O_VTS = O_VTP + al(16ull * 512 * 4096 * 2);
constexpr size_t O_REGC = O_VTS + al(32ull * 512 * LKS * 2);
constexpr size_t O_GATE = O_REGB;
static_assert(O_GATE + (size_t)T * 2048 * 2 <= O_REGC, "gate overlaps region C");
constexpr size_t O_SI = O_REGC;
constexpr size_t O_G = O_SI + al((size_t)T * 8 * 384 * 2);
constexpr size_t O_XB = O_REGC;
constexpr size_t O_MIX = O_REGC;
constexpr size_t O_M2 = O_MIX + al((size_t)T * 1024 * 2);
constexpr size_t O_X1B = O_M2 + al((size_t)T * 1024 * 2);
constexpr size_t O_FB = O_REGC;
constexpr size_t WS_END = O_G + al((size_t)T * 512 * 2);
static_assert(O_HB + (size_t)T * 2816 * 2 <= O_REGC, "hb overlaps region C");
static_assert(O_X1B + (size_t)T * 1024 * 2 <= WS_END, "x1b beyond end");
static_assert(WS_END <= 1073741824ull, "workspace too large");

struct Params {
    const float *x_prompt, *x_sample, *cache_k, *cache_v, *state_wkv, *state_shift;
    const float *n_mix_pre, *n_mix_post, *n_ffn_pre, *n_ffn_post, *w_in, *b_gate;
    const float *mu, *w0, *w2, *a0, *a2, *g2, *k_k, *k_a, *r_k, *ln_w, *ln_b;
    const float *lq1, *lk1, *lq2, *lk2, *subln, *w_out_a, *w_out_b, *w_o, *w_ffn_in, *w_ffn_out;
    float* out;
    unsigned char* ws;
    int ph_lo, ph_hi;
};

__device__ __forceinline__ u16 f2bf(float f) {
    unsigned u = __float_as_uint(f);
    u += 0x7fffu + ((u >> 16) & 1u);
    return (u16)(u >> 16);
}
__device__ __forceinline__ unsigned pk2(float a, float b) { return (unsigned)f2bf(a) | ((unsigned)f2bf(b) << 16); }
__device__ __forceinline__ float bflo(unsigned u) { return __uint_as_float(u << 16); }
__device__ __forceinline__ float bfhi(unsigned u) { return __uint_as_float(u & 0xffff0000u); }
__device__ __forceinline__ uint2 pk4(float a, float b, float c, float d) { return make_uint2(pk2(a, b), pk2(c, d)); }
__device__ __forceinline__ float sigmoidf_(float x) { return 1.f / (1.f + __expf(-x)); }

template <int CTRL>
__device__ __forceinline__ float dppf(float x) {
    return __int_as_float(__builtin_amdgcn_update_dpp(0, __float_as_int(x), CTRL, 0xF, 0xF, true));
}
__device__ __forceinline__ float red8(float x) {
    x += dppf<0xB1>(x);
    x += dppf<0x4E>(x);
    x += dppf<0x141>(x);
    return x;
}
__device__ __forceinline__ float red16(float x) {
    x = red8(x);
    x += dppf<0x140>(x);
    return x;
}
__device__ __forceinline__ float red_g(float x) {
    x += __shfl_xor(x, 16);
    x += __shfl_xor(x, 32);
    return x;
}
__device__ __forceinline__ float wave_sum(float x) {
    x = red16(x);
    return red_g(x);
}
__device__ __forceinline__ bf16x8 as_frag(uint4 v) {
    union { uint4 u; bf16x8 f; } c;
    c.u = v;
    return c.f;
}
#define MFMA(a, b, c) __builtin_amdgcn_mfma_f32_16x16x32_bf16((a), (b), (c), 0, 0, 0)

constexpr int LDT = 72;
constexpr int STG = 128 * LDT;
__device__ __forceinline__ void gemm_loop(const u16* __restrict__ A, int lda, const u16* __restrict__ B, int ldb,
                                          int nkt, u16* smem, f32x4 (&acc)[4][4]) {
    const int tid = threadIdx.x, lane = tid & 63, wid = tid >> 6, wm = wid >> 1, wn = wid & 1, l16 = lane & 15, g = lane >> 4;
    const int lr = tid >> 3, lc = (tid & 7) * 8;
    u16* sA = smem;
    u16* sB = smem + 2 * STG;
    const u16* ap = A + (size_t)lr * lda + lc;
    const u16* bp = B + (size_t)lr * ldb + lc;
    uint4 ra0, ra1, ra2, ra3, rb0, rb1, rb2, rb3;
#define G_LOAD(ko)                                                   \
    ra0 = *(const uint4*)(ap + (ko));                                \
    ra1 = *(const uint4*)(ap + (size_t)32 * lda + (ko));             \
    ra2 = *(const uint4*)(ap + (size_t)64 * lda + (ko));             \
    ra3 = *(const uint4*)(ap + (size_t)96 * lda + (ko));             \
    rb0 = *(const uint4*)(bp + (ko));                                \
    rb1 = *(const uint4*)(bp + (size_t)32 * ldb + (ko));             \
    rb2 = *(const uint4*)(bp + (size_t)64 * ldb + (ko));             \
    rb3 = *(const uint4*)(bp + (size_t)96 * ldb + (ko));
#define G_STORE(bo)                                                  \
    *(uint4*)(sA + (bo) + (lr + 0) * LDT + lc) = ra0;                \
    *(uint4*)(sA + (bo) + (lr + 32) * LDT + lc) = ra1;               \
    *(uint4*)(sA + (bo) + (lr + 64) * LDT + lc) = ra2;               \
    *(uint4*)(sA + (bo) + (lr + 96) * LDT + lc) = ra3;               \
    *(uint4*)(sB + (bo) + (lr + 0) * LDT + lc) = rb0;                \
    *(uint4*)(sB + (bo) + (lr + 32) * LDT + lc) = rb1;               \
    *(uint4*)(sB + (bo) + (lr + 64) * LDT + lc) = rb2;               \
    *(uint4*)(sB + (bo) + (lr + 96) * LDT + lc) = rb3;
    G_LOAD(0)
    G_STORE(0)
    __syncthreads();
    for (int kt = 0; kt < nkt; ++kt) {
        const int buf = kt & 1;
        if (kt + 1 < nkt) { G_LOAD((kt + 1) * 64) }
        __builtin_amdgcn_sched_barrier(0);
        const u16* cA = sA + buf * STG + (wm * 64 + l16) * LDT + g * 8;
        const u16* cB = sB + buf * STG + (wn * 64 + l16) * LDT + g * 8;
#pragma unroll
        for (int ks = 0; ks < 2; ++ks) {
            bf16x8 xf[4], wf[4];
#pragma unroll
            for (int i = 0; i < 4; ++i) {
                xf[i] = *(const bf16x8*)(cA + i * 16 * LDT + ks * 32);
                wf[i] = *(const bf16x8*)(cB + i * 16 * LDT + ks * 32);
            }
#pragma unroll
            for (int nt = 0; nt < 4; ++nt)
#pragma unroll
                for (int mt = 0; mt < 4; ++mt) acc[nt][mt] = MFMA(wf[nt], xf[mt], acc[nt][mt]);
        }
        __builtin_amdgcn_sched_barrier(0);
        if (kt + 1 < nkt) { G_STORE((buf ^ 1) * STG) }
        __syncthreads();
    }
}
__device__ __forceinline__ void gemm_loop_xf32(const float* __restrict__ A, const u16* __restrict__ B, int ldb, int nkt, u16* smem,
                                               f32x4 (&acc)[4][4]) {
    const int tid = threadIdx.x, lane = tid & 63, wid = tid >> 6, wm = wid >> 1, wn = wid & 1, l16 = lane & 15, g = lane >> 4;
    const int lr = tid >> 3, lc = (tid & 7) * 8;
    u16* sA = smem;
    u16* sB = smem + 2 * STG;
    const float* ap = A + (size_t)lr * 1024 + lc;
    const u16* bp = B + (size_t)lr * ldb + lc;
    float4 fa0, fa1, fa2, fa3, fa4, fa5, fa6, fa7;
    uint4 rb0, rb1, rb2, rb3;
#define GX_LOAD(ko)                                                  \
    fa0 = *(const float4*)(ap + (ko));                               \
    fa1 = *(const float4*)(ap + (ko) + 4);                           \
    fa2 = *(const float4*)(ap + 32 * 1024 + (ko));                   \
    fa3 = *(const float4*)(ap + 32 * 1024 + (ko) + 4);               \
    fa4 = *(const float4*)(ap + 64 * 1024 + (ko));                   \
    fa5 = *(const float4*)(ap + 64 * 1024 + (ko) + 4);               \
    fa6 = *(const float4*)(ap + 96 * 1024 + (ko));                   \
    fa7 = *(const float4*)(ap + 96 * 1024 + (ko) + 4);               \
    rb0 = *(const uint4*)(bp + (ko));                                \
    rb1 = *(const uint4*)(bp + (size_t)32 * ldb + (ko));             \
    rb2 = *(const uint4*)(bp + (size_t)64 * ldb + (ko));             \
    rb3 = *(const uint4*)(bp + (size_t)96 * ldb + (ko));
#define PKF(a, b) make_uint4(pk2(a.x, a.y), pk2(a.z, a.w), pk2(b.x, b.y), pk2(b.z, b.w))
#define GX_STORE(bo)                                                 \
    *(uint4*)(sA + (bo) + (lr + 0) * LDT + lc) = PKF(fa0, fa1);      \
    *(uint4*)(sA + (bo) + (lr + 32) * LDT + lc) = PKF(fa2, fa3);     \
    *(uint4*)(sA + (bo) + (lr + 64) * LDT + lc) = PKF(fa4, fa5);     \
    *(uint4*)(sA + (bo) + (lr + 96) * LDT + lc) = PKF(fa6, fa7);     \
    *(uint4*)(sB + (bo) + (lr + 0) * LDT + lc) = rb0;                \
    *(uint4*)(sB + (bo) + (lr + 32) * LDT + lc) = rb1;               \
    *(uint4*)(sB + (bo) + (lr + 64) * LDT + lc) = rb2;               \
    *(uint4*)(sB + (bo) + (lr + 96) * LDT + lc) = rb3;
    GX_LOAD(0)
    GX_STORE(0)
    __syncthreads();
    for (int kt = 0; kt < nkt; ++kt) {
        const int buf = kt & 1;
        if (kt + 1 < nkt) { GX_LOAD((kt + 1) * 64) }
        __builtin_amdgcn_sched_barrier(0);
        const u16* cA = sA + buf * STG + (wm * 64 + l16) * LDT + g * 8;
        const u16* cB = sB + buf * STG + (wn * 64 + l16) * LDT + g * 8;
#pragma unroll
        for (int ks = 0; ks < 2; ++ks) {
            bf16x8 xf[4], wf[4];
#pragma unroll
            for (int i = 0; i < 4; ++i) {
                xf[i] = *(const bf16x8*)(cA + i * 16 * LDT + ks * 32);
                wf[i] = *(const bf16x8*)(cB + i * 16 * LDT + ks * 32);
            }
#pragma unroll
            for (int nt = 0; nt < 4; ++nt)
#pragma unroll
                for (int mt = 0; mt < 4; ++mt) acc[nt][mt] = MFMA(wf[nt], xf[mt], acc[nt][mt]);
        }
        __builtin_amdgcn_sched_barrier(0);
        if (kt + 1 < nkt) { GX_STORE((buf ^ 1) * STG) }
        __syncthreads();
    }
}
__device__ __forceinline__ void zero_acc(f32x4 (&acc)[4][4]) {
#pragma unroll
    for (int i = 0; i < 4; ++i)
#pragma unroll
        for (int j = 0; j < 4; ++j) acc[i][j] = (f32x4){0.f, 0.f, 0.f, 0.f};
}
__device__ __forceinline__ void tile_map(int t, int NT, int& mt, int& nt) {
    const int x = t & 7, u = t >> 3;
    const int gsz = 8 * NT;
    const int g = u / gsz;
    const int w = u - g * gsz;
    const int rows = (g < 8) ? 8 : 1;
    const int q = w / rows;
    mt = x * 65 + g * 8 + (w - q * rows);
    nt = q;
}

__device__ __forceinline__ void tr_tile(const float* __restrict__ in, int R, int C, int ldin, u16* __restrict__ out, int ldout,
                        const float* __restrict__ scale, int r0, int c0, int Cout, bool perm, float* tile) {
    const int tid = threadIdx.x;
    {
        const int tx = tid & 63, ty = tid >> 6;
        const int c = c0 + tx;
        for (int rr = ty; rr < 64; rr += 4) {
            const int r = r0 + rr;
            float v = 0.f;
            if (r < R && c < C) {
                v = in[(size_t)r * ldin + c];
                if (scale) v *= scale[r];
            }
            tile[rr * 65 + tx] = v;
        }
    }
    __syncthreads();
    {
        const int rch = (tid & 7) * 8;
#pragma unroll
        for (int pass = 0; pass < 2; ++pass) {
            const int cc = (tid >> 3) + pass * 32;
            const int c = c0 + cc;
            if (c < Cout && r0 + rch < R) {
                float v[8];
#pragma unroll
                for (int k = 0; k < 8; ++k) v[k] = tile[(rch + k) * 65 + cc];
                int orow = c;
                if (perm) {
                    const int type = c >= 2816 ? 1 : 0;
                    const int j = c - type * 2816;
                    orow = (j >> 4) * 32 + type * 16 + (j & 15);
                }
                uint4 o = make_uint4(pk2(v[0], v[1]), pk2(v[2], v[3]), pk2(v[4], v[5]), pk2(v[6], v[7]));
                *(uint4*)(out + (size_t)orow * ldout + r0 + rch) = o;
            }
        }
    }
    __syncthreads();
}

__device__ __forceinline__ void phase0(const Params& p, unsigned char* smem) {
    float* tile = (float*)smem;
    const int tid = threadIdx.x, lane = tid & 63, wid = tid >> 6;
    unsigned char* ws = p.ws;
    const int G = gridDim.x;
    for (int u = blockIdx.x; u < 8136; u += G) {
        const float* in;
        int R, C, Cout, ldout, tl;
        u16* out;
        const float* scale = nullptr;
        bool perm = false;
        if (u < 1376) { tl = u; in = p.w_in; R = 1024; C = 5408; Cout = 5504; out = (u16*)(ws + O_WIN); ldout = 1024; scale = p.n_mix_pre; }
        else if (u < 1504) { tl = u - 1376; in = p.w_out_a; R = 512; C = 1024; Cout = 1024; out = (u16*)(ws + O_WOA); ldout = 512; }
        else if (u < 1632) { tl = u - 1504; in = p.w_out_b; R = 512; C = 1024; Cout = 1024; out = (u16*)(ws + O_WOB); ldout = 512; }
        else if (u < 1888) { tl = u - 1632; in = p.w_o; R = 1024; C = 1024; Cout = 1024; out = (u16*)(ws + O_WO); ldout = 1024; }
        else if (u < 3296) { tl = u - 1888; in = p.w_ffn_in; R = 1024; C = 5632; Cout = 5632; out = (u16*)(ws + O_WFI); ldout = 1024; scale = p.n_ffn_pre; perm = true; }
        else if (u < 4000) { tl = u - 3296; in = p.w_ffn_out; R = 2816; C = 1024; Cout = 1024; out = (u16*)(ws + O_WFO); ldout = 2816; }
        else if (u < 4008) { tl = u - 4000; in = p.w2; R = 64; C = 512; Cout = 512; out = (u16*)(ws + O_W2); ldout = 64; }
        else if (u < 4016) { tl = u - 4008; in = p.a2; R = 64; C = 512; Cout = 512; out = (u16*)(ws + O_A2); ldout = 64; }
        else if (u < 4040) { tl = u - 4016; in = p.g2; R = 160; C = 512; Cout = 512; out = (u16*)(ws + O_G2); ldout = 160; }
        else {
            tl = u - 4040;
            const int b = tl >> 7;
            tl &= 127;
            in = p.cache_v + (size_t)b * 1024 * 512; R = 1024; C = 512; Cout = 512;
            out = (u16*)(ws + O_VTS) + (size_t)b * 512 * LKS; ldout = LKS;
        }
        const int ctiles = (Cout + 63) >> 6;
        const int rt = tl / ctiles, ct = tl - rt * ctiles;
        tr_tile(in, R, C, C, out, ldout, scale, rt * 64, ct * 64, Cout, perm, tile);
    }
    {
        u16* xb = (u16*)(ws + O_XB);
        float* rs1 = (float*)(ws + O_RS1);
        for (int m = blockIdx.x * 4 + wid; m < T; m += G * 4) {
            const float* xr = (m < TP) ? p.x_prompt + (size_t)m * 1024 : p.x_sample + (size_t)(m - TP) * 1024;
            float ss = 0.f;
#pragma unroll
            for (int i = 0; i < 4; ++i) {
                const float4 v = *(const float4*)(xr + i * 256 + lane * 4);
                ss += v.x * v.x + v.y * v.y + v.z * v.z + v.w * v.w;
                *(uint2*)(xb + (size_t)m * 1024 + i * 256 + lane * 4) = pk4(v.x, v.y, v.z, v.w);
            }
            ss = wave_sum(ss);
            if (lane == 0) rs1[m] = rsqrtf(ss * (1.f / 1024.f) + EPS);
        }
    }
    {
        u16* kS = (u16*)(ws + O_KS);
        const int n8 = 32 * 1024 * 64;
        for (int i = blockIdx.x * 256 + tid; i < n8; i += G * 256) {
            const int b = i >> 16, rem = i & 65535, key = rem >> 6, c8 = rem & 63;
            const float4 v0 = *(const float4*)(p.cache_k + (size_t)i * 8);
            const float4 v1 = *(const float4*)(p.cache_k + (size_t)i * 8 + 4);
            *(uint4*)(kS + ((size_t)b * LKS + key) * 512 + c8 * 8) =
                make_uint4(pk2(v0.x, v0.y), pk2(v0.z, v0.w), pk2(v1.x, v1.y), pk2(v1.z, v1.w));
        }
        for (int i = blockIdx.x * 256 + tid; i < 32 * 32 * 64; i += G * 256) {
            const int b = i >> 11, rem = i & 2047, row = rem >> 6, c8 = rem & 63;
            *(uint4*)(kS + ((size_t)b * LKS + 1056 + row) * 512 + c8 * 8) = make_uint4(0, 0, 0, 0);
        }
        u16* vtS = (u16*)(ws + O_VTS);
        for (int i = blockIdx.x * 256 + tid; i < 32 * 512 * 4; i += G * 256) {
            const int row = i >> 2, c8 = i & 3;
            *(uint4*)(vtS + (size_t)row * LKS + 1056 + c8 * 8) = make_uint4(0, 0, 0, 0);
        }
    }
    {
        u16* cA = (u16*)(ws + O_CA);
        for (int i = blockIdx.x * 256 + tid; i < 48 * ACOLS; i += G * 256) {
            const int s = i / ACOLS, c = i - s * ACOLS;
            float v = 0.f;
            size_t row;
            if (s < 16) row = (size_t)s * 4097;
            else { row = (size_t)16 * 4097 + (size_t)(s - 16) * 33; v = p.state_shift[(size_t)(s - 16) * ACOLS + c]; }
            cA[row * ACOLS + c] = f2bf(v);
        }
        if (blockIdx.x == 0 && tid == 0) {
            float d1 = 0.f, d2 = 0.f;
            for (int i = 0; i < 64; ++i) { d1 += p.lq1[i] * p.lk1[i]; d2 += p.lq2[i] * p.lk2[i]; }
            float* sc = (float*)(ws + O_SCAL);
            sc[0] = __expf(d1) - __expf(d2) + 0.2f;
            for (int i = 1; i < 32; ++i) ((unsigned*)sc)[i] = 0u;
        }
    }
}

__device__ __forceinline__ void phase1(const Params& p, unsigned char* smem) {
    unsigned char* ws = p.ws;
    const u16* xb = (const u16*)(ws + O_XB);
    const u16* W = (const u16*)(ws + O_WIN);
    const float* rs1 = (const float*)(ws + O_RS1);
    u16* cA = (u16*)(ws + O_CA);
    u16* qb = (u16*)(ws + O_QB);
    u16* kP = (u16*)(ws + O_KP);
    u16* kS = (u16*)(ws + O_KS);
    u16* vtP = (u16*)(ws + O_VTP);
    u16* vtS = (u16*)(ws + O_VTS);
    float* out = p.out;
    const int tid = threadIdx.x, lane = tid & 63, wid = tid >> 6, wm = wid >> 1, wn = wid & 1, l16 = lane & 15, g = lane >> 4;
    constexpr int NT = 27;
    for (int t = blockIdx.x; t < 520 * NT; t += gridDim.x) {
        int mtile, ntile;
        tile_map(t, NT, mtile, ntile);
        const int m0 = mtile * 128, n0 = ntile * 128;
        f32x4 acc[4][4];
        zero_acc(acc);
        gemm_loop(xb + (size_t)m0 * 1024, 1024, W + (size_t)n0 * 1024, 1024, 16, (u16*)smem, acc);
#pragma unroll
        for (int mt = 0; mt < 4; ++mt) {
            const int m = m0 + wm * 64 + mt * 16 + l16;
            const float rs = rs1[m];
            const bool isP = m < TP;
            int seq, tt;
            if (isP) { seq = m >> 12; tt = m & 4095; }
            else { const int ms = m - TP; seq = 16 + (ms >> 5); tt = ms & 31; }
            const size_t carow = (size_t)m + seq + 1;
            const bool last = isP ? (tt == 4095) : (tt == 31);
#pragma unroll
            for (int nt = 0; nt < 4; ++nt) {
                const int n = n0 + wn * 64 + nt * 16 + g * 4;
                if (n >= 3360) continue;
                f32x4 v = acc[nt][mt];
                v[0] *= rs; v[1] *= rs; v[2] *= rs; v[3] *= rs;
                if (n < 1824) {
                    *(uint2*)(cA + carow * ACOLS + n) = pk4(v[0], v[1], v[2], v[3]);
                    if (last) {
                        float* so = isP ? out + OFF_SHP + (size_t)seq * ACOLS + n : out + OFF_SHS + (size_t)(seq - 16) * ACOLS + n;
                        *(float4*)so = make_float4(v[0], v[1], v[2], v[3]);
                    }
                } else if (n < 2336) {
                    *(uint2*)(qb + (size_t)m * 512 + (n - 1824)) = pk4(v[0], v[1], v[2], v[3]);
                } else if (n < 2848) {
                    const int c = n - 2336;
                    if (isP) {
                        *(uint2*)(kP + (size_t)m * 512 + c) = pk4(v[0], v[1], v[2], v[3]);
                        *(float4*)(out + OFF_KP + (size_t)m * 512 + c) = make_float4(v[0], v[1], v[2], v[3]);
                    } else {
                        *(uint2*)(kS + ((size_t)(seq - 16) * LKS + 1024 + tt) * 512 + c) = pk4(v[0], v[1], v[2], v[3]);
                        *(float4*)(out + OFF_KS + (size_t)(m - TP) * 512 + c) = make_float4(v[0], v[1], v[2], v[3]);
                    }
                } else {
                    const int c = n - 2848;
                    if (isP) {
                        *(float4*)(out + OFF_VP + (size_t)m * 512 + c) = make_float4(v[0], v[1], v[2], v[3]);
                        u16* d = vtP + ((size_t)seq * 512 + c) * 4096 + tt;
                        d[0] = f2bf(v[0]); d[4096] = f2bf(v[1]); d[2 * 4096] = f2bf(v[2]); d[3 * 4096] = f2bf(v[3]);
                    } else {
                        *(float4*)(out + OFF_VS + (size_t)(m - TP) * 512 + c) = make_float4(v[0], v[1], v[2], v[3]);
                        u16* d = vtS + ((size_t)(seq - 16) * 512 + c) * LKS + 1024 + tt;
                        d[0] = f2bf(v[0]); d[LKS] = f2bf(v[1]); d[2 * LKS] = f2bf(v[2]); d[3 * LKS] = f2bf(v[3]);
                    }
                }
            }
        }
    }
}

__device__ __forceinline__ void lerp8(const u16* cur, const u16* prv, const float* mu, int col, float (&xs)[8]) {
    const uint4 cu = *(const uint4*)(cur + col);
    const uint4 pv = *(const uint4*)(prv + col);
    const float4 m0 = *(const float4*)(mu + col);
    const float4 m1 = *(const float4*)(mu + col + 4);
    const unsigned cw[4] = {cu.x, cu.y, cu.z, cu.w}, pw[4] = {pv.x, pv.y, pv.z, pv.w};
    const float mm[8] = {m0.x, m0.y, m0.z, m0.w, m1.x, m1.y, m1.z, m1.w};
#pragma unroll
    for (int i = 0; i < 4; ++i) {
        const float c0 = bflo(cw[i]), c1 = bfhi(cw[i]), p0 = bflo(pw[i]), p1 = bfhi(pw[i]);
        xs[2 * i] = c0 + (p0 - c0) * mm[2 * i];
        xs[2 * i + 1] = c1 + (p1 - c1) * mm[2 * i + 1];
    }
}
__device__ __forceinline__ void lerp4(const u16* cur, const u16* prv, const float* mu, int col, float (&xs)[4]) {
    const uint2 cu = *(const uint2*)(cur + col);
    const uint2 pv = *(const uint2*)(prv + col);
    const float4 m0 = *(const float4*)(mu + col);
    float c0 = bflo(cu.x), c1 = bfhi(cu.x), c2 = bflo(cu.y), c3 = bfhi(cu.y);
    xs[0] = c0 + (bflo(pv.x) - c0) * m0.x;
    xs[1] = c1 + (bfhi(pv.x) - c1) * m0.y;
    xs[2] = c2 + (bflo(pv.y) - c2) * m0.z;
    xs[3] = c3 + (bfhi(pv.y) - c3) * m0.w;
}
__device__ __forceinline__ bf16x8 packfrag(const float (&v)[8]) {
    return as_frag(make_uint4(pk2(v[0], v[1]), pk2(v[2], v[3]), pk2(v[4], v[5]), pk2(v[6], v[7])));
}

__device__ __forceinline__ void phase2(const Params& p) {
    unsigned char* ws = p.ws;
    const u16* cA = (const u16*)(ws + O_CA);
    const u16* w2t = (const u16*)(ws + O_W2);
    const u16* a2t = (const u16*)(ws + O_A2);
    const u16* g2t = (const u16*)(ws + O_G2);
    u16* SI = (u16*)(ws + O_SI);
    u16* Gb = (u16*)(ws + O_G);
    float* rk = (float*)(ws + O_RK);
    const int tid = threadIdx.x, lane = tid & 63, wid = tid >> 6, l16 = lane & 15, g = lane >> 4;
    for (int u = blockIdx.x; u < T / 64; u += gridDim.x) {
        const int mw = u * 64 + wid * 16;
        const int m = mw + l16;
        const bool isP = mw < TP;
        int seq, tt;
        if (isP) { seq = m >> 12; tt = m & 4095; }
        else { const int ms = m - TP; seq = 16 + (ms >> 5); tt = ms & 31; }
        const u16* cur = cA + ((size_t)m + seq + 1) * ACOLS;
        const u16* prv = cur - ACOLS;
        bf16x8 xw[2], xa[2], xg[5];
#pragma unroll
        for (int s = 0; s < 9; ++s) {
            float xs[8];
            lerp8(cur, prv, p.mu, 1536 + s * 32 + g * 8, xs);
            if (s < 2) {
#pragma unroll
                for (int i = 0; i < 8; ++i) xs[i] = 1.f - 2.f / (__expf(2.f * xs[i]) + 1.f);
                xw[s] = packfrag(xs);
            } else if (s < 4) {
                xa[s - 2] = packfrag(xs);
            } else {
#pragma unroll
                for (int i = 0; i < 8; ++i) xs[i] = sigmoidf_(xs[i]);
                xg[s - 4] = packfrag(xs);
            }
        }
        for (int h = 0; h < 8; ++h) {
            float kkr[16], av[16];
            float ssq = 0.f, rkacc = 0.f;
            const size_t sirow = isP ? ((size_t)(seq * 8 + h) * 4096 + tt) : ((size_t)128 * 4096 + (size_t)((seq - 16) * 8 + h) * 32 + tt);
            u16* sib = SI + sirow * 384;
#pragma unroll
            for (int nt = 0; nt < 4; ++nt) {
                const int wrow = h * 64 + nt * 16 + l16;
                f32x4 accw = {0.f, 0.f, 0.f, 0.f}, acca = accw, accg = accw;
#pragma unroll
                for (int s = 0; s < 2; ++s) {
                    accw = MFMA(*(const bf16x8*)(w2t + wrow * 64 + s * 32 + g * 8), xw[s], accw);
                    acca = MFMA(*(const bf16x8*)(a2t + wrow * 64 + s * 32 + g * 8), xa[s], acca);
                }
#pragma unroll
                for (int s = 0; s < 5; ++s) accg = MFMA(*(const bf16x8*)(g2t + wrow * 160 + s * 32 + g * 8), xg[s], accg);
                const int ch = h * 64 + nt * 16 + g * 4;
                float xr[4], xk[4], xv[4];
                lerp4(cur, prv, p.mu, ch, xr);
                lerp4(cur, prv, p.mu, 512 + ch, xk);
                lerp4(cur, prv, p.mu, 1024 + ch, xv);
                const float4 w0 = *(const float4*)(p.w0 + ch), a0 = *(const float4*)(p.a0 + ch), kk4 = *(const float4*)(p.k_k + ch),
                             ka4 = *(const float4*)(p.k_a + ch), rk4 = *(const float4*)(p.r_k + ch);
                const float w0a[4] = {w0.x, w0.y, w0.z, w0.w}, a0a[4] = {a0.x, a0.y, a0.z, a0.w}, kka[4] = {kk4.x, kk4.y, kk4.z, kk4.w},
                            kaa[4] = {ka4.x, ka4.y, ka4.z, ka4.w}, rka[4] = {rk4.x, rk4.y, rk4.z, rk4.w};
                float ev[4], kp[4];
#pragma unroll
                for (int r = 0; r < 4; ++r) {
                    const float z = -(w0a[r] + accw[r]);
                    const float sp = (z > 20.f) ? z : __logf(1.f + __expf(z));
                    ev[r] = __expf(-sp - 0.5f);
                    const float a = sigmoidf_(a0a[r] + acca[r]);
                    const float kraw = xk[r] * kka[r];
                    ssq += kraw * kraw;
                    kp[r] = xk[r] * (1.f + (a - 1.f) * kaa[r]);
                    rkacc += xr[r] * kp[r] * rka[r];
                    kkr[nt * 4 + r] = kraw;
                    av[nt * 4 + r] = a;
                }
                const int co = nt * 16 + g * 4;
                *(uint2*)(sib + 0 * 64 + co) = pk4(xr[0], xr[1], xr[2], xr[3]);
                *(uint2*)(sib + 1 * 64 + co) = pk4(ev[0], ev[1], ev[2], ev[3]);
                *(uint2*)(sib + 2 * 64 + co) = pk4(kp[0], kp[1], kp[2], kp[3]);
                *(uint2*)(sib + 3 * 64 + co) = pk4(xv[0], xv[1], xv[2], xv[3]);
                *(uint2*)(Gb + (size_t)m * 512 + ch) = pk4(accg[0], accg[1], accg[2], accg[3]);
            }
            ssq = red_g(ssq);
            rkacc = red_g(rkacc);
            const float inv = rsqrtf(fmaxf(ssq, 1e-24f));
#pragma unroll
            for (int nt = 0; nt < 4; ++nt) {
                const int co = nt * 16 + g * 4;
                float k0 = kkr[nt * 4 + 0] * inv, k1 = kkr[nt * 4 + 1] * inv, k2 = kkr[nt * 4 + 2] * inv, k3 = kkr[nt * 4 + 3] * inv;
                *(uint2*)(sib + 4 * 64 + co) = pk4(k0, k1, k2, k3);
                *(uint2*)(sib + 5 * 64 + co) = pk4(k0 * av[nt * 4 + 0], k1 * av[nt * 4 + 1], k2 * av[nt * 4 + 2], k3 * av[nt * 4 + 3]);
            }
            if (g == 0) rk[(size_t)m * 8 + h] = rkacc;
        }
    }
}

__device__ __forceinline__ void scan_item(const Params& p, const u16* __restrict__ si, int nch, const float* __restrict__ s0, float* __restrict__ sout,
                          size_t m0, int h, unsigned char* smem) {
    float* inb = (float*)smem;
    float* ybuf = (float*)(smem + 49152);
    unsigned char* ws = p.ws;
    const u16* Gb = (const u16*)(ws + O_G);
    const float* rk = (const float*)(ws + O_RK);
    u16* ya = (u16*)(ws + O_YA);
    const int tid = threadIdx.x;
    const int vp = tid >> 3, kq = tid & 7;
    float S0[8], S1[8];
    if (s0) {
        const float4 a = *(const float4*)(s0 + (vp * 2) * 64 + kq * 8), b = *(const float4*)(s0 + (vp * 2) * 64 + kq * 8 + 4);
        const float4 c = *(const float4*)(s0 + (vp * 2 + 1) * 64 + kq * 8), d = *(const float4*)(s0 + (vp * 2 + 1) * 64 + kq * 8 + 4);
        S0[0] = a.x; S0[1] = a.y; S0[2] = a.z; S0[3] = a.w; S0[4] = b.x; S0[5] = b.y; S0[6] = b.z; S0[7] = b.w;
        S1[0] = c.x; S1[1] = c.y; S1[2] = c.z; S1[3] = c.w; S1[4] = d.x; S1[5] = d.y; S1[6] = d.z; S1[7] = d.w;
    } else {
#pragma unroll
        for (int j = 0; j < 8; ++j) { S0[j] = 0.f; S1[j] = 0.f; }
    }
    uint4 st0, st1, st2;
    st0 = *(const uint4*)(si + (size_t)(0 * 256 + tid) * 8);
    st1 = *(const uint4*)(si + (size_t)(1 * 256 + tid) * 8);
    st2 = *(const uint4*)(si + (size_t)(2 * 256 + tid) * 8);
#define S_WRITE1(sv, i, buf)                                                                                          \
    {                                                                                                                 \
        const int idx = (i) * 256 + tid;                                                                              \
        const int vec = (idx % 48) >> 3;                                                                              \
        float v[8] = {bflo(sv.x), bfhi(sv.x), bflo(sv.y), bfhi(sv.y), bflo(sv.z), bfhi(sv.z), bflo(sv.w), bfhi(sv.w)}; \
        if (vec == 1) {                                                                                               \
            _Pragma("unroll") for (int k = 0; k < 8; ++k) v[k] = __expf(-v[k]);                                       \
        }                                                                                                             \
        float* d = inb + (buf) * 6144 + idx * 8;                                                                      \
        *(float4*)d = make_float4(v[0], v[1], v[2], v[3]);                                                            \
        *(float4*)(d + 4) = make_float4(v[4], v[5], v[6], v[7]);                                                      \
    }
#define stage_write(buf) S_WRITE1(st0, 0, buf) S_WRITE1(st1, 1, buf) S_WRITE1(st2, 2, buf)
    stage_write(0)
    __syncthreads();
    for (int c = 0; c < nch; ++c) {
        const int buf = c & 1;
        if (c + 1 < nch) {
            const u16* sn = si + (size_t)(c + 1) * 6144 + (size_t)tid * 8;
            st0 = *(const uint4*)(sn);
            st1 = *(const uint4*)(sn + 2048);
            st2 = *(const uint4*)(sn + 4096);
        }
        const float* cb = inb + buf * 6144;
#pragma unroll 2
        for (int tt = 0; tt < 16; ++tt) {
            const float* base = cb + tt * 384;
            float kk[8], dd[8], bb[8], kv[8], rr[8];
#define LD8(dst, off)                                                      \
    {                                                                      \
        const float4 q0 = *(const float4*)(base + (off) + kq * 8);         \
        const float4 q1 = *(const float4*)(base + (off) + kq * 8 + 4);     \
        dst[0] = q0.x; dst[1] = q0.y; dst[2] = q0.z; dst[3] = q0.w;        \
        dst[4] = q1.x; dst[5] = q1.y; dst[6] = q1.z; dst[7] = q1.w;        \
    }
            LD8(kk, 256) LD8(dd, 64) LD8(bb, 320) LD8(kv, 128) LD8(rr, 0)
            const float2 vv = *(const float2*)(base + 192 + vp * 2);
            float sa0 = 0.f, sa1 = 0.f;
#pragma unroll
            for (int j = 0; j < 8; ++j) { sa0 += S0[j] * kk[j]; sa1 += S1[j] * kk[j]; }
            sa0 = -red8(sa0);
            sa1 = -red8(sa1);
            float y0 = 0.f, y1 = 0.f;
#pragma unroll
            for (int j = 0; j < 8; ++j) {
                S0[j] = S0[j] * dd[j] + (sa0 * bb[j] + vv.x * kv[j]);
                S1[j] = S1[j] * dd[j] + (sa1 * bb[j] + vv.y * kv[j]);
                y0 += S0[j] * rr[j];
                y1 += S1[j] * rr[j];
            }
            y0 = red8(y0);
            y1 = red8(y1);
            if (kq == 0) *(float2*)(ybuf + tt * 64 + vp * 2) = make_float2(y0, y1);
        }
        __syncthreads();
        {
            const int tt = tid >> 4, cq = (tid & 15) * 4;
            const float4 y = *(const float4*)(ybuf + tt * 64 + cq);
            const float mean = red16(y.x + y.y + y.z + y.w) * (1.f / 64.f);
            const float d0 = y.x - mean, d1 = y.y - mean, d2 = y.z - mean, d3 = y.w - mean;
            const float var = red16(d0 * d0 + d1 * d1 + d2 * d2 + d3 * d3) * (1.f / 64.f);
            const float rstd = rsqrtf(var + 64e-5f);
            const size_t m = m0 + (size_t)c * 16 + tt;
            const float rkv = rk[m * 8 + h];
            const float4 v4 = *(const float4*)(cb + tt * 384 + 192 + cq);
            const uint2 gg = *(const uint2*)(Gb + m * 512 + h * 64 + cq);
            const float4 lw = *(const float4*)(p.ln_w + h * 64 + cq), lb = *(const float4*)(p.ln_b + h * 64 + cq);
            const float o0 = (d0 * rstd * lw.x + lb.x + rkv * v4.x) * bflo(gg.x);
            const float o1 = (d1 * rstd * lw.y + lb.y + rkv * v4.y) * bfhi(gg.x);
            const float o2 = (d2 * rstd * lw.z + lb.z + rkv * v4.z) * bflo(gg.y);
            const float o3 = (d3 * rstd * lw.w + lb.w + rkv * v4.w) * bfhi(gg.y);
            *(uint2*)(ya + m * 512 + h * 64 + cq) = pk4(o0, o1, o2, o3);
        }
        if (c + 1 < nch) { stage_write(buf ^ 1) }
        __syncthreads();
    }
    {
        float* d0 = sout + (vp * 2) * 64 + kq * 8;
        float* d1 = sout + (vp * 2 + 1) * 64 + kq * 8;
        *(float4*)d0 = make_float4(S0[0], S0[1], S0[2], S0[3]);
        *(float4*)(d0 + 4) = make_float4(S0[4], S0[5], S0[6], S0[7]);
        *(float4*)d1 = make_float4(S1[0], S1[1], S1[2], S1[3]);
        *(float4*)(d1 + 4) = make_float4(S1[4], S1[5], S1[6], S1[7]);
    }
}

constexpr int KLD = 136, VLD = 72;
__device__ __forceinline__ void attn_item(const u16* __restrict__ Q, int nq, const u16* __restrict__ K, const u16* __restrict__ Vt, int ldv, int nkt,
                          int lastvalid, u16* __restrict__ O, float lam, const float* __restrict__ subln, unsigned char* smem) {
    u16* sK = (u16*)smem;
    u16* sV = (u16*)(smem + 2 * 64 * KLD * 2);
    float* ex = (float*)smem;
    const int tid = threadIdx.x, lane = tid & 63, wid = tid >> 6, l16 = lane & 15, g = lane >> 4;
    const int n = wid >> 1, qh = wid & 1;
    const bool active = (qh * 32) < nq;
    bf16x8 qf[2][2];
#pragma unroll
    for (int qt = 0; qt < 2; ++qt)
#pragma unroll
        for (int s = 0; s < 2; ++s) {
            const int row = qh * 32 + qt * 16 + l16;
            uint4 v = make_uint4(0, 0, 0, 0);
            if (row < nq) v = *(const uint4*)(Q + (size_t)row * 512 + n * 64 + s * 32 + g * 8);
            qf[qt][s] = as_frag(v);
        }
    f32x4 o[2][8];
#pragma unroll
    for (int qt = 0; qt < 2; ++qt)
#pragma unroll
        for (int et = 0; et < 8; ++et) o[qt][et] = (f32x4){0.f, 0.f, 0.f, 0.f};
    float mrow[2] = {-1e30f, -1e30f}, lrow[2] = {0.f, 0.f};
    uint4 kr0, kr1, kr2, kr3, vr0, vr1, vr2, vr3;
    const int krow = tid >> 4, kch = (tid & 15) * 8;
    const int vrow = tid >> 3, vch = (tid & 7) * 8;
    const u16* kp_ = K + (size_t)krow * 512 + kch;
    const u16* vp_ = Vt + (size_t)vrow * ldv + vch;
#define A_LOAD(key0)                                                      \
    kr0 = *(const uint4*)(kp_ + (size_t)((key0) + 0) * 512);              \
    kr1 = *(const uint4*)(kp_ + (size_t)((key0) + 16) * 512);             \
    kr2 = *(const uint4*)(kp_ + (size_t)((key0) + 32) * 512);             \
    kr3 = *(const uint4*)(kp_ + (size_t)((key0) + 48) * 512);             \
    vr0 = *(const uint4*)(vp_ + (key0));                                  \
    vr1 = *(const uint4*)(vp_ + (size_t)32 * ldv + (key0));               \
    vr2 = *(const uint4*)(vp_ + (size_t)64 * ldv + (key0));               \
    vr3 = *(const uint4*)(vp_ + (size_t)96 * ldv + (key0));
#define A_STORE(nb)                                                       \
    *(uint4*)(sK + (nb) * 64 * KLD + (krow + 0) * KLD + kch) = kr0;       \
    *(uint4*)(sK + (nb) * 64 * KLD + (krow + 16) * KLD + kch) = kr1;      \
    *(uint4*)(sK + (nb) * 64 * KLD + (krow + 32) * KLD + kch) = kr2;      \
    *(uint4*)(sK + (nb) * 64 * KLD + (krow + 48) * KLD + kch) = kr3;      \
    *(uint4*)(sV + (nb) * 128 * VLD + (vrow + 0) * VLD + vch) = vr0;      \
    *(uint4*)(sV + (nb) * 128 * VLD + (vrow + 32) * VLD + vch) = vr1;     \
    *(uint4*)(sV + (nb) * 128 * VLD + (vrow + 64) * VLD + vch) = vr2;     \
    *(uint4*)(sV + (nb) * 128 * VLD + (vrow + 96) * VLD + vch) = vr3;
    A_LOAD(0)
    A_STORE(0)
    __syncthreads();
    constexpr float SC = 0.125f * 1.4426950408889634f;
    for (int kt = 0; kt < nkt; ++kt) {
        const int buf = kt & 1;
        if (kt + 1 < nkt) { A_LOAD((kt + 1) * 64) }
        __builtin_amdgcn_sched_barrier(0);
        if (active) {
            const int valid = (kt == nkt - 1) ? lastvalid : 64;
            const u16* cK = sK + buf * 64 * KLD + l16 * KLD + n * 64 + g * 8;
            const u16* cV = sV + buf * 128 * VLD + l16 * VLD + g * 4;
            f32x4 s[4][2];
#pragma unroll
            for (int k16 = 0; k16 < 4; ++k16) {
                const bf16x8 kf0 = *(const bf16x8*)(cK + k16 * 16 * KLD);
                const bf16x8 kf1 = *(const bf16x8*)(cK + k16 * 16 * KLD + 32);
#pragma unroll
                for (int qt = 0; qt < 2; ++qt) {
                    f32x4 z = {0.f, 0.f, 0.f, 0.f};
                    z = MFMA(kf0, qf[qt][0], z);
                    s[k16][qt] = MFMA(kf1, qf[qt][1], z);
                }
            }
            bf16x8 pf[2][2];
#pragma unroll
            for (int qt = 0; qt < 2; ++qt) {
                float mx = -1e30f;
#pragma unroll
                for (int k16 = 0; k16 < 4; ++k16)
#pragma unroll
                    for (int r = 0; r < 4; ++r) {
                        float v = s[k16][qt][r] * SC;
                        if (k16 * 16 >= valid) v = -1e30f;
                        s[k16][qt][r] = v;
                        mx = fmaxf(mx, v);
                    }
                mx = fmaxf(mx, __shfl_xor(mx, 16));
                mx = fmaxf(mx, __shfl_xor(mx, 32));
                const float mnew = fmaxf(mrow[qt], mx);
                const float alpha = exp2f(mrow[qt] - mnew);
                mrow[qt] = mnew;
                float psum = 0.f;
#pragma unroll
                for (int k16 = 0; k16 < 4; ++k16)
#pragma unroll
                    for (int r = 0; r < 4; ++r) {
                        const float pv = exp2f(s[k16][qt][r] - mnew);
                        s[k16][qt][r] = pv;
                        psum += pv;
                    }
                lrow[qt] = lrow[qt] * alpha + psum;
#pragma unroll
                for (int et = 0; et < 8; ++et) {
                    o[qt][et][0] *= alpha; o[qt][et][1] *= alpha; o[qt][et][2] *= alpha; o[qt][et][3] *= alpha;
                }
#pragma unroll
                for (int kb = 0; kb < 2; ++kb)
                    pf[qt][kb] = as_frag(make_uint4(pk2(s[2 * kb][qt][0], s[2 * kb][qt][1]), pk2(s[2 * kb][qt][2], s[2 * kb][qt][3]),
                                                    pk2(s[2 * kb + 1][qt][0], s[2 * kb + 1][qt][1]), pk2(s[2 * kb + 1][qt][2], s[2 * kb + 1][qt][3])));
            }
#pragma unroll
            for (int et = 0; et < 8; ++et)
#pragma unroll
                for (int kb = 0; kb < 2; ++kb) {
                    const uint2 lo = *(const uint2*)(cV + et * 16 * VLD + kb * 32);
                    const uint2 hi = *(const uint2*)(cV + et * 16 * VLD + kb * 32 + 16);
                    const bf16x8 vf = as_frag(make_uint4(lo.x, lo.y, hi.x, hi.y));
#pragma unroll
                    for (int qt = 0; qt < 2; ++qt) o[qt][et] = MFMA(vf, pf[qt][kb], o[qt][et]);
                }
        }
        __builtin_amdgcn_sched_barrier(0);
        if (kt + 1 < nkt) { A_STORE(buf ^ 1) }
        __syncthreads();
    }
    float inv[2];
#pragma unroll
    for (int qt = 0; qt < 2; ++qt) {
        const float l = red_g(lrow[qt]);
        inv[qt] = 1.f / fmaxf(l, 1e-30f);
    }
    if (active && n == 1) {
#pragma unroll
        for (int qt = 0; qt < 2; ++qt)
#pragma unroll
            for (int et = 0; et < 8; ++et) {
                const f32x4 v = o[qt][et];
                *(float4*)(ex + (qh * 32 + qt * 16 + l16) * 132 + et * 16 + g * 4) =
                    make_float4(v[0] * inv[qt], v[1] * inv[qt], v[2] * inv[qt], v[3] * inv[qt]);
            }
    }
    __syncthreads();
    if (active && n == 0) {
#pragma unroll
        for (int qt = 0; qt < 2; ++qt) {
            const int row = qh * 32 + qt * 16 + l16;
            float ss = 0.f;
#pragma unroll
            for (int et = 0; et < 8; ++et) {
                const float4 o2 = *(const float4*)(ex + row * 132 + et * 16 + g * 4);
                f32x4 v = o[qt][et];
                v[0] = v[0] * inv[qt] - lam * o2.x;
                v[1] = v[1] * inv[qt] - lam * o2.y;
                v[2] = v[2] * inv[qt] - lam * o2.z;
                v[3] = v[3] * inv[qt] - lam * o2.w;
                o[qt][et] = v;
                ss += v[0] * v[0] + v[1] * v[1] + v[2] * v[2] + v[3] * v[3];
            }
            ss = red_g(ss);
            const float rn = rsqrtf(ss * (1.f / 128.f) + EPS) * 0.8f;
            if (row < nq) {
#pragma unroll
                for (int et = 0; et < 8; ++et) {
                    const float4 sl = *(const float4*)(subln + et * 16 + g * 4);
                    const f32x4 v = o[qt][et];
                    *(uint2*)(O + (size_t)row * 512 + et * 16 + g * 4) = pk4(v[0] * rn * sl.x, v[1] * rn * sl.y, v[2] * rn * sl.z, v[3] * rn * sl.w);
                }
            }
        }
    }
    __syncthreads();
}

__device__ __forceinline__ void phase3(const Params& p, unsigned char* smem) {
    unsigned char* ws = p.ws;
    int* s_item = (int*)(smem + LDS_BYTES - 16);
    unsigned* ctr = (unsigned*)(ws + O_SCAL) + 1;
    const float lam = ((const float*)(ws + O_SCAL))[0];
    const u16* SI = (const u16*)(ws + O_SI);
    const u16* qb = (const u16*)(ws + O_QB);
    const u16* kP = (const u16*)(ws + O_KP);
    const u16* kS = (const u16*)(ws + O_KS);
    const u16* vtP = (const u16*)(ws + O_VTP);
    const u16* vtS = (const u16*)(ws + O_VTS);
    u16* ob = (u16*)(ws + O_OB);
    constexpr int NITEMS = 128 + 4096 + 128 + 256;
    int stage = 0;
    for (;;) {
        if (threadIdx.x == 0) {
            int it;
            if (stage == 0) it = (blockIdx.x < 128) ? (int)blockIdx.x : ((blockIdx.x < 384) ? (int)blockIdx.x - 128 + (128 + 4096 + 128) : -1);
            else {
                const int x = blockIdx.x & 7;
                const int i = (int)atomicAdd(ctr + 16 + x, 1u);
                if (i < 512) it = 128 + (((i >> 3) << 6) | (x + 8 * (i & 7)));
                else if (i < 528) it = 128 + 4096 + (x + 8 * (i - 512));
                else it = 1 << 30;
            }
            *s_item = it;
        }
        __syncthreads();
        const int item = *s_item;
        __syncthreads();
        if (item >= NITEMS) break;
        if (item < 0) {
        } else if (item < 128 || item >= 128 + 4096 + 128) {
            const u16* si; int nch; const float* s0; float* sout; size_t m0; int h;
            if (item < 128) {
                h = item & 7;
                si = SI + (size_t)item * 4096 * 384; nch = 256; s0 = nullptr;
                sout = p.out + OFF_WP + (size_t)item * 4096; m0 = (size_t)(item >> 3) * 4096;
            } else {
                const int idx = item - (128 + 4096 + 128);
                h = idx & 7;
                si = SI + ((size_t)128 * 4096 + (size_t)idx * 32) * 384; nch = 2; s0 = p.state_wkv + (size_t)idx * 4096;
                sout = p.out + OFF_WS + (size_t)idx * 4096; m0 = (size_t)TP + (size_t)(idx >> 3) * 32;
            }
            scan_item(p, si, nch, s0, sout, m0, h, smem);
        } else {
            const u16 *Q, *K, *Vt; u16* O; int nq, ldv, nkt, lastvalid;
            if (item < 128 + 4096) {
                const int idx = item - 128;
                const int c = 63 - (idx >> 6), bh = idx & 63, b = bh >> 2, h = bh & 3;
                const size_t m0 = (size_t)b * 4096 + (size_t)c * 64;
                Q = qb + m0 * 512 + h * 128; nq = 64; K = kP + (size_t)b * 4096 * 512 + h * 128;
                Vt = vtP + ((size_t)b * 512 + h * 128) * 4096; ldv = 4096; nkt = c + 1; lastvalid = 64; O = ob + m0 * 512 + h * 128;
            } else {
                const int idx = item - (128 + 4096);
                const int b = idx >> 2, h = idx & 3;
                const size_t m0 = (size_t)TP + (size_t)b * 32;
                Q = qb + m0 * 512 + h * 128; nq = 32; K = kS + (size_t)b * LKS * 512 + h * 128;
                Vt = vtS + ((size_t)b * 512 + h * 128) * LKS; ldv = LKS; nkt = 17; lastvalid = 32; O = ob + m0 * 512 + h * 128;
            }
            attn_item(Q, nq, K, Vt, ldv, nkt, lastvalid, O, lam, p.subln, smem);
        }
        if (stage == 0) {
            asm volatile("s_waitcnt vmcnt(0) lgkmcnt(0)" ::: "memory");
            cg::this_grid().sync();
            stage = 1;
        }
    }
}

__device__ __forceinline__ void phase4g(const Params& p, unsigned char* smem) {
    unsigned char* ws = p.ws;
    const u16* Wg = (const u16*)(ws + O_WIN) + (size_t)3360 * 1024;
    const float* rs1 = (const float*)(ws + O_RS1);
    u16* gate = (u16*)(ws + O_GATE);
    const int tid = threadIdx.x, lane = tid & 63, wid = tid >> 6, wm = wid >> 1, wn = wid & 1, l16 = lane & 15, g = lane >> 4;
    constexpr int NT = 16;
    for (int t = blockIdx.x; t < 520 * NT; t += gridDim.x) {
        int mtile, ntile;
        tile_map(t, NT, mtile, ntile);
        const int m0 = mtile * 128, n0 = ntile * 128;
        const float* xs = (m0 < TP) ? p.x_prompt + (size_t)m0 * 1024 : p.x_sample + (size_t)(m0 - TP) * 1024;
        f32x4 acc[4][4];
        zero_acc(acc);
        gemm_loop_xf32(xs, Wg + (size_t)n0 * 1024, 1024, 16, (u16*)smem, acc);
#pragma unroll
        for (int mt = 0; mt < 4; ++mt) {
            const int m = m0 + wm * 64 + mt * 16 + l16;
            const float rs = rs1[m];
#pragma unroll
            for (int nt = 0; nt < 4; ++nt) {
                const int n = n0 + wn * 64 + nt * 16 + g * 4;
                const float4 bg = *(const float4*)(p.b_gate + n);
                const f32x4 v = acc[nt][mt];
                *(uint2*)(gate + (size_t)m * 2048 + n) =
                    pk4(sigmoidf_(v[0] * rs + bg.x), sigmoidf_(v[1] * rs + bg.y), sigmoidf_(v[2] * rs + bg.z), sigmoidf_(v[3] * rs + bg.w));
            }
        }
    }
}

__device__ __forceinline__ void phase4(const Params& p, unsigned char* smem) {
    unsigned char* ws = p.ws;
    const u16* ya = (const u16*)(ws + O_YA);
    const u16* ob = (const u16*)(ws + O_OB);
    const u16* Wa = (const u16*)(ws + O_WOA);
    const u16* Wb = (const u16*)(ws + O_WOB);
    const u16* gate = (const u16*)(ws + O_GATE);
    u16* mix = (u16*)(ws + O_MIX);
    const int tid = threadIdx.x, lane = tid & 63, wid = tid >> 6, wm = wid >> 1, wn = wid & 1, l16 = lane & 15, g = lane >> 4;
    constexpr int NT = 8;
    for (int t = blockIdx.x; t < 520 * NT; t += gridDim.x) {
        int mtile, ntile;
        tile_map(t, NT, mtile, ntile);
        const int m0 = mtile * 128, n0 = ntile * 128;
        f32x4 acc[4][4], acc2[4][4];
        zero_acc(acc);
        zero_acc(acc2);
        gemm_loop(ya + (size_t)m0 * 512, 512, Wa + (size_t)n0 * 512, 512, 8, (u16*)smem, acc);
        gemm_loop(ob + (size_t)m0 * 512, 512, Wb + (size_t)n0 * 512, 512, 8, (u16*)smem, acc2);
#pragma unroll
        for (int mt = 0; mt < 4; ++mt) {
            const int m = m0 + wm * 64 + mt * 16 + l16;
#pragma unroll
            for (int nt = 0; nt < 4; ++nt) {
                const int n = n0 + wn * 64 + nt * 16 + g * 4;
                const uint2 ga = *(const uint2*)(gate + (size_t)m * 2048 + n);
                const uint2 gb = *(const uint2*)(gate + (size_t)m * 2048 + 1024 + n);
                const f32x4 a = acc[nt][mt], b = acc2[nt][mt];
                *(uint2*)(mix + (size_t)m * 1024 + n) =
                    pk4(bflo(ga.x) * a[0] + bflo(gb.x) * b[0], bfhi(ga.x) * a[1] + bfhi(gb.x) * b[1],
                        bflo(ga.y) * a[2] + bflo(gb.y) * b[2], bfhi(ga.y) * a[3] + bfhi(gb.y) * b[3]);
            }
        }
    }
}

__device__ __forceinline__ void gemm_rowss(const u16* A, int K, const u16* W, u16* outb, float* ssq, unsigned char* smem) {
    const int tid = threadIdx.x, lane = tid & 63, wid = tid >> 6, wm = wid >> 1, wn = wid & 1, l16 = lane & 15, g = lane >> 4;
    constexpr int NT = 8;
    for (int t = blockIdx.x; t < 520 * NT; t += gridDim.x) {
        int mtile, ntile;
        tile_map(t, NT, mtile, ntile);
        const int m0 = mtile * 128, n0 = ntile * 128;
        f32x4 acc[4][4];
        zero_acc(acc);
        gemm_loop(A + (size_t)m0 * K, K, W + (size_t)n0 * K, K, K / 64, (u16*)smem, acc);
#pragma unroll
        for (int mt = 0; mt < 4; ++mt) {
            const int m = m0 + wm * 64 + mt * 16 + l16;
#pragma unroll
            for (int nt = 0; nt < 4; ++nt) {
                const int n = n0 + wn * 64 + nt * 16 + g * 4;
                const f32x4 a = acc[nt][mt];
                *(uint2*)(outb + (size_t)m * 1024 + n) = pk4(a[0], a[1], a[2], a[3]);
            }
        }
    }
}

__device__ __forceinline__ float sum16(const float* q) {
    const float4 a = *(const float4*)q, b = *(const float4*)(q + 4), c = *(const float4*)(q + 8), d = *(const float4*)(q + 12);
    return ((a.x + a.y) + (a.z + a.w)) + ((b.x + b.y) + (b.z + b.w)) + (((c.x + c.y) + (c.z + c.w)) + ((d.x + d.y) + (d.z + d.w)));
}
__device__ __forceinline__ void phase6(const Params& p) {
    unsigned char* ws = p.ws;
    const u16* m2 = (const u16*)(ws + O_M2);
    u16* x1b = (u16*)(ws + O_X1B);
    float* rs3 = (float*)(ws + O_RS3);
    const int lane = threadIdx.x & 63, wid = threadIdx.x >> 6;
    for (int m = blockIdx.x * 4 + wid; m < T; m += gridDim.x * 4) {
        const float* xr = (m < TP) ? p.x_prompt + (size_t)m * 1024 : p.x_sample + (size_t)(m - TP) * 1024;
        uint2 mvv[4];
        float s2 = 0.f;
#pragma unroll
        for (int i = 0; i < 4; ++i) {
            mvv[i] = *(const uint2*)(m2 + (size_t)m * 1024 + i * 256 + lane * 4);
            const float a = bflo(mvv[i].x), b = bfhi(mvv[i].x), c = bflo(mvv[i].y), d = bfhi(mvv[i].y);
            s2 += a * a + b * b + c * c + d * d;
        }
        s2 = wave_sum(s2);
        const float rs = rsqrtf(s2 * (1.f / 1024.f) + EPS);
        float ss = 0.f;
#pragma unroll
        for (int i = 0; i < 4; ++i) {
            const int col = i * 256 + lane * 4;
            const float4 xv = *(const float4*)(xr + col);
            const uint2 mv = mvv[i];
            const float4 gp = *(const float4*)(p.n_mix_post + col);
            float4 r;
            r.x = xv.x + bflo(mv.x) * rs * gp.x;
            r.y = xv.y + bfhi(mv.x) * rs * gp.y;
            r.z = xv.z + bflo(mv.y) * rs * gp.z;
            r.w = xv.w + bfhi(mv.y) * rs * gp.w;
            ss += r.x * r.x + r.y * r.y + r.z * r.z + r.w * r.w;
            *(float4*)(p.out + (size_t)m * 1024 + col) = r;
            *(uint2*)(x1b + (size_t)m * 1024 + col) = pk4(r.x, r.y, r.z, r.w);
        }
        ss = wave_sum(ss);
        if (lane == 0) rs3[m] = rsqrtf(ss * (1.f / 1024.f) + EPS);
    }
}

__device__ __forceinline__ void phase7(const Params& p, unsigned char* smem) {
    unsigned char* ws = p.ws;
    const u16* x1b = (const u16*)(ws + O_X1B);
    const u16* W = (const u16*)(ws + O_WFI);
    const float* rs3 = (const float*)(ws + O_RS3);
    u16* hb = (u16*)(ws + O_HB);
    const int tid = threadIdx.x, lane = tid & 63, wid = tid >> 6, wm = wid >> 1, wn = wid & 1, l16 = lane & 15, g = lane >> 4;
    constexpr int NT = 44;
    for (int t = blockIdx.x; t < 520 * NT; t += gridDim.x) {
        int mtile, ntile;
        tile_map(t, NT, mtile, ntile);
        const int m0 = mtile * 128, n0 = ntile * 128;
        f32x4 acc[4][4];
        zero_acc(acc);
        gemm_loop(x1b + (size_t)m0 * 1024, 1024, W + (size_t)n0 * 1024, 1024, 16, (u16*)smem, acc);
#pragma unroll
        for (int mt = 0; mt < 4; ++mt) {
            const int m = m0 + wm * 64 + mt * 16 + l16;
            const float rs = rs3[m];
#pragma unroll
            for (int pr = 0; pr < 2; ++pr) {
                const f32x4 ug = acc[2 * pr][mt], uv = acc[2 * pr + 1][mt];
                const int j = ((n0 + wn * 64) >> 5) * 16 + pr * 16 + g * 4;
                float hv[4];
#pragma unroll
                for (int r = 0; r < 4; ++r) {
                    const float a = ug[r] * rs, b = uv[r] * rs;
                    hv[r] = a * sigmoidf_(a) * b;
                }
                *(uint2*)(hb + (size_t)m * 2816 + j) = pk4(hv[0], hv[1], hv[2], hv[3]);
            }
        }
    }
}

__device__ __forceinline__ void phase9(const Params& p) {
    unsigned char* ws = p.ws;
    const u16* fb = (const u16*)(ws + O_FB);
    const int lane = threadIdx.x & 63, wid = threadIdx.x >> 6;
    for (int m = blockIdx.x * 4 + wid; m < T; m += gridDim.x * 4) {
        uint2 fvv[4];
        float s2 = 0.f;
#pragma unroll
        for (int i = 0; i < 4; ++i) {
            fvv[i] = *(const uint2*)(fb + (size_t)m * 1024 + i * 256 + lane * 4);
            const float a = bflo(fvv[i].x), b = bfhi(fvv[i].x), c = bflo(fvv[i].y), d = bfhi(fvv[i].y);
            s2 += a * a + b * b + c * c + d * d;
        }
        s2 = wave_sum(s2);
        const float rs = rsqrtf(s2 * (1.f / 1024.f) + EPS);
#pragma unroll
        for (int i = 0; i < 4; ++i) {
            const int col = i * 256 + lane * 4;
            float4 r = *(const float4*)(p.out + (size_t)m * 1024 + col);
            const uint2 fv = fvv[i];
            const float4 gp = *(const float4*)(p.n_ffn_post + col);
            r.x += bflo(fv.x) * rs * gp.x;
            r.y += bfhi(fv.x) * rs * gp.y;
            r.z += bflo(fv.y) * rs * gp.z;
            r.w += bfhi(fv.y) * rs * gp.w;
            *(float4*)(p.out + (size_t)m * 1024 + col) = r;
        }
    }
}

__global__ void __launch_bounds__(256, 2) mega(Params p) {
    extern __shared__ __attribute__((aligned(16))) unsigned char smem[];
    cg::grid_group grid = cg::this_grid();
#define IN(k) (p.ph_lo <= (k) && (k) < p.ph_hi)
#define SEAM(k) if (IN(k) && IN((k) + 1)) { asm volatile("s_waitcnt vmcnt(0) lgkmcnt(0)" ::: "memory"); grid.sync(); }
    unsigned char* ws = p.ws;
    if (IN(0)) phase0(p, smem);
    SEAM(0)
    if (IN(1)) phase1(p, smem);
    SEAM(1)
    if (IN(2)) phase2(p);
    SEAM(2)
    if (IN(3)) phase3(p, smem);
    SEAM(3)
    if (IN(4)) phase4g(p, smem);
    SEAM(4)
    if (IN(5)) phase4(p, smem);
    SEAM(5)
    if (IN(6)) gemm_rowss((const u16*)(ws + O_MIX), 1024, (const u16*)(ws + O_WO), (u16*)(ws + O_M2), (float*)(ws + O_SS2), smem);
    SEAM(6)
    if (IN(7)) phase6(p);
    SEAM(7)
    if (IN(8)) phase7(p, smem);
    SEAM(8)
    if (IN(9)) gemm_rowss((const u16*)(ws + O_HB), 2816, (const u16*)(ws + O_WFO), (u16*)(ws + O_FB), (float*)(ws + O_SS4), smem);
    SEAM(9)
    if (IN(10)) phase9(p);
}

extern "C" void kernel_launch(void* const* d_in, const int* in_sizes, int n_in, void* d_out, int out_size, void* d_ws, size_t ws_size,
                              hipStream_t stream) {
    static int grid_blocks = 0;
    if (!grid_blocks) {
        int dev = 0, cus = 0, per_cu = 0;
        hipGetDevice(&dev);
        hipDeviceGetAttribute(&cus, hipDeviceAttributeMultiprocessorCount, dev);
        hipFuncSetAttribute((const void*)mega, hipFuncAttributeMaxDynamicSharedMemorySize, LDS_BYTES);
        hipOccupancyMaxActiveBlocksPerMultiprocessor(&per_cu, (const void*)mega, 256, LDS_BYTES);
        if (per_cu < 1) per_cu = 1;
        if (per_cu > 2) per_cu = 2;
        grid_blocks = cus * per_cu;
        if (ws_size < WS_END) fprintf(stderr, "kernel_launch: workspace too small: %zu < %zu\n", ws_size, (size_t)WS_END);
    }
    Params p{};
    const float** pp = (const float**)&p;
    for (int i = 0; i < 33; ++i) pp[i] = (const float*)d_in[i];
    p.out = (float*)d_out;
    p.ws = (unsigned char*)d_ws;
#ifndef MULTI_LAUNCH
    p.ph_lo = 0;
    p.ph_hi = 11;
    void* args[] = {&p};
    hipError_t e = hipLaunchCooperativeKernel((const void*)mega, dim3(grid_blocks), dim3(256), args, LDS_BYTES, stream);
    if (e != hipSuccess) fprintf(stderr, "cooperative launch failed: %s (grid %d)\n", hipGetErrorString(e), grid_blocks);
#else
    for (int k = 0; k < 11; ++k) {
        p.ph_lo = k;
        p.ph_hi = k + 1;
        hipLaunchKernelGGL(mega, dim3(grid_blocks), dim3(256), LDS_BYTES, stream, p);
    }
#endif
}
```

```cpp
#include <hip/hip_runtime.h>
#include <hip/hip_cooperative_groups.h>
#include <cstdio>
#include <cstdint>
namespace cg = cooperative_groups;

typedef unsigned short u16;
typedef __attribute__((ext_vector_type(8))) short bf16x8;
typedef __attribute__((ext_vector_type(4))) float f32x4;

constexpr int TP = 65536, TS = 1024, T = TP + TS;
constexpr int ACOLS = 1824;
constexpr int LKS = 1088;
constexpr int LDS_BYTES = 73728;
constexpr float EPS = 1e-6f;

constexpr size_t OFF_YS = 67108864ull, OFF_KP = 68157440ull, OFF_VP = 101711872ull, OFF_WP = 135266304ull,
                 OFF_SHP = 135790592ull, OFF_KS = 135819776ull, OFF_VS = 136344064ull, OFF_WS = 136868352ull,
                 OFF_SHS = 137916928ull;

constexpr size_t al(size_t x) { return (x + 255) & ~(size_t)255; }
constexpr size_t O_WIN = 0;
constexpr size_t O_WOA = O_WIN + al(5504ull * 1024 * 2);
constexpr size_t O_WOB = O_WOA + al(1024ull * 512 * 2);
constexpr size_t O_WO = O_WOB + al(1024ull * 512 * 2);
constexpr size_t O_WFI = O_WO + al(1024ull * 1024 * 2);
constexpr size_t O_WFO = O_WFI + al(5632ull * 1024 * 2);
constexpr size_t O_W2 = O_WFO + al(1024ull * 2816 * 2);
constexpr size_t O_A2 = O_W2 + al(512 * 64 * 2);
constexpr size_t O_G2 = O_A2 + al(512 * 64 * 2);
constexpr size_t O_RS1 = O_G2 + al(512 * 160 * 2);
constexpr size_t O_SS2 = O_RS1 + al((size_t)T * 4);
constexpr size_t O_SS4 = O_SS2 + al((size_t)T * 16 * 4);
constexpr size_t O_RS3 = O_SS4 + al((size_t)T * 16 * 4);
constexpr size_t O_RK = O_RS3 + al((size_t)T * 4);
constexpr size_t O_SCAL = O_RK + al((size_t)T * 8 * 16);
constexpr size_t O_REGA = O_SCAL + 256;
constexpr size_t O_CA = O_REGA;
constexpr size_t O_YA = O_REGA;
constexpr size_t O_OB = O_YA + al((size_t)T * 512 * 2);
constexpr size_t O_HB = O_REGA;
constexpr size_t O_REGB = O_REGA + al((size_t)(T + 48) * 1824 * 2);
constexpr size_t O_QB = O_REGB;
constexpr size_t O_KP = O_QB + al((size_t)T * 512 * 2);
constexpr size_t O_KS = O_KP + al((size_t)TP * 512 * 2);
constexpr size_t O_VTP = O_KS + al(32ull * LKS * 512 * 2);
constexpr size_t O_VTS = O_VTP + al(16ull * 512 * 4096 * 2);
constexpr size_t O_REGC = O_VTS + al(32ull * 512 * LKS * 2);
constexpr size_t O_GATE = O_REGB;
static_assert(O_GATE + (size_t)T * 2048 * 2 <= O_REGC, "gate overlaps region C");
constexpr size_t O_SI = O_REGC;
constexpr size_t O_G = O_SI + al((size_t)T * 8 * 384 * 2);
constexpr size_t O_XB = O_REGC;
constexpr size_t O_MIX = O_REGC;
constexpr size_t O_M2 = O_MIX + al((size_t)T * 1024 * 2);
constexpr size_t O_X1B = O_M2 + al((size_t)T * 1024 * 2);
constexpr size_t O_FB = O_REGC;
constexpr size_t WS_END = O_G + al((size_t)T * 512 * 2);
static_assert(O_HB + (size_t)T * 2816 * 2 <= O_REGC, "hb overlaps region C");
static_assert(O_X1B + (size_t)T * 1024 * 2 <= WS_END, "x1b beyond end");
static_assert(WS_END <= 1073741824ull, "workspace too large");

struct Params {
    const float *x_prompt, *x_sample, *cache_k, *cache_v, *state_wkv, *state_shift;
    const float *n_mix_pre, *n_mix_post, *n_ffn_pre, *n_ffn_post, *w_in, *b_gate;
    const float *mu, *w0, *w2, *a0, *a2, *g2, *k_k, *k_a, *r_k, *ln_w, *ln_b;
    const float *lq1, *lk1, *lq2, *lk2, *subln, *w_out_a, *w_out_b, *w_o, *w_ffn_in, *w_ffn_out;
    float* out;
    unsigned char* ws;
    int ph_lo, ph_hi;
};

__device__ __forceinline__ u16 f2bf(float f) {
    unsigned u = __float_as_uint(f);
    u += 0x7fffu + ((u >> 16) & 1u);
    return (u16)(u >> 16);
}
__device__ __forceinline__ unsigned pk2(float a, float b) { return (unsigned)f2bf(a) | ((unsigned)f2bf(b) << 16); }
__device__ __forceinline__ float bflo(unsigned u) { return __uint_as_float(u << 16); }
__device__ __forceinline__ float bfhi(unsigned u) { return __uint_as_float(u & 0xffff0000u); }
__device__ __forceinline__ uint2 pk4(float a, float b, float c, float d) { return make_uint2(pk2(a, b), pk2(c, d)); }
__device__ __forceinline__ float sigmoidf_(float x) { return 1.f / (1.f + __expf(-x)); }

template <int CTRL>
__device__ __forceinline__ float dppf(float x) {
    return __int_as_float(__builtin_amdgcn_update_dpp(0, __float_as_int(x), CTRL, 0xF, 0xF, true));
}
__device__ __forceinline__ float red8(float x) {
    x += dppf<0xB1>(x);
    x += dppf<0x4E>(x);
    x += dppf<0x141>(x);
    return x;
}
__device__ __forceinline__ float red16(float x) {
    x = red8(x);
    x += dppf<0x140>(x);
    return x;
}
__device__ __forceinline__ float red_g(float x) {
    x += __shfl_xor(x, 16);
    x += __shfl_xor(x, 32);
    return x;
}
__device__ __forceinline__ float wave_sum(float x) {
    x = red16(x);
    return red_g(x);
}
__device__ __forceinline__ bf16x8 as_frag(uint4 v) {
    union { uint4 u; bf16x8 f; } c;
    c.u = v;
    return c.f;
}
#define MFMA(a, b, c) __builtin_amdgcn_mfma_f32_16x16x32_bf16((a), (b), (c), 0, 0, 0)

constexpr int LDT = 72;
constexpr int STG = 128 * LDT;
__device__ __forceinline__ void gemm_loop(const u16* __restrict__ A, int lda, const u16* __restrict__ B, int ldb,
                                          int nkt, u16* smem, f32x4 (&acc)[4][4]) {
    const int tid = threadIdx.x, lane = tid & 63, wid = tid >> 6, wm = wid >> 1, wn = wid & 1, l16 = lane & 15, g = lane >> 4;
    const int lr = tid >> 3, lc = (tid & 7) * 8;
    u16* sA = smem;
    u16* sB = smem + 2 * STG;
    const u16* ap = A + (size_t)lr * lda + lc;
    const u16* bp = B + (size_t)lr * ldb + lc;
    uint4 ra0, ra1, ra2, ra3, rb0, rb1, rb2, rb3;
#define G_LOAD(ko)                                                   \
    ra0 = *(const uint4*)(ap + (ko));                                \
    ra1 = *(const uint4*)(ap + (size_t)32 * lda + (ko));             \
    ra2 = *(const uint4*)(ap + (size_t)64 * lda + (ko));             \
    ra3 = *(const uint4*)(ap + (size_t)96 * lda + (ko));             \
    rb0 = *(const uint4*)(bp + (ko));                                \
    rb1 = *(const uint4*)(bp + (size_t)32 * ldb + (ko));             \
    rb2 = *(const uint4*)(bp + (size_t)64 * ldb + (ko));             \
    rb3 = *(const uint4*)(bp + (size_t)96 * ldb + (ko));
#define G_STORE(bo)                                                  \
    *(uint4*)(sA + (bo) + (lr + 0) * LDT + lc) = ra0;                \
    *(uint4*)(sA + (bo) + (lr + 32) * LDT + lc) = ra1;               \
    *(uint4*)(sA + (bo) + (lr + 64) * LDT + lc) = ra2;               \
    *(uint4*)(sA + (bo) + (lr + 96) * LDT + lc) = ra3;               \
    *(uint4*)(sB + (bo) + (lr + 0) * LDT + lc) = rb0;                \
    *(uint4*)(sB + (bo) + (lr + 32) * LDT + lc) = rb1;               \
    *(uint4*)(sB + (bo) + (lr + 64) * LDT + lc) = rb2;               \
    *(uint4*)(sB + (bo) + (lr + 96) * LDT + lc) = rb3;
    G_LOAD(0)
    G_STORE(0)
    __syncthreads();
    for (int kt = 0; kt < nkt; ++kt) {
        const int buf = kt & 1;
        if (kt + 1 < nkt) { G_LOAD((kt + 1) * 64) }
        __builtin_amdgcn_sched_barrier(0);
        const u16* cA = sA + buf * STG + (wm * 64 + l16) * LDT + g * 8;
        const u16* cB = sB + buf * STG + (wn * 64 + l16) * LDT + g * 8;
#pragma unroll
        for (int ks = 0; ks < 2; ++ks) {
            bf16x8 xf[4], wf[4];
#pragma unroll
            for (int i = 0; i < 4; ++i) {
                xf[i] = *(const bf16x8*)(cA + i * 16 * LDT + ks * 32);
                wf[i] = *(const bf16x8*)(cB + i * 16 * LDT + ks * 32);
            }
#pragma unroll
            for (int nt = 0; nt < 4; ++nt)
#pragma unroll
                for (int mt = 0; mt < 4; ++mt) acc[nt][mt] = MFMA(wf[nt], xf[mt], acc[nt][mt]);
        }
        __builtin_amdgcn_sched_barrier(0);
        if (kt + 1 < nkt) { G_STORE((buf ^ 1) * STG) }
        __syncthreads();
    }
}
__device__ __forceinline__ void gemm_loop_xf32(const float* __restrict__ A, const u16* __restrict__ B, int ldb, int nkt, u16* smem,
                                               f32x4 (&acc)[4][4]) {
    const int tid = threadIdx.x, lane = tid & 63, wid = tid >> 6, wm = wid >> 1, wn = wid & 1, l16 = lane & 15, g = lane >> 4;
    const int lr = tid >> 3, lc = (tid & 7) * 8;
    u16* sA = smem;
    u16* sB = smem + 2 * STG;
    const float* ap = A + (size_t)lr * 1024 + lc;
    const u16* bp = B + (size_t)lr * ldb + lc;
    float4 fa0, fa1, fa2, fa3, fa4, fa5, fa6, fa7;
    uint4 rb0, rb1, rb2, rb3;
#define GX_LOAD(ko)                                                  \
    fa0 = *(const float4*)(ap + (ko));                               \
    fa1 = *(const float4*)(ap + (ko) + 4);                           \
    fa2 = *(const float4*)(ap + 32 * 1024 + (ko));                   \
    fa3 = *(const float4*)(ap + 32 * 1024 + (ko) + 4);               \
    fa4 = *(const float4*)(ap + 64 * 1024 + (ko));                   \
    fa5 = *(const float4*)(ap + 64 * 1024 + (ko) + 4);               \
    fa6 = *(const float4*)(ap + 96 * 1024 + (ko));                   \
    fa7 = *(const float4*)(ap + 96 * 1024 + (ko) + 4);               \
    rb0 = *(const uint4*)(bp + (ko));                                \
    rb1 = *(const uint4*)(bp + (size_t)32 * ldb + (ko));             \
    rb2 = *(const uint4*)(bp + (size_t)64 * ldb + (ko));             \
    rb3 = *(const uint4*)(bp + (size_t)96 * ldb + (ko));
#define PKF(a, b) make_uint4(pk2(a.x, a.y), pk2(a.z, a.w), pk2(b.x, b.y), pk2(b.z, b.w))
#define GX_STORE(bo)                                                 \
    *(uint4*)(sA + (bo) + (lr + 0) * LDT + lc) = PKF(fa0, fa1);      \
    *(uint4*)(sA + (bo) + (lr + 32) * LDT + lc) = PKF(fa2, fa3);     \
    *(uint4*)(sA + (bo) + (lr + 64) * LDT + lc) = PKF(fa4, fa5);     \
    *(uint4*)(sA + (bo) + (lr + 96) * LDT + lc) = PKF(fa6, fa7);     \
    *(uint4*)(sB + (bo) + (lr + 0) * LDT + lc) = rb0;                \
    *(uint4*)(sB + (bo) + (lr + 32) * LDT + lc) = rb1;               \
    *(uint4*)(sB + (bo) + (lr + 64) * LDT + lc) = rb2;               \
    *(uint4*)(sB + (bo) + (lr + 96) * LDT + lc) = rb3;
    GX_LOAD(0)
    GX_STORE(0)
    __syncthreads();
    for (int kt = 0; kt < nkt; ++kt) {
        const int buf = kt & 1;
        if (kt + 1 < nkt) { GX_LOAD((kt + 1) * 64) }
        __builtin_amdgcn_sched_barrier(0);
        const u16* cA = sA + buf * STG + (wm * 64 + l16) * LDT + g * 8;
        const u16* cB = sB + buf * STG + (wn * 64 + l16) * LDT + g * 8;
#pragma unroll
        for (int ks = 0; ks < 2; ++ks) {
            bf16x8 xf[4], wf[4];
#pragma unroll
            for (int i = 0; i < 4; ++i) {
                xf[i] = *(const bf16x8*)(cA + i * 16 * LDT + ks * 32);
                wf[i] = *(const bf16x8*)(cB + i * 16 * LDT + ks * 32);
            }
#pragma unroll
            for (int nt = 0; nt < 4; ++nt)
#pragma unroll
                for (int mt = 0; mt < 4; ++mt) acc[nt][mt] = MFMA(wf[nt], xf[mt], acc[nt][mt]);
        }
        __builtin_amdgcn_sched_barrier(0);
        if (kt + 1 < nkt) { GX_STORE((buf ^ 1) * STG) }
        __syncthreads();
    }
}
__device__ __forceinline__ void zero_acc(f32x4 (&acc)[4][4]) {
#pragma unroll
    for (int i = 0; i < 4; ++i)
#pragma unroll
        for (int j = 0; j < 4; ++j) acc[i][j] = (f32x4){0.f, 0.f, 0.f, 0.f};
}
__device__ __forceinline__ void tile_map(int t, int NT, int& mt, int& nt) {
    const int x = t & 7, u = t >> 3;
    const int gsz = 8 * NT;
    const int g = u / gsz;
    const int w = u - g * gsz;
    const int rows = (g < 8) ? 8 : 1;
    const int q = w / rows;
    mt = x * 65 + g * 8 + (w - q * rows);
    nt = q;
}

__device__ __forceinline__ void tr_tile(const float* __restrict__ in, int R, int C, int ldin, u16* __restrict__ out, int ldout,
                        const float* __restrict__ scale, int r0, int c0, int Cout, bool perm, float* tile) {
    const int tid = threadIdx.x;
    {
        const int tx = tid & 63, ty = tid >> 6;
        const int c = c0 + tx;
        for (int rr = ty; rr < 64; rr += 4) {
            const int r = r0 + rr;
            float v = 0.f;
            if (r < R && c < C) {
                v = in[(size_t)r * ldin + c];
                if (scale) v *= scale[r];
            }
            tile[rr * 65 + tx] = v;
        }
    }
    __syncthreads();
    {
        const int rch = (tid & 7) * 8;
#pragma unroll
        for (int pass = 0; pass < 2; ++pass) {
            const int cc = (tid >> 3) + pass * 32;
            const int c = c0 + cc;
            if (c < Cout && r0 + rch < R) {
                float v[8];
#pragma unroll
                for (int k = 0; k < 8; ++k) v[k] = tile[(rch + k) * 65 + cc];
                int orow = c;
                if (perm) {
                    const int type = c >= 2816 ? 1 : 0;
                    const int j = c - type * 2816;
                    orow = (j >> 4) * 32 + type * 16 + (j & 15);
                }
                uint4 o = make_uint4(pk2(v[0], v[1]), pk2(v[2], v[3]), pk2(v[4], v[5]), pk2(v[6], v[7]));
                *(uint4*)(out + (size_t)orow * ldout + r0 + rch) = o;
            }
        }
    }
    __syncthreads();
}

__device__ __forceinline__ void phase0(const Params& p, unsigned char* smem) {
    float* tile = (float*)smem;
    const int tid = threadIdx.x, lane = tid & 63, wid = tid >> 6;
    unsigned char* ws = p.ws;
    const int G = gridDim.x;
    for (int u = blockIdx.x; u < 8136; u += G) {
        const float* in;
        int R, C, Cout, ldout, tl;
        u16* out;
        const float* scale = nullptr;
        bool perm = false;
        if (u < 1376) { tl = u; in = p.w_in; R = 1024; C = 5408; Cout = 5504; out = (u16*)(ws + O_WIN); ldout = 1024; scale = p.n_mix_pre; }
        else if (u < 1504) { tl = u - 1376; in = p.w_out_a; R = 512; C = 1024; Cout = 1024; out = (u16*)(ws + O_WOA); ldout = 512; }
        else if (u < 1632) { tl = u - 1504; in = p.w_out_b; R = 512; C = 1024; Cout = 1024; out = (u16*)(ws + O_WOB); ldout = 512; }
        else if (u < 1888) { tl = u - 1632; in = p.w_o; R = 1024; C = 1024; Cout = 1024; out = (u16*)(ws + O_WO); ldout = 1024; }
        else if (u < 3296) { tl = u - 1888; in = p.w_ffn_in; R = 1024; C = 5632; Cout = 5632; out = (u16*)(ws + O_WFI); ldout = 1024; scale = p.n_ffn_pre; perm = true; }
        else if (u < 4000) { tl = u - 3296; in = p.w_ffn_out; R = 2816; C = 1024; Cout = 1024; out = (u16*)(ws + O_WFO); ldout = 2816; }
        else if (u < 4008) { tl = u - 4000; in = p.w2; R = 64; C = 512; Cout = 512; out = (u16*)(ws + O_W2); ldout = 64; }
        else if (u < 4016) { tl = u - 4008; in = p.a2; R = 64; C = 512; Cout = 512; out = (u16*)(ws + O_A2); ldout = 64; }
        else if (u < 4040) { tl = u - 4016; in = p.g2; R = 160; C = 512; Cout = 512; out = (u16*)(ws + O_G2); ldout = 160; }
        else {
            tl = u - 4040;
            const int b = tl >> 7;
            tl &= 127;
            in = p.cache_v + (size_t)b * 1024 * 512; R = 1024; C = 512; Cout = 512;
            out = (u16*)(ws + O_VTS) + (size_t)b * 512 * LKS; ldout = LKS;
        }
        const int ctiles = (Cout + 63) >> 6;
        const int rt = tl / ctiles, ct = tl - rt * ctiles;
        tr_tile(in, R, C, C, out, ldout, scale, rt * 64, ct * 64, Cout, perm, tile);
    }
    {
        u16* xb = (u16*)(ws + O_XB);
        float* rs1 = (float*)(ws + O_RS1);
        for (int m = blockIdx.x * 4 + wid; m < T; m += G * 4) {
            const float* xr = (m < TP) ? p.x_prompt + (size_t)m * 1024 : p.x_sample + (size_t)(m - TP) * 1024;
            float ss = 0.f;
#pragma unroll
            for (int i = 0; i < 4; ++i) {
                const float4 v = *(const float4*)(xr + i * 256 + lane * 4);
                ss += v.x * v.x + v.y * v.y + v.z * v.z + v.w * v.w;
                *(uint2*)(xb + (size_t)m * 1024 + i * 256 + lane * 4) = pk4(v.x, v.y, v.z, v.w);
            }
            ss = wave_sum(ss);
            if (lane == 0) rs1[m] = rsqrtf(ss * (1.f / 1024.f) + EPS);
        }
    }
    {
        u16* kS = (u16*)(ws + O_KS);
        const int n8 = 32 * 1024 * 64;
        for (int i = blockIdx.x * 256 + tid; i < n8; i += G * 256) {
            const int b = i >> 16, rem = i & 65535, key = rem >> 6, c8 = rem & 63;
            const float4 v0 = *(const float4*)(p.cache_k + (size_t)i * 8);
            const float4 v1 = *(const float4*)(p.cache_k + (size_t)i * 8 + 4);
            *(uint4*)(kS + ((size_t)b * LKS + key) * 512 + c8 * 8) =
                make_uint4(pk2(v0.x, v0.y), pk2(v0.z, v0.w), pk2(v1.x, v1.y), pk2(v1.z, v1.w));
        }
        for (int i = blockIdx.x * 256 + tid; i < 32 * 32 * 64; i += G * 256) {
            const int b = i >> 11, rem = i & 2047, row = rem >> 6, c8 = rem & 63;
            *(uint4*)(kS + ((size_t)b * LKS + 1056 + row) * 512 + c8 * 8) = make_uint4(0, 0, 0, 0);
        }
        u16* vtS = (u16*)(ws + O_VTS);
        for (int i = blockIdx.x * 256 + tid; i < 32 * 512 * 4; i += G * 256) {
            const int row = i >> 2, c8 = i & 3;
            *(uint4*)(vtS + (size_t)row * LKS + 1056 + c8 * 8) = make_uint4(0, 0, 0, 0);
        }
    }
    {
        u16* cA = (u16*)(ws + O_CA);
        for (int i = blockIdx.x * 256 + tid; i < 48 * ACOLS; i += G * 256) {
            const int s = i / ACOLS, c = i - s * ACOLS;
            float v = 0.f;
            size_t row;
            if (s < 16) row = (size_t)s * 4097;
            else { row = (size_t)16 * 4097 + (size_t)(s - 16) * 33; v = p.state_shift[(size_t)(s - 16) * ACOLS + c]; }
            cA[row * ACOLS + c] = f2bf(v);
        }
        if (blockIdx.x == 0 && tid == 0) {
            float d1 = 0.f, d2 = 0.f;
            for (int i = 0; i < 64; ++i) { d1 += p.lq1[i] * p.lk1[i]; d2 += p.lq2[i] * p.lk2[i]; }
            float* sc = (float*)(ws + O_SCAL);
            sc[0] = __expf(d1) - __expf(d2) + 0.2f;
            for (int i = 1; i < 32; ++i) ((unsigned*)sc)[i] = 0u;
        }
    }
}

__device__ __forceinline__ void phase1(const Params& p, unsigned char* smem) {
    unsigned char* ws = p.ws;
    const u16* xb = (const u16*)(ws + O_XB);
    const u16* W = (const u16*)(ws + O_WIN);
    const float* rs1 = (const float*)(ws + O_RS1);
    u16* cA = (u16*)(ws + O_CA);
    u16* qb = (u16*)(ws + O_QB);
    u16* kP = (u16*)(ws + O_KP);
    u16* kS = (u16*)(ws + O_KS);
    u16* vtP = (u16*)(ws + O_VTP);
    u16* vtS = (u16*)(ws + O_VTS);
    float* out = p.out;
    const int tid = threadIdx.x, lane = tid & 63, wid = tid >> 6, wm = wid >> 1, wn = wid & 1, l16 = lane & 15, g = lane >> 4;
    constexpr int NT = 27;
    for (int t = blockIdx.x; t < 520 * NT; t += gridDim.x) {
        int mtile, ntile;
        tile_map(t, NT, mtile, ntile);
        const int m0 = mtile * 128, n0 = ntile * 128;
        f32x4 acc[4][4];
        zero_acc(acc);
        gemm_loop(xb + (size_t)m0 * 1024, 1024, W + (size_t)n0 * 1024, 1024, 16, (u16*)smem, acc);
#pragma unroll
        for (int mt = 0; mt < 4; ++mt) {
            const int m = m0 + wm * 64 + mt * 16 + l16;
            const float rs = rs1[m];
            const bool isP = m < TP;
            int seq, tt;
            if (isP) { seq = m >> 12; tt = m & 4095; }
            else { const int ms = m - TP; seq = 16 + (ms >> 5); tt = ms & 31; }
            const size_t carow = (size_t)m + seq + 1;
            const bool last = isP ? (tt == 4095) : (tt == 31);
#pragma unroll
            for (int nt = 0; nt < 4; ++nt) {
                const int n = n0 + wn * 64 + nt * 16 + g * 4;
                if (n >= 3360) continue;
                f32x4 v = acc[nt][mt];
                v[0] *= rs; v[1] *= rs; v[2] *= rs; v[3] *= rs;
                if (n < 1824) {
                    *(uint2*)(cA + carow * ACOLS + n) = pk4(v[0], v[1], v[2], v[3]);
                    if (last) {
                        float* so = isP ? out + OFF_SHP + (size_t)seq * ACOLS + n : out + OFF_SHS + (size_t)(seq - 16) * ACOLS + n;
                        *(float4*)so = make_float4(v[0], v[1], v[2], v[3]);
                    }
                } else if (n < 2336) {
                    *(uint2*)(qb + (size_t)m * 512 + (n - 1824)) = pk4(v[0], v[1], v[2], v[3]);
                } else if (n < 2848) {
                    const int c = n - 2336;
                    if (isP) {
                        *(uint2*)(kP + (size_t)m * 512 + c) = pk4(v[0], v[1], v[2], v[3]);
                        *(float4*)(out + OFF_KP + (size_t)m * 512 + c) = make_float4(v[0], v[1], v[2], v[3]);
                    } else {
                        *(uint2*)(kS + ((size_t)(seq - 16) * LKS + 1024 + tt) * 512 + c) = pk4(v[0], v[1], v[2], v[3]);
                        *(float4*)(out + OFF_KS + (size_t)(m - TP) * 512 + c) = make_float4(v[0], v[1], v[2], v[3]);
                    }
                } else {
                    const int c = n - 2848;
                    if (isP) {
                        *(float4*)(out + OFF_VP + (size_t)m * 512 + c) = make_float4(v[0], v[1], v[2], v[3]);
                        u16* d = vtP + ((size_t)seq * 512 + c) * 4096 + tt;
                        d[0] = f2bf(v[0]); d[4096] = f2bf(v[1]); d[2 * 4096] = f2bf(v[2]); d[3 * 4096] = f2bf(v[3]);
                    } else {
                        *(float4*)(out + OFF_VS + (size_t)(m - TP) * 512 + c) = make_float4(v[0], v[1], v[2], v[3]);
                        u16* d = vtS + ((size_t)(seq - 16) * 512 + c) * LKS + 1024 + tt;
                        d[0] = f2bf(v[0]); d[LKS] = f2bf(v[1]); d[2 * LKS] = f2bf(v[2]); d[3 * LKS] = f2bf(v[3]);
                    }
                }
            }
        }
    }
}

__device__ __forceinline__ void lerp8(const u16* cur, const u16* prv, const float* mu, int col, float (&xs)[8]) {
    const uint4 cu = *(const uint4*)(cur + col);
    const uint4 pv = *(const uint4*)(prv + col);
    const float4 m0 = *(const float4*)(mu + col);
    const float4 m1 = *(const float4*)(mu + col + 4);
    const unsigned cw[4] = {cu.x, cu.y, cu.z, cu.w}, pw[4] = {pv.x, pv.y, pv.z, pv.w};
    const float mm[8] = {m0.x, m0.y, m0.z, m0.w, m1.x, m1.y, m1.z, m1.w};
#pragma unroll
    for (int i = 0; i < 4; ++i) {
        const float c0 = bflo(cw[i]), c1 = bfhi(cw[i]), p0 = bflo(pw[i]), p1 = bfhi(pw[i]);
        xs[2 * i] = c0 + (p0 - c0) * mm[2 * i];
        xs[2 * i + 1] = c1 + (p1 - c1) * mm[2 * i + 1];
    }
}
__device__ __forceinline__ void lerp4(const u16* cur, const u16* prv, const float* mu, int col, float (&xs)[4]) {
    const uint2 cu = *(const uint2*)(cur + col);
    const uint2 pv = *(const uint2*)(prv + col);
    const float4 m0 = *(const float4*)(mu + col);
    float c0 = bflo(cu.x), c1 = bfhi(cu.x), c2 = bflo(cu.y), c3 = bfhi(cu.y);
    xs[0] = c0 + (bflo(pv.x) - c0) * m0.x;
    xs[1] = c1 + (bfhi(pv.x) - c1) * m0.y;
    xs[2] = c2 + (bflo(pv.y) - c2) * m0.z;
    xs[3] = c3 + (bfhi(pv.y) - c3) * m0.w;
}
__device__ __forceinline__ bf16x8 packfrag(const float (&v)[8]) {
    return as_frag(make_uint4(pk2(v[0], v[1]), pk2(v[2], v[3]), pk2(v[4], v[5]), pk2(v[6], v[7])));
}

__device__ __forceinline__ void phase2(const Params& p) {
    unsigned char* ws = p.ws;
    const u16* cA = (const u16*)(ws + O_CA);
    const u16* w2t = (const u16*)(ws + O_W2);
    const u16* a2t = (const u16*)(ws + O_A2);
    const u16* g2t = (const u16*)(ws + O_G2);
    u16* SI = (u16*)(ws + O_SI);
    u16* Gb = (u16*)(ws + O_G);
    float4* rk4 = (float4*)(ws + O_RK);
    const int tid = threadIdx.x, lane = tid & 63, wid = tid >> 6, l16 = lane & 15, g = lane >> 4;
    for (int u = blockIdx.x; u < T / 64; u += gridDim.x) {
        const int mw = u * 64 + wid * 16;
        const int m = mw + l16;
        const bool isP = mw < TP;
        int seq, tt;
        if (isP) { seq = m >> 12; tt = m & 4095; }
        else { const int ms = m - TP; seq = 16 + (ms >> 5); tt = ms & 31; }
        const u16* cur = cA + ((size_t)m + seq + 1) * ACOLS;
        const u16* prv = cur - ACOLS;
        bf16x8 xw[2], xa[2], xg[5];
#pragma unroll
        for (int s = 0; s < 9; ++s) {
            float xs[8];
            lerp8(cur, prv, p.mu, 1536 + s * 32 + g * 8, xs);
            if (s < 2) {
#pragma unroll
                for (int i = 0; i < 8; ++i) xs[i] = 1.f - 2.f / (__expf(2.f * xs[i]) + 1.f);
                xw[s] = packfrag(xs);
            } else if (s < 4) {
                xa[s - 2] = packfrag(xs);
            } else {
#pragma unroll
                for (int i = 0; i < 8; ++i) xs[i] = sigmoidf_(xs[i]);
                xg[s - 4] = packfrag(xs);
            }
        }
        for (int h = 0; h < 8; ++h) {
            float kkr[16], av[16];
            float ssq = 0.f, rkacc = 0.f, bracc = 0.f, kracc = 0.f;
            const size_t sirow = isP ? ((size_t)(seq * 8 + h) * 4096 + tt) : ((size_t)128 * 4096 + (size_t)((seq - 16) * 8 + h) * 32 + tt);
            u16* sib = SI + sirow * 384;
#pragma unroll
            for (int nt = 0; nt < 4; ++nt) {
                const int wrow = h * 64 + nt * 16 + l16;
                f32x4 accw = {0.f, 0.f, 0.f, 0.f}, acca = accw, accg = accw;
#pragma unroll
                for (int s = 0; s < 2; ++s) {
                    accw = MFMA(*(const bf16x8*)(w2t + wrow * 64 + s * 32 + g * 8), xw[s], accw);
                    acca = MFMA(*(const bf16x8*)(a2t + wrow * 64 + s * 32 + g * 8), xa[s], acca);
                }
#pragma unroll
                for (int s = 0; s < 5; ++s) accg = MFMA(*(const bf16x8*)(g2t + wrow * 160 + s * 32 + g * 8), xg[s], accg);
                const int ch = h * 64 + nt * 16 + g * 4;
                float xr[4], xk[4], xv[4];
                lerp4(cur, prv, p.mu, ch, xr);
                lerp4(cur, prv, p.mu, 512 + ch, xk);
                lerp4(cur, prv, p.mu, 1024 + ch, xv);
                const float4 w0 = *(const float4*)(p.w0 + ch), a0 = *(const float4*)(p.a0 + ch), kk4 = *(const float4*)(p.k_k + ch),
                             ka4 = *(const float4*)(p.k_a + ch), rk4 = *(const float4*)(p.r_k + ch);
                const float w0a[4] = {w0.x, w0.y, w0.z, w0.w}, a0a[4] = {a0.x, a0.y, a0.z, a0.w}, kka[4] = {kk4.x, kk4.y, kk4.z, kk4.w},
                            kaa[4] = {ka4.x, ka4.y, ka4.z, ka4.w}, rka[4] = {rk4.x, rk4.y, rk4.z, rk4.w};
                float ev[4], kp[4], dr[4];
#pragma unroll
                for (int r = 0; r < 4; ++r) {
                    const float z = -(w0a[r] + accw[r]);
                    const float sp = (z > 20.f) ? z : __logf(1.f + __expf(z));
                    ev[r] = __expf(-sp - 0.5f);
                    const float a = sigmoidf_(a0a[r] + acca[r]);
                    const float kraw = xk[r] * kka[r];
                    ssq += kraw * kraw;
                    kp[r] = xk[r] * (1.f + (a - 1.f) * kaa[r]);
                    rkacc += xr[r] * kp[r] * rka[r];
                    kracc += xr[r] * kp[r];
                    bracc += kraw * a * xr[r];
                    dr[r] = xr[r] * __expf(-ev[r]);
                    kkr[nt * 4 + r] = kraw;
                    av[nt * 4 + r] = a;
                }
                const int co = nt * 16 + g * 4;
                *(uint2*)(sib + 0 * 64 + co) = pk4(dr[0], dr[1], dr[2], dr[3]);
                *(uint2*)(sib + 1 * 64 + co) = pk4(ev[0], ev[1], ev[2], ev[3]);
                *(uint2*)(sib + 2 * 64 + co) = pk4(kp[0], kp[1], kp[2], kp[3]);
                *(uint2*)(sib + 3 * 64 + co) = pk4(xv[0], xv[1], xv[2], xv[3]);
                *(uint2*)(Gb + (size_t)m * 512 + ch) = pk4(accg[0], accg[1], accg[2], accg[3]);
            }
            ssq = red_g(ssq);
            rkacc = red_g(rkacc);
            bracc = red_g(bracc);
            kracc = red_g(kracc);
            const float inv = rsqrtf(fmaxf(ssq, 1e-24f));
#pragma unroll
            for (int nt = 0; nt < 4; ++nt) {
                const int co = nt * 16 + g * 4;
                float k0 = kkr[nt * 4 + 0] * inv, k1 = kkr[nt * 4 + 1] * inv, k2 = kkr[nt * 4 + 2] * inv, k3 = kkr[nt * 4 + 3] * inv;
                *(uint2*)(sib + 4 * 64 + co) = pk4(k0, k1, k2, k3);
                *(uint2*)(sib + 5 * 64 + co) = pk4(k0 * av[nt * 4 + 0], k1 * av[nt * 4 + 1], k2 * av[nt * 4 + 2], k3 * av[nt * 4 + 3]);
            }
            if (g == 0) rk4[(size_t)m * 8 + h] = make_float4(rkacc, bracc * inv, kracc, 0.f);
        }
    }
}

typedef float v2f __attribute__((ext_vector_type(2)));
__device__ __forceinline__ void scan_item(const Params& p, const u16* __restrict__ si, int nch, const float* __restrict__ s0, float* __restrict__ sout,
                          size_t m0, int h, unsigned char* smem) {
    float* inb = (float*)smem;
    float* ybuf = (float*)(smem + 49152);
    float* scal = (float*)(smem + 53248);
    unsigned char* ws = p.ws;
    const u16* Gb = (const u16*)(ws + O_G);
    const float4* rk4 = (const float4*)(ws + O_RK);
    u16* ya = (u16*)(ws + O_YA);
    const int tid = threadIdx.x;
    const int vp = tid >> 3, kq = tid & 7;
    v2f S0[4], S1[4];
    if (s0) {
        const float4 a = *(const float4*)(s0 + (vp * 2) * 64 + kq * 8), b = *(const float4*)(s0 + (vp * 2) * 64 + kq * 8 + 4);
        const float4 c = *(const float4*)(s0 + (vp * 2 + 1) * 64 + kq * 8), d = *(const float4*)(s0 + (vp * 2 + 1) * 64 + kq * 8 + 4);
        S0[0] = (v2f){a.x, a.y}; S0[1] = (v2f){a.z, a.w}; S0[2] = (v2f){b.x, b.y}; S0[3] = (v2f){b.z, b.w};
        S1[0] = (v2f){c.x, c.y}; S1[1] = (v2f){c.z, c.w}; S1[2] = (v2f){d.x, d.y}; S1[3] = (v2f){d.z, d.w};
    } else {
#pragma unroll
        for (int j = 0; j < 4; ++j) { S0[j] = (v2f){0.f, 0.f}; S1[j] = (v2f){0.f, 0.f}; }
    }
    uint4 st0, st1, st2;
    float4 sq = make_float4(0.f, 0.f, 0.f, 0.f);
    st0 = *(const uint4*)(si + (size_t)(0 * 256 + tid) * 8);
    st1 = *(const uint4*)(si + (size_t)(1 * 256 + tid) * 8);
    st2 = *(const uint4*)(si + (size_t)(2 * 256 + tid) * 8);
    if (tid < 16) sq = rk4[(m0 + tid) * 8 + h];
#define S_WRITE1(sv, i, buf)                                                                                          \
    {                                                                                                                 \
        const int idx = (i) * 256 + tid;                                                                              \
        const int vec = (idx % 48) >> 3;                                                                              \
        float v[8] = {bflo(sv.x), bfhi(sv.x), bflo(sv.y), bfhi(sv.y), bflo(sv.z), bfhi(sv.z), bflo(sv.w), bfhi(sv.w)}; \
        if (vec == 1) {                                                                                               \
            _Pragma("unroll") for (int k = 0; k < 8; ++k) v[k] = __expf(-v[k]);                                       \
        }                                                                                                             \
        float* d = inb + (buf) * 6144 + idx * 8;                                                                      \
        *(float4*)d = make_float4(v[0], v[1], v[2], v[3]);                                                            \
        *(float4*)(d + 4) = make_float4(v[4], v[5], v[6], v[7]);                                                      \
    }
#define stage_write(buf) S_WRITE1(st0, 0, buf) S_WRITE1(st1, 1, buf) S_WRITE1(st2, 2, buf) if (tid < 16) *(float4*)(scal + (buf) * 64 + tid * 4) = sq;
    stage_write(0)
    __syncthreads();
    for (int c = 0; c < nch; ++c) {
        const int buf = c & 1;
        if (c + 1 < nch) {
            const u16* sn = si + (size_t)(c + 1) * 6144 + (size_t)tid * 8;
            st0 = *(const uint4*)(sn);
            st1 = *(const uint4*)(sn + 2048);
            st2 = *(const uint4*)(sn + 4096);
            if (tid < 16) sq = rk4[(m0 + (size_t)(c + 1) * 16 + tid) * 8 + h];
        }
        const float* cb = inb + buf * 6144;
        const float* cs = scal + buf * 64;
#pragma unroll 2
        for (int tt = 0; tt < 16; ++tt) {
            const float* base = cb + tt * 384;
            v2f kk[4], dr[4], dd[4], bb[4], kv[4];
#define LD8(dst, off)                                                      \
    {                                                                      \
        const float4 q0 = *(const float4*)(base + (off) + kq * 8);         \
        const float4 q1 = *(const float4*)(base + (off) + kq * 8 + 4);     \
        dst[0] = (v2f){q0.x, q0.y}; dst[1] = (v2f){q0.z, q0.w};            \
        dst[2] = (v2f){q1.x, q1.y}; dst[3] = (v2f){q1.z, q1.w};            \
    }
            LD8(kk, 256) LD8(dr, 0) LD8(dd, 64) LD8(bb, 320) LD8(kv, 128)
            const float2 vv = *(const float2*)(base + 192 + vp * 2);
            const float2 brkr = *(const float2*)(cs + tt * 4 + 1);
            v2f a0 = (v2f){0.f, 0.f}, a1 = a0, q0 = a0, q1 = a0;
#pragma unroll
            for (int j = 0; j < 4; ++j) {
                a0 = __builtin_elementwise_fma(S0[j], kk[j], a0);
                a1 = __builtin_elementwise_fma(S1[j], kk[j], a1);
                q0 = __builtin_elementwise_fma(S0[j], dr[j], q0);
                q1 = __builtin_elementwise_fma(S1[j], dr[j], q1);
            }
            float sa0 = a0.x + a0.y, sa1 = a1.x + a1.y, pp0 = q0.x + q0.y, pp1 = q1.x + q1.y;
            sa0 = -red8(sa0);
            sa1 = -red8(sa1);
            pp0 = red8(pp0);
            pp1 = red8(pp1);
            const float y0 = pp0 + sa0 * brkr.x + vv.x * brkr.y;
            const float y1 = pp1 + sa1 * brkr.x + vv.y * brkr.y;
            if (kq == 0) *(float2*)(ybuf + tt * 64 + vp * 2) = make_float2(y0, y1);
            const v2f sa0v = (v2f){sa0, sa0}, sa1v = (v2f){sa1, sa1}, v0v = (v2f){vv.x, vv.x}, v1v = (v2f){vv.y, vv.y};
#pragma unroll
            for (int j = 0; j < 4; ++j) {
                const v2f t0 = __builtin_elementwise_fma(v0v, kv[j], sa0v * bb[j]);
                const v2f t1 = __builtin_elementwise_fma(v1v, kv[j], sa1v * bb[j]);
                S0[j] = __builtin_elementwise_fma(S0[j], dd[j], t0);
                S1[j] = __builtin_elementwise_fma(S1[j], dd[j], t1);
            }
        }
        __syncthreads();
        {
            const int tt = tid >> 4, cq = (tid & 15) * 4;
            const float4 y = *(const float4*)(ybuf + tt * 64 + cq);
            const float mean = red16(y.x + y.y + y.z + y.w) * (1.f / 64.f);
            const float d0 = y.x - mean, d1 = y.y - mean, d2 = y.z - mean, d3 = y.w - mean;
            const float var = red16(d0 * d0 + d1 * d1 + d2 * d2 + d3 * d3) * (1.f / 64.f);
            const float rstd = rsqrtf(var + 64e-5f);
            const size_t m = m0 + (size_t)c * 16 + tt;
            const float rkv = cs[tt * 4];
            const float4 v4 = *(const float4*)(cb + tt * 384 + 192 + cq);
            const uint2 gg = *(const uint2*)(Gb + m * 512 + h * 64 + cq);
            const float4 lw = *(const float4*)(p.ln_w + h * 64 + cq), lb = *(const float4*)(p.ln_b + h * 64 + cq);
            const float o0 = (d0 * rstd * lw.x + lb.x + rkv * v4.x) * bflo(gg.x);
            const float o1 = (d1 * rstd * lw.y + lb.y + rkv * v4.y) * bfhi(gg.x);
            const float o2 = (d2 * rstd * lw.z + lb.z + rkv * v4.z) * bflo(gg.y);
            const float o3 = (d3 * rstd * lw.w + lb.w + rkv * v4.w) * bfhi(gg.y);
            *(uint2*)(ya + m * 512 + h * 64 + cq) = pk4(o0, o1, o2, o3);
        }
        if (c + 1 < nch) { stage_write(buf ^ 1) }
        __syncthreads();
    }
    {
        float* d0 = sout + (vp * 2) * 64 + kq * 8;
        float* d1 = sout + (vp * 2 + 1) * 64 + kq * 8;
        *(float4*)d0 = make_float4(S0[0].x, S0[0].y, S0[1].x, S0[1].y);
        *(float4*)(d0 + 4) = make_float4(S0[2].x, S0[2].y, S0[3].x, S0[3].y);
        *(float4*)d1 = make_float4(S1[0].x, S1[0].y, S1[1].x, S1[1].y);
        *(float4*)(d1 + 4) = make_float4(S1[2].x, S1[2].y, S1[3].x, S1[3].y);
    }
}

constexpr int KLD = 136, VLD = 72;
__device__ __forceinline__ void attn_item(const u16* __restrict__ Q, int nq, const u16* __restrict__ K, const u16* __restrict__ Vt, int ldv, int nkt,
                          int lastvalid, u16* __restrict__ O, float lam, const float* __restrict__ subln, unsigned char* smem) {
    u16* sK = (u16*)smem;
    u16* sV = (u16*)(smem + 2 * 64 * KLD * 2);
    float* ex = (float*)smem;
    const int tid = threadIdx.x, lane = tid & 63, wid = tid >> 6, l16 = lane & 15, g = lane >> 4;
    const int n = wid >> 1, qh = wid & 1;
    const bool active = (qh * 32) < nq;
    bf16x8 qf[2][2];
#pragma unroll
    for (int qt = 0; qt < 2; ++qt)
#pragma unroll
        for (int s = 0; s < 2; ++s) {
            const int row = qh * 32 + qt * 16 + l16;
            uint4 v = make_uint4(0, 0, 0, 0);
            if (row < nq) v = *(const uint4*)(Q + (row * 512 + n * 64 + s * 32 + g * 8));
            qf[qt][s] = as_frag(v);
        }
    f32x4 o[2][8];
#pragma unroll
    for (int qt = 0; qt < 2; ++qt)
#pragma unroll
        for (int et = 0; et < 8; ++et) o[qt][et] = (f32x4){0.f, 0.f, 0.f, 0.f};
    float mrow[2] = {-1e30f, -1e30f}, lrow[2] = {0.f, 0.f};
    uint4 kr0, kr1, kr2, kr3, vr0, vr1, vr2, vr3;
    const int krow = tid >> 4, kch = (tid & 15) * 8;
    const int vrow = tid >> 3, vch = (tid & 7) * 8;
    const int ko_ = krow * 512 + kch;
    const int vo_ = vrow * ldv + vch;
#define A_LOAD(key0)                                                      \
    kr0 = *(const uint4*)(K + (ko_ + ((key0) + 0) * 512));                \
    kr1 = *(const uint4*)(K + (ko_ + ((key0) + 16) * 512));               \
    kr2 = *(const uint4*)(K + (ko_ + ((key0) + 32) * 512));               \
    kr3 = *(const uint4*)(K + (ko_ + ((key0) + 48) * 512));               \
    vr0 = *(const uint4*)(Vt + (vo_ + (key0)));                           \
    vr1 = *(const uint4*)(Vt + (vo_ + 32 * ldv + (key0)));                \
    vr2 = *(const uint4*)(Vt + (vo_ + 64 * ldv + (key0)));                \
    vr3 = *(const uint4*)(Vt + (vo_ + 96 * ldv + (key0)));
#define A_STORE(nb)                                                       \
    *(uint4*)(sK + (nb) * 64 * KLD + (krow + 0) * KLD + kch) = kr0;       \
    *(uint4*)(sK + (nb) * 64 * KLD + (krow + 16) * KLD + kch) = kr1;      \
    *(uint4*)(sK + (nb) * 64 * KLD + (krow + 32) * KLD + kch) = kr2;      \
    *(uint4*)(sK + (nb) * 64 * KLD + (krow + 48) * KLD + kch) = kr3;      \
    *(uint4*)(sV + (nb) * 128 * VLD + (vrow + 0) * VLD + vch) = vr0;      \
    *(uint4*)(sV + (nb) * 128 * VLD + (vrow + 32) * VLD + vch) = vr1;     \
    *(uint4*)(sV + (nb) * 128 * VLD + (vrow + 64) * VLD + vch) = vr2;     \
    *(uint4*)(sV + (nb) * 128 * VLD + (vrow + 96) * VLD + vch) = vr3;
    A_LOAD(0)
    A_STORE(0)
    __syncthreads();
    constexpr float SC = 0.125f * 1.4426950408889634f;
    for (int kt = 0; kt < nkt; ++kt) {
        const int buf = kt & 1;
        if (kt + 1 < nkt) { A_LOAD((kt + 1) * 64) }
        __builtin_amdgcn_sched_barrier(0);
        if (active) {
            const int valid = (kt == nkt - 1) ? lastvalid : 64;
            const u16* cK = sK + buf * 64 * KLD + l16 * KLD + n * 64 + g * 8;
            const u16* cV = sV + buf * 128 * VLD + l16 * VLD + g * 4;
            f32x4 s[4][2];
#pragma unroll
            for (int k16 = 0; k16 < 4; ++k16) {
                const bf16x8 kf0 = *(const bf16x8*)(cK + k16 * 16 * KLD);
                const bf16x8 kf1 = *(const bf16x8*)(cK + k16 * 16 * KLD + 32);
#pragma unroll
                for (int qt = 0; qt < 2; ++qt) {
                    f32x4 z = {0.f, 0.f, 0.f, 0.f};
                    z = MFMA(kf0, qf[qt][0], z);
                    s[k16][qt] = MFMA(kf1, qf[qt][1], z);
                }
            }
            bf16x8 pf[2][2];
#pragma unroll
            for (int qt = 0; qt < 2; ++qt) {
                float mx = -1e30f;
#pragma unroll
                for (int k16 = 0; k16 < 4; ++k16)
#pragma unroll
                    for (int r = 0; r < 4; ++r) {
                        float v = s[k16][qt][r] * SC;
                        if (k16 * 16 >= valid) v = -1e30f;
                        s[k16][qt][r] = v;
                        mx = fmaxf(mx, v);
                    }
                mx = fmaxf(mx, __shfl_xor(mx, 16));
                mx = fmaxf(mx, __shfl_xor(mx, 32));
                const float mnew = fmaxf(mrow[qt], mx);
                const float alpha = exp2f(mrow[qt] - mnew);
                mrow[qt] = mnew;
                float psum = 0.f;
#pragma unroll
                for (int k16 = 0; k16 < 4; ++k16)
#pragma unroll
                    for (int r = 0; r < 4; ++r) {
                        const float pv = exp2f(s[k16][qt][r] - mnew);
                        s[k16][qt][r] = pv;
                        psum += pv;
                    }
                lrow[qt] = lrow[qt] * alpha + psum;
#pragma unroll
                for (int et = 0; et < 8; ++et) {
                    o[qt][et][0] *= alpha; o[qt][et][1] *= alpha; o[qt][et][2] *= alpha; o[qt][et][3] *= alpha;
                }
#pragma unroll
                for (int kb = 0; kb < 2; ++kb)
                    pf[qt][kb] = as_frag(make_uint4(pk2(s[2 * kb][qt][0], s[2 * kb][qt][1]), pk2(s[2 * kb][qt][2], s[2 * kb][qt][3]),
                                                    pk2(s[2 * kb + 1][qt][0], s[2 * kb + 1][qt][1]), pk2(s[2 * kb + 1][qt][2], s[2 * kb + 1][qt][3])));
            }
#pragma unroll
            for (int et = 0; et < 8; ++et)
#pragma unroll
                for (int kb = 0; kb < 2; ++kb) {
                    const uint2 lo = *(const uint2*)(cV + et * 16 * VLD + kb * 32);
                    const uint2 hi = *(const uint2*)(cV + et * 16 * VLD + kb * 32 + 16);
                    const bf16x8 vf = as_frag(make_uint4(lo.x, lo.y, hi.x, hi.y));
#pragma unroll
                    for (int qt = 0; qt < 2; ++qt) o[qt][et] = MFMA(vf, pf[qt][kb], o[qt][et]);
                }
        }
        __builtin_amdgcn_sched_barrier(0);
        if (kt + 1 < nkt) { A_STORE(buf ^ 1) }
        __syncthreads();
    }
    float inv[2];
#pragma unroll
    for (int qt = 0; qt < 2; ++qt) {
        const float l = red_g(lrow[qt]);
        inv[qt] = 1.f / fmaxf(l, 1e-30f);
    }
    if (active && n == 1) {
#pragma unroll
        for (int qt = 0; qt < 2; ++qt)
#pragma unroll
            for (int et = 0; et < 8; ++et) {
                const f32x4 v = o[qt][et];
                *(float4*)(ex + (qh * 32 + qt * 16 + l16) * 132 + et * 16 + g * 4) =
                    make_float4(v[0] * inv[qt], v[1] * inv[qt], v[2] * inv[qt], v[3] * inv[qt]);
            }
    }
    __syncthreads();
    if (active && n == 0) {
#pragma unroll
        for (int qt = 0; qt < 2; ++qt) {
            const int row = qh * 32 + qt * 16 + l16;
            float ss = 0.f;
#pragma unroll
            for (int et = 0; et < 8; ++et) {
                const float4 o2 = *(const float4*)(ex + row * 132 + et * 16 + g * 4);
                f32x4 v = o[qt][et];
                v[0] = v[0] * inv[qt] - lam * o2.x;
                v[1] = v[1] * inv[qt] - lam * o2.y;
                v[2] = v[2] * inv[qt] - lam * o2.z;
                v[3] = v[3] * inv[qt] - lam * o2.w;
                o[qt][et] = v;
                ss += v[0] * v[0] + v[1] * v[1] + v[2] * v[2] + v[3] * v[3];
            }
            ss = red_g(ss);
            const float rn = rsqrtf(ss * (1.f / 128.f) + EPS) * 0.8f;
            if (row < nq) {
#pragma unroll
                for (int et = 0; et < 8; ++et) {
                    const float4 sl = *(const float4*)(subln + et * 16 + g * 4);
                    const f32x4 v = o[qt][et];
                    *(uint2*)(O + (row * 512 + et * 16 + g * 4)) = pk4(v[0] * rn * sl.x, v[1] * rn * sl.y, v[2] * rn * sl.z, v[3] * rn * sl.w);
                }
            }
        }
    }
    __syncthreads();
}

__device__ __forceinline__ void phase3(const Params& p, unsigned char* smem) {
    unsigned char* ws = p.ws;
    int* s_item = (int*)(smem + LDS_BYTES - 16);
    unsigned* ctr = (unsigned*)(ws + O_SCAL) + 1;
    const float lam = ((const float*)(ws + O_SCAL))[0];
    const u16* SI = (const u16*)(ws + O_SI);
    const u16* qb = (const u16*)(ws + O_QB);
    const u16* kP = (const u16*)(ws + O_KP);
    const u16* kS = (const u16*)(ws + O_KS);
    const u16* vtP = (const u16*)(ws + O_VTP);
    const u16* vtS = (const u16*)(ws + O_VTS);
    u16* ob = (u16*)(ws + O_OB);
    constexpr int NITEMS = 128 + 4096 + 128 + 256;
    int stage = 0;
    for (;;) {
        if (threadIdx.x == 0) {
            int it;
            if (stage == 0) it = (blockIdx.x < 128) ? (int)blockIdx.x : ((blockIdx.x < 384) ? (int)blockIdx.x - 128 + (128 + 4096 + 128) : -1);
            else {
                const int x = blockIdx.x & 7;
                const int i = (int)atomicAdd(ctr + 16 + x, 1u);
                if (i < 512) it = 128 + (((i >> 3) << 6) | (x + 8 * (i & 7)));
                else if (i < 528) it = 128 + 4096 + (x + 8 * (i - 512));
                else it = 1 << 30;
            }
            *s_item = it;
        }
        __syncthreads();
        const int item = __builtin_amdgcn_readfirstlane(*s_item);
        __syncthreads();
        if (item >= NITEMS) break;
        if (item < 0) {
        } else if (item < 128 || item >= 128 + 4096 + 128) {
            const u16* si; int nch; const float* s0; float* sout; size_t m0; int h;
            if (item < 128) {
                h = item & 7;
                si = SI + (size_t)item * 4096 * 384; nch = 256; s0 = nullptr;
                sout = p.out + OFF_WP + (size_t)item * 4096; m0 = (size_t)(item >> 3) * 4096;
            } else {
                const int idx = item - (128 + 4096 + 128);
                h = idx & 7;
                si = SI + ((size_t)128 * 4096 + (size_t)idx * 32) * 384; nch = 2; s0 = p.state_wkv + (size_t)idx * 4096;
                sout = p.out + OFF_WS + (size_t)idx * 4096; m0 = (size_t)TP + (size_t)(idx >> 3) * 32;
            }
            scan_item(p, si, nch, s0, sout, m0, h, smem);
        } else {
            const u16 *Q, *K, *Vt; u16* O; int nq, ldv, nkt, lastvalid;
            if (item < 128 + 4096) {
                const int idx = item - 128;
                const int c = 63 - (idx >> 6), bh = idx & 63, b = bh >> 2, h = bh & 3;
                const size_t m0 = (size_t)b * 4096 + (size_t)c * 64;
                Q = qb + m0 * 512 + h * 128; nq = 64; K = kP + (size_t)b * 4096 * 512 + h * 128;
                Vt = vtP + ((size_t)b * 512 + h * 128) * 4096; ldv = 4096; nkt = c + 1; lastvalid = 64; O = ob + m0 * 512 + h * 128;
            } else {
                const int idx = item - (128 + 4096);
                const int b = idx >> 2, h = idx & 3;
                const size_t m0 = (size_t)TP + (size_t)b * 32;
                Q = qb + m0 * 512 + h * 128; nq = 32; K = kS + (size_t)b * LKS * 512 + h * 128;
                Vt = vtS + ((size_t)b * 512 + h * 128) * LKS; ldv = LKS; nkt = 17; lastvalid = 32; O = ob + m0 * 512 + h * 128;
            }
            attn_item(Q, nq, K, Vt, ldv, nkt, lastvalid, O, lam, p.subln, smem);
        }
        if (stage == 0) {
            asm volatile("s_waitcnt vmcnt(0) lgkmcnt(0)" ::: "memory");
            cg::this_grid().sync();
            stage = 1;
        }
    }
}

__device__ __forceinline__ void phase4g(const Params& p, unsigned char* smem) {
    unsigned char* ws = p.ws;
    const u16* Wg = (const u16*)(ws + O_WIN) + (size_t)3360 * 1024;
    const float* rs1 = (const float*)(ws + O_RS1);
    u16* gate = (u16*)(ws + O_GATE);
    const int tid = threadIdx.x, lane = tid & 63, wid = tid >> 6, wm = wid >> 1, wn = wid & 1, l16 = lane & 15, g = lane >> 4;
    constexpr int NT = 16;
    for (int t = blockIdx.x; t < 520 * NT; t += gridDim.x) {
        int mtile, ntile;
        tile_map(t, NT, mtile, ntile);
        const int m0 = mtile * 128, n0 = ntile * 128;
        const float* xs = (m0 < TP) ? p.x_prompt + (size_t)m0 * 1024 : p.x_sample + (size_t)(m0 - TP) * 1024;
        f32x4 acc[4][4];
        zero_acc(acc);
        gemm_loop_xf32(xs, Wg + (size_t)n0 * 1024, 1024, 16, (u16*)smem, acc);
#pragma unroll
        for (int mt = 0; mt < 4; ++mt) {
            const int m = m0 + wm * 64 + mt * 16 + l16;
            const float rs = rs1[m];
#pragma unroll
            for (int nt = 0; nt < 4; ++nt) {
                const int n = n0 + wn * 64 + nt * 16 + g * 4;
                const float4 bg = *(const float4*)(p.b_gate + n);
                const f32x4 v = acc[nt][mt];
                *(uint2*)(gate + (size_t)m * 2048 + n) =
                    pk4(sigmoidf_(v[0] * rs + bg.x), sigmoidf_(v[1] * rs + bg.y), sigmoidf_(v[2] * rs + bg.z), sigmoidf_(v[3] * rs + bg.w));
            }
        }
    }
}

__device__ __forceinline__ void phase4(const Params& p, unsigned char* smem) {
    unsigned char* ws = p.ws;
    const u16* ya = (const u16*)(ws + O_YA);
    const u16* ob = (const u16*)(ws + O_OB);
    const u16* Wa = (const u16*)(ws + O_WOA);
    const u16* Wb = (const u16*)(ws + O_WOB);
    const u16* gate = (const u16*)(ws + O_GATE);
    u16* mix = (u16*)(ws + O_MIX);
    const int tid = threadIdx.x, lane = tid & 63, wid = tid >> 6, wm = wid >> 1, wn = wid & 1, l16 = lane & 15, g = lane >> 4;
    constexpr int NT = 8;
    for (int t = blockIdx.x; t < 520 * NT; t += gridDim.x) {
        int mtile, ntile;
        tile_map(t, NT, mtile, ntile);
        const int m0 = mtile * 128, n0 = ntile * 128;
        f32x4 acc[4][4], acc2[4][4];
        zero_acc(acc);
        zero_acc(acc2);
        gemm_loop(ya + (size_t)m0 * 512, 512, Wa + (size_t)n0 * 512, 512, 8, (u16*)smem, acc);
        gemm_loop(ob + (size_t)m0 * 512, 512, Wb + (size_t)n0 * 512, 512, 8, (u16*)smem, acc2);
#pragma unroll
        for (int mt = 0; mt < 4; ++mt) {
            const int m = m0 + wm * 64 + mt * 16 + l16;
#pragma unroll
            for (int nt = 0; nt < 4; ++nt) {
                const int n = n0 + wn * 64 + nt * 16 + g * 4;
                const uint2 ga = *(const uint2*)(gate + (size_t)m * 2048 + n);
                const uint2 gb = *(const uint2*)(gate + (size_t)m * 2048 + 1024 + n);
                const f32x4 a = acc[nt][mt], b = acc2[nt][mt];
                *(uint2*)(mix + (size_t)m * 1024 + n) =
                    pk4(bflo(ga.x) * a[0] + bflo(gb.x) * b[0], bfhi(ga.x) * a[1] + bfhi(gb.x) * b[1],
                        bflo(ga.y) * a[2] + bflo(gb.y) * b[2], bfhi(ga.y) * a[3] + bfhi(gb.y) * b[3]);
            }
        }
    }
}

__device__ __forceinline__ void gemm_rowss(const u16* A, int K, const u16* W, u16* outb, float* ssq, unsigned char* smem) {
    const int tid = threadIdx.x, lane = tid & 63, wid = tid >> 6, wm = wid >> 1, wn = wid & 1, l16 = lane & 15, g = lane >> 4;
    constexpr int NT = 8;
    for (int t = blockIdx.x; t < 520 * NT; t += gridDim.x) {
        int mtile, ntile;
        tile_map(t, NT, mtile, ntile);
        const int m0 = mtile * 128, n0 = ntile * 128;
        f32x4 acc[4][4];
        zero_acc(acc);
        gemm_loop(A + (size_t)m0 * K, K, W + (size_t)n0 * K, K, K / 64, (u16*)smem, acc);
#pragma unroll
        for (int mt = 0; mt < 4; ++mt) {
            const int m = m0 + wm * 64 + mt * 16 + l16;
#pragma unroll
            for (int nt = 0; nt < 4; ++nt) {
                const int n = n0 + wn * 64 + nt * 16 + g * 4;
                const f32x4 a = acc[nt][mt];
                *(uint2*)(outb + (size_t)m * 1024 + n) = pk4(a[0], a[1], a[2], a[3]);
            }
        }
    }
}

__device__ __forceinline__ float sum16(const float* q) {
    const float4 a = *(const float4*)q, b = *(const float4*)(q + 4), c = *(const float4*)(q + 8), d = *(const float4*)(q + 12);
    return ((a.x + a.y) + (a.z + a.w)) + ((b.x + b.y) + (b.z + b.w)) + (((c.x + c.y) + (c.z + c.w)) + ((d.x + d.y) + (d.z + d.w)));
}
__device__ __forceinline__ void phase6(const Params& p) {
    unsigned char* ws = p.ws;
    const u16* m2 = (const u16*)(ws + O_M2);
    u16* x1b = (u16*)(ws + O_X1B);
    float* rs3 = (float*)(ws + O_RS3);
    const int lane = threadIdx.x & 63, wid = threadIdx.x >> 6;
    for (int m = blockIdx.x * 4 + wid; m < T; m += gridDim.x * 4) {
        const float* xr = (m < TP) ? p.x_prompt + (size_t)m * 1024 : p.x_sample + (size_t)(m - TP) * 1024;
        uint2 mvv[4];
        float s2 = 0.f;
#pragma unroll
        for (int i = 0; i < 4; ++i) {
            mvv[i] = *(const uint2*)(m2 + (size_t)m * 1024 + i * 256 + lane * 4);
            const float a = bflo(mvv[i].x), b = bfhi(mvv[i].x), c = bflo(mvv[i].y), d = bfhi(mvv[i].y);
            s2 += a * a + b * b + c * c + d * d;
        }
        s2 = wave_sum(s2);
        const float rs = rsqrtf(s2 * (1.f / 1024.f) + EPS);
        float ss = 0.f;
#pragma unroll
        for (int i = 0; i < 4; ++i) {
            const int col = i * 256 + lane * 4;
            const float4 xv = *(const float4*)(xr + col);
            const uint2 mv = mvv[i];
            const float4 gp = *(const float4*)(p.n_mix_post + col);
            float4 r;
            r.x = xv.x + bflo(mv.x) * rs * gp.x;
            r.y = xv.y + bfhi(mv.x) * rs * gp.y;
            r.z = xv.z + bflo(mv.y) * rs * gp.z;
            r.w = xv.w + bfhi(mv.y) * rs * gp.w;
            ss += r.x * r.x + r.y * r.y + r.z * r.z + r.w * r.w;
            *(float4*)(p.out + (size_t)m * 1024 + col) = r;
            *(uint2*)(x1b + (size_t)m * 1024 + col) = pk4(r.x, r.y, r.z, r.w);
        }
        ss = wave_sum(ss);
        if (lane == 0) rs3[m] = rsqrtf(ss * (1.f / 1024.f) + EPS);
    }
}

__device__ __forceinline__ void phase7(const Params& p, unsigned char* smem) {
    unsigned char* ws = p.ws;
    const u16* x1b = (const u16*)(ws + O_X1B);
    const u16* W = (const u16*)(ws + O_WFI);
    const float* rs3 = (const float*)(ws + O_RS3);
    u16* hb = (u16*)(ws + O_HB);
    const int tid = threadIdx.x, lane = tid & 63, wid = tid >> 6, wm = wid >> 1, wn = wid & 1, l16 = lane & 15, g = lane >> 4;
    constexpr int NT = 44;
    for (int t = blockIdx.x; t < 520 * NT; t += gridDim.x) {
        int mtile, ntile;
        tile_map(t, NT, mtile, ntile);
        const int m0 = mtile * 128, n0 = ntile * 128;
        f32x4 acc[4][4];
        zero_acc(acc);
        gemm_loop(x1b + (size_t)m0 * 1024, 1024, W + (size_t)n0 * 1024, 1024, 16, (u16*)smem, acc);
#pragma unroll
        for (int mt = 0; mt < 4; ++mt) {
            const int m = m0 + wm * 64 + mt * 16 + l16;
            const float rs = rs3[m];
#pragma unroll
            for (int pr = 0; pr < 2; ++pr) {
                const f32x4 ug = acc[2 * pr][mt], uv = acc[2 * pr + 1][mt];
                const int j = ((n0 + wn * 64) >> 5) * 16 + pr * 16 + g * 4;
                float hv[4];
#pragma unroll
                for (int r = 0; r < 4; ++r) {
                    const float a = ug[r] * rs, b = uv[r] * rs;
                    hv[r] = a * sigmoidf_(a) * b;
                }
                *(uint2*)(hb + (size_t)m * 2816 + j) = pk4(hv[0], hv[1], hv[2], hv[3]);
            }
        }
    }
}

__device__ __forceinline__ void phase9(const Params& p) {
    unsigned char* ws = p.ws;
    const u16* fb = (const u16*)(ws + O_FB);
    const int lane = threadIdx.x & 63, wid = threadIdx.x >> 6;
    for (int m = blockIdx.x * 4 + wid; m < T; m += gridDim.x * 4) {
        uint2 fvv[4];
        float s2 = 0.f;
#pragma unroll
        for (int i = 0; i < 4; ++i) {
            fvv[i] = *(const uint2*)(fb + (size_t)m * 1024 + i * 256 + lane * 4);
            const float a = bflo(fvv[i].x), b = bfhi(fvv[i].x), c = bflo(fvv[i].y), d = bfhi(fvv[i].y);
            s2 += a * a + b * b + c * c + d * d;
        }
        s2 = wave_sum(s2);
        const float rs = rsqrtf(s2 * (1.f / 1024.f) + EPS);
#pragma unroll
        for (int i = 0; i < 4; ++i) {
            const int col = i * 256 + lane * 4;
            float4 r = *(const float4*)(p.out + (size_t)m * 1024 + col);
            const uint2 fv = fvv[i];
            const float4 gp = *(const float4*)(p.n_ffn_post + col);
            r.x += bflo(fv.x) * rs * gp.x;
            r.y += bfhi(fv.x) * rs * gp.y;
            r.z += bflo(fv.y) * rs * gp.z;
            r.w += bfhi(fv.y) * rs * gp.w;
            *(float4*)(p.out + (size_t)m * 1024 + col) = r;
        }
    }
}

__global__ void __launch_bounds__(256, 2) mega(Params p) {
    extern __shared__ __attribute__((aligned(16))) unsigned char smem[];
    cg::grid_group grid = cg::this_grid();
#define IN(k) (p.ph_lo <= (k) && (k) < p.ph_hi)
#define SEAM(k) if (IN(k) && IN((k) + 1)) { asm volatile("s_waitcnt vmcnt(0) lgkmcnt(0)" ::: "memory"); grid.sync(); }
    unsigned char* ws = p.ws;
    if (IN(0)) phase0(p, smem);
    SEAM(0)
    if (IN(1)) phase1(p, smem);
    SEAM(1)
    if (IN(2)) phase2(p);
    SEAM(2)
    if (IN(3)) phase3(p, smem);
    SEAM(3)
    if (IN(4)) phase4g(p, smem);
    SEAM(4)
    if (IN(5)) phase4(p, smem);
    SEAM(5)
    if (IN(6)) gemm_rowss((const u16*)(ws + O_MIX), 1024, (const u16*)(ws + O_WO), (u16*)(ws + O_M2), (float*)(ws + O_SS2), smem);
    SEAM(6)
    if (IN(7)) phase6(p);
    SEAM(7)
    if (IN(8)) phase7(p, smem);
    SEAM(8)
    if (IN(9)) gemm_rowss((const u16*)(ws + O_HB), 2816, (const u16*)(ws + O_WFO), (u16*)(ws + O_FB), (float*)(ws + O_SS4), smem);
    SEAM(9)
    if (IN(10)) phase9(p);
}

extern "C" void kernel_launch(void* const* d_in, const int* in_sizes, int n_in, void* d_out, int out_size, void* d_ws, size_t ws_size,
                              hipStream_t stream) {
    static int grid_blocks = 0;
    if (!grid_blocks) {
        int dev = 0, cus = 0, per_cu = 0;
        hipGetDevice(&dev);
        hipDeviceGetAttribute(&cus, hipDeviceAttributeMultiprocessorCount, dev);
        hipFuncSetAttribute((const void*)mega, hipFuncAttributeMaxDynamicSharedMemorySize, LDS_BYTES);
        hipOccupancyMaxActiveBlocksPerMultiprocessor(&per_cu, (const void*)mega, 256, LDS_BYTES);
        if (per_cu < 1) per_cu = 1;
        if (per_cu > 2) per_cu = 2;
        grid_blocks = cus * per_cu;
        if (ws_size < WS_END) fprintf(stderr, "kernel_launch: workspace too small: %zu < %zu\n", ws_size, (size_t)WS_END);
    }
    Params p{};
    const float** pp = (const float**)&p;
    for (int i = 0; i < 33; ++i) pp[i] = (const float*)d_in[i];
    p.out = (float*)d_out;
    p.ws = (unsigned char*)d_ws;
#ifndef MULTI_LAUNCH
    p.ph_lo = 0;
    p.ph_hi = 11;
    void* args[] = {&p};
    hipError_t e = hipLaunchCooperativeKernel((const void*)mega, dim3(grid_blocks), dim3(256), args, LDS_BYTES, stream);
    if (e != hipSuccess) fprintf(stderr, "cooperative launch failed: %s (grid %d)\n", hipGetErrorString(e), grid_blocks);
#else
    for (int k = 0; k < 11; ++k) {
        p.ph_lo = k;
        p.ph_hi = k + 1;
        hipLaunchKernelGGL(mega, dim3(grid_blocks), dim3(256), LDS_BYTES, stream, p);
    }
#endif
}
```

```cpp
#include <hip/hip_runtime.h>
#include <hip/hip_cooperative_groups.h>
#include <cstdio>
#include <cstdint>
namespace cg = cooperative_groups;

typedef unsigned short u16;
typedef __attribute__((ext_vector_type(8))) short bf16x8;
typedef __attribute__((ext_vector_type(4))) float f32x4;

constexpr int TP = 65536, TS = 1024, T = TP + TS;
constexpr int ACOLS = 1824;
constexpr int LKS = 1088;
constexpr int LDS_BYTES = 73728;
constexpr float EPS = 1e-6f;

constexpr size_t OFF_YS = 67108864ull, OFF_KP = 68157440ull, OFF_VP = 101711872ull, OFF_WP = 135266304ull,
                 OFF_SHP = 135790592ull, OFF_KS = 135819776ull, OFF_VS = 136344064ull, OFF_WS = 136868352ull,
                 OFF_SHS = 137916928ull;

constexpr size_t al(size_t x) { return (x + 255) & ~(size_t)255; }
constexpr size_t O_WIN = 0;
constexpr size_t O_WOA = O_WIN + al(5504ull * 1024 * 2);
constexpr size_t O_WOB = O_WOA + al(1024ull * 512 * 2);
constexpr size_t O_WO = O_WOB + al(1024ull * 512 * 2);
constexpr size_t O_WFI = O_WO + al(1024ull * 1024 * 2);
constexpr size_t O_WFO = O_WFI + al(5632ull * 1024 * 2);
constexpr size_t O_W2 = O_WFO + al(1024ull * 2816 * 2);
constexpr size_t O_A2 = O_W2 + al(512 * 64 * 2);
constexpr size_t O_G2 = O_A2 + al(512 * 64 * 2);
constexpr size_t O_RS1 = O_G2 + al(512 * 160 * 2);
constexpr size_t O_SS2 = O_RS1 + al((size_t)T * 4);
constexpr size_t O_SS4 = O_SS2 + al((size_t)T * 16 * 4);
constexpr size_t O_RS3 = O_SS4 + al((size_t)T * 16 * 4);
constexpr size_t O_RK = O_RS3 + al((size_t)T * 4);
constexpr size_t O_SCAL = O_RK + al((size_t)T * 8 * 16);
constexpr size_t O_REGA = O_SCAL + 256;
constexpr size_t O_CA = O_REGA;
constexpr size_t O_YA = O_REGA;
constexpr size_t O_OB = O_YA + al((size_t)T * 512 * 2);
constexpr size_t O_HB = O_REGA;
constexpr size_t O_REGB = O_REGA + al((size_t)(T + 48) * 1824 * 2);
constexpr size_t O_QB = O_REGB;
constexpr size_t O_KP = O_QB + al((size_t)T * 512 * 2);
constexpr size_t O_KS = O_KP + al((size_t)TP * 512 * 2);
constexpr size_t O_VTP = O_KS + al(32ull * LKS * 512 * 2);
constexpr size_t O_VTS = O_VTP + al(16ull * 512 * 4096 * 2);
constexpr size_t O_REGC = O_VTS + al(32ull * 512 * LKS * 2);
constexpr size_t O_GATE = O_REGB;
static_assert(O_GATE + (size_t)T * 2048 * 2 <= O_REGC, "gate overlaps region C");
constexpr size_t O_SI = O_REGC;
constexpr size_t O_G = O_SI + al((size_t)T * 8 * 384 * 2);
constexpr size_t O_XB = O_REGC;
constexpr size_t O_MIX = O_REGC;
constexpr size_t O_M2 = O_MIX + al((size_t)T * 1024 * 2);
constexpr size_t O_X1B = O_M2 + al((size_t)T * 1024 * 2);
constexpr size_t O_FB = O_REGC;
constexpr size_t WS_END = O_G + al((size_t)T * 512 * 2);
static_assert(O_HB + (size_t)T * 2816 * 2 <= O_REGC, "hb overlaps region C");
static_assert(O_X1B + (size_t)T * 1024 * 2 <= WS_END, "x1b beyond end");
static_assert(WS_END <= 1073741824ull, "workspace too large");

struct Params {
    const float *x_prompt, *x_sample, *cache_k, *cache_v, *state_wkv, *state_shift;
    const float *n_mix_pre, *n_mix_post, *n_ffn_pre, *n_ffn_post, *w_in, *b_gate;
    const float *mu, *w0, *w2, *a0, *a2, *g2, *k_k, *k_a, *r_k, *ln_w, *ln_b;
    const float *lq1, *lk1, *lq2, *lk2, *subln, *w_out_a, *w_out_b, *w_o, *w_ffn_in, *w_ffn_out;
    float* out;
    unsigned char* ws;
    int ph_lo, ph_hi;
};

__device__ __forceinline__ u16 f2bf(float f) {
    unsigned u = __float_as_uint(f);
    u += 0x7fffu + ((u >> 16) & 1u);
    return (u16)(u >> 16);
}
__device__ __forceinline__ unsigned pk2(float a, float b) { return (unsigned)f2bf(a) | ((unsigned)f2bf(b) << 16); }
__device__ __forceinline__ float bflo(unsigned u) { return __uint_as_float(u << 16); }
__device__ __forceinline__ float bfhi(unsigned u) { return __uint_as_float(u & 0xffff0000u); }
__device__ __forceinline__ uint2 pk4(float a, float b, float c, float d) { return make_uint2(pk2(a, b), pk2(c, d)); }
__device__ __forceinline__ float sigmoidf_(float x) { return 1.f / (1.f + __expf(-x)); }

template <int CTRL>
__device__ __forceinline__ float dppf(float x) {
    return __int_as_float(__builtin_amdgcn_update_dpp(0, __float_as_int(x), CTRL, 0xF, 0xF, true));
}
__device__ __forceinline__ float red8(float x) {
    x += dppf<0xB1>(x);
    x += dppf<0x4E>(x);
    x += dppf<0x141>(x);
    return x;
}
__device__ __forceinline__ float red16(float x) {
    x = red8(x);
    x += dppf<0x140>(x);
    return x;
}
__device__ __forceinline__ float red_g(float x) {
    x += __shfl_xor(x, 16);
    x += __shfl_xor(x, 32);
    return x;
}
__device__ __forceinline__ float wave_sum(float x) {
    x = red16(x);
    return red_g(x);
}
__device__ __forceinline__ bf16x8 as_frag(uint4 v) {
    union { uint4 u; bf16x8 f; } c;
    c.u = v;
    return c.f;
}
#define MFMA(a, b, c) __builtin_amdgcn_mfma_f32_16x16x32_bf16((a), (b), (c), 0, 0, 0)

constexpr int LDT = 72;
constexpr int STG = 128 * LDT;
__device__ __forceinline__ void gemm_loop(const u16* __restrict__ A, int lda, const u16* __restrict__ B, int ldb,
                                          int nkt, u16* smem, f32x4 (&acc)[4][4]) {
    const int tid = threadIdx.x, lane = tid & 63, wid = tid >> 6, wm = wid >> 1, wn = wid & 1, l16 = lane & 15, g = lane >> 4;
    const int lr = tid >> 3, lc = (tid & 7) * 8;
    u16* sA = smem;
    u16* sB = smem + 2 * STG;
    const u16* ap = A + (size_t)lr * lda + lc;
    const u16* bp = B + (size_t)lr * ldb + lc;
    uint4 ra0, ra1, ra2, ra3, rb0, rb1, rb2, rb3;
#define G_LOAD(ko)                                                   \
    ra0 = *(const uint4*)(ap + (ko));                                \
    ra1 = *(const uint4*)(ap + (size_t)32 * lda + (ko));             \
    ra2 = *(const uint4*)(ap + (size_t)64 * lda + (ko));             \
    ra3 = *(const uint4*)(ap + (size_t)96 * lda + (ko));             \
    rb0 = *(const uint4*)(bp + (ko));                                \
    rb1 = *(const uint4*)(bp + (size_t)32 * ldb + (ko));             \
    rb2 = *(const uint4*)(bp + (size_t)64 * ldb + (ko));             \
    rb3 = *(const uint4*)(bp + (size_t)96 * ldb + (ko));
#define G_STORE(bo)                                                  \
    *(uint4*)(sA + (bo) + (lr + 0) * LDT + lc) = ra0;                \
    *(uint4*)(sA + (bo) + (lr + 32) * LDT + lc) = ra1;               \
    *(uint4*)(sA + (bo) + (lr + 64) * LDT + lc) = ra2;               \
    *(uint4*)(sA + (bo) + (lr + 96) * LDT + lc) = ra3;               \
    *(uint4*)(sB + (bo) + (lr + 0) * LDT + lc) = rb0;                \
    *(uint4*)(sB + (bo) + (lr + 32) * LDT + lc) = rb1;               \
    *(uint4*)(sB + (bo) + (lr + 64) * LDT + lc) = rb2;               \
    *(uint4*)(sB + (bo) + (lr + 96) * LDT + lc) = rb3;
    G_LOAD(0)
    G_STORE(0)
    __syncthreads();
    for (int kt = 0; kt < nkt; ++kt) {
        const int buf = kt & 1;
        if (kt + 1 < nkt) { G_LOAD((kt + 1) * 64) }
        __builtin_amdgcn_sched_barrier(0);
        const u16* cA = sA + buf * STG + (wm * 64 + l16) * LDT + g * 8;
        const u16* cB = sB + buf * STG + (wn * 64 + l16) * LDT + g * 8;
#pragma unroll
        for (int ks = 0; ks < 2; ++ks) {
            bf16x8 xf[4], wf[4];
#pragma unroll
            for (int i = 0; i < 4; ++i) {
                xf[i] = *(const bf16x8*)(cA + i * 16 * LDT + ks * 32);
                wf[i] = *(const bf16x8*)(cB + i * 16 * LDT + ks * 32);
            }
#pragma unroll
            for (int nt = 0; nt < 4; ++nt)
#pragma unroll
                for (int mt = 0; mt < 4; ++mt) acc[nt][mt] = MFMA(wf[nt], xf[mt], acc[nt][mt]);
        }
        __builtin_amdgcn_sched_barrier(0);
        if (kt + 1 < nkt) { G_STORE((buf ^ 1) * STG) }
        __syncthreads();
    }
}
__device__ __forceinline__ void gemm_loop_xf32(const float* __restrict__ A, const u16* __restrict__ B, int ldb, int nkt, u16* smem,
                                               f32x4 (&acc)[4][4]) {
    const int tid = threadIdx.x, lane = tid & 63, wid = tid >> 6, wm = wid >> 1, wn = wid & 1, l16 = lane & 15, g = lane >> 4;
    const int lr = tid >> 3, lc = (tid & 7) * 8;
    u16* sA = smem;
    u16* sB = smem + 2 * STG;
    const float* ap = A + (size_t)lr * 1024 + lc;
    const u16* bp = B + (size_t)lr * ldb + lc;
    float4 fa0, fa1, fa2, fa3, fa4, fa5, fa6, fa7;
    uint4 rb0, rb1, rb2, rb3;
#define GX_LOAD(ko)                                                  \
    fa0 = *(const float4*)(ap + (ko));                               \
    fa1 = *(const float4*)(ap + (ko) + 4);                           \
    fa2 = *(const float4*)(ap + 32 * 1024 + (ko));                   \
    fa3 = *(const float4*)(ap + 32 * 1024 + (ko) + 4);               \
    fa4 = *(const float4*)(ap + 64 * 1024 + (ko));                   \
    fa5 = *(const float4*)(ap + 64 * 1024 + (ko) + 4);               \
    fa6 = *(const float4*)(ap + 96 * 1024 + (ko));                   \
    fa7 = *(const float4*)(ap + 96 * 1024 + (ko) + 4);               \
    rb0 = *(const uint4*)(bp + (ko));                                \
    rb1 = *(const uint4*)(bp + (size_t)32 * ldb + (ko));             \
    rb2 = *(const uint4*)(bp + (size_t)64 * ldb + (ko));             \
    rb3 = *(const uint4*)(bp + (size_t)96 * ldb + (ko));
#define PKF(a, b) make_uint4(pk2(a.x, a.y), pk2(a.z, a.w), pk2(b.x, b.y), pk2(b.z, b.w))
#define GX_STORE(bo)                                                 \
    *(uint4*)(sA + (bo) + (lr + 0) * LDT + lc) = PKF(fa0, fa1);      \
    *(uint4*)(sA + (bo) + (lr + 32) * LDT + lc) = PKF(fa2, fa3);     \
    *(uint4*)(sA + (bo) + (lr + 64) * LDT + lc) = PKF(fa4, fa5);     \
    *(uint4*)(sA + (bo) + (lr + 96) * LDT + lc) = PKF(fa6, fa7);     \
    *(uint4*)(sB + (bo) + (lr + 0) * LDT + lc) = rb0;                \
    *(uint4*)(sB + (bo) + (lr + 32) * LDT + lc) = rb1;               \
    *(uint4*)(sB + (bo) + (lr + 64) * LDT + lc) = rb2;               \
    *(uint4*)(sB + (bo) + (lr + 96) * LDT + lc) = rb3;
    GX_LOAD(0)
    GX_STORE(0)
    __syncthreads();
    for (int kt = 0; kt < nkt; ++kt) {
        const int buf = kt & 1;
        if (kt + 1 < nkt) { GX_LOAD((kt + 1) * 64) }
        __builtin_amdgcn_sched_barrier(0);
        const u16* cA = sA + buf * STG + (wm * 64 + l16) * LDT + g * 8;
        const u16* cB = sB + buf * STG + (wn * 64 + l16) * LDT + g * 8;
#pragma unroll
        for (int ks = 0; ks < 2; ++ks) {
            bf16x8 xf[4], wf[4];
#pragma unroll
            for (int i = 0; i < 4; ++i) {
                xf[i] = *(const bf16x8*)(cA + i * 16 * LDT + ks * 32);
                wf[i] = *(const bf16x8*)(cB + i * 16 * LDT + ks * 32);
            }
#pragma unroll
            for (int nt = 0; nt < 4; ++nt)
#pragma unroll
                for (int mt = 0; mt < 4; ++mt) acc[nt][mt] = MFMA(wf[nt], xf[mt], acc[nt][mt]);
        }
        __builtin_amdgcn_sched_barrier(0);
        if (kt + 1 < nkt) { GX_STORE((buf ^ 1) * STG) }
        __syncthreads();
    }
}
__device__ __forceinline__ void zero_acc(f32x4 (&acc)[4][4]) {
#pragma unroll
    for (int i = 0; i < 4; ++i)
#pragma unroll
        for (int j = 0; j < 4; ++j) acc[i][j] = (f32x4){0.f, 0.f, 0.f, 0.f};
}
__device__ __forceinline__ void tile_map(int t, int NT, int& mt, int& nt) {
    const int x = t & 7, u = t >> 3;
    const int gsz = 8 * NT;
    const int g = u / gsz;
    const int w = u - g * gsz;
    const int rows = (g < 8) ? 8 : 1;
    const int q = w / rows;
    mt = x * 65 + g * 8 + (w - q * rows);
    nt = q;
}

__device__ __forceinline__ void tr_tile(const float* __restrict__ in, int R, int C, int ldin, u16* __restrict__ out, int ldout,
                        const float* __restrict__ scale, int r0, int c0, int Cout, bool perm, float* tile) {
    const int tid = threadIdx.x;
    {
        const int tx = tid & 63, ty = tid >> 6;
        const int c = c0 + tx;
        for (int rr = ty; rr < 64; rr += 4) {
            const int r = r0 + rr;
            float v = 0.f;
            if (r < R && c < C) {
                v = in[(size_t)r * ldin + c];
                if (scale) v *= scale[r];
            }
            tile[rr * 65 + tx] = v;
        }
    }
    __syncthreads();
    {
        const int rch = (tid & 7) * 8;
#pragma unroll
        for (int pass = 0; pass < 2; ++pass) {
            const int cc = (tid >> 3) + pass * 32;
            const int c = c0 + cc;
            if (c < Cout && r0 + rch < R) {
                float v[8];
#pragma unroll
                for (int k = 0; k < 8; ++k) v[k] = tile[(rch + k) * 65 + cc];
                int orow = c;
                if (perm) {
                    const int type = c >= 2816 ? 1 : 0;
                    const int j = c - type * 2816;
                    orow = (j >> 4) * 32 + type * 16 + (j & 15);
                }
                uint4 o = make_uint4(pk2(v[0], v[1]), pk2(v[2], v[3]), pk2(v[4], v[5]), pk2(v[6], v[7]));
                *(uint4*)(out + (size_t)orow * ldout + r0 + rch) = o;
            }
        }
    }
    __syncthreads();
}

__device__ __forceinline__ void phase0(const Params& p, unsigned char* smem) {
    float* tile = (float*)smem;
    const int tid = threadIdx.x, lane = tid & 63, wid = tid >> 6;
    unsigned char* ws = p.ws;
    const int G = gridDim.x;
    for (int u = blockIdx.x; u < 8136; u += G) {
        const float* in;
        int R, C, Cout, ldout, tl;
        u16* out;
        const float* scale = nullptr;
        bool perm = false;
        if (u < 1376) { tl = u; in = p.w_in; R = 1024; C = 5408; Cout = 5504; out = (u16*)(ws + O_WIN); ldout = 1024; scale = p.n_mix_pre; }
        else if (u < 1504) { tl = u - 1376; in = p.w_out_a; R = 512; C = 1024; Cout = 1024; out = (u16*)(ws + O_WOA); ldout = 512; }
        else if (u < 1632) { tl = u - 1504; in = p.w_out_b; R = 512; C = 1024; Cout = 1024; out = (u16*)(ws + O_WOB); ldout = 512; }
        else if (u < 1888) { tl = u - 1632; in = p.w_o; R = 1024; C = 1024; Cout = 1024; out = (u16*)(ws + O_WO); ldout = 1024; }
        else if (u < 3296) { tl = u - 1888; in = p.w_ffn_in; R = 1024; C = 5632; Cout = 5632; out = (u16*)(ws + O_WFI); ldout = 1024; scale = p.n_ffn_pre; perm = true; }
        else if (u < 4000) { tl = u - 3296; in = p.w_ffn_out; R = 2816; C = 1024; Cout = 1024; out = (u16*)(ws + O_WFO); ldout = 2816; }
        else if (u < 4008) { tl = u - 4000; in = p.w2; R = 64; C = 512; Cout = 512; out = (u16*)(ws + O_W2); ldout = 64; }
        else if (u < 4016) { tl = u - 4008; in = p.a2; R = 64; C = 512; Cout = 512; out = (u16*)(ws + O_A2); ldout = 64; }
        else if (u < 4040) { tl = u - 4016; in = p.g2; R = 160; C = 512; Cout = 512; out = (u16*)(ws + O_G2); ldout = 160; }
        else {
            tl = u - 4040;
            const int b = tl >> 7;
            tl &= 127;
            in = p.cache_v + (size_t)b * 1024 * 512; R = 1024; C = 512; Cout = 512;
            out = (u16*)(ws + O_VTS) + (size_t)b * 512 * LKS; ldout = LKS;
        }
        const int ctiles = (Cout + 63) >> 6;
        const int rt = tl / ctiles, ct = tl - rt * ctiles;
        tr_tile(in, R, C, C, out, ldout, scale, rt * 64, ct * 64, Cout, perm, tile);
    }
    {
        u16* xb = (u16*)(ws + O_XB);
        float* rs1 = (float*)(ws + O_RS1);
        for (int m = blockIdx.x * 4 + wid; m < T; m += G * 4) {
            const float* xr = (m < TP) ? p.x_prompt + (size_t)m * 1024 : p.x_sample + (size_t)(m - TP) * 1024;
            float ss = 0.f;
#pragma unroll
            for (int i = 0; i < 4; ++i) {
                const float4 v = *(const float4*)(xr + i * 256 + lane * 4);
                ss += v.x * v.x + v.y * v.y + v.z * v.z + v.w * v.w;
                *(uint2*)(xb + (size_t)m * 1024 + i * 256 + lane * 4) = pk4(v.x, v.y, v.z, v.w);
            }
            ss = wave_sum(ss);
            if (lane == 0) rs1[m] = rsqrtf(ss * (1.f / 1024.f) + EPS);
        }
    }
    {
        u16* kS = (u16*)(ws + O_KS);
        const int n8 = 32 * 1024 * 64;
        for (int i = blockIdx.x * 256 + tid; i < n8; i += G * 256) {
            const int b = i >> 16, rem = i & 65535, key = rem >> 6, c8 = rem & 63;
            const float4 v0 = *(const float4*)(p.cache_k + (size_t)i * 8);
            const float4 v1 = *(const float4*)(p.cache_k + (size_t)i * 8 + 4);
            *(uint4*)(kS + ((size_t)b * LKS + key) * 512 + c8 * 8) =
                make_uint4(pk2(v0.x, v0.y), pk2(v0.z, v0.w), pk2(v1.x, v1.y), pk2(v1.z, v1.w));
        }
        for (int i = blockIdx.x * 256 + tid; i < 32 * 32 * 64; i += G * 256) {
            const int b = i >> 11, rem = i & 2047, row = rem >> 6, c8 = rem & 63;
            *(uint4*)(kS + ((size_t)b * LKS + 1056 + row) * 512 + c8 * 8) = make_uint4(0, 0, 0, 0);
        }
        u16* vtS = (u16*)(ws + O_VTS);
        for (int i = blockIdx.x * 256 + tid; i < 32 * 512 * 4; i += G * 256) {
            const int row = i >> 2, c8 = i & 3;
            *(uint4*)(vtS + (size_t)row * LKS + 1056 + c8 * 8) = make_uint4(0, 0, 0, 0);
        }
    }
    {
        u16* cA = (u16*)(ws + O_CA);
        for (int i = blockIdx.x * 256 + tid; i < 48 * ACOLS; i += G * 256) {
            const int s = i / ACOLS, c = i - s * ACOLS;
            float v = 0.f;
            size_t row;
            if (s < 16) row = (size_t)s * 4097;
            else { row = (size_t)16 * 4097 + (size_t)(s - 16) * 33; v = p.state_shift[(size_t)(s - 16) * ACOLS + c]; }
            cA[row * ACOLS + c] = f2bf(v);
        }
        if (blockIdx.x == 0 && tid == 0) {
            float d1 = 0.f, d2 = 0.f;
            for (int i = 0; i < 64; ++i) { d1 += p.lq1[i] * p.lk1[i]; d2 += p.lq2[i] * p.lk2[i]; }
            float* sc = (float*)(ws + O_SCAL);
            sc[0] = __expf(d1) - __expf(d2) + 0.2f;
            for (int i = 1; i < 32; ++i) ((unsigned*)sc)[i] = 0u;
        }
    }
}

__device__ __forceinline__ void phase1(const Params& p, unsigned char* smem) {
    unsigned char* ws = p.ws;
    const u16* xb = (const u16*)(ws + O_XB);
    const u16* W = (const u16*)(ws + O_WIN);
    const float* rs1 = (const float*)(ws + O_RS1);
    u16* cA = (u16*)(ws + O_CA);
    u16* qb = (u16*)(ws + O_QB);
    u16* kP = (u16*)(ws + O_KP);
    u16* kS = (u16*)(ws + O_KS);
    u16* vtP = (u16*)(ws + O_VTP);
    u16* vtS = (u16*)(ws + O_VTS);
    float* out = p.out;
    const int tid = threadIdx.x, lane = tid & 63, wid = tid >> 6, wm = wid >> 1, wn = wid & 1, l16 = lane & 15, g = lane >> 4;
    constexpr int NT = 43;
    u16* gate = (u16*)p.out;
    for (int t = blockIdx.x; t < 520 * NT; t += gridDim.x) {
        int mtile, ntile;
        tile_map(t, NT, mtile, ntile);
        const int m0 = mtile * 128, n0 = ntile * 128;
        f32x4 acc[4][4];
        zero_acc(acc);
        gemm_loop(xb + (size_t)m0 * 1024, 1024, W + (size_t)n0 * 1024, 1024, 16, (u16*)smem, acc);
#pragma unroll
        for (int mt = 0; mt < 4; ++mt) {
            const int m = m0 + wm * 64 + mt * 16 + l16;
            const float rs = rs1[m];
            const bool isP = m < TP;
            int seq, tt;
            if (isP) { seq = m >> 12; tt = m & 4095; }
            else { const int ms = m - TP; seq = 16 + (ms >> 5); tt = ms & 31; }
            const size_t carow = (size_t)m + seq + 1;
            const bool last = isP ? (tt == 4095) : (tt == 31);
#pragma unroll
            for (int nt = 0; nt < 4; ++nt) {
                const int n = n0 + wn * 64 + nt * 16 + g * 4;
                if (n >= 5408) continue;
                f32x4 v = acc[nt][mt];
                v[0] *= rs; v[1] *= rs; v[2] *= rs; v[3] *= rs;
                if (n < 1824) {
                    *(uint2*)(cA + carow * ACOLS + n) = pk4(v[0], v[1], v[2], v[3]);
                    if (last) {
                        float* so = isP ? out + OFF_SHP + (size_t)seq * ACOLS + n : out + OFF_SHS + (size_t)(seq - 16) * ACOLS + n;
                        *(float4*)so = make_float4(v[0], v[1], v[2], v[3]);
                    }
                } else if (n < 2336) {
                    *(uint2*)(qb + (size_t)m * 512 + (n - 1824)) = pk4(v[0], v[1], v[2], v[3]);
                } else if (n < 2848) {
                    const int c = n - 2336;
                    if (isP) {
                        *(uint2*)(kP + (size_t)m * 512 + c) = pk4(v[0], v[1], v[2], v[3]);
                        *(float4*)(out + OFF_KP + (size_t)m * 512 + c) = make_float4(v[0], v[1], v[2], v[3]);
                    } else {
                        *(uint2*)(kS + ((size_t)(seq - 16) * LKS + 1024 + tt) * 512 + c) = pk4(v[0], v[1], v[2], v[3]);
                        *(float4*)(out + OFF_KS + (size_t)(m - TP) * 512 + c) = make_float4(v[0], v[1], v[2], v[3]);
                    }
                } else if (n < 3360) {
                    const int c = n - 2848;
                    if (isP) {
                        *(float4*)(out + OFF_VP + (size_t)m * 512 + c) = make_float4(v[0], v[1], v[2], v[3]);
                        u16* d = vtP + ((size_t)seq * 512 + c) * 4096 + tt;
                        d[0] = f2bf(v[0]); d[4096] = f2bf(v[1]); d[2 * 4096] = f2bf(v[2]); d[3 * 4096] = f2bf(v[3]);
                    } else {
                        *(float4*)(out + OFF_VS + (size_t)(m - TP) * 512 + c) = make_float4(v[0], v[1], v[2], v[3]);
                        u16* d = vtS + ((size_t)(seq - 16) * 512 + c) * LKS + 1024 + tt;
                        d[0] = f2bf(v[0]); d[LKS] = f2bf(v[1]); d[2 * LKS] = f2bf(v[2]); d[3 * LKS] = f2bf(v[3]);
                    }
                } else {
                    const int c = n - 3360;
                    const float4 bg = *(const float4*)(p.b_gate + c);
                    *(uint2*)(gate + (size_t)m * 2048 + c) =
                        pk4(sigmoidf_(v[0] + bg.x), sigmoidf_(v[1] + bg.y), sigmoidf_(v[2] + bg.z), sigmoidf_(v[3] + bg.w));
                }
            }
        }
    }
}

__device__ __forceinline__ void lerp8(const u16* cur, const u16* prv, const float* mu, int col, float (&xs)[8]) {
    const uint4 cu = *(const uint4*)(cur + col);
    const uint4 pv = *(const uint4*)(prv + col);
    const float4 m0 = *(const float4*)(mu + col);
    const float4 m1 = *(const float4*)(mu + col + 4);
    const unsigned cw[4] = {cu.x, cu.y, cu.z, cu.w}, pw[4] = {pv.x, pv.y, pv.z, pv.w};
    const float mm[8] = {m0.x, m0.y, m0.z, m0.w, m1.x, m1.y, m1.z, m1.w};
#pragma unroll
    for (int i = 0; i < 4; ++i) {
        const float c0 = bflo(cw[i]), c1 = bfhi(cw[i]), p0 = bflo(pw[i]), p1 = bfhi(pw[i]);
        xs[2 * i] = c0 + (p0 - c0) * mm[2 * i];
        xs[2 * i + 1] = c1 + (p1 - c1) * mm[2 * i + 1];
    }
}
__device__ __forceinline__ void lerp4(const u16* cur, const u16* prv, const float* mu, int col, float (&xs)[4]) {
    const uint2 cu = *(const uint2*)(cur + col);
    const uint2 pv = *(const uint2*)(prv + col);
    const float4 m0 = *(const float4*)(mu + col);
    float c0 = bflo(cu.x), c1 = bfhi(cu.x), c2 = bflo(cu.y), c3 = bfhi(cu.y);
    xs[0] = c0 + (bflo(pv.x) - c0) * m0.x;
    xs[1] = c1 + (bfhi(pv.x) - c1) * m0.y;
    xs[2] = c2 + (bflo(pv.y) - c2) * m0.z;
    xs[3] = c3 + (bfhi(pv.y) - c3) * m0.w;
}
__device__ __forceinline__ bf16x8 packfrag(const float (&v)[8]) {
    return as_frag(make_uint4(pk2(v[0], v[1]), pk2(v[2], v[3]), pk2(v[4], v[5]), pk2(v[6], v[7])));
}

__device__ __forceinline__ void phase2(const Params& p) {
    unsigned char* ws = p.ws;
    const u16* cA = (const u16*)(ws + O_CA);
    const u16* w2t = (const u16*)(ws + O_W2);
    const u16* a2t = (const u16*)(ws + O_A2);
    const u16* g2t = (const u16*)(ws + O_G2);
    u16* SI = (u16*)(ws + O_SI);
    u16* Gb = (u16*)(ws + O_G);
    float4* rk4 = (float4*)(ws + O_RK);
    const int tid = threadIdx.x, lane = tid & 63, wid = tid >> 6, l16 = lane & 15, g = lane >> 4;
    for (int u = blockIdx.x; u < T / 64; u += gridDim.x) {
        const int mw = u * 64 + wid * 16;
        const int m = mw + l16;
        const bool isP = mw < TP;
        int seq, tt;
        if (isP) { seq = m >> 12; tt = m & 4095; }
        else { const int ms = m - TP; seq = 16 + (ms >> 5); tt = ms & 31; }
        const u16* cur = cA + ((size_t)m + seq + 1) * ACOLS;
        const u16* prv = cur - ACOLS;
        bf16x8 xw[2], xa[2], xg[5];
#pragma unroll
        for (int s = 0; s < 9; ++s) {
            float xs[8];
            lerp8(cur, prv, p.mu, 1536 + s * 32 + g * 8, xs);
            if (s < 2) {
#pragma unroll
                for (int i = 0; i < 8; ++i) xs[i] = 1.f - 2.f / (__expf(2.f * xs[i]) + 1.f);
                xw[s] = packfrag(xs);
            } else if (s < 4) {
                xa[s - 2] = packfrag(xs);
            } else {
#pragma unroll
                for (int i = 0; i < 8; ++i) xs[i] = sigmoidf_(xs[i]);
                xg[s - 4] = packfrag(xs);
            }
        }
        for (int h = 0; h < 8; ++h) {
            float kkr[16], av[16];
            float ssq = 0.f, rkacc = 0.f, bracc = 0.f, kracc = 0.f;
            const size_t sirow = isP ? ((size_t)(seq * 8 + h) * 4096 + tt) : ((size_t)128 * 4096 + (size_t)((seq - 16) * 8 + h) * 32 + tt);
            u16* sib = SI + sirow * 384;
#pragma unroll
            for (int nt = 0; nt < 4; ++nt) {
                const int wrow = h * 64 + nt * 16 + l16;
                f32x4 accw = {0.f, 0.f, 0.f, 0.f}, acca = accw, accg = accw;
#pragma unroll
                for (int s = 0; s < 2; ++s) {
                    accw = MFMA(*(const bf16x8*)(w2t + wrow * 64 + s * 32 + g * 8), xw[s], accw);
                    acca = MFMA(*(const bf16x8*)(a2t + wrow * 64 + s * 32 + g * 8), xa[s], acca);
                }
#pragma unroll
                for (int s = 0; s < 5; ++s) accg = MFMA(*(const bf16x8*)(g2t + wrow * 160 + s * 32 + g * 8), xg[s], accg);
                const int ch = h * 64 + nt * 16 + g * 4;
                float xr[4], xk[4], xv[4];
                lerp4(cur, prv, p.mu, ch, xr);
                lerp4(cur, prv, p.mu, 512 + ch, xk);
                lerp4(cur, prv, p.mu, 1024 + ch, xv);
                const float4 w0 = *(const float4*)(p.w0 + ch), a0 = *(const float4*)(p.a0 + ch), kk4 = *(const float4*)(p.k_k + ch),
                             ka4 = *(const float4*)(p.k_a + ch), rk4 = *(const float4*)(p.r_k + ch);
                const float w0a[4] = {w0.x, w0.y, w0.z, w0.w}, a0a[4] = {a0.x, a0.y, a0.z, a0.w}, kka[4] = {kk4.x, kk4.y, kk4.z, kk4.w},
                            kaa[4] = {ka4.x, ka4.y, ka4.z, ka4.w}, rka[4] = {rk4.x, rk4.y, rk4.z, rk4.w};
                float ev[4], kp[4], dr[4];
#pragma unroll
                for (int r = 0; r < 4; ++r) {
                    const float z = -(w0a[r] + accw[r]);
                    const float sp = (z > 20.f) ? z : __logf(1.f + __expf(z));
                    ev[r] = __expf(-sp - 0.5f);
                    const float a = sigmoidf_(a0a[r] + acca[r]);
                    const float kraw = xk[r] * kka[r];
                    ssq += kraw * kraw;
                    kp[r] = xk[r] * (1.f + (a - 1.f) * kaa[r]);
                    rkacc += xr[r] * kp[r] * rka[r];
                    kracc += xr[r] * kp[r];
                    bracc += kraw * a * xr[r];
                    dr[r] = xr[r] * __expf(-ev[r]);
                    kkr[nt * 4 + r] = kraw;
                    av[nt * 4 + r] = a;
                }
                const int co = nt * 16 + g * 4;
                *(uint2*)(sib + 0 * 64 + co) = pk4(dr[0], dr[1], dr[2], dr[3]);
                *(uint2*)(sib + 1 * 64 + co) = pk4(ev[0], ev[1], ev[2], ev[3]);
                *(uint2*)(sib + 2 * 64 + co) = pk4(kp[0], kp[1], kp[2], kp[3]);
                *(uint2*)(sib + 3 * 64 + co) = pk4(xv[0], xv[1], xv[2], xv[3]);
                *(uint2*)(Gb + (size_t)m * 512 + ch) = pk4(accg[0], accg[1], accg[2], accg[3]);
            }
            ssq = red_g(ssq);
            rkacc = red_g(rkacc);
            bracc = red_g(bracc);
            kracc = red_g(kracc);
            const float inv = rsqrtf(fmaxf(ssq, 1e-24f));
#pragma unroll
            for (int nt = 0; nt < 4; ++nt) {
                const int co = nt * 16 + g * 4;
                float k0 = kkr[nt * 4 + 0] * inv, k1 = kkr[nt * 4 + 1] * inv, k2 = kkr[nt * 4 + 2] * inv, k3 = kkr[nt * 4 + 3] * inv;
                *(uint2*)(sib + 4 * 64 + co) = pk4(k0, k1, k2, k3);
                *(uint2*)(sib + 5 * 64 + co) = pk4(k0 * av[nt * 4 + 0], k1 * av[nt * 4 + 1], k2 * av[nt * 4 + 2], k3 * av[nt * 4 + 3]);
            }
            if (g == 0) rk4[(size_t)m * 8 + h] = make_float4(rkacc, bracc * inv, kracc, 0.f);
        }
    }
}

typedef float v2f __attribute__((ext_vector_type(2)));
__device__ __forceinline__ void scan_item(const Params& p, const u16* __restrict__ si, int nch, const float* __restrict__ s0, float* __restrict__ sout,
                          size_t m0, int h, unsigned char* smem) {
    float* inb = (float*)smem;
    float* ybuf = (float*)(smem + 49152);
    float* scal = (float*)(smem + 53248);
    unsigned char* ws = p.ws;
    const u16* Gb = (const u16*)(ws + O_G);
    const float4* rk4 = (const float4*)(ws + O_RK);
    u16* ya = (u16*)(ws + O_YA);
    const int tid = threadIdx.x;
    const int vp = tid >> 3, kq = tid & 7;
    v2f S0[4], S1[4];
    if (s0) {
        const float4 a = *(const float4*)(s0 + (vp * 2) * 64 + kq * 8), b = *(const float4*)(s0 + (vp * 2) * 64 + kq * 8 + 4);
        const float4 c = *(const float4*)(s0 + (vp * 2 + 1) * 64 + kq * 8), d = *(const float4*)(s0 + (vp * 2 + 1) * 64 + kq * 8 + 4);
        S0[0] = (v2f){a.x, a.y}; S0[1] = (v2f){a.z, a.w}; S0[2] = (v2f){b.x, b.y}; S0[3] = (v2f){b.z, b.w};
        S1[0] = (v2f){c.x, c.y}; S1[1] = (v2f){c.z, c.w}; S1[2] = (v2f){d.x, d.y}; S1[3] = (v2f){d.z, d.w};
    } else {
#pragma unroll
        for (int j = 0; j < 4; ++j) { S0[j] = (v2f){0.f, 0.f}; S1[j] = (v2f){0.f, 0.f}; }
    }
    uint4 st0, st1, st2;
    float4 sq = make_float4(0.f, 0.f, 0.f, 0.f);
    st0 = *(const uint4*)(si + (size_t)(0 * 256 + tid) * 8);
    st1 = *(const uint4*)(si + (size_t)(1 * 256 + tid) * 8);
    st2 = *(const uint4*)(si + (size_t)(2 * 256 + tid) * 8);
    if (tid < 16) sq = rk4[(m0 + tid) * 8 + h];
#define S_WRITE1(sv, i, buf)                                                                                          \
    {                                                                                                                 \
        const int idx = (i) * 256 + tid;                                                                              \
        const int vec = (idx % 48) >> 3;                                                                              \
        float v[8] = {bflo(sv.x), bfhi(sv.x), bflo(sv.y), bfhi(sv.y), bflo(sv.z), bfhi(sv.z), bflo(sv.w), bfhi(sv.w)}; \
        if (vec == 1) {                                                                                               \
            _Pragma("unroll") for (int k = 0; k < 8; ++k) v[k] = __expf(-v[k]);                                       \
        }                                                                                                             \
        float* d = inb + (buf) * 6144 + idx * 8;                                                                      \
        *(float4*)d = make_float4(v[0], v[1], v[2], v[3]);                                                            \
        *(float4*)(d + 4) = make_float4(v[4], v[5], v[6], v[7]);                                                      \
    }
#define stage_write(buf) S_WRITE1(st0, 0, buf) S_WRITE1(st1, 1, buf) S_WRITE1(st2, 2, buf) if (tid < 16) *(float4*)(scal + (buf) * 64 + tid * 4) = sq;
    stage_write(0)
    __syncthreads();
    for (int c = 0; c < nch; ++c) {
        const int buf = c & 1;
        if (c + 1 < nch) {
            const u16* sn = si + (size_t)(c + 1) * 6144 + (size_t)tid * 8;
            st0 = *(const uint4*)(sn);
            st1 = *(const uint4*)(sn + 2048);
            st2 = *(const uint4*)(sn + 4096);
            if (tid < 16) sq = rk4[(m0 + (size_t)(c + 1) * 16 + tid) * 8 + h];
        }
        const float* cb = inb + buf * 6144;
        const float* cs = scal + buf * 64;
#pragma unroll 2
        for (int tt = 0; tt < 16; ++tt) {
            const float* base = cb + tt * 384;
            v2f kk[4], dr[4], dd[4], bb[4], kv[4];
#define LD8(dst, off)                                                      \
    {                                                                      \
        const float4 q0 = *(const float4*)(base + (off) + kq * 8);         \
        const float4 q1 = *(const float4*)(base + (off) + kq * 8 + 4);     \
        dst[0] = (v2f){q0.x, q0.y}; dst[1] = (v2f){q0.z, q0.w};            \
        dst[2] = (v2f){q1.x, q1.y}; dst[3] = (v2f){q1.z, q1.w};            \
    }
            LD8(kk, 256) LD8(dr, 0) LD8(dd, 64) LD8(bb, 320) LD8(kv, 128)
            const float2 vv = *(const float2*)(base + 192 + vp * 2);
            const float2 brkr = *(const float2*)(cs + tt * 4 + 1);
            v2f a0 = (v2f){0.f, 0.f}, a1 = a0, q0 = a0, q1 = a0;
#pragma unroll
            for (int j = 0; j < 4; ++j) {
                a0 = __builtin_elementwise_fma(S0[j], kk[j], a0);
                a1 = __builtin_elementwise_fma(S1[j], kk[j], a1);
                q0 = __builtin_elementwise_fma(S0[j], dr[j], q0);
                q1 = __builtin_elementwise_fma(S1[j], dr[j], q1);
            }
            float sa0 = a0.x + a0.y, sa1 = a1.x + a1.y, pp0 = q0.x + q0.y, pp1 = q1.x + q1.y;
            sa0 = -red8(sa0);
            sa1 = -red8(sa1);
            pp0 = red8(pp0);
            pp1 = red8(pp1);
            const float y0 = pp0 + sa0 * brkr.x + vv.x * brkr.y;
            const float y1 = pp1 + sa1 * brkr.x + vv.y * brkr.y;
            if (kq == 0) *(float2*)(ybuf + tt * 64 + vp * 2) = make_float2(y0, y1);
            const v2f sa0v = (v2f){sa0, sa0}, sa1v = (v2f){sa1, sa1}, v0v = (v2f){vv.x, vv.x}, v1v = (v2f){vv.y, vv.y};
#pragma unroll
            for (int j = 0; j < 4; ++j) {
                const v2f t0 = __builtin_elementwise_fma(v0v, kv[j], sa0v * bb[j]);
                const v2f t1 = __builtin_elementwise_fma(v1v, kv[j], sa1v * bb[j]);
                S0[j] = __builtin_elementwise_fma(S0[j], dd[j], t0);
                S1[j] = __builtin_elementwise_fma(S1[j], dd[j], t1);
            }
        }
        __syncthreads();
        {
            const int tt = tid >> 4, cq = (tid & 15) * 4;
            const float4 y = *(const float4*)(ybuf + tt * 64 + cq);
            const float mean = red16(y.x + y.y + y.z + y.w) * (1.f / 64.f);
            const float d0 = y.x - mean, d1 = y.y - mean, d2 = y.z - mean, d3 = y.w - mean;
            const float var = red16(d0 * d0 + d1 * d1 + d2 * d2 + d3 * d3) * (1.f / 64.f);
            const float rstd = rsqrtf(var + 64e-5f);
            const size_t m = m0 + (size_t)c * 16 + tt;
            const float rkv = cs[tt * 4];
            const float4 v4 = *(const float4*)(cb + tt * 384 + 192 + cq);
            const uint2 gg = *(const uint2*)(Gb + m * 512 + h * 64 + cq);
            const float4 lw = *(const float4*)(p.ln_w + h * 64 + cq), lb = *(const float4*)(p.ln_b + h * 64 + cq);
            const float o0 = (d0 * rstd * lw.x + lb.x + rkv * v4.x) * bflo(gg.x);
            const float o1 = (d1 * rstd * lw.y + lb.y + rkv * v4.y) * bfhi(gg.x);
            const float o2 = (d2 * rstd * lw.z + lb.z + rkv * v4.z) * bflo(gg.y);
            const float o3 = (d3 * rstd * lw.w + lb.w + rkv * v4.w) * bfhi(gg.y);
            *(uint2*)(ya + m * 512 + h * 64 + cq) = pk4(o0, o1, o2, o3);
        }
        if (c + 1 < nch) { stage_write(buf ^ 1) }
        __syncthreads();
    }
    {
        float* d0 = sout + (vp * 2) * 64 + kq * 8;
        float* d1 = sout + (vp * 2 + 1) * 64 + kq * 8;
        *(float4*)d0 = make_float4(S0[0].x, S0[0].y, S0[1].x, S0[1].y);
        *(float4*)(d0 + 4) = make_float4(S0[2].x, S0[2].y, S0[3].x, S0[3].y);
        *(float4*)d1 = make_float4(S1[0].x, S1[0].y, S1[1].x, S1[1].y);
        *(float4*)(d1 + 4) = make_float4(S1[2].x, S1[2].y, S1[3].x, S1[3].y);
    }
}

constexpr int KLD = 136, VLD = 72;
__device__ __forceinline__ void attn_item(const u16* __restrict__ Q, int nq, const u16* __restrict__ K, const u16* __restrict__ Vt, int ldv, int nkt,
                          int lastvalid, u16* __restrict__ O, float lam, const float* __restrict__ subln, unsigned char* smem) {
    u16* sK = (u16*)smem;
    u16* sV = (u16*)(smem + 2 * 64 * KLD * 2);
    float* ex = (float*)smem;
    const int tid = threadIdx.x, lane = tid & 63, wid = tid >> 6, l16 = lane & 15, g = lane >> 4;
    const int n = wid >> 1, qh = wid & 1;
    const bool active = (qh * 32) < nq;
    bf16x8 qf[2][2];
#pragma unroll
    for (int qt = 0; qt < 2; ++qt)
#pragma unroll
        for (int s = 0; s < 2; ++s) {
            const int row = qh * 32 + qt * 16 + l16;
            uint4 v = make_uint4(0, 0, 0, 0);
            if (row < nq) v = *(const uint4*)(Q + (row * 512 + n * 64 + s * 32 + g * 8));
            qf[qt][s] = as_frag(v);
        }
    f32x4 o[2][8];
#pragma unroll
    for (int qt = 0; qt < 2; ++qt)
#pragma unroll
        for (int et = 0; et < 8; ++et) o[qt][et] = (f32x4){0.f, 0.f, 0.f, 0.f};
    float mrow[2] = {-1e30f, -1e30f}, lrow[2] = {0.f, 0.f};
    uint4 kr0, kr1, kr2, kr3, vr0, vr1, vr2, vr3;
    const int krow = tid >> 4, kch = (tid & 15) * 8;
    const int vrow = tid >> 3, vch = (tid & 7) * 8;
    const int ko_ = krow * 512 + kch;
    const int vo_ = vrow * ldv + vch;
#define A_LOAD(key0)                                                      \
    kr0 = *(const uint4*)(K + (ko_ + ((key0) + 0) * 512));                \
    kr1 = *(const uint4*)(K + (ko_ + ((key0) + 16) * 512));               \
    kr2 = *(const uint4*)(K + (ko_ + ((key0) + 32) * 512));               \
    kr3 = *(const uint4*)(K + (ko_ + ((key0) + 48) * 512));               \
    vr0 = *(const uint4*)(Vt + (vo_ + (key0)));                           \
    vr1 = *(const uint4*)(Vt + (vo_ + 32 * ldv + (key0)));                \
    vr2 = *(const uint4*)(Vt + (vo_ + 64 * ldv + (key0)));                \
    vr3 = *(const uint4*)(Vt + (vo_ + 96 * ldv + (key0)));
#define A_STORE(nb)                                                       \
    *(uint4*)(sK + (nb) * 64 * KLD + (krow + 0) * KLD + kch) = kr0;       \
    *(uint4*)(sK + (nb) * 64 * KLD + (krow + 16) * KLD + kch) = kr1;      \
    *(uint4*)(sK + (nb) * 64 * KLD + (krow + 32) * KLD + kch) = kr2;      \
    *(uint4*)(sK + (nb) * 64 * KLD + (krow + 48) * KLD + kch) = kr3;      \
    *(uint4*)(sV + (nb) * 128 * VLD + (vrow + 0) * VLD + vch) = vr0;      \
    *(uint4*)(sV + (nb) * 128 * VLD + (vrow + 32) * VLD + vch) = vr1;     \
    *(uint4*)(sV + (nb) * 128 * VLD + (vrow + 64) * VLD + vch) = vr2;     \
    *(uint4*)(sV + (nb) * 128 * VLD + (vrow + 96) * VLD + vch) = vr3;
    A_LOAD(0)
    A_STORE(0)
    __syncthreads();
    constexpr float SC = 0.125f * 1.4426950408889634f;
    for (int kt = 0; kt < nkt; ++kt) {
        const int buf = kt & 1;
        if (kt + 1 < nkt) { A_LOAD((kt + 1) * 64) }
        __builtin_amdgcn_sched_barrier(0);
        if (active) {
            const int valid = (kt == nkt - 1) ? lastvalid : 64;
            const u16* cK = sK + buf * 64 * KLD + l16 * KLD + n * 64 + g * 8;
            const u16* cV = sV + buf * 128 * VLD + l16 * VLD + g * 4;
            f32x4 s[4][2];
#pragma unroll
            for (int k16 = 0; k16 < 4; ++k16) {
                const bf16x8 kf0 = *(const bf16x8*)(cK + k16 * 16 * KLD);
                const bf16x8 kf1 = *(const bf16x8*)(cK + k16 * 16 * KLD + 32);
#pragma unroll
                for (int qt = 0; qt < 2; ++qt) {
                    f32x4 z = {0.f, 0.f, 0.f, 0.f};
                    z = MFMA(kf0, qf[qt][0], z);
                    s[k16][qt] = MFMA(kf1, qf[qt][1], z);
                }
            }
            bf16x8 pf[2][2];
#pragma unroll
            for (int qt = 0; qt < 2; ++qt) {
                float mx = -1e30f;
#pragma unroll
                for (int k16 = 0; k16 < 4; ++k16)
#pragma unroll
                    for (int r = 0; r < 4; ++r) {
                        float v = s[k16][qt][r] * SC;
                        if (k16 * 16 >= valid) v = -1e30f;
                        s[k16][qt][r] = v;
                        mx = fmaxf(mx, v);
                    }
                mx = fmaxf(mx, __shfl_xor(mx, 16));
                mx = fmaxf(mx, __shfl_xor(mx, 32));
                const float mnew = fmaxf(mrow[qt], mx);
                const float alpha = exp2f(mrow[qt] - mnew);
                mrow[qt] = mnew;
                float psum = 0.f;
#pragma unroll
                for (int k16 = 0; k16 < 4; ++k16)
#pragma unroll
                    for (int r = 0; r < 4; ++r) {
                        const float pv = exp2f(s[k16][qt][r] - mnew);
                        s[k16][qt][r] = pv;
                        psum += pv;
                    }
                lrow[qt] = lrow[qt] * alpha + psum;
#pragma unroll
                for (int et = 0; et < 8; ++et) {
                    o[qt][et][0] *= alpha; o[qt][et][1] *= alpha; o[qt][et][2] *= alpha; o[qt][et][3] *= alpha;
                }
#pragma unroll
                for (int kb = 0; kb < 2; ++kb)
                    pf[qt][kb] = as_frag(make_uint4(pk2(s[2 * kb][qt][0], s[2 * kb][qt][1]), pk2(s[2 * kb][qt][2], s[2 * kb][qt][3]),
                                                    pk2(s[2 * kb + 1][qt][0], s[2 * kb + 1][qt][1]), pk2(s[2 * kb + 1][qt][2], s[2 * kb + 1][qt][3])));
            }
#pragma unroll
            for (int et = 0; et < 8; ++et)
#pragma unroll
                for (int kb = 0; kb < 2; ++kb) {
                    const uint2 lo = *(const uint2*)(cV + et * 16 * VLD + kb * 32);
                    const uint2 hi = *(const uint2*)(cV + et * 16 * VLD + kb * 32 + 16);
                    const bf16x8 vf = as_frag(make_uint4(lo.x, lo.y, hi.x, hi.y));
#pragma unroll
                    for (int qt = 0; qt < 2; ++qt) o[qt][et] = MFMA(vf, pf[qt][kb], o[qt][et]);
                }
        }
        __builtin_amdgcn_sched_barrier(0);
        if (kt + 1 < nkt) { A_STORE(buf ^ 1) }
        __syncthreads();
    }
    float inv[2];
#pragma unroll
    for (int qt = 0; qt < 2; ++qt) {
        const float l = red_g(lrow[qt]);
        inv[qt] = 1.f / fmaxf(l, 1e-30f);
    }
    if (active && n == 1) {
#pragma unroll
        for (int qt = 0; qt < 2; ++qt)
#pragma unroll
            for (int et = 0; et < 8; ++et) {
                const f32x4 v = o[qt][et];
                *(float4*)(ex + (qh * 32 + qt * 16 + l16) * 132 + et * 16 + g * 4) =
                    make_float4(v[0] * inv[qt], v[1] * inv[qt], v[2] * inv[qt], v[3] * inv[qt]);
            }
    }
    __syncthreads();
    if (active && n == 0) {
#pragma unroll
        for (int qt = 0; qt < 2; ++qt) {
            const int row = qh * 32 + qt * 16 + l16;
            float ss = 0.f;
#pragma unroll
            for (int et = 0; et < 8; ++et) {
                const float4 o2 = *(const float4*)(ex + row * 132 + et * 16 + g * 4);
                f32x4 v = o[qt][et];
                v[0] = v[0] * inv[qt] - lam * o2.x;
                v[1] = v[1] * inv[qt] - lam * o2.y;
                v[2] = v[2] * inv[qt] - lam * o2.z;
                v[3] = v[3] * inv[qt] - lam * o2.w;
                o[qt][et] = v;
                ss += v[0] * v[0] + v[1] * v[1] + v[2] * v[2] + v[3] * v[3];
            }
            ss = red_g(ss);
            const float rn = rsqrtf(ss * (1.f / 128.f) + EPS) * 0.8f;
            if (row < nq) {
#pragma unroll
                for (int et = 0; et < 8; ++et) {
                    const float4 sl = *(const float4*)(subln + et * 16 + g * 4);
                    const f32x4 v = o[qt][et];
                    *(uint2*)(O + (row * 512 + et * 16 + g * 4)) = pk4(v[0] * rn * sl.x, v[1] * rn * sl.y, v[2] * rn * sl.z, v[3] * rn * sl.w);
                }
            }
        }
    }
    __syncthreads();
}

__device__ __forceinline__ void phase3(const Params& p, unsigned char* smem) {
    unsigned char* ws = p.ws;
    int* s_item = (int*)(smem + LDS_BYTES - 16);
    unsigned* ctr = (unsigned*)(ws + O_SCAL) + 1;
    const float lam = ((const float*)(ws + O_SCAL))[0];
    const u16* SI = (const u16*)(ws + O_SI);
    const u16* qb = (const u16*)(ws + O_QB);
    const u16* kP = (const u16*)(ws + O_KP);
    const u16* kS = (const u16*)(ws + O_KS);
    const u16* vtP = (const u16*)(ws + O_VTP);
    const u16* vtS = (const u16*)(ws + O_VTS);
    u16* ob = (u16*)(ws + O_OB);
    constexpr int NITEMS = 128 + 4096 + 128 + 256;
    int stage = 0;
    for (;;) {
        if (threadIdx.x == 0) {
            int it;
            if (stage == 0) it = (blockIdx.x < 128) ? (int)blockIdx.x : ((blockIdx.x < 384) ? (int)blockIdx.x - 128 + (128 + 4096 + 128) : -1);
            else {
                const int x = blockIdx.x & 7;
                const int i = (int)atomicAdd(ctr + 16 + x, 1u);
                if (i < 512) it = 128 + (((i >> 3) << 6) | (x + 8 * (i & 7)));
                else if (i < 528) it = 128 + 4096 + (x + 8 * (i - 512));
                else it = 1 << 30;
            }
            *s_item = it;
        }
        __syncthreads();
        const int item = __builtin_amdgcn_readfirstlane(*s_item);
        __syncthreads();
        if (item >= NITEMS) break;
        if (item < 0) {
        } else if (item < 128 || item >= 128 + 4096 + 128) {
            const u16* si; int nch; const float* s0; float* sout; size_t m0; int h;
            if (item < 128) {
                h = item & 7;
                si = SI + (size_t)item * 4096 * 384; nch = 256; s0 = nullptr;
                sout = p.out + OFF_WP + (size_t)item * 4096; m0 = (size_t)(item >> 3) * 4096;
            } else {
                const int idx = item - (128 + 4096 + 128);
                h = idx & 7;
                si = SI + ((size_t)128 * 4096 + (size_t)idx * 32) * 384; nch = 2; s0 = p.state_wkv + (size_t)idx * 4096;
                sout = p.out + OFF_WS + (size_t)idx * 4096; m0 = (size_t)TP + (size_t)(idx >> 3) * 32;
            }
            scan_item(p, si, nch, s0, sout, m0, h, smem);
        } else {
            const u16 *Q, *K, *Vt; u16* O; int nq, ldv, nkt, lastvalid;
            if (item < 128 + 4096) {
                const int idx = item - 128;
                const int c = 63 - (idx >> 6), bh = idx & 63, b = bh >> 2, h = bh & 3;
                const size_t m0 = (size_t)b * 4096 + (size_t)c * 64;
                Q = qb + m0 * 512 + h * 128; nq = 64; K = kP + (size_t)b * 4096 * 512 + h * 128;
                Vt = vtP + ((size_t)b * 512 + h * 128) * 4096; ldv = 4096; nkt = c + 1; lastvalid = 64; O = ob + m0 * 512 + h * 128;
            } else {
                const int idx = item - (128 + 4096);
                const int b = idx >> 2, h = idx & 3;
                const size_t m0 = (size_t)TP + (size_t)b * 32;
                Q = qb + m0 * 512 + h * 128; nq = 32; K = kS + (size_t)b * LKS * 512 + h * 128;
                Vt = vtS + ((size_t)b * 512 + h * 128) * LKS; ldv = LKS; nkt = 17; lastvalid = 32; O = ob + m0 * 512 + h * 128;
            }
            attn_item(Q, nq, K, Vt, ldv, nkt, lastvalid, O, lam, p.subln, smem);
        }
        if (stage == 0) {
            asm volatile("s_waitcnt vmcnt(0) lgkmcnt(0)" ::: "memory");
            cg::this_grid().sync();
            stage = 1;
        }
    }
}

__device__ __forceinline__ void phase4g(const Params& p, unsigned char* smem) {
    unsigned char* ws = p.ws;
    const u16* Wg = (const u16*)(ws + O_WIN) + (size_t)3360 * 1024;
    const float* rs1 = (const float*)(ws + O_RS1);
    u16* gate = (u16*)(ws + O_GATE);
    const int tid = threadIdx.x, lane = tid & 63, wid = tid >> 6, wm = wid >> 1, wn = wid & 1, l16 = lane & 15, g = lane >> 4;
    constexpr int NT = 16;
    for (int t = blockIdx.x; t < 520 * NT; t += gridDim.x) {
        int mtile, ntile;
        tile_map(t, NT, mtile, ntile);
        const int m0 = mtile * 128, n0 = ntile * 128;
        const float* xs = (m0 < TP) ? p.x_prompt + (size_t)m0 * 1024 : p.x_sample + (size_t)(m0 - TP) * 1024;
        f32x4 acc[4][4];
        zero_acc(acc);
        gemm_loop_xf32(xs, Wg + (size_t)n0 * 1024, 1024, 16, (u16*)smem, acc);
#pragma unroll
        for (int mt = 0; mt < 4; ++mt) {
            const int m = m0 + wm * 64 + mt * 16 + l16;
            const float rs = rs1[m];
#pragma unroll
            for (int nt = 0; nt < 4; ++nt) {
                const int n = n0 + wn * 64 + nt * 16 + g * 4;
                const float4 bg = *(const float4*)(p.b_gate + n);
                const f32x4 v = acc[nt][mt];
                *(uint2*)(gate + (size_t)m * 2048 + n) =
                    pk4(sigmoidf_(v[0] * rs + bg.x), sigmoidf_(v[1] * rs + bg.y), sigmoidf_(v[2] * rs + bg.z), sigmoidf_(v[3] * rs + bg.w));
            }
        }
    }
}

__device__ __forceinline__ void phase4(const Params& p, unsigned char* smem) {
    unsigned char* ws = p.ws;
    const u16* ya = (const u16*)(ws + O_YA);
    const u16* ob = (const u16*)(ws + O_OB);
    const u16* Wa = (const u16*)(ws + O_WOA);
    const u16* Wb = (const u16*)(ws + O_WOB);
    const u16* gate = (const u16*)p.out;
    u16* mix = (u16*)(ws + O_MIX);
    const int tid = threadIdx.x, lane = tid & 63, wid = tid >> 6, wm = wid >> 1, wn = wid & 1, l16 = lane & 15, g = lane >> 4;
    constexpr int NT = 8;
    for (int t = blockIdx.x; t < 520 * NT; t += gridDim.x) {
        int mtile, ntile;
        tile_map(t, NT, mtile, ntile);
        const int m0 = mtile * 128, n0 = ntile * 128;
        f32x4 acc[4][4], acc2[4][4];
        zero_acc(acc);
        zero_acc(acc2);
        gemm_loop(ya + (size_t)m0 * 512, 512, Wa + (size_t)n0 * 512, 512, 8, (u16*)smem, acc);
        gemm_loop(ob + (size_t)m0 * 512, 512, Wb + (size_t)n0 * 512, 512, 8, (u16*)smem, acc2);
#pragma unroll
        for (int mt = 0; mt < 4; ++mt) {
            const int m = m0 + wm * 64 + mt * 16 + l16;
#pragma unroll
            for (int nt = 0; nt < 4; ++nt) {
                const int n = n0 + wn * 64 + nt * 16 + g * 4;
                const uint2 ga = *(const uint2*)(gate + (size_t)m * 2048 + n);
                const uint2 gb = *(const uint2*)(gate + (size_t)m * 2048 + 1024 + n);
                const f32x4 a = acc[nt][mt], b = acc2[nt][mt];
                *(uint2*)(mix + (size_t)m * 1024 + n) =
                    pk4(bflo(ga.x) * a[0] + bflo(gb.x) * b[0], bfhi(ga.x) * a[1] + bfhi(gb.x) * b[1],
                        bflo(ga.y) * a[2] + bflo(gb.y) * b[2], bfhi(ga.y) * a[3] + bfhi(gb.y) * b[3]);
            }
        }
    }
}

__device__ __forceinline__ void gemm_rowss(const u16* A, int K, const u16* W, u16* outb, float* ssq, unsigned char* smem) {
    const int tid = threadIdx.x, lane = tid & 63, wid = tid >> 6, wm = wid >> 1, wn = wid & 1, l16 = lane & 15, g = lane >> 4;
    constexpr int NT = 8;
    for (int t = blockIdx.x; t < 520 * NT; t += gridDim.x) {
        int mtile, ntile;
        tile_map(t, NT, mtile, ntile);
        const int m0 = mtile * 128, n0 = ntile * 128;
        f32x4 acc[4][4];
        zero_acc(acc);
        gemm_loop(A + (size_t)m0 * K, K, W + (size_t)n0 * K, K, K / 64, (u16*)smem, acc);
#pragma unroll
        for (int mt = 0; mt < 4; ++mt) {
            const int m = m0 + wm * 64 + mt * 16 + l16;
#pragma unroll
            for (int nt = 0; nt < 4; ++nt) {
                const int n = n0 + wn * 64 + nt * 16 + g * 4;
                const f32x4 a = acc[nt][mt];
                *(uint2*)(outb + (size_t)m * 1024 + n) = pk4(a[0], a[1], a[2], a[3]);
            }
        }
    }
}

__device__ __forceinline__ float sum16(const float* q) {
    const float4 a = *(const float4*)q, b = *(const float4*)(q + 4), c = *(const float4*)(q + 8), d = *(const float4*)(q + 12);
    return ((a.x + a.y) + (a.z + a.w)) + ((b.x + b.y) + (b.z + b.w)) + (((c.x + c.y) + (c.z + c.w)) + ((d.x + d.y) + (d.z + d.w)));
}
__device__ __forceinline__ void phase6(const Params& p) {
    unsigned char* ws = p.ws;
    const u16* m2 = (const u16*)(ws + O_M2);
    u16* x1b = (u16*)(ws + O_X1B);
    float* rs3 = (float*)(ws + O_RS3);
    const int lane = threadIdx.x & 63, wid = threadIdx.x >> 6;
    for (int m = blockIdx.x * 4 + wid; m < T; m += gridDim.x * 4) {
        const float* xr = (m < TP) ? p.x_prompt + (size_t)m * 1024 : p.x_sample + (size_t)(m - TP) * 1024;
        uint2 mvv[4];
        float s2 = 0.f;
#pragma unroll
        for (int i = 0; i < 4; ++i) {
            mvv[i] = *(const uint2*)(m2 + (size_t)m * 1024 + i * 256 + lane * 4);
            const float a = bflo(mvv[i].x), b = bfhi(mvv[i].x), c = bflo(mvv[i].y), d = bfhi(mvv[i].y);
            s2 += a * a + b * b + c * c + d * d;
        }
        s2 = wave_sum(s2);
        const float rs = rsqrtf(s2 * (1.f / 1024.f) + EPS);
        float ss = 0.f;
#pragma unroll
        for (int i = 0; i < 4; ++i) {
            const int col = i * 256 + lane * 4;
            const float4 xv = *(const float4*)(xr + col);
            const uint2 mv = mvv[i];
            const float4 gp = *(const float4*)(p.n_mix_post + col);
            float4 r;
            r.x = xv.x + bflo(mv.x) * rs * gp.x;
            r.y = xv.y + bfhi(mv.x) * rs * gp.y;
            r.z = xv.z + bflo(mv.y) * rs * gp.z;
            r.w = xv.w + bfhi(mv.y) * rs * gp.w;
            ss += r.x * r.x + r.y * r.y + r.z * r.z + r.w * r.w;
            *(float4*)(p.out + (size_t)m * 1024 + col) = r;
            *(uint2*)(x1b + (size_t)m * 1024 + col) = pk4(r.x, r.y, r.z, r.w);
        }
        ss = wave_sum(ss);
        if (lane == 0) rs3[m] = rsqrtf(ss * (1.f / 1024.f) + EPS);
    }
}

__device__ __forceinline__ void phase7(const Params& p, unsigned char* smem) {
    unsigned char* ws = p.ws;
    const u16* x1b = (const u16*)(ws + O_X1B);
    const u16* W = (const u16*)(ws + O_WFI);
    const float* rs3 = (const float*)(ws + O_RS3);
    u16* hb = (u16*)(ws + O_HB);
    const int tid = threadIdx.x, lane = tid & 63, wid = tid >> 6, wm = wid >> 1, wn = wid & 1, l16 = lane & 15, g = lane >> 4;
    constexpr int NT = 44;
    for (int t = blockIdx.x; t < 520 * NT; t += gridDim.x) {
        int mtile, ntile;
        tile_map(t, NT, mtile, ntile);
        const int m0 = mtile * 128, n0 = ntile * 128;
        f32x4 acc[4][4];
        zero_acc(acc);
        gemm_loop(x1b + (size_t)m0 * 1024, 1024, W + (size_t)n0 * 1024, 1024, 16, (u16*)smem, acc);
#pragma unroll
        for (int mt = 0; mt < 4; ++mt) {
            const int m = m0 + wm * 64 + mt * 16 + l16;
            const float rs = rs3[m];
#pragma unroll
            for (int pr = 0; pr < 2; ++pr) {
                const f32x4 ug = acc[2 * pr][mt], uv = acc[2 * pr + 1][mt];
                const int j = ((n0 + wn * 64) >> 5) * 16 + pr * 16 + g * 4;
                float hv[4];
#pragma unroll
                for (int r = 0; r < 4; ++r) {
                    const float a = ug[r] * rs, b = uv[r] * rs;
                    hv[r] = a * sigmoidf_(a) * b;
                }
                *(uint2*)(hb + (size_t)m * 2816 + j) = pk4(hv[0], hv[1], hv[2], hv[3]);
            }
        }
    }
}

__device__ __forceinline__ void phase9(const Params& p) {
    unsigned char* ws = p.ws;
    const u16* fb = (const u16*)(ws + O_FB);
    const int lane = threadIdx.x & 63, wid = threadIdx.x >> 6;
    for (int m = blockIdx.x * 4 + wid; m < T; m += gridDim.x * 4) {
        uint2 fvv[4];
        float s2 = 0.f;
#pragma unroll
        for (int i = 0; i < 4; ++i) {
            fvv[i] = *(const uint2*)(fb + (size_t)m * 1024 + i * 256 + lane * 4);
            const float a = bflo(fvv[i].x), b = bfhi(fvv[i].x), c = bflo(fvv[i].y), d = bfhi(fvv[i].y);
            s2 += a * a + b * b + c * c + d * d;
        }
        s2 = wave_sum(s2);
        const float rs = rsqrtf(s2 * (1.f / 1024.f) + EPS);
#pragma unroll
        for (int i = 0; i < 4; ++i) {
            const int col = i * 256 + lane * 4;
            float4 r = *(const float4*)(p.out + (size_t)m * 1024 + col);
            const uint2 fv = fvv[i];
            const float4 gp = *(const float4*)(p.n_ffn_post + col);
            r.x += bflo(fv.x) * rs * gp.x;
            r.y += bfhi(fv.x) * rs * gp.y;
            r.z += bflo(fv.y) * rs * gp.z;
            r.w += bfhi(fv.y) * rs * gp.w;
            *(float4*)(p.out + (size_t)m * 1024 + col) = r;
        }
    }
}

__global__ void __launch_bounds__(256, 2) mega(Params p) {
    extern __shared__ __attribute__((aligned(16))) unsigned char smem[];
    cg::grid_group grid = cg::this_grid();
#define IN(k) (p.ph_lo <= (k) && (k) < p.ph_hi)
#define SEAM(k) if (IN(k) && IN((k) + 1)) { asm volatile("s_waitcnt vmcnt(0) lgkmcnt(0)" ::: "memory"); grid.sync(); }
    unsigned char* ws = p.ws;
    if (IN(0)) phase0(p, smem);
    SEAM(0)
    if (IN(1)) phase1(p, smem);
    SEAM(1)
    if (IN(2)) phase2(p);
    SEAM(2)
    if (IN(3)) phase3(p, smem);
    SEAM(3)
    if (IN(5)) phase4(p, smem);
    SEAM(5)
    if (IN(6)) gemm_rowss((const u16*)(ws + O_MIX), 1024, (const u16*)(ws + O_WO), (u16*)(ws + O_M2), (float*)(ws + O_SS2), smem);
    SEAM(6)
    if (IN(7)) phase6(p);
    SEAM(7)
    if (IN(8)) phase7(p, smem);
    SEAM(8)
    if (IN(9)) gemm_rowss((const u16*)(ws + O_HB), 2816, (const u16*)(ws + O_WFO), (u16*)(ws + O_FB), (float*)(ws + O_SS4), smem);
    SEAM(9)
    if (IN(10)) phase9(p);
}

extern "C" void kernel_launch(void* const* d_in, const int* in_sizes, int n_in, void* d_out, int out_size, void* d_ws, size_t ws_size,
                              hipStream_t stream) {
    static int grid_blocks = 0;
    if (!grid_blocks) {
        int dev = 0, cus = 0, per_cu = 0;
        hipGetDevice(&dev);
        hipDeviceGetAttribute(&cus, hipDeviceAttributeMultiprocessorCount, dev);
        hipFuncSetAttribute((const void*)mega, hipFuncAttributeMaxDynamicSharedMemorySize, LDS_BYTES);
        hipOccupancyMaxActiveBlocksPerMultiprocessor(&per_cu, (const void*)mega, 256, LDS_BYTES);
        if (per_cu < 1) per_cu = 1;
        if (per_cu > 2) per_cu = 2;
        grid_blocks = cus * per_cu;
        if (ws_size < WS_END) fprintf(stderr, "kernel_launch: workspace too small: %zu < %zu\n", ws_size, (size_t)WS_END);
    }
    Params p{};
    const float** pp = (const float**)&p;
    for (int i = 0; i < 33; ++i) pp[i] = (const float*)d_in[i];
    p.out = (float*)d_out;
    p.ws = (unsigned char*)d_ws;
#ifndef MULTI_LAUNCH
    p.ph_lo = 0;
    p.ph_hi = 11;
    void* args[] = {&p};
    hipError_t e = hipLaunchCooperativeKernel((const void*)mega, dim3(grid_blocks), dim3(256), args, LDS_BYTES, stream);
    if (e != hipSuccess) fprintf(stderr, "cooperative launch failed: %s (grid %d)\n", hipGetErrorString(e), grid_blocks);
#else
    for (int k = 0; k < 11; ++k) {
        p.ph_lo = k;
        p.ph_hi = k + 1;
        hipLaunchKernelGGL(mega, dim3(grid_blocks), dim3(256), LDS_BYTES, stream, p);
    }
#endif
}
```

```cpp
#include <hip/hip_runtime.h>
#include <hip/hip_cooperative_groups.h>
#include <cstdio>
#include <cstdint>
namespace cg = cooperative_groups;

typedef unsigned short u16;
typedef __attribute__((ext_vector_type(8))) short bf16x8;
typedef __attribute__((ext_vector_type(4))) float f32x4;

constexpr int TP = 65536, TS = 1024, T = TP + TS;
constexpr int ACOLS = 1824;
constexpr int LKS = 1088;
constexpr int LDS_BYTES = 73728;
constexpr float EPS = 1e-6f;

constexpr size_t OFF_YS = 67108864ull, OFF_KP = 68157440ull, OFF_VP = 101711872ull, OFF_WP = 135266304ull,
                 OFF_SHP = 135790592ull, OFF_KS = 135819776ull, OFF_VS = 136344064ull, OFF_WS = 136868352ull,
                 OFF_SHS = 137916928ull;

constexpr size_t al(size_t x) { return (x + 255) & ~(size_t)255; }
constexpr size_t O_WIN = 0;
constexpr size_t O_WOA = O_WIN + al(5504ull * 1024 * 2);
constexpr size_t O_WOB = O_WOA + al(1024ull * 512 * 2);
constexpr size_t O_WO = O_WOB + al(1024ull * 512 * 2);
constexpr size_t O_WFI = O_WO + al(1024ull * 1024 * 2);
constexpr size_t O_WFO = O_WFI + al(5632ull * 1024 * 2);
constexpr size_t O_W2 = O_WFO + al(1024ull * 2816 * 2);
constexpr size_t O_A2 = O_W2 + al(512 * 64 * 2);
constexpr size_t O_G2 = O_A2 + al(512 * 64 * 2);
constexpr size_t O_RS1 = O_G2 + al(512 * 160 * 2);
constexpr size_t O_SS2 = O_RS1 + al((size_t)T * 4);
constexpr size_t O_SS4 = O_SS2 + al((size_t)T * 16 * 4);
constexpr size_t O_RS3 = O_SS4 + al((size_t)T * 16 * 4);
constexpr size_t O_RK = O_RS3 + al((size_t)T * 4);
constexpr size_t O_SCAL = O_RK + al((size_t)T * 8 * 16);
constexpr size_t O_REGA = O_SCAL + 256;
constexpr size_t O_CA = O_REGA;
constexpr size_t O_YA = O_REGA;
constexpr size_t O_OB = O_YA + al((size_t)T * 512 * 2);
constexpr size_t O_YRAW = O_OB + al((size_t)T * 512 * 2);
constexpr size_t O_HB = O_REGA;
constexpr size_t O_REGB = O_REGA + al((size_t)(T + 48) * 1824 * 2);
constexpr size_t O_QB = O_REGB;
constexpr size_t O_KP = O_QB + al((size_t)T * 512 * 2);
constexpr size_t O_KS = O_KP + al((size_t)TP * 512 * 2);
constexpr size_t O_VTP = O_KS + al(32ull * LKS * 512 * 2);
constexpr size_t O_VTS = O_VTP + al(16ull * 512 * 4096 * 2);
constexpr size_t O_REGC = O_VTS + al(32ull * 512 * LKS * 2);
constexpr size_t O_GATE = O_REGB;
static_assert(O_GATE + (size_t)T * 2048 * 2 <= O_REGC, "gate overlaps region C");
constexpr size_t O_SI = O_REGC;
constexpr size_t O_G = O_SI + al((size_t)T * 8 * 384 * 2);
constexpr size_t O_XB = O_REGC;
constexpr size_t O_MIX = O_REGC;
constexpr size_t O_M2 = O_MIX + al((size_t)T * 1024 * 2);
constexpr size_t O_X1B = O_M2 + al((size_t)T * 1024 * 2);
constexpr size_t O_FB = O_REGC;
constexpr size_t WS_END = O_G + al((size_t)T * 512 * 2);
static_assert(O_HB + (size_t)T * 2816 * 2 <= O_REGC, "hb overlaps region C");
static_assert(O_YRAW + (size_t)T * 512 * 2 <= O_REGB, "yraw overlaps region B");
static_assert(O_X1B + (size_t)T * 1024 * 2 <= WS_END, "x1b beyond end");
static_assert(WS_END <= 1073741824ull, "workspace too large");

struct Params {
    const float *x_prompt, *x_sample, *cache_k, *cache_v, *state_wkv, *state_shift;
    const float *n_mix_pre, *n_mix_post, *n_ffn_pre, *n_ffn_post, *w_in, *b_gate;
    const float *mu, *w0, *w2, *a0, *a2, *g2, *k_k, *k_a, *r_k, *ln_w, *ln_b;
    const float *lq1, *lk1, *lq2, *lk2, *subln, *w_out_a, *w_out_b, *w_o, *w_ffn_in, *w_ffn_out;
    float* out;
    unsigned char* ws;
    int ph_lo, ph_hi;
};

__device__ __forceinline__ u16 f2bf(float f) {
    unsigned u = __float_as_uint(f);
    u += 0x7fffu + ((u >> 16) & 1u);
    return (u16)(u >> 16);
}
__device__ __forceinline__ unsigned pk2(float a, float b) { return (unsigned)f2bf(a) | ((unsigned)f2bf(b) << 16); }
__device__ __forceinline__ float bflo(unsigned u) { return __uint_as_float(u << 16); }
__device__ __forceinline__ float bfhi(unsigned u) { return __uint_as_float(u & 0xffff0000u); }
__device__ __forceinline__ uint2 pk4(float a, float b, float c, float d) { return make_uint2(pk2(a, b), pk2(c, d)); }
__device__ __forceinline__ float sigmoidf_(float x) { return 1.f / (1.f + __expf(-x)); }

template <int CTRL>
__device__ __forceinline__ float dppf(float x) {
    return __int_as_float(__builtin_amdgcn_update_dpp(0, __float_as_int(x), CTRL, 0xF, 0xF, true));
}
__device__ __forceinline__ float red8(float x) {
    x += dppf<0xB1>(x);
    x += dppf<0x4E>(x);
    x += dppf<0x141>(x);
    return x;
}
__device__ __forceinline__ float red16(float x) {
    x = red8(x);
    x += dppf<0x140>(x);
    return x;
}
__device__ __forceinline__ float red_g(float x) {
    x += __shfl_xor(x, 16);
    x += __shfl_xor(x, 32);
    return x;
}
__device__ __forceinline__ float wave_sum(float x) {
    x = red16(x);
    return red_g(x);
}
__device__ __forceinline__ bf16x8 as_frag(uint4 v) {
    union { uint4 u; bf16x8 f; } c;
    c.u = v;
    return c.f;
}
#define MFMA(a, b, c) __builtin_amdgcn_mfma_f32_16x16x32_bf16((a), (b), (c), 0, 0, 0)

constexpr int LDT = 72;
constexpr int STG = 128 * LDT;
__device__ __forceinline__ void gemm_loop(const u16* __restrict__ A, int lda, const u16* __restrict__ B, int ldb,
                                          int nkt, u16* smem, f32x4 (&acc)[4][4]) {
    const int tid = threadIdx.x, lane = tid & 63, wid = tid >> 6, wm = wid >> 1, wn = wid & 1, l16 = lane & 15, g = lane >> 4;
    const int lr = tid >> 3, lc = (tid & 7) * 8;
    u16* sA = smem;
    u16* sB = smem + 2 * STG;
    const u16* ap = A + (size_t)lr * lda + lc;
    const u16* bp = B + (size_t)lr * ldb + lc;
    uint4 ra0, ra1, ra2, ra3, rb0, rb1, rb2, rb3;
#define G_LOAD(ko)                                                   \
    ra0 = *(const uint4*)(ap + (ko));                                \
    ra1 = *(const uint4*)(ap + (size_t)32 * lda + (ko));             \
    ra2 = *(const uint4*)(ap + (size_t)64 * lda + (ko));             \
    ra3 = *(const uint4*)(ap + (size_t)96 * lda + (ko));             \
    rb0 = *(const uint4*)(bp + (ko));                                \
    rb1 = *(const uint4*)(bp + (size_t)32 * ldb + (ko));             \
    rb2 = *(const uint4*)(bp + (size_t)64 * ldb + (ko));             \
    rb3 = *(const uint4*)(bp + (size_t)96 * ldb + (ko));
#define G_STORE(bo)                                                  \
    *(uint4*)(sA + (bo) + (lr + 0) * LDT + lc) = ra0;                \
    *(uint4*)(sA + (bo) + (lr + 32) * LDT + lc) = ra1;               \
    *(uint4*)(sA + (bo) + (lr + 64) * LDT + lc) = ra2;               \
    *(uint4*)(sA + (bo) + (lr + 96) * LDT + lc) = ra3;               \
    *(uint4*)(sB + (bo) + (lr + 0) * LDT + lc) = rb0;                \
    *(uint4*)(sB + (bo) + (lr + 32) * LDT + lc) = rb1;               \
    *(uint4*)(sB + (bo) + (lr + 64) * LDT + lc) = rb2;               \
    *(uint4*)(sB + (bo) + (lr + 96) * LDT + lc) = rb3;
    G_LOAD(0)
    G_STORE(0)
    __syncthreads();
    for (int kt = 0; kt < nkt; ++kt) {
        const int buf = kt & 1;
        if (kt + 1 < nkt) { G_LOAD((kt + 1) * 64) }
        __builtin_amdgcn_sched_barrier(0);
        const u16* cA = sA + buf * STG + (wm * 64 + l16) * LDT + g * 8;
        const u16* cB = sB + buf * STG + (wn * 64 + l16) * LDT + g * 8;
#pragma unroll
        for (int ks = 0; ks < 2; ++ks) {
            bf16x8 xf[4], wf[4];
#pragma unroll
            for (int i = 0; i < 4; ++i) {
                xf[i] = *(const bf16x8*)(cA + i * 16 * LDT + ks * 32);
                wf[i] = *(const bf16x8*)(cB + i * 16 * LDT + ks * 32);
            }
#pragma unroll
            for (int nt = 0; nt < 4; ++nt)
#pragma unroll
                for (int mt = 0; mt < 4; ++mt) acc[nt][mt] = MFMA(wf[nt], xf[mt], acc[nt][mt]);
        }
        __builtin_amdgcn_sched_barrier(0);
        if (kt + 1 < nkt) { G_STORE((buf ^ 1) * STG) }
        __syncthreads();
    }
}
__device__ __forceinline__ void gemm_loop_xf32(const float* __restrict__ A, const u16* __restrict__ B, int ldb, int nkt, u16* smem,
                                               f32x4 (&acc)[4][4]) {
    const int tid = threadIdx.x, lane = tid & 63, wid = tid >> 6, wm = wid >> 1, wn = wid & 1, l16 = lane & 15, g = lane >> 4;
    const int lr = tid >> 3, lc = (tid & 7) * 8;
    u16* sA = smem;
    u16* sB = smem + 2 * STG;
    const float* ap = A + (size_t)lr * 1024 + lc;
    const u16* bp = B + (size_t)lr * ldb + lc;
    float4 fa0, fa1, fa2, fa3, fa4, fa5, fa6, fa7;
    uint4 rb0, rb1, rb2, rb3;
#define GX_LOAD(ko)                                                  \
    fa0 = *(const float4*)(ap + (ko));                               \
    fa1 = *(const float4*)(ap + (ko) + 4);                           \
    fa2 = *(const float4*)(ap + 32 * 1024 + (ko));                   \
    fa3 = *(const float4*)(ap + 32 * 1024 + (ko) + 4);               \
    fa4 = *(const float4*)(ap + 64 * 1024 + (ko));                   \
    fa5 = *(const float4*)(ap + 64 * 1024 + (ko) + 4);               \
    fa6 = *(const float4*)(ap + 96 * 1024 + (ko));                   \
    fa7 = *(const float4*)(ap + 96 * 1024 + (ko) + 4);               \
    rb0 = *(const uint4*)(bp + (ko));                                \
    rb1 = *(const uint4*)(bp + (size_t)32 * ldb + (ko));             \
    rb2 = *(const uint4*)(bp + (size_t)64 * ldb + (ko));             \
    rb3 = *(const uint4*)(bp + (size_t)96 * ldb + (ko));
#define PKF(a, b) make_uint4(pk2(a.x, a.y), pk2(a.z, a.w), pk2(b.x, b.y), pk2(b.z, b.w))
#define GX_STORE(bo)                                                 \
    *(uint4*)(sA + (bo) + (lr + 0) * LDT + lc) = PKF(fa0, fa1);      \
    *(uint4*)(sA + (bo) + (lr + 32) * LDT + lc) = PKF(fa2, fa3);     \
    *(uint4*)(sA + (bo) + (lr + 64) * LDT + lc) = PKF(fa4, fa5);     \
    *(uint4*)(sA + (bo) + (lr + 96) * LDT + lc) = PKF(fa6, fa7);     \
    *(uint4*)(sB + (bo) + (lr + 0) * LDT + lc) = rb0;                \
    *(uint4*)(sB + (bo) + (lr + 32) * LDT + lc) = rb1;               \
    *(uint4*)(sB + (bo) + (lr + 64) * LDT + lc) = rb2;               \
    *(uint4*)(sB + (bo) + (lr + 96) * LDT + lc) = rb3;
    GX_LOAD(0)
    GX_STORE(0)
    __syncthreads();
    for (int kt = 0; kt < nkt; ++kt) {
        const int buf = kt & 1;
        if (kt + 1 < nkt) { GX_LOAD((kt + 1) * 64) }
        __builtin_amdgcn_sched_barrier(0);
        const u16* cA = sA + buf * STG + (wm * 64 + l16) * LDT + g * 8;
        const u16* cB = sB + buf * STG + (wn * 64 + l16) * LDT + g * 8;
#pragma unroll
        for (int ks = 0; ks < 2; ++ks) {
            bf16x8 xf[4], wf[4];
#pragma unroll
            for (int i = 0; i < 4; ++i) {
                xf[i] = *(const bf16x8*)(cA + i * 16 * LDT + ks * 32);
                wf[i] = *(const bf16x8*)(cB + i * 16 * LDT + ks * 32);
            }
#pragma unroll
            for (int nt = 0; nt < 4; ++nt)
#pragma unroll
                for (int mt = 0; mt < 4; ++mt) acc[nt][mt] = MFMA(wf[nt], xf[mt], acc[nt][mt]);
        }
        __builtin_amdgcn_sched_barrier(0);
        if (kt + 1 < nkt) { GX_STORE((buf ^ 1) * STG) }
        __syncthreads();
    }
}
__device__ __forceinline__ void zero_acc(f32x4 (&acc)[4][4]) {
#pragma unroll
    for (int i = 0; i < 4; ++i)
#pragma unroll
        for (int j = 0; j < 4; ++j) acc[i][j] = (f32x4){0.f, 0.f, 0.f, 0.f};
}
__device__ __forceinline__ void tile_map(int t, int NT, int& mt, int& nt) {
    const int x = t & 7, u = t >> 3;
    const int gsz = 8 * NT;
    const int g = u / gsz;
    const int w = u - g * gsz;
    const int rows = (g < 8) ? 8 : 1;
    const int q = w / rows;
    mt = x * 65 + g * 8 + (w - q * rows);
    nt = q;
}

__device__ __forceinline__ void tr_tile(const float* __restrict__ in, int R, int C, int ldin, u16* __restrict__ out, int ldout,
                        const float* __restrict__ scale, int r0, int c0, int Cout, bool perm, float* tile) {
    const int tid = threadIdx.x;
    {
        const int tx = tid & 63, ty = tid >> 6;
        const int c = c0 + tx;
        for (int rr = ty; rr < 64; rr += 4) {
            const int r = r0 + rr;
            float v = 0.f;
            if (r < R && c < C) {
                v = in[(size_t)r * ldin + c];
                if (scale) v *= scale[r];
            }
            tile[rr * 65 + tx] = v;
        }
    }
    __syncthreads();
    {
        const int rch = (tid & 7) * 8;
#pragma unroll
        for (int pass = 0; pass < 2; ++pass) {
            const int cc = (tid >> 3) + pass * 32;
            const int c = c0 + cc;
            if (c < Cout && r0 + rch < R) {
                float v[8];
#pragma unroll
                for (int k = 0; k < 8; ++k) v[k] = tile[(rch + k) * 65 + cc];
                int orow = c;
                if (perm) {
                    const int type = c >= 2816 ? 1 : 0;
                    const int j = c - type * 2816;
                    orow = (j >> 4) * 32 + type * 16 + (j & 15);
                }
                uint4 o = make_uint4(pk2(v[0], v[1]), pk2(v[2], v[3]), pk2(v[4], v[5]), pk2(v[6], v[7]));
                *(uint4*)(out + (size_t)orow * ldout + r0 + rch) = o;
            }
        }
    }
    __syncthreads();
}

__device__ __forceinline__ void phase0(const Params& p, unsigned char* smem) {
    float* tile = (float*)smem;
    const int tid = threadIdx.x, lane = tid & 63, wid = tid >> 6;
    unsigned char* ws = p.ws;
    const int G = gridDim.x;
    for (int u = blockIdx.x; u < 8136; u += G) {
        const float* in;
        int R, C, Cout, ldout, tl;
        u16* out;
        const float* scale = nullptr;
        bool perm = false;
        if (u < 1376) { tl = u; in = p.w_in; R = 1024; C = 5408; Cout = 5504; out = (u16*)(ws + O_WIN); ldout = 1024; scale = p.n_mix_pre; }
        else if (u < 1504) { tl = u - 1376; in = p.w_out_a; R = 512; C = 1024; Cout = 1024; out = (u16*)(ws + O_WOA); ldout = 512; }
        else if (u < 1632) { tl = u - 1504; in = p.w_out_b; R = 512; C = 1024; Cout = 1024; out = (u16*)(ws + O_WOB); ldout = 512; }
        else if (u < 1888) { tl = u - 1632; in = p.w_o; R = 1024; C = 1024; Cout = 1024; out = (u16*)(ws + O_WO); ldout = 1024; }
        else if (u < 3296) { tl = u - 1888; in = p.w_ffn_in; R = 1024; C = 5632; Cout = 5632; out = (u16*)(ws + O_WFI); ldout = 1024; scale = p.n_ffn_pre; perm = true; }
        else if (u < 4000) { tl = u - 3296; in = p.w_ffn_out; R = 2816; C = 1024; Cout = 1024; out = (u16*)(ws + O_WFO); ldout = 2816; }
        else if (u < 4008) { tl = u - 4000; in = p.w2; R = 64; C = 512; Cout = 512; out = (u16*)(ws + O_W2); ldout = 64; }
        else if (u < 4016) { tl = u - 4008; in = p.a2; R = 64; C = 512; Cout = 512; out = (u16*)(ws + O_A2); ldout = 64; }
        else if (u < 4040) { tl = u - 4016; in = p.g2; R = 160; C = 512; Cout = 512; out = (u16*)(ws + O_G2); ldout = 160; }
        else {
            tl = u - 4040;
            const int b = tl >> 7;
            tl &= 127;
            in = p.cache_v + (size_t)b * 1024 * 512; R = 1024; C = 512; Cout = 512;
            out = (u16*)(ws + O_VTS) + (size_t)b * 512 * LKS; ldout = LKS;
        }
        const int ctiles = (Cout + 63) >> 6;
        const int rt = tl / ctiles, ct = tl - rt * ctiles;
        tr_tile(in, R, C, C, out, ldout, scale, rt * 64, ct * 64, Cout, perm, tile);
    }
    {
        u16* xb = (u16*)(ws + O_XB);
        float* rs1 = (float*)(ws + O_RS1);
        for (int m = blockIdx.x * 4 + wid; m < T; m += G * 4) {
            const float* xr = (m < TP) ? p.x_prompt + (size_t)m * 1024 : p.x_sample + (size_t)(m - TP) * 1024;
            float ss = 0.f;
#pragma unroll
            for (int i = 0; i < 4; ++i) {
                const float4 v = *(const float4*)(xr + i * 256 + lane * 4);
                ss += v.x * v.x + v.y * v.y + v.z * v.z + v.w * v.w;
                *(uint2*)(xb + (size_t)m * 1024 + i * 256 + lane * 4) = pk4(v.x, v.y, v.z, v.w);
            }
            ss = wave_sum(ss);
            if (lane == 0) rs1[m] = rsqrtf(ss * (1.f / 1024.f) + EPS);
        }
    }
    {
        u16* kS = (u16*)(ws + O_KS);
        const int n8 = 32 * 1024 * 64;
        for (int i = blockIdx.x * 256 + tid; i < n8; i += G * 256) {
            const int b = i >> 16, rem = i & 65535, key = rem >> 6, c8 = rem & 63;
            const float4 v0 = *(const float4*)(p.cache_k + (size_t)i * 8);
            const float4 v1 = *(const float4*)(p.cache_k + (size_t)i * 8 + 4);
            *(uint4*)(kS + ((size_t)b * LKS + key) * 512 + c8 * 8) =
                make_uint4(pk2(v0.x, v0.y), pk2(v0.z, v0.w), pk2(v1.x, v1.y), pk2(v1.z, v1.w));
        }
        for (int i = blockIdx.x * 256 + tid; i < 32 * 32 * 64; i += G * 256) {
            const int b = i >> 11, rem = i & 2047, row = rem >> 6, c8 = rem & 63;
            *(uint4*)(kS + ((size_t)b * LKS + 1056 + row) * 512 + c8 * 8) = make_uint4(0, 0, 0, 0);
        }
        u16* vtS = (u16*)(ws + O_VTS);
        for (int i = blockIdx.x * 256 + tid; i < 32 * 512 * 4; i += G * 256) {
            const int row = i >> 2, c8 = i & 3;
            *(uint4*)(vtS + (size_t)row * LKS + 1056 + c8 * 8) = make_uint4(0, 0, 0, 0);
        }
    }
    {
        u16* cA = (u16*)(ws + O_CA);
        for (int i = blockIdx.x * 256 + tid; i < 48 * ACOLS; i += G * 256) {
            const int s = i / ACOLS, c = i - s * ACOLS;
            float v = 0.f;
            size_t row;
            if (s < 16) row = (size_t)s * 4097;
            else { row = (size_t)16 * 4097 + (size_t)(s - 16) * 33; v = p.state_shift[(size_t)(s - 16) * ACOLS + c]; }
            cA[row * ACOLS + c] = f2bf(v);
        }
        if (blockIdx.x == 0 && tid == 0) {
            float d1 = 0.f, d2 = 0.f;
            for (int i = 0; i < 64; ++i) { d1 += p.lq1[i] * p.lk1[i]; d2 += p.lq2[i] * p.lk2[i]; }
            float* sc = (float*)(ws + O_SCAL);
            sc[0] = __expf(d1) - __expf(d2) + 0.2f;
            for (int i = 1; i < 32; ++i) ((unsigned*)sc)[i] = 0u;
        }
    }
}

__device__ __forceinline__ void phase1(const Params& p, unsigned char* smem) {
    unsigned char* ws = p.ws;
    const u16* xb = (const u16*)(ws + O_XB);
    const u16* W = (const u16*)(ws + O_WIN);
    const float* rs1 = (const float*)(ws + O_RS1);
    u16* cA = (u16*)(ws + O_CA);
    u16* qb = (u16*)(ws + O_QB);
    u16* kP = (u16*)(ws + O_KP);
    u16* kS = (u16*)(ws + O_KS);
    u16* vtP = (u16*)(ws + O_VTP);
    u16* vtS = (u16*)(ws + O_VTS);
    float* out = p.out;
    const int tid = threadIdx.x, lane = tid & 63, wid = tid >> 6, wm = wid >> 1, wn = wid & 1, l16 = lane & 15, g = lane >> 4;
    constexpr int NT = 43;
    u16* gate = (u16*)p.out;
    for (int t = blockIdx.x; t < 520 * NT; t += gridDim.x) {
        int mtile, ntile;
        tile_map(t, NT, mtile, ntile);
        const int m0 = mtile * 128, n0 = ntile * 128;
        f32x4 acc[4][4];
        zero_acc(acc);
        gemm_loop(xb + (size_t)m0 * 1024, 1024, W + (size_t)n0 * 1024, 1024, 16, (u16*)smem, acc);
#pragma unroll
        for (int mt = 0; mt < 4; ++mt) {
            const int m = m0 + wm * 64 + mt * 16 + l16;
            const float rs = rs1[m];
            const bool isP = m < TP;
            int seq, tt;
            if (isP) { seq = m >> 12; tt = m & 4095; }
            else { const int ms = m - TP; seq = 16 + (ms >> 5); tt = ms & 31; }
            const size_t carow = (size_t)m + seq + 1;
            const bool last = isP ? (tt == 4095) : (tt == 31);
#pragma unroll
            for (int nt = 0; nt < 4; ++nt) {
                const int n = n0 + wn * 64 + nt * 16 + g * 4;
                if (n >= 5408) continue;
                f32x4 v = acc[nt][mt];
                v[0] *= rs; v[1] *= rs; v[2] *= rs; v[3] *= rs;
                if (n < 1824) {
                    *(uint2*)(cA + carow * ACOLS + n) = pk4(v[0], v[1], v[2], v[3]);
                    if (last) {
                        float* so = isP ? out + OFF_SHP + (size_t)seq * ACOLS + n : out + OFF_SHS + (size_t)(seq - 16) * ACOLS + n;
                        *(float4*)so = make_float4(v[0], v[1], v[2], v[3]);
                    }
                } else if (n < 2336) {
                    *(uint2*)(qb + (size_t)m * 512 + (n - 1824)) = pk4(v[0], v[1], v[2], v[3]);
                } else if (n < 2848) {
                    const int c = n - 2336;
                    if (isP) {
                        *(uint2*)(kP + (size_t)m * 512 + c) = pk4(v[0], v[1], v[2], v[3]);
                        *(float4*)(out + OFF_KP + (size_t)m * 512 + c) = make_float4(v[0], v[1], v[2], v[3]);
                    } else {
                        *(uint2*)(kS + ((size_t)(seq - 16) * LKS + 1024 + tt) * 512 + c) = pk4(v[0], v[1], v[2], v[3]);
                        *(float4*)(out + OFF_KS + (size_t)(m - TP) * 512 + c) = make_float4(v[0], v[1], v[2], v[3]);
                    }
                } else if (n < 3360) {
                    const int c = n - 2848;
                    if (isP) {
                        *(float4*)(out + OFF_VP + (size_t)m * 512 + c) = make_float4(v[0], v[1], v[2], v[3]);
                        u16* d = vtP + ((size_t)seq * 512 + c) * 4096 + tt;
                        d[0] = f2bf(v[0]); d[4096] = f2bf(v[1]); d[2 * 4096] = f2bf(v[2]); d[3 * 4096] = f2bf(v[3]);
                    } else {
                        *(float4*)(out + OFF_VS + (size_t)(m - TP) * 512 + c) = make_float4(v[0], v[1], v[2], v[3]);
                        u16* d = vtS + ((size_t)(seq - 16) * 512 + c) * LKS + 1024 + tt;
                        d[0] = f2bf(v[0]); d[LKS] = f2bf(v[1]); d[2 * LKS] = f2bf(v[2]); d[3 * LKS] = f2bf(v[3]);
                    }
                } else {
                    const int c = n - 3360;
                    const float4 bg = *(const float4*)(p.b_gate + c);
                    *(uint2*)(gate + (size_t)m * 2048 + c) =
                        pk4(sigmoidf_(v[0] + bg.x), sigmoidf_(v[1] + bg.y), sigmoidf_(v[2] + bg.z), sigmoidf_(v[3] + bg.w));
                }
            }
        }
    }
}

__device__ __forceinline__ void lerp8(const u16* cur, const u16* prv, const float* mu, int col, float (&xs)[8]) {
    const uint4 cu = *(const uint4*)(cur + col);
    const uint4 pv = *(const uint4*)(prv + col);
    const float4 m0 = *(const float4*)(mu + col);
    const float4 m1 = *(const float4*)(mu + col + 4);
    const unsigned cw[4] = {cu.x, cu.y, cu.z, cu.w}, pw[4] = {pv.x, pv.y, pv.z, pv.w};
    const float mm[8] = {m0.x, m0.y, m0.z, m0.w, m1.x, m1.y, m1.z, m1.w};
#pragma unroll
    for (int i = 0; i < 4; ++i) {
        const float c0 = bflo(cw[i]), c1 = bfhi(cw[i]), p0 = bflo(pw[i]), p1 = bfhi(pw[i]);
        xs[2 * i] = c0 + (p0 - c0) * mm[2 * i];
        xs[2 * i + 1] = c1 + (p1 - c1) * mm[2 * i + 1];
    }
}
__device__ __forceinline__ void lerp4(const u16* cur, const u16* prv, const float* mu, int col, float (&xs)[4]) {
    const uint2 cu = *(const uint2*)(cur + col);
    const uint2 pv = *(const uint2*)(prv + col);
    const float4 m0 = *(const float4*)(mu + col);
    float c0 = bflo(cu.x), c1 = bfhi(cu.x), c2 = bflo(cu.y), c3 = bfhi(cu.y);
    xs[0] = c0 + (bflo(pv.x) - c0) * m0.x;
    xs[1] = c1 + (bfhi(pv.x) - c1) * m0.y;
    xs[2] = c2 + (bflo(pv.y) - c2) * m0.z;
    xs[3] = c3 + (bfhi(pv.y) - c3) * m0.w;
}
__device__ __forceinline__ bf16x8 packfrag(const float (&v)[8]) {
    return as_frag(make_uint4(pk2(v[0], v[1]), pk2(v[2], v[3]), pk2(v[4], v[5]), pk2(v[6], v[7])));
}

__device__ __forceinline__ void phase2(const Params& p) {
    unsigned char* ws = p.ws;
    const u16* cA = (const u16*)(ws + O_CA);
    const u16* w2t = (const u16*)(ws + O_W2);
    const u16* a2t = (const u16*)(ws + O_A2);
    const u16* g2t = (const u16*)(ws + O_G2);
    u16* SI = (u16*)(ws + O_SI);
    u16* Gb = (u16*)(ws + O_G);
    float4* rk4 = (float4*)(ws + O_RK);
    const int tid = threadIdx.x, lane = tid & 63, wid = tid >> 6, l16 = lane & 15, g = lane >> 4;
    for (int u = blockIdx.x; u < T / 64; u += gridDim.x) {
        const int mw = u * 64 + wid * 16;
        const int m = mw + l16;
        const bool isP = mw < TP;
        int seq, tt;
        if (isP) { seq = m >> 12; tt = m & 4095; }
        else { const int ms = m - TP; seq = 16 + (ms >> 5); tt = ms & 31; }
        const u16* cur = cA + ((size_t)m + seq + 1) * ACOLS;
        const u16* prv = cur - ACOLS;
        bf16x8 xw[2], xa[2], xg[5];
#pragma unroll
        for (int s = 0; s < 9; ++s) {
            float xs[8];
            lerp8(cur, prv, p.mu, 1536 + s * 32 + g * 8, xs);
            if (s < 2) {
#pragma unroll
                for (int i = 0; i < 8; ++i) xs[i] = 1.f - 2.f / (__expf(2.f * xs[i]) + 1.f);
                xw[s] = packfrag(xs);
            } else if (s < 4) {
                xa[s - 2] = packfrag(xs);
            } else {
#pragma unroll
                for (int i = 0; i < 8; ++i) xs[i] = sigmoidf_(xs[i]);
                xg[s - 4] = packfrag(xs);
            }
        }
        for (int h = 0; h < 8; ++h) {
            float kkr[16], av[16];
            float ssq = 0.f, rkacc = 0.f, bracc = 0.f, kracc = 0.f;
            const size_t sirow = isP ? ((size_t)(seq * 8 + h) * 4096 + tt) : ((size_t)128 * 4096 + (size_t)((seq - 16) * 8 + h) * 32 + tt);
            u16* sib = SI + sirow * 384;
#pragma unroll
            for (int nt = 0; nt < 4; ++nt) {
                const int wrow = h * 64 + nt * 16 + l16;
                f32x4 accw = {0.f, 0.f, 0.f, 0.f}, acca = accw, accg = accw;
#pragma unroll
                for (int s = 0; s < 2; ++s) {
                    accw = MFMA(*(const bf16x8*)(w2t + wrow * 64 + s * 32 + g * 8), xw[s], accw);
                    acca = MFMA(*(const bf16x8*)(a2t + wrow * 64 + s * 32 + g * 8), xa[s], acca);
                }
#pragma unroll
                for (int s = 0; s < 5; ++s) accg = MFMA(*(const bf16x8*)(g2t + wrow * 160 + s * 32 + g * 8), xg[s], accg);
                const int ch = h * 64 + nt * 16 + g * 4;
                float xr[4], xk[4], xv[4];
                lerp4(cur, prv, p.mu, ch, xr);
                lerp4(cur, prv, p.mu, 512 + ch, xk);
                lerp4(cur, prv, p.mu, 1024 + ch, xv);
                const float4 w0 = *(const float4*)(p.w0 + ch), a0 = *(const float4*)(p.a0 + ch), kk4 = *(const float4*)(p.k_k + ch),
                             ka4 = *(const float4*)(p.k_a + ch), rk4 = *(const float4*)(p.r_k + ch);
                const float w0a[4] = {w0.x, w0.y, w0.z, w0.w}, a0a[4] = {a0.x, a0.y, a0.z, a0.w}, kka[4] = {kk4.x, kk4.y, kk4.z, kk4.w},
                            kaa[4] = {ka4.x, ka4.y, ka4.z, ka4.w}, rka[4] = {rk4.x, rk4.y, rk4.z, rk4.w};
                float ev[4], kp[4], dr[4];
#pragma unroll
                for (int r = 0; r < 4; ++r) {
                    const float z = -(w0a[r] + accw[r]);
                    const float sp = (z > 20.f) ? z : __logf(1.f + __expf(z));
                    ev[r] = __expf(-sp - 0.5f);
                    const float a = sigmoidf_(a0a[r] + acca[r]);
                    const float kraw = xk[r] * kka[r];
                    ssq += kraw * kraw;
                    kp[r] = xk[r] * (1.f + (a - 1.f) * kaa[r]);
                    rkacc += xr[r] * kp[r] * rka[r];
                    kracc += xr[r] * kp[r];
                    bracc += kraw * a * xr[r];
                    dr[r] = xr[r] * __expf(-ev[r]);
                    kkr[nt * 4 + r] = kraw;
                    av[nt * 4 + r] = a;
                }
                const int co = nt * 16 + g * 4;
                *(uint2*)(sib + 0 * 64 + co) = pk4(dr[0], dr[1], dr[2], dr[3]);
                *(uint2*)(sib + 1 * 64 + co) = pk4(ev[0], ev[1], ev[2], ev[3]);
                *(uint2*)(sib + 2 * 64 + co) = pk4(kp[0], kp[1], kp[2], kp[3]);
                *(uint2*)(sib + 3 * 64 + co) = pk4(xv[0], xv[1], xv[2], xv[3]);
                *(uint2*)(Gb + (size_t)m * 512 + ch) = pk4(accg[0], accg[1], accg[2], accg[3]);
            }
            ssq = red_g(ssq);
            rkacc = red_g(rkacc);
            bracc = red_g(bracc);
            kracc = red_g(kracc);
            const float inv = rsqrtf(fmaxf(ssq, 1e-24f));
#pragma unroll
            for (int nt = 0; nt < 4; ++nt) {
                const int co = nt * 16 + g * 4;
                float k0 = kkr[nt * 4 + 0] * inv, k1 = kkr[nt * 4 + 1] * inv, k2 = kkr[nt * 4 + 2] * inv, k3 = kkr[nt * 4 + 3] * inv;
                *(uint2*)(sib + 4 * 64 + co) = pk4(k0, k1, k2, k3);
                *(uint2*)(sib + 5 * 64 + co) = pk4(k0 * av[nt * 4 + 0], k1 * av[nt * 4 + 1], k2 * av[nt * 4 + 2], k3 * av[nt * 4 + 3]);
            }
            if (g == 0) rk4[(size_t)m * 8 + h] = make_float4(rkacc, bracc * inv, kracc, 0.f);
        }
    }
}

typedef float v2f __attribute__((ext_vector_type(2)));
__device__ __forceinline__ void scan_item(const Params& p, const u16* __restrict__ si, int nch, const float* __restrict__ s0, float* __restrict__ sout,
                          int m0, int h, int half, unsigned char* smem) {
    float* inb = (float*)smem;
    float* ybuf = (float*)(smem + 49152);
    float* scal = (float*)(smem + 53248);
    unsigned char* ws = p.ws;
    const float4* rk4 = (const float4*)(ws + O_RK);
    u16* yraw = (u16*)(ws + O_YRAW);
    const int tid = threadIdx.x;
    const int vp = tid >> 3, kq = tid & 7;
    const int row = half * 32 + vp;
    v2f S[4];
    if (s0) {
        const float4 a = *(const float4*)(s0 + row * 64 + kq * 8), b = *(const float4*)(s0 + row * 64 + kq * 8 + 4);
        S[0] = (v2f){a.x, a.y}; S[1] = (v2f){a.z, a.w}; S[2] = (v2f){b.x, b.y}; S[3] = (v2f){b.z, b.w};
    } else {
#pragma unroll
        for (int j = 0; j < 4; ++j) S[j] = (v2f){0.f, 0.f};
    }
    uint4 st0, st1, st2;
    float4 sq = make_float4(0.f, 0.f, 0.f, 0.f);
    st0 = *(const uint4*)(si + (0 * 256 + tid) * 8);
    st1 = *(const uint4*)(si + (1 * 256 + tid) * 8);
    st2 = *(const uint4*)(si + (2 * 256 + tid) * 8);
    if (tid < 16) sq = rk4[(m0 + tid) * 8 + h];
#define S_WRITE1(sv, i, buf)                                                                                          \
    {                                                                                                                 \
        const int idx = (i) * 256 + tid;                                                                              \
        const int vec = (idx % 48) >> 3;                                                                              \
        float v[8] = {bflo(sv.x), bfhi(sv.x), bflo(sv.y), bfhi(sv.y), bflo(sv.z), bfhi(sv.z), bflo(sv.w), bfhi(sv.w)}; \
        if (vec == 1) {                                                                                               \
            _Pragma("unroll") for (int k = 0; k < 8; ++k) v[k] = __expf(-v[k]);                                       \
        }                                                                                                             \
        float* d = inb + (buf) * 6144 + idx * 8;                                                                      \
        *(float4*)d = make_float4(v[0], v[1], v[2], v[3]);                                                            \
        *(float4*)(d + 4) = make_float4(v[4], v[5], v[6], v[7]);                                                      \
    }
#define stage_write(buf) S_WRITE1(st0, 0, buf) S_WRITE1(st1, 1, buf) S_WRITE1(st2, 2, buf) if (tid < 16) *(float4*)(scal + (buf) * 64 + tid * 4) = sq;
    stage_write(0)
    __syncthreads();
    for (int c = 0; c < nch; ++c) {
        const int buf = c & 1;
        if (c + 1 < nch) {
            const u16* sn = si + (c + 1) * 6144 + tid * 8;
            st0 = *(const uint4*)(sn);
            st1 = *(const uint4*)(sn + 2048);
            st2 = *(const uint4*)(sn + 4096);
            if (tid < 16) sq = rk4[(m0 + (c + 1) * 16 + tid) * 8 + h];
        }
        const float* cb = inb + buf * 6144;
        const float* cs = scal + buf * 64;
#pragma unroll 2
        for (int tt = 0; tt < 16; ++tt) {
            const float* base = cb + tt * 384;
            v2f kk[4], dr[4], dd[4], bb[4], kv[4];
#define LD8(dst, off)                                                      \
    {                                                                      \
        const float4 q0 = *(const float4*)(base + (off) + kq * 8);         \
        const float4 q1 = *(const float4*)(base + (off) + kq * 8 + 4);     \
        dst[0] = (v2f){q0.x, q0.y}; dst[1] = (v2f){q0.z, q0.w};            \
        dst[2] = (v2f){q1.x, q1.y}; dst[3] = (v2f){q1.z, q1.w};            \
    }
            LD8(kk, 256) LD8(dr, 0) LD8(dd, 64) LD8(bb, 320) LD8(kv, 128)
            const float vv = base[192 + row];
            const float2 brkr = *(const float2*)(cs + tt * 4 + 1);
            v2f a0 = S[0] * kk[0], a1 = S[1] * kk[1], q0 = S[0] * dr[0], q1 = S[1] * dr[1];
            a0 = __builtin_elementwise_fma(S[2], kk[2], a0);
            a1 = __builtin_elementwise_fma(S[3], kk[3], a1);
            q0 = __builtin_elementwise_fma(S[2], dr[2], q0);
            q1 = __builtin_elementwise_fma(S[3], dr[3], q1);
            a0 += a1;
            q0 += q1;
            const float sa = -red8(a0.x + a0.y);
            const float pp = red8(q0.x + q0.y);
            const float y = pp + sa * brkr.x + vv * brkr.y;
            if (kq == 0) ybuf[tt * 32 + vp] = y;
            const v2f sav = (v2f){sa, sa}, vvv = (v2f){vv, vv};
#pragma unroll
            for (int j = 0; j < 4; ++j) S[j] = __builtin_elementwise_fma(S[j], dd[j], __builtin_elementwise_fma(vvv, kv[j], sav * bb[j]));
        }
        __syncthreads();
        {
            const int tt = tid >> 4, e2 = (tid & 15) * 2;
            const float2 y2 = *(const float2*)(ybuf + tt * 32 + e2);
            *(unsigned*)(yraw + (m0 + c * 16 + tt) * 512 + h * 64 + half * 32 + e2) = pk2(y2.x, y2.y);
        }
        if (c + 1 < nch) { stage_write(buf ^ 1) }
        __syncthreads();
    }
    {
        float* d0 = sout + row * 64 + kq * 8;
        *(float4*)d0 = make_float4(S[0].x, S[0].y, S[1].x, S[1].y);
        *(float4*)(d0 + 4) = make_float4(S[2].x, S[2].y, S[3].x, S[3].y);
    }
}

__device__ __forceinline__ void ln_pass(const Params& p) {
    unsigned char* ws = p.ws;
    const u16* yraw = (const u16*)(ws + O_YRAW);
    const u16* Gb = (const u16*)(ws + O_G);
    const u16* SI = (const u16*)(ws + O_SI);
    const float4* rk4 = (const float4*)(ws + O_RK);
    u16* ya = (u16*)(ws + O_YA);
    const int tid = threadIdx.x, cq = (tid & 15) * 4;
    for (int q0 = blockIdx.x * 16; q0 < T * 8; q0 += gridDim.x * 16) {
        const int q = q0 + (tid >> 4);
        const int m = q >> 3, h = q & 7;
        const int e = m * 512 + h * 64 + cq;
        const uint2 yv = *(const uint2*)(yraw + e);
        const float y0 = bflo(yv.x), y1 = bfhi(yv.x), y2 = bflo(yv.y), y3 = bfhi(yv.y);
        const float mean = red16(y0 + y1 + y2 + y3) * (1.f / 64.f);
        const float d0 = y0 - mean, d1 = y1 - mean, d2 = y2 - mean, d3 = y3 - mean;
        const float var = red16(d0 * d0 + d1 * d1 + d2 * d2 + d3 * d3) * (1.f / 64.f);
        const float rstd = rsqrtf(var + 64e-5f);
        const float rkv = rk4[q].x;
        int sirow;
        if (m < TP) sirow = ((m >> 12) * 8 + h) * 4096 + (m & 4095);
        else { const int ms = m - TP; sirow = 128 * 4096 + ((ms >> 5) * 8 + h) * 32 + (ms & 31); }
        const uint2 vq = *(const uint2*)(SI + (size_t)sirow * 384 + 192 + cq);
        const uint2 gg = *(const uint2*)(Gb + e);
        const float4 lw = *(const float4*)(p.ln_w + h * 64 + cq), lb = *(const float4*)(p.ln_b + h * 64 + cq);
        const float o0 = (d0 * rstd * lw.x + lb.x + rkv * bflo(vq.x)) * bflo(gg.x);
        const float o1 = (d1 * rstd * lw.y + lb.y + rkv * bfhi(vq.x)) * bfhi(gg.x);
        const float o2 = (d2 * rstd * lw.z + lb.z + rkv * bflo(vq.y)) * bflo(gg.y);
        const float o3 = (d3 * rstd * lw.w + lb.w + rkv * bfhi(vq.y)) * bfhi(gg.y);
        *(uint2*)(ya + e) = pk4(o0, o1, o2, o3);
    }
}

constexpr int KLD = 136, VLD = 72;
__device__ __forceinline__ void attn_item(const u16* __restrict__ Q, int nq, const u16* __restrict__ K, const u16* __restrict__ Vt, int ldv, int nkt,
                          int lastvalid, u16* __restrict__ O, float lam, const float* __restrict__ subln, unsigned char* smem) {
    u16* sK = (u16*)smem;
    u16* sV = (u16*)(smem + 2 * 64 * KLD * 2);
    float* ex = (float*)smem;
    const int tid = threadIdx.x, lane = tid & 63, wid = tid >> 6, l16 = lane & 15, g = lane >> 4;
    const int n = wid >> 1, qh = wid & 1;
    const bool active = (qh * 32) < nq;
    bf16x8 qf[2][2];
#pragma unroll
    for (int qt = 0; qt < 2; ++qt)
#pragma unroll
        for (int s = 0; s < 2; ++s) {
            const int row = qh * 32 + qt * 16 + l16;
            uint4 v = make_uint4(0, 0, 0, 0);
            if (row < nq) v = *(const uint4*)(Q + (row * 512 + n * 64 + s * 32 + g * 8));
            qf[qt][s] = as_frag(v);
        }
    f32x4 o[2][8];
#pragma unroll
    for (int qt = 0; qt < 2; ++qt)
#pragma unroll
        for (int et = 0; et < 8; ++et) o[qt][et] = (f32x4){0.f, 0.f, 0.f, 0.f};
    float mrow[2] = {-1e30f, -1e30f}, lrow[2] = {0.f, 0.f};
    uint4 kr0, kr1, kr2, kr3, vr0, vr1, vr2, vr3;
    const int krow = tid >> 4, kch = (tid & 15) * 8;
    const int vrow = tid >> 3, vch = (tid & 7) * 8;
    const int ko_ = krow * 512 + kch;
    const int vo_ = vrow * ldv + vch;
#define A_LOAD(key0)                                                      \
    kr0 = *(const uint4*)(K + (ko_ + ((key0) + 0) * 512));                \
    kr1 = *(const uint4*)(K + (ko_ + ((key0) + 16) * 512));               \
    kr2 = *(const uint4*)(K + (ko_ + ((key0) + 32) * 512));               \
    kr3 = *(const uint4*)(K + (ko_ + ((key0) + 48) * 512));               \
    vr0 = *(const uint4*)(Vt + (vo_ + (key0)));                           \
    vr1 = *(const uint4*)(Vt + (vo_ + 32 * ldv + (key0)));                \
    vr2 = *(const uint4*)(Vt + (vo_ + 64 * ldv + (key0)));                \
    vr3 = *(const uint4*)(Vt + (vo_ + 96 * ldv + (key0)));
#define A_STORE(nb)                                                       \
    *(uint4*)(sK + (nb) * 64 * KLD + (krow + 0) * KLD + kch) = kr0;       \
    *(uint4*)(sK + (nb) * 64 * KLD + (krow + 16) * KLD + kch) = kr1;      \
    *(uint4*)(sK + (nb) * 64 * KLD + (krow + 32) * KLD + kch) = kr2;      \
    *(uint4*)(sK + (nb) * 64 * KLD + (krow + 48) * KLD + kch) = kr3;      \
    *(uint4*)(sV + (nb) * 128 * VLD + (vrow + 0) * VLD + vch) = vr0;      \
    *(uint4*)(sV + (nb) * 128 * VLD + (vrow + 32) * VLD + vch) = vr1;     \
    *(uint4*)(sV + (nb) * 128 * VLD + (vrow + 64) * VLD + vch) = vr2;     \
    *(uint4*)(sV + (nb) * 128 * VLD + (vrow + 96) * VLD + vch) = vr3;
    A_LOAD(0)
    A_STORE(0)
    __syncthreads();
    constexpr float SC = 0.125f * 1.4426950408889634f;
    for (int kt = 0; kt < nkt; ++kt) {
        const int buf = kt & 1;
        if (kt + 1 < nkt) { A_LOAD((kt + 1) * 64) }
        __builtin_amdgcn_sched_barrier(0);
        if (active) {
            const int valid = (kt == nkt - 1) ? lastvalid : 64;
            const u16* cK = sK + buf * 64 * KLD + l16 * KLD + n * 64 + g * 8;
            const u16* cV = sV + buf * 128 * VLD + l16 * VLD + g * 4;
            f32x4 s[4][2];
#pragma unroll
            for (int k16 = 0; k16 < 4; ++k16) {
                const bf16x8 kf0 = *(const bf16x8*)(cK + k16 * 16 * KLD);
                const bf16x8 kf1 = *(const bf16x8*)(cK + k16 * 16 * KLD + 32);
#pragma unroll
                for (int qt = 0; qt < 2; ++qt) {
                    f32x4 z = {0.f, 0.f, 0.f, 0.f};
                    z = MFMA(kf0, qf[qt][0], z);
                    s[k16][qt] = MFMA(kf1, qf[qt][1], z);
                }
            }
            bf16x8 pf[2][2];
#pragma unroll
            for (int qt = 0; qt < 2; ++qt) {
                float mx = -1e30f;
#pragma unroll
                for (int k16 = 0; k16 < 4; ++k16)
#pragma unroll
                    for (int r = 0; r < 4; ++r) {
                        float v = s[k16][qt][r] * SC;
                        if (k16 * 16 >= valid) v = -1e30f;
                        s[k16][qt][r] = v;
                        mx = fmaxf(mx, v);
                    }
                mx = fmaxf(mx, __shfl_xor(mx, 16));
                mx = fmaxf(mx, __shfl_xor(mx, 32));
                const float mnew = fmaxf(mrow[qt], mx);
                const float alpha = exp2f(mrow[qt] - mnew);
                mrow[qt] = mnew;
                float psum = 0.f;
#pragma unroll
                for (int k16 = 0; k16 < 4; ++k16)
#pragma unroll
                    for (int r = 0; r < 4; ++r) {
                        const float pv = exp2f(s[k16][qt][r] - mnew);
                        s[k16][qt][r] = pv;
                        psum += pv;
                    }
                lrow[qt] = lrow[qt] * alpha + psum;
#pragma unroll
                for (int et = 0; et < 8; ++et) {
                    o[qt][et][0] *= alpha; o[qt][et][1] *= alpha; o[qt][et][2] *= alpha; o[qt][et][3] *= alpha;
                }
#pragma unroll
                for (int kb = 0; kb < 2; ++kb)
                    pf[qt][kb] = as_frag(make_uint4(pk2(s[2 * kb][qt][0], s[2 * kb][qt][1]), pk2(s[2 * kb][qt][2], s[2 * kb][qt][3]),
                                                    pk2(s[2 * kb + 1][qt][0], s[2 * kb + 1][qt][1]), pk2(s[2 * kb + 1][qt][2], s[2 * kb + 1][qt][3])));
            }
#pragma unroll
            for (int et = 0; et < 8; ++et)
#pragma unroll
                for (int kb = 0; kb < 2; ++kb) {
                    const uint2 lo = *(const uint2*)(cV + et * 16 * VLD + kb * 32);
                    const uint2 hi = *(const uint2*)(cV + et * 16 * VLD + kb * 32 + 16);
                    const bf16x8 vf = as_frag(make_uint4(lo.x, lo.y, hi.x, hi.y));
#pragma unroll
                    for (int qt = 0; qt < 2; ++qt) o[qt][et] = MFMA(vf, pf[qt][kb], o[qt][et]);
                }
        }
        __builtin_amdgcn_sched_barrier(0);
        if (kt + 1 < nkt) { A_STORE(buf ^ 1) }
        __syncthreads();
    }
    float inv[2];
#pragma unroll
    for (int qt = 0; qt < 2; ++qt) {
        const float l = red_g(lrow[qt]);
        inv[qt] = 1.f / fmaxf(l, 1e-30f);
    }
    if (active && n == 1) {
#pragma unroll
        for (int qt = 0; qt < 2; ++qt)
#pragma unroll
            for (int et = 0; et < 8; ++et) {
                const f32x4 v = o[qt][et];
                *(float4*)(ex + (qh * 32 + qt * 16 + l16) * 132 + et * 16 + g * 4) =
                    make_float4(v[0] * inv[qt], v[1] * inv[qt], v[2] * inv[qt], v[3] * inv[qt]);
            }
    }
    __syncthreads();
    if (active && n == 0) {
#pragma unroll
        for (int qt = 0; qt < 2; ++qt) {
            const int row = qh * 32 + qt * 16 + l16;
            float ss = 0.f;
#pragma unroll
            for (int et = 0; et < 8; ++et) {
                const float4 o2 = *(const float4*)(ex + row * 132 + et * 16 + g * 4);
                f32x4 v = o[qt][et];
                v[0] = v[0] * inv[qt] - lam * o2.x;
                v[1] = v[1] * inv[qt] - lam * o2.y;
                v[2] = v[2] * inv[qt] - lam * o2.z;
                v[3] = v[3] * inv[qt] - lam * o2.w;
                o[qt][et] = v;
                ss += v[0] * v[0] + v[1] * v[1] + v[2] * v[2] + v[3] * v[3];
            }
            ss = red_g(ss);
            const float rn = rsqrtf(ss * (1.f / 128.f) + EPS) * 0.8f;
            if (row < nq) {
#pragma unroll
                for (int et = 0; et < 8; ++et) {
                    const float4 sl = *(const float4*)(subln + et * 16 + g * 4);
                    const f32x4 v = o[qt][et];
                    *(uint2*)(O + (row * 512 + et * 16 + g * 4)) = pk4(v[0] * rn * sl.x, v[1] * rn * sl.y, v[2] * rn * sl.z, v[3] * rn * sl.w);
                }
            }
        }
    }
    __syncthreads();
}

__device__ __forceinline__ void phase3(const Params& p, unsigned char* smem) {
    unsigned char* ws = p.ws;
    int* s_item = (int*)(smem + LDS_BYTES - 16);
    unsigned* ctr = (unsigned*)(ws + O_SCAL) + 1;
    const float lam = ((const float*)(ws + O_SCAL))[0];
    const u16* SI = (const u16*)(ws + O_SI);
    const u16* qb = (const u16*)(ws + O_QB);
    const u16* kP = (const u16*)(ws + O_KP);
    const u16* kS = (const u16*)(ws + O_KS);
    const u16* vtP = (const u16*)(ws + O_VTP);
    const u16* vtS = (const u16*)(ws + O_VTS);
    u16* ob = (u16*)(ws + O_OB);
    int stage = 0, sidx = blockIdx.x;
    constexpr int SCAN_BASE = 100000, DONE = 1 << 30;
    for (;;) {
        if (threadIdx.x == 0) {
            int it;
            if (stage == 0) it = (sidx < 768) ? SCAN_BASE + sidx : -2;
            else {
                const int x = blockIdx.x & 7;
                const int i = (int)atomicAdd(ctr + 16 + x, 1u);
                if (i < 512) it = ((63 - (i >> 3)) << 6) | (x + 8 * (i & 7));
                else if (i < 528) it = 4096 + (x + 8 * (i - 512));
                else it = DONE;
            }
            *s_item = it;
        }
        __syncthreads();
        const int item = __builtin_amdgcn_readfirstlane(*s_item);
        __syncthreads();
        if (item == DONE) break;
        if (item == -2) {
            asm volatile("s_waitcnt vmcnt(0) lgkmcnt(0)" ::: "memory");
            cg::this_grid().sync();
            stage = 1;
            ln_pass(p);
            continue;
        }
        if (item >= SCAN_BASE) {
            sidx += gridDim.x;
            const int sc = item - SCAN_BASE;
            const u16* si; int nch; const float* s0; float* sout; int m0, h, half;
            if (sc < 256) {
                const int chain = sc >> 1;
                half = sc & 1; h = chain & 7;
                si = SI + (size_t)chain * 4096 * 384; nch = 256; s0 = nullptr;
                sout = p.out + OFF_WP + (size_t)chain * 4096; m0 = (chain >> 3) * 4096;
            } else {
                const int t2 = sc - 256, chain = t2 >> 1;
                half = t2 & 1; h = chain & 7;
                si = SI + ((size_t)128 * 4096 + (size_t)chain * 32) * 384; nch = 2; s0 = p.state_wkv + (size_t)chain * 4096;
                sout = p.out + OFF_WS + (size_t)chain * 4096; m0 = TP + (chain >> 3) * 32;
            }
            scan_item(p, si, nch, s0, sout, m0, h, half, smem);
        } else {
            const u16 *Q, *K, *Vt; u16* O; int nq, ldv, nkt, lastvalid;
            if (item < 4096) {
                const int c = item >> 6, bh = item & 63, b = bh >> 2, h = bh & 3;
                const size_t m0 = (size_t)b * 4096 + (size_t)c * 64;
                Q = qb + m0 * 512 + h * 128; nq = 64; K = kP + (size_t)b * 4096 * 512 + h * 128;
                Vt = vtP + ((size_t)b * 512 + h * 128) * 4096; ldv = 4096; nkt = c + 1; lastvalid = 64; O = ob + m0 * 512 + h * 128;
            } else {
                const int idx = item - 4096;
                const int b = idx >> 2, h = idx & 3;
                const size_t m0 = (size_t)TP + (size_t)b * 32;
                Q = qb + m0 * 512 + h * 128; nq = 32; K = kS + (size_t)b * LKS * 512 + h * 128;
                Vt = vtS + ((size_t)b * 512 + h * 128) * LKS; ldv = LKS; nkt = 17; lastvalid = 32; O = ob + m0 * 512 + h * 128;
            }
            attn_item(Q, nq, K, Vt, ldv, nkt, lastvalid, O, lam, p.subln, smem);
        }
    }
}

__device__ __forceinline__ void phase4(const Params& p, unsigned char* smem) {
    unsigned char* ws = p.ws;
    const u16* ya = (const u16*)(ws + O_YA);
    const u16* ob = (const u16*)(ws + O_OB);
    const u16* Wa = (const u16*)(ws + O_WOA);
    const u16* Wb = (const u16*)(ws + O_WOB);
    const u16* gate = (const u16*)p.out;
    u16* mix = (u16*)(ws + O_MIX);
    const int tid = threadIdx.x, lane = tid & 63, wid = tid >> 6, wm = wid >> 1, wn = wid & 1, l16 = lane & 15, g = lane >> 4;
    constexpr int NT = 8;
    for (int t = blockIdx.x; t < 520 * NT; t += gridDim.x) {
        int mtile, ntile;
        tile_map(t, NT, mtile, ntile);
        const int m0 = mtile * 128, n0 = ntile * 128;
        f32x4 acc[4][4], acc2[4][4];
        zero_acc(acc);
        zero_acc(acc2);
        gemm_loop(ya + (size_t)m0 * 512, 512, Wa + (size_t)n0 * 512, 512, 8, (u16*)smem, acc);
        gemm_loop(ob + (size_t)m0 * 512, 512, Wb + (size_t)n0 * 512, 512, 8, (u16*)smem, acc2);
#pragma unroll
        for (int mt = 0; mt < 4; ++mt) {
            const int m = m0 + wm * 64 + mt * 16 + l16;
#pragma unroll
            for (int nt = 0; nt < 4; ++nt) {
                const int n = n0 + wn * 64 + nt * 16 + g * 4;
                const uint2 ga = *(const uint2*)(gate + (size_t)m * 2048 + n);
                const uint2 gb = *(const uint2*)(gate + (size_t)m * 2048 + 1024 + n);
                const f32x4 a = acc[nt][mt], b = acc2[nt][mt];
                *(uint2*)(mix + (size_t)m * 1024 + n) =
                    pk4(bflo(ga.x) * a[0] + bflo(gb.x) * b[0], bfhi(ga.x) * a[1] + bfhi(gb.x) * b[1],
                        bflo(ga.y) * a[2] + bflo(gb.y) * b[2], bfhi(ga.y) * a[3] + bfhi(gb.y) * b[3]);
            }
        }
    }
}

__device__ __forceinline__ void gemm_rowss(const u16* A, int K, const u16* W, u16* outb, float* ssq, unsigned char* smem) {
    const int tid = threadIdx.x, lane = tid & 63, wid = tid >> 6, wm = wid >> 1, wn = wid & 1, l16 = lane & 15, g = lane >> 4;
    constexpr int NT = 8;
    for (int t = blockIdx.x; t < 520 * NT; t += gridDim.x) {
        int mtile, ntile;
        tile_map(t, NT, mtile, ntile);
        const int m0 = mtile * 128, n0 = ntile * 128;
        f32x4 acc[4][4];
        zero_acc(acc);
        gemm_loop(A + (size_t)m0 * K, K, W + (size_t)n0 * K, K, K / 64, (u16*)smem, acc);
#pragma unroll
        for (int mt = 0; mt < 4; ++mt) {
            const int m = m0 + wm * 64 + mt * 16 + l16;
#pragma unroll
            for (int nt = 0; nt < 4; ++nt) {
                const int n = n0 + wn * 64 + nt * 16 + g * 4;
                const f32x4 a = acc[nt][mt];
                *(uint2*)(outb + (size_t)m * 1024 + n) = pk4(a[0], a[1], a[2], a[3]);
            }
        }
    }
}

__device__ __forceinline__ float sum16(const float* q) {
    const float4 a = *(const float4*)q, b = *(const float4*)(q + 4), c = *(const float4*)(q + 8), d = *(const float4*)(q + 12);
    return ((a.x + a.y) + (a.z + a.w)) + ((b.x + b.y) + (b.z + b.w)) + (((c.x + c.y) + (c.z + c.w)) + ((d.x + d.y) + (d.z + d.w)));
}
__device__ __forceinline__ void phase6(const Params& p) {
    unsigned char* ws = p.ws;
    const u16* m2 = (const u16*)(ws + O_M2);
    u16* x1b = (u16*)(ws + O_X1B);
    float* rs3 = (float*)(ws + O_RS3);
    const int lane = threadIdx.x & 63, wid = threadIdx.x >> 6;
    for (int m = blockIdx.x * 4 + wid; m < T; m += gridDim.x * 4) {
        const float* xr = (m < TP) ? p.x_prompt + (size_t)m * 1024 : p.x_sample + (size_t)(m - TP) * 1024;
        uint2 mvv[4];
        float s2 = 0.f;
#pragma unroll
        for (int i = 0; i < 4; ++i) {
            mvv[i] = *(const uint2*)(m2 + (size_t)m * 1024 + i * 256 + lane * 4);
            const float a = bflo(mvv[i].x), b = bfhi(mvv[i].x), c = bflo(mvv[i].y), d = bfhi(mvv[i].y);
            s2 += a * a + b * b + c * c + d * d;
        }
        s2 = wave_sum(s2);
        const float rs = rsqrtf(s2 * (1.f / 1024.f) + EPS);
        float ss = 0.f;
#pragma unroll
        for (int i = 0; i < 4; ++i) {
            const int col = i * 256 + lane * 4;
            const float4 xv = *(const float4*)(xr + col);
            const uint2 mv = mvv[i];
            const float4 gp = *(const float4*)(p.n_mix_post + col);
            float4 r;
            r.x = xv.x + bflo(mv.x) * rs * gp.x;
            r.y = xv.y + bfhi(mv.x) * rs * gp.y;
            r.z = xv.z + bflo(mv.y) * rs * gp.z;
            r.w = xv.w + bfhi(mv.y) * rs * gp.w;
            ss += r.x * r.x + r.y * r.y + r.z * r.z + r.w * r.w;
            *(float4*)(p.out + (size_t)m * 1024 + col) = r;
            *(uint2*)(x1b + (size_t)m * 1024 + col) = pk4(r.x, r.y, r.z, r.w);
        }
        ss = wave_sum(ss);
        if (lane == 0) rs3[m] = rsqrtf(ss * (1.f / 1024.f) + EPS);
    }
}

__device__ __forceinline__ void phase7(const Params& p, unsigned char* smem) {
    unsigned char* ws = p.ws;
    const u16* x1b = (const u16*)(ws + O_X1B);
    const u16* W = (const u16*)(ws + O_WFI);
    const float* rs3 = (const float*)(ws + O_RS3);
    u16* hb = (u16*)(ws + O_HB);
    const int tid = threadIdx.x, lane = tid & 63, wid = tid >> 6, wm = wid >> 1, wn = wid & 1, l16 = lane & 15, g = lane >> 4;
    constexpr int NT = 44;
    for (int t = blockIdx.x; t < 520 * NT; t += gridDim.x) {
        int mtile, ntile;
        tile_map(t, NT, mtile, ntile);
        const int m0 = mtile * 128, n0 = ntile * 128;
        f32x4 acc[4][4];
        zero_acc(acc);
        gemm_loop(x1b + (size_t)m0 * 1024, 1024, W + (size_t)n0 * 1024, 1024, 16, (u16*)smem, acc);
#pragma unroll
        for (int mt = 0; mt < 4; ++mt) {
            const int m = m0 + wm * 64 + mt * 16 + l16;
            const float rs = rs3[m];
#pragma unroll
            for (int pr = 0; pr < 2; ++pr) {
                const f32x4 ug = acc[2 * pr][mt], uv = acc[2 * pr + 1][mt];
                const int j = ((n0 + wn * 64) >> 5) * 16 + pr * 16 + g * 4;
                float hv[4];
#pragma unroll
                for (int r = 0; r < 4; ++r) {
                    const float a = ug[r] * rs, b = uv[r] * rs;
                    hv[r] = a * sigmoidf_(a) * b;
                }
                *(uint2*)(hb + (size_t)m * 2816 + j) = pk4(hv[0], hv[1], hv[2], hv[3]);
            }
        }
    }
}

__device__ __forceinline__ void phase9(const Params& p) {
    unsigned char* ws = p.ws;
    const u16* fb = (const u16*)(ws + O_FB);
    const int lane = threadIdx.x & 63, wid = threadIdx.x >> 6;
    for (int m = blockIdx.x * 4 + wid; m < T; m += gridDim.x * 4) {
        uint2 fvv[4];
        float s2 = 0.f;
#pragma unroll
        for (int i = 0; i < 4; ++i) {
            fvv[i] = *(const uint2*)(fb + (size_t)m * 1024 + i * 256 + lane * 4);
            const float a = bflo(fvv[i].x), b = bfhi(fvv[i].x), c = bflo(fvv[i].y), d = bfhi(fvv[i].y);
            s2 += a * a + b * b + c * c + d * d;
        }
        s2 = wave_sum(s2);
        const float rs = rsqrtf(s2 * (1.f / 1024.f) + EPS);
#pragma unroll
        for (int i = 0; i < 4; ++i) {
            const int col = i * 256 + lane * 4;
            float4 r = *(const float4*)(p.out + (size_t)m * 1024 + col);
            const uint2 fv = fvv[i];
            const float4 gp = *(const float4*)(p.n_ffn_post + col);
            r.x += bflo(fv.x) * rs * gp.x;
            r.y += bfhi(fv.x) * rs * gp.y;
            r.z += bflo(fv.y) * rs * gp.z;
            r.w += bfhi(fv.y) * rs * gp.w;
            *(float4*)(p.out + (size_t)m * 1024 + col) = r;
        }
    }
}

__global__ void __launch_bounds__(256, 2) mega(Params p) {
    extern __shared__ __attribute__((aligned(16))) unsigned char smem[];
    cg::grid_group grid = cg::this_grid();
#define IN(k) (p.ph_lo <= (k) && (k) < p.ph_hi)
#define SEAM(k) if (IN(k) && IN((k) + 1)) { asm volatile("s_waitcnt vmcnt(0) lgkmcnt(0)" ::: "memory"); grid.sync(); }
    unsigned char* ws = p.ws;
    if (IN(0)) phase0(p, smem);
    SEAM(0)
    if (IN(1)) phase1(p, smem);
    SEAM(1)
    if (IN(2)) phase2(p);
    SEAM(2)
    if (IN(3)) phase3(p, smem);
    SEAM(3)
    if (IN(5)) phase4(p, smem);
    SEAM(5)
    if (IN(6)) gemm_rowss((const u16*)(ws + O_MIX), 1024, (const u16*)(ws + O_WO), (u16*)(ws + O_M2), (float*)(ws + O_SS2), smem);
    SEAM(6)
    if (IN(7)) phase6(p);
    SEAM(7)
    if (IN(8)) phase7(p, smem);
    SEAM(8)
    if (IN(9)) gemm_rowss((const u16*)(ws + O_HB), 2816, (const u16*)(ws + O_WFO), (u16*)(ws + O_FB), (float*)(ws + O_SS4), smem);
    SEAM(9)
    if (IN(10)) phase9(p);
}

extern "C" void kernel_launch(void* const* d_in, const int* in_sizes, int n_in, void* d_out, int out_size, void* d_ws, size_t ws_size,
                              hipStream_t stream) {
    static int grid_blocks = 0;
    if (!grid_blocks) {
        int dev = 0, cus = 0, per_cu = 0;
        hipGetDevice(&dev);
        hipDeviceGetAttribute(&cus, hipDeviceAttributeMultiprocessorCount, dev);
        hipFuncSetAttribute((const void*)mega, hipFuncAttributeMaxDynamicSharedMemorySize, LDS_BYTES);
        hipOccupancyMaxActiveBlocksPerMultiprocessor(&per_cu, (const void*)mega, 256, LDS_BYTES);
        if (per_cu < 1) per_cu = 1;
        if (per_cu > 2) per_cu = 2;
        grid_blocks = cus * per_cu;
        if (ws_size < WS_END) fprintf(stderr, "kernel_launch: workspace too small: %zu < %zu\n", ws_size, (size_t)WS_END);
    }
    Params p{};
    const float** pp = (const float**)&p;
    for (int i = 0; i < 33; ++i) pp[i] = (const float*)d_in[i];
    p.out = (float*)d_out;
    p.ws = (unsigned char*)d_ws;
#ifndef MULTI_LAUNCH
    p.ph_lo = 0;
    p.ph_hi = 11;
    void* args[] = {&p};
    hipError_t e = hipLaunchCooperativeKernel((const void*)mega, dim3(grid_blocks), dim3(256), args, LDS_BYTES, stream);
    if (e != hipSuccess) fprintf(stderr, "cooperative launch failed: %s (grid %d)\n", hipGetErrorString(e), grid_blocks);
#else
    for (int k = 0; k < 11; ++k) {
        p.ph_lo = k;
        p.ph_hi = k + 1;
        hipLaunchKernelGGL(mega, dim3(grid_blocks), dim3(256), LDS_BYTES, stream, p);
    }
#endif
}
```

```cpp
#include <hip/hip_runtime.h>
#include <hip/hip_cooperative_groups.h>
#include <cstdio>
#include <cstdint>
namespace cg = cooperative_groups;

typedef unsigned short u16;
typedef __attribute__((ext_vector_type(8))) short bf16x8;
typedef __attribute__((ext_vector_type(4))) float f32x4;

constexpr int TP = 65536, TS = 1024, T = TP + TS;
constexpr int ACOLS = 1824;
constexpr int LKS = 1088;
constexpr int LDS_BYTES = 73728;
constexpr float EPS = 1e-6f;

constexpr size_t OFF_YS = 67108864ull, OFF_KP = 68157440ull, OFF_VP = 101711872ull, OFF_WP = 135266304ull,
                 OFF_SHP = 135790592ull, OFF_KS = 135819776ull, OFF_VS = 136344064ull, OFF_WS = 136868352ull,
                 OFF_SHS = 137916928ull;

constexpr size_t al(size_t x) { return (x + 255) & ~(size_t)255; }
constexpr size_t O_WIN = 0;
constexpr size_t O_WOA = O_WIN + al(5504ull * 1024 * 2);
constexpr size_t O_WOB = O_WOA + al(1024ull * 512 * 2);
constexpr size_t O_WO = O_WOB + al(1024ull * 512 * 2);
constexpr size_t O_WFI = O_WO + al(1024ull * 1024 * 2);
constexpr size_t O_WFO = O_WFI + al(5632ull * 1024 * 2);
constexpr size_t O_W2 = O_WFO + al(1024ull * 2816 * 2);
constexpr size_t O_A2 = O_W2 + al(512 * 64 * 2);
constexpr size_t O_G2 = O_A2 + al(512 * 64 * 2);
constexpr size_t O_RS1 = O_G2 + al(512 * 160 * 2);
constexpr size_t O_SS2 = O_RS1 + al((size_t)T * 4);
constexpr size_t O_SS4 = O_SS2 + al((size_t)T * 16 * 4);
constexpr size_t O_RS3 = O_SS4 + al((size_t)T * 16 * 4);
constexpr size_t O_RK = O_RS3 + al((size_t)T * 4);
constexpr size_t O_SCAL = O_RK + al((size_t)T * 8 * 16);
constexpr size_t O_REGA = O_SCAL + 256;
constexpr size_t O_CA = O_REGA;
constexpr size_t O_YA = O_REGA;
constexpr size_t O_OB = O_YA + al((size_t)T * 512 * 2);
constexpr size_t O_YRAW = O_OB + al((size_t)T * 512 * 2);
constexpr size_t O_HB = O_REGA;
constexpr size_t O_REGB = O_REGA + al((size_t)(T + 48) * 1824 * 2);
constexpr size_t O_QB = O_REGB;
constexpr size_t O_KP = O_QB + al((size_t)T * 512 * 2);
constexpr size_t O_KS = O_KP + al((size_t)TP * 512 * 2);
constexpr size_t O_VTP = O_KS + al(32ull * LKS * 512 * 2);
constexpr size_t O_VTS = O_VTP + al(16ull * 512 * 4096 * 2);
constexpr size_t O_REGC = O_VTS + al(32ull * 512 * LKS * 2);
constexpr size_t O_GATE = O_REGB;
static_assert(O_GATE + (size_t)T * 2048 * 2 <= O_REGC, "gate overlaps region C");
constexpr size_t O_SI = O_REGC;
constexpr size_t O_G = O_SI + al((size_t)T * 8 * 384 * 2);
constexpr size_t O_XB = O_REGC;
constexpr size_t O_MIX = O_REGC;
constexpr size_t O_M2 = O_MIX + al((size_t)T * 1024 * 2);
constexpr size_t O_X1B = O_M2 + al((size_t)T * 1024 * 2);
constexpr size_t O_FB = O_REGC;
constexpr size_t WS_END = O_G + al((size_t)T * 512 * 2);
static_assert(O_HB + (size_t)T * 2816 * 2 <= O_REGC, "hb overlaps region C");
static_assert(O_YRAW + (size_t)T * 512 * 2 <= O_REGB, "yraw overlaps region B");
static_assert(O_X1B + (size_t)T * 1024 * 2 <= WS_END, "x1b beyond end");
static_assert(WS_END <= 1073741824ull, "workspace too large");

struct Params {
    const float *x_prompt, *x_sample, *cache_k, *cache_v, *state_wkv, *state_shift;
    const float *n_mix_pre, *n_mix_post, *n_ffn_pre, *n_ffn_post, *w_in, *b_gate;
    const float *mu, *w0, *w2, *a0, *a2, *g2, *k_k, *k_a, *r_k, *ln_w, *ln_b;
    const float *lq1, *lk1, *lq2, *lk2, *subln, *w_out_a, *w_out_b, *w_o, *w_ffn_in, *w_ffn_out;
    float* out;
    unsigned char* ws;
    int ph_lo, ph_hi;
};

__device__ __forceinline__ u16 f2bf(float f) {
    unsigned u = __float_as_uint(f);
    u += 0x7fffu + ((u >> 16) & 1u);
    return (u16)(u >> 16);
}
__device__ __forceinline__ unsigned pk2(float a, float b) { return (unsigned)f2bf(a) | ((unsigned)f2bf(b) << 16); }
__device__ __forceinline__ float bflo(unsigned u) { return __uint_as_float(u << 16); }
__device__ __forceinline__ float bfhi(unsigned u) { return __uint_as_float(u & 0xffff0000u); }
__device__ __forceinline__ uint2 pk4(float a, float b, float c, float d) { return make_uint2(pk2(a, b), pk2(c, d)); }
__device__ __forceinline__ float sigmoidf_(float x) { return 1.f / (1.f + __expf(-x)); }

template <int CTRL>
__device__ __forceinline__ float dppf(float x) {
    return __int_as_float(__builtin_amdgcn_update_dpp(0, __float_as_int(x), CTRL, 0xF, 0xF, true));
}
__device__ __forceinline__ float red8(float x) {
    x += dppf<0xB1>(x);
    x += dppf<0x4E>(x);
    x += dppf<0x141>(x);
    return x;
}
__device__ __forceinline__ float red16(float x) {
    x = red8(x);
    x += dppf<0x140>(x);
    return x;
}
__device__ __forceinline__ float red_g(float x) {
    x += __shfl_xor(x, 16);
    x += __shfl_xor(x, 32);
    return x;
}
__device__ __forceinline__ float wave_sum(float x) {
    x = red16(x);
    return red_g(x);
}
__device__ __forceinline__ bf16x8 as_frag(uint4 v) {
    union { uint4 u; bf16x8 f; } c;
    c.u = v;
    return c.f;
}
#define MFMA(a, b, c) __builtin_amdgcn_mfma_f32_16x16x32_bf16((a), (b), (c), 0, 0, 0)

constexpr int LDT = 72;
constexpr int STG = 128 * LDT;
__device__ __forceinline__ void gemm_loop(const u16* __restrict__ A, int lda, const u16* __restrict__ B, int ldb,
                                          int nkt, u16* smem, f32x4 (&acc)[4][4]) {
    const int tid = threadIdx.x, lane = tid & 63, wid = tid >> 6, wm = wid >> 1, wn = wid & 1, l16 = lane & 15, g = lane >> 4;
    const int lr = tid >> 3, lc = (tid & 7) * 8;
    u16* sA = smem;
    u16* sB = smem + 2 * STG;
    const u16* ap = A + (size_t)lr * lda + lc;
    const u16* bp = B + (size_t)lr * ldb + lc;
    uint4 ra0, ra1, ra2, ra3, rb0, rb1, rb2, rb3;
#define G_LOAD(ko)                                                   \
    ra0 = *(const uint4*)(ap + (ko));                                \
    ra1 = *(const uint4*)(ap + (size_t)32 * lda + (ko));             \
    ra2 = *(const uint4*)(ap + (size_t)64 * lda + (ko));             \
    ra3 = *(const uint4*)(ap + (size_t)96 * lda + (ko));             \
    rb0 = *(const uint4*)(bp + (ko));                                \
    rb1 = *(const uint4*)(bp + (size_t)32 * ldb + (ko));             \
    rb2 = *(const uint4*)(bp + (size_t)64 * ldb + (ko));             \
    rb3 = *(const uint4*)(bp + (size_t)96 * ldb + (ko));
#define G_STORE(bo)                                                  \
    *(uint4*)(sA + (bo) + (lr + 0) * LDT + lc) = ra0;                \
    *(uint4*)(sA + (bo) + (lr + 32) * LDT + lc) = ra1;               \
    *(uint4*)(sA + (bo) + (lr + 64) * LDT + lc) = ra2;               \
    *(uint4*)(sA + (bo) + (lr + 96) * LDT + lc) = ra3;               \
    *(uint4*)(sB + (bo) + (lr + 0) * LDT + lc) = rb0;                \
    *(uint4*)(sB + (bo) + (lr + 32) * LDT + lc) = rb1;               \
    *(uint4*)(sB + (bo) + (lr + 64) * LDT + lc) = rb2;               \
    *(uint4*)(sB + (bo) + (lr + 96) * LDT + lc) = rb3;
    G_LOAD(0)
    G_STORE(0)
    __syncthreads();
    for (int kt = 0; kt < nkt; ++kt) {
        const int buf = kt & 1;
        if (kt + 1 < nkt) { G_LOAD((kt + 1) * 64) }
        __builtin_amdgcn_sched_barrier(0);
        const u16* cA = sA + buf * STG + (wm * 64 + l16) * LDT + g * 8;
        const u16* cB = sB + buf * STG + (wn * 64 + l16) * LDT + g * 8;
#pragma unroll
        for (int ks = 0; ks < 2; ++ks) {
            bf16x8 xf[4], wf[4];
#pragma unroll
            for (int i = 0; i < 4; ++i) {
                xf[i] = *(const bf16x8*)(cA + i * 16 * LDT + ks * 32);
                wf[i] = *(const bf16x8*)(cB + i * 16 * LDT + ks * 32);
            }
#pragma unroll
            for (int nt = 0; nt < 4; ++nt)
#pragma unroll
                for (int mt = 0; mt < 4; ++mt) acc[nt][mt] = MFMA(wf[nt], xf[mt], acc[nt][mt]);
        }
        __builtin_amdgcn_sched_barrier(0);
        if (kt + 1 < nkt) { G_STORE((buf ^ 1) * STG) }
        __syncthreads();
    }
}
__device__ __forceinline__ void gemm_loop_xf32(const float* __restrict__ A, const u16* __restrict__ B, int ldb, int nkt, u16* smem,
                                               f32x4 (&acc)[4][4]) {
    const int tid = threadIdx.x, lane = tid & 63, wid = tid >> 6, wm = wid >> 1, wn = wid & 1, l16 = lane & 15, g = lane >> 4;
    const int lr = tid >> 3, lc = (tid & 7) * 8;
    u16* sA = smem;
    u16* sB = smem + 2 * STG;
    const float* ap = A + (size_t)lr * 1024 + lc;
    const u16* bp = B + (size_t)lr * ldb + lc;
    float4 fa0, fa1, fa2, fa3, fa4, fa5, fa6, fa7;
    uint4 rb0, rb1, rb2, rb3;
#define GX_LOAD(ko)                                                  \
    fa0 = *(const float4*)(ap + (ko));                               \
    fa1 = *(const float4*)(ap + (ko) + 4);                           \
    fa2 = *(const float4*)(ap + 32 * 1024 + (ko));                   \
    fa3 = *(const float4*)(ap + 32 * 1024 + (ko) + 4);               \
    fa4 = *(const float4*)(ap + 64 * 1024 + (ko));                   \
    fa5 = *(const float4*)(ap + 64 * 1024 + (ko) + 4);               \
    fa6 = *(const float4*)(ap + 96 * 1024 + (ko));                   \
    fa7 = *(const float4*)(ap + 96 * 1024 + (ko) + 4);               \
    rb0 = *(const uint4*)(bp + (ko));                                \
    rb1 = *(const uint4*)(bp + (size_t)32 * ldb + (ko));             \
    rb2 = *(const uint4*)(bp + (size_t)64 * ldb + (ko));             \
    rb3 = *(const uint4*)(bp + (size_t)96 * ldb + (ko));
#define PKF(a, b) make_uint4(pk2(a.x, a.y), pk2(a.z, a.w), pk2(b.x, b.y), pk2(b.z, b.w))
#define GX_STORE(bo)                                                 \
    *(uint4*)(sA + (bo) + (lr + 0) * LDT + lc) = PKF(fa0, fa1);      \
    *(uint4*)(sA + (bo) + (lr + 32) * LDT + lc) = PKF(fa2, fa3);     \
    *(uint4*)(sA + (bo) + (lr + 64) * LDT + lc) = PKF(fa4, fa5);     \
    *(uint4*)(sA + (bo) + (lr + 96) * LDT + lc) = PKF(fa6, fa7);     \
    *(uint4*)(sB + (bo) + (lr + 0) * LDT + lc) = rb0;                \
    *(uint4*)(sB + (bo) + (lr + 32) * LDT + lc) = rb1;               \
    *(uint4*)(sB + (bo) + (lr + 64) * LDT + lc) = rb2;               \
    *(uint4*)(sB + (bo) + (lr + 96) * LDT + lc) = rb3;
    GX_LOAD(0)
    GX_STORE(0)
    __syncthreads();
    for (int kt = 0; kt < nkt; ++kt) {
        const int buf = kt & 1;
        if (kt + 1 < nkt) { GX_LOAD((kt + 1) * 64) }
        __builtin_amdgcn_sched_barrier(0);
        const u16* cA = sA + buf * STG + (wm * 64 + l16) * LDT + g * 8;
        const u16* cB = sB + buf * STG + (wn * 64 + l16) * LDT + g * 8;
#pragma unroll
        for (int ks = 0; ks < 2; ++ks) {
            bf16x8 xf[4], wf[4];
#pragma unroll
            for (int i = 0; i < 4; ++i) {
                xf[i] = *(const bf16x8*)(cA + i * 16 * LDT + ks * 32);
                wf[i] = *(const bf16x8*)(cB + i * 16 * LDT + ks * 32);
            }
#pragma unroll
            for (int nt = 0; nt < 4; ++nt)
#pragma unroll
                for (int mt = 0; mt < 4; ++mt) acc[nt][mt] = MFMA(wf[nt], xf[mt], acc[nt][mt]);
        }
        __builtin_amdgcn_sched_barrier(0);
        if (kt + 1 < nkt) { GX_STORE((buf ^ 1) * STG) }
        __syncthreads();
    }
}
__device__ __forceinline__ void zero_acc(f32x4 (&acc)[4][4]) {
#pragma unroll
    for (int i = 0; i < 4; ++i)
#pragma unroll
        for (int j = 0; j < 4; ++j) acc[i][j] = (f32x4){0.f, 0.f, 0.f, 0.f};
}
__device__ __forceinline__ void tile_map(int t, int NT, int& mt, int& nt) {
    const int x = t & 7, u = t >> 3;
    const int gsz = 8 * NT;
    const int g = u / gsz;
    const int w = u - g * gsz;
    const int rows = (g < 8) ? 8 : 1;
    const int q = w / rows;
    mt = x * 65 + g * 8 + (w - q * rows);
    nt = q;
}

__device__ __forceinline__ void tr_tile(const float* __restrict__ in, int R, int C, int ldin, u16* __restrict__ out, int ldout,
                        const float* __restrict__ scale, int r0, int c0, int Cout, bool perm, float* tile) {
    const int tid = threadIdx.x;
    {
        const int tx = tid & 63, ty = tid >> 6;
        const int c = c0 + tx;
        for (int rr = ty; rr < 64; rr += 4) {
            const int r = r0 + rr;
            float v = 0.f;
            if (r < R && c < C) {
                v = in[(size_t)r * ldin + c];
                if (scale) v *= scale[r];
            }
            tile[rr * 65 + tx] = v;
        }
    }
    __syncthreads();
    {
        const int rch = (tid & 7) * 8;
#pragma unroll
        for (int pass = 0; pass < 2; ++pass) {
            const int cc = (tid >> 3) + pass * 32;
            const int c = c0 + cc;
            if (c < Cout && r0 + rch < R) {
                float v[8];
#pragma unroll
                for (int k = 0; k < 8; ++k) v[k] = tile[(rch + k) * 65 + cc];
                int orow = c;
                if (perm) {
                    const int type = c >= 2816 ? 1 : 0;
                    const int j = c - type * 2816;
                    orow = (j >> 4) * 32 + type * 16 + (j & 15);
                }
                uint4 o = make_uint4(pk2(v[0], v[1]), pk2(v[2], v[3]), pk2(v[4], v[5]), pk2(v[6], v[7]));
                *(uint4*)(out + (size_t)orow * ldout + r0 + rch) = o;
            }
        }
    }
    __syncthreads();
}

__device__ __forceinline__ void phase0(const Params& p, unsigned char* smem) {
    float* tile = (float*)smem;
    const int tid = threadIdx.x, lane = tid & 63, wid = tid >> 6;
    unsigned char* ws = p.ws;
    const int G = gridDim.x;
    for (int u = blockIdx.x; u < 8136; u += G) {
        const float* in;
        int R, C, Cout, ldout, tl;
        u16* out;
        const float* scale = nullptr;
        bool perm = false;
        if (u < 1376) { tl = u; in = p.w_in; R = 1024; C = 5408; Cout = 5504; out = (u16*)(ws + O_WIN); ldout = 1024; scale = p.n_mix_pre; }
        else if (u < 1504) { tl = u - 1376; in = p.w_out_a; R = 512; C = 1024; Cout = 1024; out = (u16*)(ws + O_WOA); ldout = 512; }
        else if (u < 1632) { tl = u - 1504; in = p.w_out_b; R = 512; C = 1024; Cout = 1024; out = (u16*)(ws + O_WOB); ldout = 512; }
        else if (u < 1888) { tl = u - 1632; in = p.w_o; R = 1024; C = 1024; Cout = 1024; out = (u16*)(ws + O_WO); ldout = 1024; }
        else if (u < 3296) { tl = u - 1888; in = p.w_ffn_in; R = 1024; C = 5632; Cout = 5632; out = (u16*)(ws + O_WFI); ldout = 1024; scale = p.n_ffn_pre; perm = true; }
        else if (u < 4000) { tl = u - 3296; in = p.w_ffn_out; R = 2816; C = 1024; Cout = 1024; out = (u16*)(ws + O_WFO); ldout = 2816; }
        else if (u < 4008) { tl = u - 4000; in = p.w2; R = 64; C = 512; Cout = 512; out = (u16*)(ws + O_W2); ldout = 64; }
        else if (u < 4016) { tl = u - 4008; in = p.a2; R = 64; C = 512; Cout = 512; out = (u16*)(ws + O_A2); ldout = 64; }
        else if (u < 4040) { tl = u - 4016; in = p.g2; R = 160; C = 512; Cout = 512; out = (u16*)(ws + O_G2); ldout = 160; }
        else {
            tl = u - 4040;
            const int b = tl >> 7;
            tl &= 127;
            in = p.cache_v + (size_t)b * 1024 * 512; R = 1024; C = 512; Cout = 512;
            out = (u16*)(ws + O_VTS) + (size_t)b * 512 * LKS; ldout = LKS;
        }
        const int ctiles = (Cout + 63) >> 6;
        const int rt = tl / ctiles, ct = tl - rt * ctiles;
        tr_tile(in, R, C, C, out, ldout, scale, rt * 64, ct * 64, Cout, perm, tile);
    }
    {
        u16* xb = (u16*)(ws + O_XB);
        float* rs1 = (float*)(ws + O_RS1);
        for (int m = blockIdx.x * 4 + wid; m < T; m += G * 4) {
            const float* xr = (m < TP) ? p.x_prompt + (size_t)m * 1024 : p.x_sample + (size_t)(m - TP) * 1024;
            float ss = 0.f;
#pragma unroll
            for (int i = 0; i < 4; ++i) {
                const float4 v = *(const float4*)(xr + i * 256 + lane * 4);
                ss += v.x * v.x + v.y * v.y + v.z * v.z + v.w * v.w;
                *(uint2*)(xb + (size_t)m * 1024 + i * 256 + lane * 4) = pk4(v.x, v.y, v.z, v.w);
            }
            ss = wave_sum(ss);
            if (lane == 0) rs1[m] = rsqrtf(ss * (1.f / 1024.f) + EPS);
        }
    }
    {
        u16* kS = (u16*)(ws + O_KS);
        const int n8 = 32 * 1024 * 64;
        for (int i = blockIdx.x * 256 + tid; i < n8; i += G * 256) {
            const int b = i >> 16, rem = i & 65535, key = rem >> 6, c8 = rem & 63;
            const float4 v0 = *(const float4*)(p.cache_k + (size_t)i * 8);
            const float4 v1 = *(const float4*)(p.cache_k + (size_t)i * 8 + 4);
            *(uint4*)(kS + ((size_t)b * LKS + key) * 512 + c8 * 8) =
                make_uint4(pk2(v0.x, v0.y), pk2(v0.z, v0.w), pk2(v1.x, v1.y), pk2(v1.z, v1.w));
        }
        for (int i = blockIdx.x * 256 + tid; i < 32 * 32 * 64; i += G * 256) {
            const int b = i >> 11, rem = i & 2047, row = rem >> 6, c8 = rem & 63;
            *(uint4*)(kS + ((size_t)b * LKS + 1056 + row) * 512 + c8 * 8) = make_uint4(0, 0, 0, 0);
        }
        u16* vtS = (u16*)(ws + O_VTS);
        for (int i = blockIdx.x * 256 + tid; i < 32 * 512 * 4; i += G * 256) {
            const int row = i >> 2, c8 = i & 3;
            *(uint4*)(vtS + (size_t)row * LKS + 1056 + c8 * 8) = make_uint4(0, 0, 0, 0);
        }
    }
    {
        u16* cA = (u16*)(ws + O_CA);
        for (int i = blockIdx.x * 256 + tid; i < 48 * ACOLS; i += G * 256) {
            const int s = i / ACOLS, c = i - s * ACOLS;
            float v = 0.f;
            size_t row;
            if (s < 16) row = (size_t)s * 4097;
            else { row = (size_t)16 * 4097 + (size_t)(s - 16) * 33; v = p.state_shift[(size_t)(s - 16) * ACOLS + c]; }
            cA[row * ACOLS + c] = f2bf(v);
        }
        if (blockIdx.x == 0 && tid == 0) {
            float d1 = 0.f, d2 = 0.f;
            for (int i = 0; i < 64; ++i) { d1 += p.lq1[i] * p.lk1[i]; d2 += p.lq2[i] * p.lk2[i]; }
            float* sc = (float*)(ws + O_SCAL);
            sc[0] = __expf(d1) - __expf(d2) + 0.2f;
            for (int i = 1; i < 32; ++i) ((unsigned*)sc)[i] = 0u;
        }
    }
}

__device__ __forceinline__ void phase1(const Params& p, unsigned char* smem) {
    unsigned char* ws = p.ws;
    const u16* xb = (const u16*)(ws + O_XB);
    const u16* W = (const u16*)(ws + O_WIN);
    const float* rs1 = (const float*)(ws + O_RS1);
    u16* cA = (u16*)(ws + O_CA);
    u16* qb = (u16*)(ws + O_QB);
    u16* kP = (u16*)(ws + O_KP);
    u16* kS = (u16*)(ws + O_KS);
    u16* vtP = (u16*)(ws + O_VTP);
    u16* vtS = (u16*)(ws + O_VTS);
    float* out = p.out;
    const int tid = threadIdx.x, lane = tid & 63, wid = tid >> 6, wm = wid >> 1, wn = wid & 1, l16 = lane & 15, g = lane >> 4;
    constexpr int NT = 43;
    u16* gate = (u16*)p.out;
    for (int t = blockIdx.x; t < 520 * NT; t += gridDim.x) {
        int mtile, ntile;
        tile_map(t, NT, mtile, ntile);
        const int m0 = mtile * 128, n0 = ntile * 128;
        f32x4 acc[4][4];
        zero_acc(acc);
        gemm_loop(xb + (size_t)m0 * 1024, 1024, W + (size_t)n0 * 1024, 1024, 16, (u16*)smem, acc);
#pragma unroll
        for (int mt = 0; mt < 4; ++mt) {
            const int m = m0 + wm * 64 + mt * 16 + l16;
            const float rs = rs1[m];
            const bool isP = m < TP;
            int seq, tt;
            if (isP) { seq = m >> 12; tt = m & 4095; }
            else { const int ms = m - TP; seq = 16 + (ms >> 5); tt = ms & 31; }
            const size_t carow = (size_t)m + seq + 1;
            const bool last = isP ? (tt == 4095) : (tt == 31);
#pragma unroll
            for (int nt = 0; nt < 4; ++nt) {
                const int n = n0 + wn * 64 + nt * 16 + g * 4;
                if (n >= 5408) continue;
                f32x4 v = acc[nt][mt];
                v[0] *= rs; v[1] *= rs; v[2] *= rs; v[3] *= rs;
                if (n < 1824) {
                    *(uint2*)(cA + carow * ACOLS + n) = pk4(v[0], v[1], v[2], v[3]);
                    if (last) {
                        float* so = isP ? out + OFF_SHP + (size_t)seq * ACOLS + n : out + OFF_SHS + (size_t)(seq - 16) * ACOLS + n;
                        *(float4*)so = make_float4(v[0], v[1], v[2], v[3]);
                    }
                } else if (n < 2336) {
                    *(uint2*)(qb + (size_t)m * 512 + (n - 1824)) = pk4(v[0], v[1], v[2], v[3]);
                } else if (n < 2848) {
                    const int c = n - 2336;
                    if (isP) {
                        *(uint2*)(kP + (size_t)m * 512 + c) = pk4(v[0], v[1], v[2], v[3]);
                        *(float4*)(out + OFF_KP + (size_t)m * 512 + c) = make_float4(v[0], v[1], v[2], v[3]);
                    } else {
                        *(uint2*)(kS + ((size_t)(seq - 16) * LKS + 1024 + tt) * 512 + c) = pk4(v[0], v[1], v[2], v[3]);
                        *(float4*)(out + OFF_KS + (size_t)(m - TP) * 512 + c) = make_float4(v[0], v[1], v[2], v[3]);
                    }
                } else if (n < 3360) {
                    const int c = n - 2848;
                    if (isP) {
                        *(float4*)(out + OFF_VP + (size_t)m * 512 + c) = make_float4(v[0], v[1], v[2], v[3]);
                        u16* d = vtP + ((size_t)seq * 512 + c) * 4096 + tt;
                        d[0] = f2bf(v[0]); d[4096] = f2bf(v[1]); d[2 * 4096] = f2bf(v[2]); d[3 * 4096] = f2bf(v[3]);
                    } else {
                        *(float4*)(out + OFF_VS + (size_t)(m - TP) * 512 + c) = make_float4(v[0], v[1], v[2], v[3]);
                        u16* d = vtS + ((size_t)(seq - 16) * 512 + c) * LKS + 1024 + tt;
                        d[0] = f2bf(v[0]); d[LKS] = f2bf(v[1]); d[2 * LKS] = f2bf(v[2]); d[3 * LKS] = f2bf(v[3]);
                    }
                } else {
                    const int c = n - 3360;
                    const float4 bg = *(const float4*)(p.b_gate + c);
                    *(uint2*)(gate + (size_t)m * 2048 + c) =
                        pk4(sigmoidf_(v[0] + bg.x), sigmoidf_(v[1] + bg.y), sigmoidf_(v[2] + bg.z), sigmoidf_(v[3] + bg.w));
                }
            }
        }
    }
}

__device__ __forceinline__ void lerp8(const u16* cur, const u16* prv, const float* mu, int col, float (&xs)[8]) {
    const uint4 cu = *(const uint4*)(cur + col);
    const uint4 pv = *(const uint4*)(prv + col);
    const float4 m0 = *(const float4*)(mu + col);
    const float4 m1 = *(const float4*)(mu + col + 4);
    const unsigned cw[4] = {cu.x, cu.y, cu.z, cu.w}, pw[4] = {pv.x, pv.y, pv.z, pv.w};
    const float mm[8] = {m0.x, m0.y, m0.z, m0.w, m1.x, m1.y, m1.z, m1.w};
#pragma unroll
    for (int i = 0; i < 4; ++i) {
        const float c0 = bflo(cw[i]), c1 = bfhi(cw[i]), p0 = bflo(pw[i]), p1 = bfhi(pw[i]);
        xs[2 * i] = c0 + (p0 - c0) * mm[2 * i];
        xs[2 * i + 1] = c1 + (p1 - c1) * mm[2 * i + 1];
    }
}
__device__ __forceinline__ void lerp4(const u16* cur, const u16* prv, const float* mu, int col, float (&xs)[4]) {
    const uint2 cu = *(const uint2*)(cur + col);
    const uint2 pv = *(const uint2*)(prv + col);
    const float4 m0 = *(const float4*)(mu + col);
    float c0 = bflo(cu.x), c1 = bfhi(cu.x), c2 = bflo(cu.y), c3 = bfhi(cu.y);
    xs[0] = c0 + (bflo(pv.x) - c0) * m0.x;
    xs[1] = c1 + (bfhi(pv.x) - c1) * m0.y;
    xs[2] = c2 + (bflo(pv.y) - c2) * m0.z;
    xs[3] = c3 + (bfhi(pv.y) - c3) * m0.w;
}
__device__ __forceinline__ bf16x8 packfrag(const float (&v)[8]) {
    return as_frag(make_uint4(pk2(v[0], v[1]), pk2(v[2], v[3]), pk2(v[4], v[5]), pk2(v[6], v[7])));
}

__device__ __forceinline__ void phase2(const Params& p, unsigned char* smem) {
    unsigned char* ws = p.ws;
    const u16* cA = (const u16*)(ws + O_CA);
    const u16* w2t = (const u16*)(ws + O_W2);
    const u16* a2t = (const u16*)(ws + O_A2);
    const u16* g2t = (const u16*)(ws + O_G2);
    u16* SI = (u16*)(ws + O_SI);
    u16* Gb = (u16*)(ws + O_G);
    float4* rk4 = (float4*)(ws + O_RK);
    const int tid = threadIdx.x, lane = tid & 63, wid = tid >> 6, l16 = lane & 15, g = lane >> 4;
    float* sp = (float*)smem;
    for (int i = tid; i < 1824; i += 256) sp[i] = p.mu[i];
    for (int i = tid; i < 512; i += 256) {
        sp[1824 + i] = p.w0[i]; sp[2336 + i] = p.a0[i]; sp[2848 + i] = p.k_k[i]; sp[3360 + i] = p.k_a[i]; sp[3872 + i] = p.r_k[i];
    }
    __syncthreads();
    for (int u = blockIdx.x; u < T / 64; u += gridDim.x) {
        const int mw = u * 64 + wid * 16;
        const int m = mw + l16;
        const bool isP = mw < TP;
        int seq, tt;
        if (isP) { seq = m >> 12; tt = m & 4095; }
        else { const int ms = m - TP; seq = 16 + (ms >> 5); tt = ms & 31; }
        const u16* cur = cA + ((size_t)m + seq + 1) * ACOLS;
        const u16* prv = cur - ACOLS;
        bf16x8 xw[2], xa[2], xg[5];
#pragma unroll
        for (int s = 0; s < 9; ++s) {
            float xs[8];
            lerp8(cur, prv, sp, 1536 + s * 32 + g * 8, xs);
            if (s < 2) {
#pragma unroll
                for (int i = 0; i < 8; ++i) xs[i] = 1.f - 2.f / (__expf(2.f * xs[i]) + 1.f);
                xw[s] = packfrag(xs);
            } else if (s < 4) {
                xa[s - 2] = packfrag(xs);
            } else {
#pragma unroll
                for (int i = 0; i < 8; ++i) xs[i] = sigmoidf_(xs[i]);
                xg[s - 4] = packfrag(xs);
            }
        }
        for (int h = 0; h < 8; ++h) {
            float kkr[16], av[16];
            float ssq = 0.f, rkacc = 0.f, bracc = 0.f, kracc = 0.f;
            const size_t sirow = isP ? ((size_t)(seq * 8 + h) * 4096 + tt) : ((size_t)128 * 4096 + (size_t)((seq - 16) * 8 + h) * 32 + tt);
            u16* sib = SI + sirow * 384;
#pragma unroll
            for (int nt = 0; nt < 4; ++nt) {
                const int wrow = h * 64 + nt * 16 + l16;
                f32x4 accw = {0.f, 0.f, 0.f, 0.f}, acca = accw, accg = accw;
#pragma unroll
                for (int s = 0; s < 2; ++s) {
                    accw = MFMA(*(const bf16x8*)(w2t + wrow * 64 + s * 32 + g * 8), xw[s], accw);
                    acca = MFMA(*(const bf16x8*)(a2t + wrow * 64 + s * 32 + g * 8), xa[s], acca);
                }
#pragma unroll
                for (int s = 0; s < 5; ++s) accg = MFMA(*(const bf16x8*)(g2t + wrow * 160 + s * 32 + g * 8), xg[s], accg);
                const int ch = h * 64 + nt * 16 + g * 4;
                float xr[4], xk[4], xv[4];
                lerp4(cur, prv, sp, ch, xr);
                lerp4(cur, prv, sp, 512 + ch, xk);
                lerp4(cur, prv, sp, 1024 + ch, xv);
                const float4 w0 = *(const float4*)(sp + 1824 + ch), a0 = *(const float4*)(sp + 2336 + ch), kk4 = *(const float4*)(sp + 2848 + ch),
                             ka4 = *(const float4*)(sp + 3360 + ch), rk4 = *(const float4*)(sp + 3872 + ch);
                const float w0a[4] = {w0.x, w0.y, w0.z, w0.w}, a0a[4] = {a0.x, a0.y, a0.z, a0.w}, kka[4] = {kk4.x, kk4.y, kk4.z, kk4.w},
                            kaa[4] = {ka4.x, ka4.y, ka4.z, ka4.w}, rka[4] = {rk4.x, rk4.y, rk4.z, rk4.w};
                float ev[4], kp[4], dr[4];
#pragma unroll
                for (int r = 0; r < 4; ++r) {
                    const float z = -(w0a[r] + accw[r]);
                    const float sp = (z > 20.f) ? z : __logf(1.f + __expf(z));
                    ev[r] = __expf(-sp - 0.5f);
                    const float a = sigmoidf_(a0a[r] + acca[r]);
                    const float kraw = xk[r] * kka[r];
                    ssq += kraw * kraw;
                    kp[r] = xk[r] * (1.f + (a - 1.f) * kaa[r]);
                    rkacc += xr[r] * kp[r] * rka[r];
                    kracc += xr[r] * kp[r];
                    bracc += kraw * a * xr[r];
                    dr[r] = xr[r] * __expf(-ev[r]);
                    kkr[nt * 4 + r] = kraw;
                    av[nt * 4 + r] = a;
                }
                const int co = nt * 16 + g * 4;
                *(uint2*)(sib + 0 * 64 + co) = pk4(dr[0], dr[1], dr[2], dr[3]);
                *(uint2*)(sib + 1 * 64 + co) = pk4(ev[0], ev[1], ev[2], ev[3]);
                *(uint2*)(sib + 2 * 64 + co) = pk4(kp[0], kp[1], kp[2], kp[3]);
                *(uint2*)(sib + 3 * 64 + co) = pk4(xv[0], xv[1], xv[2], xv[3]);
                *(uint2*)(Gb + (size_t)m * 512 + ch) = pk4(accg[0], accg[1], accg[2], accg[3]);
            }
            ssq = red_g(ssq);
            rkacc = red_g(rkacc);
            bracc = red_g(bracc);
            kracc = red_g(kracc);
            const float inv = rsqrtf(fmaxf(ssq, 1e-24f));
#pragma unroll
            for (int nt = 0; nt < 4; ++nt) {
                const int co = nt * 16 + g * 4;
                float k0 = kkr[nt * 4 + 0] * inv, k1 = kkr[nt * 4 + 1] * inv, k2 = kkr[nt * 4 + 2] * inv, k3 = kkr[nt * 4 + 3] * inv;
                *(uint2*)(sib + 4 * 64 + co) = pk4(k0, k1, k2, k3);
                *(uint2*)(sib + 5 * 64 + co) = pk4(k0 * av[nt * 4 + 0], k1 * av[nt * 4 + 1], k2 * av[nt * 4 + 2], k3 * av[nt * 4 + 3]);
            }
            if (g == 0) rk4[(size_t)m * 8 + h] = make_float4(rkacc, bracc * inv, kracc, 0.f);
        }
    }
}

typedef float v2f __attribute__((ext_vector_type(2)));
__device__ __forceinline__ void scan_item(const Params& p, const u16* __restrict__ si, int nch, const float* __restrict__ s0, float* __restrict__ sout,
                          int m0, int h, int half, unsigned char* smem) {
    float* inb = (float*)smem;
    float* ybuf = (float*)(smem + 49152);
    float* scal = (float*)(smem + 53248);
    unsigned char* ws = p.ws;
    const float4* rk4 = (const float4*)(ws + O_RK);
    u16* yraw = (u16*)(ws + O_YRAW);
    const int tid = threadIdx.x;
    const int vp = tid >> 3, kq = tid & 7;
    const int row = half * 32 + vp;
    v2f S[4];
    if (s0) {
        const float4 a = *(const float4*)(s0 + row * 64 + kq * 8), b = *(const float4*)(s0 + row * 64 + kq * 8 + 4);
        S[0] = (v2f){a.x, a.y}; S[1] = (v2f){a.z, a.w}; S[2] = (v2f){b.x, b.y}; S[3] = (v2f){b.z, b.w};
    } else {
#pragma unroll
        for (int j = 0; j < 4; ++j) S[j] = (v2f){0.f, 0.f};
    }
    uint4 st0, st1, st2;
    float4 sq = make_float4(0.f, 0.f, 0.f, 0.f);
    st0 = *(const uint4*)(si + (0 * 256 + tid) * 8);
    st1 = *(const uint4*)(si + (1 * 256 + tid) * 8);
    st2 = *(const uint4*)(si + (2 * 256 + tid) * 8);
    if (tid < 16) sq = rk4[(m0 + tid) * 8 + h];
#define S_WRITE1(sv, i, buf)                                                                                          \
    {                                                                                                                 \
        const int idx = (i) * 256 + tid;                                                                              \
        const int vec = (idx % 48) >> 3;                                                                              \
        float v[8] = {bflo(sv.x), bfhi(sv.x), bflo(sv.y), bfhi(sv.y), bflo(sv.z), bfhi(sv.z), bflo(sv.w), bfhi(sv.w)}; \
        if (vec == 1) {                                                                                               \
            _Pragma("unroll") for (int k = 0; k < 8; ++k) v[k] = __expf(-v[k]);                                       \
        }                                                                                                             \
        float* d = inb + (buf) * 6144 + idx * 8;                                                                      \
        *(float4*)d = make_float4(v[0], v[1], v[2], v[3]);                                                            \
        *(float4*)(d + 4) = make_float4(v[4], v[5], v[6], v[7]);                                                      \
    }
#define stage_write(buf) S_WRITE1(st0, 0, buf) S_WRITE1(st1, 1, buf) S_WRITE1(st2, 2, buf) if (tid < 16) *(float4*)(scal + (buf) * 64 + tid * 4) = sq;
    stage_write(0)
    __syncthreads();
    for (int c = 0; c < nch; ++c) {
        const int buf = c & 1;
        if (c + 1 < nch) {
            const u16* sn = si + (c + 1) * 6144 + tid * 8;
            st0 = *(const uint4*)(sn);
            st1 = *(const uint4*)(sn + 2048);
            st2 = *(const uint4*)(sn + 4096);
            if (tid < 16) sq = rk4[(m0 + (c + 1) * 16 + tid) * 8 + h];
        }
        const float* cb = inb + buf * 6144;
        const float* cs = scal + buf * 64;
#pragma unroll 2
        for (int tt = 0; tt < 16; ++tt) {
            const float* base = cb + tt * 384;
            v2f kk[4], dr[4], dd[4], bb[4], kv[4];
#define LD8(dst, off)                                                      \
    {                                                                      \
        const float4 q0 = *(const float4*)(base + (off) + kq * 8);         \
        const float4 q1 = *(const float4*)(base + (off) + kq * 8 + 4);     \
        dst[0] = (v2f){q0.x, q0.y}; dst[1] = (v2f){q0.z, q0.w};            \
        dst[2] = (v2f){q1.x, q1.y}; dst[3] = (v2f){q1.z, q1.w};            \
    }
            LD8(kk, 256) LD8(dr, 0) LD8(dd, 64) LD8(bb, 320) LD8(kv, 128)
            const float vv = base[192 + row];
            const float2 brkr = *(const float2*)(cs + tt * 4 + 1);
            v2f a0 = S[0] * kk[0], a1 = S[1] * kk[1], q0 = S[0] * dr[0], q1 = S[1] * dr[1];
            a0 = __builtin_elementwise_fma(S[2], kk[2], a0);
            a1 = __builtin_elementwise_fma(S[3], kk[3], a1);
            q0 = __builtin_elementwise_fma(S[2], dr[2], q0);
            q1 = __builtin_elementwise_fma(S[3], dr[3], q1);
            a0 += a1;
            q0 += q1;
            const float sa = -red8(a0.x + a0.y);
            const float pp = red8(q0.x + q0.y);
            const float y = pp + sa * brkr.x + vv * brkr.y;
            if (kq == 0) ybuf[tt * 32 + vp] = y;
            const v2f sav = (v2f){sa, sa}, vvv = (v2f){vv, vv};
#pragma unroll
            for (int j = 0; j < 4; ++j) S[j] = __builtin_elementwise_fma(S[j], dd[j], __builtin_elementwise_fma(vvv, kv[j], sav * bb[j]));
        }
        __syncthreads();
        {
            const int tt = tid >> 4, e2 = (tid & 15) * 2;
            const float2 y2 = *(const float2*)(ybuf + tt * 32 + e2);
            *(unsigned*)(yraw + (m0 + c * 16 + tt) * 512 + h * 64 + half * 32 + e2) = pk2(y2.x, y2.y);
        }
        if (c + 1 < nch) { stage_write(buf ^ 1) }
        __syncthreads();
    }
    {
        float* d0 = sout + row * 64 + kq * 8;
        *(float4*)d0 = make_float4(S[0].x, S[0].y, S[1].x, S[1].y);
        *(float4*)(d0 + 4) = make_float4(S[2].x, S[2].y, S[3].x, S[3].y);
    }
}

__device__ __forceinline__ void ln_pass(const Params& p) {
    unsigned char* ws = p.ws;
    const u16* yraw = (const u16*)(ws + O_YRAW);
    const u16* Gb = (const u16*)(ws + O_G);
    const u16* SI = (const u16*)(ws + O_SI);
    const float4* rk4 = (const float4*)(ws + O_RK);
    u16* ya = (u16*)(ws + O_YA);
    const int tid = threadIdx.x, cq = (tid & 15) * 4;
    for (int q0 = blockIdx.x * 16; q0 < T * 8; q0 += gridDim.x * 16) {
        const int q = q0 + (tid >> 4);
        const int m = q >> 3, h = q & 7;
        const int e = m * 512 + h * 64 + cq;
        const uint2 yv = *(const uint2*)(yraw + e);
        const float y0 = bflo(yv.x), y1 = bfhi(yv.x), y2 = bflo(yv.y), y3 = bfhi(yv.y);
        const float mean = red16(y0 + y1 + y2 + y3) * (1.f / 64.f);
        const float d0 = y0 - mean, d1 = y1 - mean, d2 = y2 - mean, d3 = y3 - mean;
        const float var = red16(d0 * d0 + d1 * d1 + d2 * d2 + d3 * d3) * (1.f / 64.f);
        const float rstd = rsqrtf(var + 64e-5f);
        const float rkv = rk4[q].x;
        int sirow;
        if (m < TP) sirow = ((m >> 12) * 8 + h) * 4096 + (m & 4095);
        else { const int ms = m - TP; sirow = 128 * 4096 + ((ms >> 5) * 8 + h) * 32 + (ms & 31); }
        const uint2 vq = *(const uint2*)(SI + (size_t)sirow * 384 + 192 + cq);
        const uint2 gg = *(const uint2*)(Gb + e);
        const float4 lw = *(const float4*)(p.ln_w + h * 64 + cq), lb = *(const float4*)(p.ln_b + h * 64 + cq);
        const float o0 = (d0 * rstd * lw.x + lb.x + rkv * bflo(vq.x)) * bflo(gg.x);
        const float o1 = (d1 * rstd * lw.y + lb.y + rkv * bfhi(vq.x)) * bfhi(gg.x);
        const float o2 = (d2 * rstd * lw.z + lb.z + rkv * bflo(vq.y)) * bflo(gg.y);
        const float o3 = (d3 * rstd * lw.w + lb.w + rkv * bfhi(vq.y)) * bfhi(gg.y);
        *(uint2*)(ya + e) = pk4(o0, o1, o2, o3);
    }
}

constexpr int KLD = 136, VLD = 72;
__device__ __forceinline__ void attn_item(const u16* __restrict__ Q, int nq, const u16* __restrict__ K, const u16* __restrict__ Vt, int ldv, int nkt,
                          int lastvalid, u16* __restrict__ O, float lam, const float* __restrict__ subln, unsigned char* smem) {
    u16* sK = (u16*)smem;
    u16* sV = (u16*)(smem + 2 * 64 * KLD * 2);
    float* ex = (float*)smem;
    const int tid = threadIdx.x, lane = tid & 63, wid = tid >> 6, l16 = lane & 15, g = lane >> 4;
    const int n = wid >> 1, qh = wid & 1;
    const bool active = (qh * 32) < nq;
    bf16x8 qf[2][2];
#pragma unroll
    for (int qt = 0; qt < 2; ++qt)
#pragma unroll
        for (int s = 0; s < 2; ++s) {
            const int row = qh * 32 + qt * 16 + l16;
            uint4 v = make_uint4(0, 0, 0, 0);
            if (row < nq) v = *(const uint4*)(Q + (row * 512 + n * 64 + s * 32 + g * 8));
            qf[qt][s] = as_frag(v);
        }
    f32x4 o[2][8];
#pragma unroll
    for (int qt = 0; qt < 2; ++qt)
#pragma unroll
        for (int et = 0; et < 8; ++et) o[qt][et] = (f32x4){0.f, 0.f, 0.f, 0.f};
    float mrow[2] = {-1e30f, -1e30f}, lrow[2] = {0.f, 0.f};
    uint4 kr0, kr1, kr2, kr3, vr0, vr1, vr2, vr3;
    const int krow = tid >> 4, kch = (tid & 15) * 8;
    const int vrow = tid >> 3, vch = (tid & 7) * 8;
    const int ko_ = krow * 512 + kch;
    const int vo_ = vrow * ldv + vch;
#define A_LOAD(key0)                                                      \
    kr0 = *(const uint4*)(K + (ko_ + ((key0) + 0) * 512));                \
    kr1 = *(const uint4*)(K + (ko_ + ((key0) + 16) * 512));               \
    kr2 = *(const uint4*)(K + (ko_ + ((key0) + 32) * 512));               \
    kr3 = *(const uint4*)(K + (ko_ + ((key0) + 48) * 512));               \
    vr0 = *(const uint4*)(Vt + (vo_ + (key0)));                           \
    vr1 = *(const uint4*)(Vt + (vo_ + 32 * ldv + (key0)));                \
    vr2 = *(const uint4*)(Vt + (vo_ + 64 * ldv + (key0)));                \
    vr3 = *(const uint4*)(Vt + (vo_ + 96 * ldv + (key0)));
#define A_STORE(nb)                                                       \
    *(uint4*)(sK + (nb) * 64 * KLD + (krow + 0) * KLD + kch) = kr0;       \
    *(uint4*)(sK + (nb) * 64 * KLD + (krow + 16) * KLD + kch) = kr1;      \
    *(uint4*)(sK + (nb) * 64 * KLD + (krow + 32) * KLD + kch) = kr2;      \
    *(uint4*)(sK + (nb) * 64 * KLD + (krow + 48) * KLD + kch) = kr3;      \
    *(uint4*)(sV + (nb) * 128 * VLD + (vrow + 0) * VLD + vch) = vr0;      \
    *(uint4*)(sV + (nb) * 128 * VLD + (vrow + 32) * VLD + vch) = vr1;     \
    *(uint4*)(sV + (nb) * 128 * VLD + (vrow + 64) * VLD + vch) = vr2;     \
    *(uint4*)(sV + (nb) * 128 * VLD + (vrow + 96) * VLD + vch) = vr3;
    A_LOAD(0)
    A_STORE(0)
    __syncthreads();
    constexpr float SC = 0.125f * 1.4426950408889634f;
    for (int kt = 0; kt < nkt; ++kt) {
        const int buf = kt & 1;
        if (kt + 1 < nkt) { A_LOAD((kt + 1) * 64) }
        __builtin_amdgcn_sched_barrier(0);
        if (active) {
            const int valid = (kt == nkt - 1) ? lastvalid : 64;
            const u16* cK = sK + buf * 64 * KLD + l16 * KLD + n * 64 + g * 8;
            const u16* cV = sV + buf * 128 * VLD + l16 * VLD + g * 4;
            f32x4 s[4][2];
#pragma unroll
            for (int k16 = 0; k16 < 4; ++k16) {
                const bf16x8 kf0 = *(const bf16x8*)(cK + k16 * 16 * KLD);
                const bf16x8 kf1 = *(const bf16x8*)(cK + k16 * 16 * KLD + 32);
#pragma unroll
                for (int qt = 0; qt < 2; ++qt) {
                    f32x4 z = {0.f, 0.f, 0.f, 0.f};
                    z = MFMA(kf0, qf[qt][0], z);
                    s[k16][qt] = MFMA(kf1, qf[qt][1], z);
                }
            }
            bf16x8 pf[2][2];
#pragma unroll
            for (int qt = 0; qt < 2; ++qt) {
                float mx = -1e30f;
#pragma unroll
                for (int k16 = 0; k16 < 4; ++k16)
#pragma unroll
                    for (int r = 0; r < 4; ++r) {
                        float v = s[k16][qt][r] * SC;
                        if (k16 * 16 >= valid) v = -1e30f;
                        s[k16][qt][r] = v;
                        mx = fmaxf(mx, v);
                    }
                mx = fmaxf(mx, __shfl_xor(mx, 16));
                mx = fmaxf(mx, __shfl_xor(mx, 32));
                const float mnew = fmaxf(mrow[qt], mx);
                const float alpha = exp2f(mrow[qt] - mnew);
                mrow[qt] = mnew;
                float psum = 0.f;
#pragma unroll
                for (int k16 = 0; k16 < 4; ++k16)
#pragma unroll
                    for (int r = 0; r < 4; ++r) {
                        const float pv = exp2f(s[k16][qt][r] - mnew);
                        s[k16][qt][r] = pv;
                        psum += pv;
                    }
                lrow[qt] = lrow[qt] * alpha + psum;
#pragma unroll
                for (int et = 0; et < 8; ++et) {
                    o[qt][et][0] *= alpha; o[qt][et][1] *= alpha; o[qt][et][2] *= alpha; o[qt][et][3] *= alpha;
                }
#pragma unroll
                for (int kb = 0; kb < 2; ++kb)
                    pf[qt][kb] = as_frag(make_uint4(pk2(s[2 * kb][qt][0], s[2 * kb][qt][1]), pk2(s[2 * kb][qt][2], s[2 * kb][qt][3]),
                                                    pk2(s[2 * kb + 1][qt][0], s[2 * kb + 1][qt][1]), pk2(s[2 * kb + 1][qt][2], s[2 * kb + 1][qt][3])));
            }
#pragma unroll
            for (int et = 0; et < 8; ++et)
#pragma unroll
                for (int kb = 0; kb < 2; ++kb) {
                    const uint2 lo = *(const uint2*)(cV + et * 16 * VLD + kb * 32);
                    const uint2 hi = *(const uint2*)(cV + et * 16 * VLD + kb * 32 + 16);
                    const bf16x8 vf = as_frag(make_uint4(lo.x, lo.y, hi.x, hi.y));
#pragma unroll
                    for (int qt = 0; qt < 2; ++qt) o[qt][et] = MFMA(vf, pf[qt][kb], o[qt][et]);
                }
        }
        __builtin_amdgcn_sched_barrier(0);
        if (kt + 1 < nkt) { A_STORE(buf ^ 1) }
        __syncthreads();
    }
    float inv[2];
#pragma unroll
    for (int qt = 0; qt < 2; ++qt) {
        const float l = red_g(lrow[qt]);
        inv[qt] = 1.f / fmaxf(l, 1e-30f);
    }
    if (active && n == 1) {
#pragma unroll
        for (int qt = 0; qt < 2; ++qt)
#pragma unroll
            for (int et = 0; et < 8; ++et) {
                const f32x4 v = o[qt][et];
                *(float4*)(ex + (qh * 32 + qt * 16 + l16) * 132 + et * 16 + g * 4) =
                    make_float4(v[0] * inv[qt], v[1] * inv[qt], v[2] * inv[qt], v[3] * inv[qt]);
            }
    }
    __syncthreads();
    if (active && n == 0) {
#pragma unroll
        for (int qt = 0; qt < 2; ++qt) {
            const int row = qh * 32 + qt * 16 + l16;
            float ss = 0.f;
#pragma unroll
            for (int et = 0; et < 8; ++et) {
                const float4 o2 = *(const float4*)(ex + row * 132 + et * 16 + g * 4);
                f32x4 v = o[qt][et];
                v[0] = v[0] * inv[qt] - lam * o2.x;
                v[1] = v[1] * inv[qt] - lam * o2.y;
                v[2] = v[2] * inv[qt] - lam * o2.z;
                v[3] = v[3] * inv[qt] - lam * o2.w;
                o[qt][et] = v;
                ss += v[0] * v[0] + v[1] * v[1] + v[2] * v[2] + v[3] * v[3];
            }
            ss = red_g(ss);
            const float rn = rsqrtf(ss * (1.f / 128.f) + EPS) * 0.8f;
            if (row < nq) {
#pragma unroll
                for (int et = 0; et < 8; ++et) {
                    const float4 sl = *(const float4*)(subln + et * 16 + g * 4);
                    const f32x4 v = o[qt][et];
                    *(uint2*)(O + (row * 512 + et * 16 + g * 4)) = pk4(v[0] * rn * sl.x, v[1] * rn * sl.y, v[2] * rn * sl.z, v[3] * rn * sl.w);
                }
            }
        }
    }
    __syncthreads();
}

__device__ __forceinline__ void phase3(const Params& p, unsigned char* smem) {
    unsigned char* ws = p.ws;
    int* s_item = (int*)(smem + LDS_BYTES - 16);
    unsigned* ctr = (unsigned*)(ws + O_SCAL) + 1;
    const float lam = ((const float*)(ws + O_SCAL))[0];
    const u16* SI = (const u16*)(ws + O_SI);
    const u16* qb = (const u16*)(ws + O_QB);
    const u16* kP = (const u16*)(ws + O_KP);
    const u16* kS = (const u16*)(ws + O_KS);
    const u16* vtP = (const u16*)(ws + O_VTP);
    const u16* vtS = (const u16*)(ws + O_VTS);
    u16* ob = (u16*)(ws + O_OB);
    int stage = 0, sidx = blockIdx.x;
    constexpr int SCAN_BASE = 100000, DONE = 1 << 30;
    for (;;) {
        if (threadIdx.x == 0) {
            int it;
            if (stage == 0) it = (sidx < 768) ? SCAN_BASE + sidx : -2;
            else {
                const int x = blockIdx.x & 7;
                const int i = (int)atomicAdd(ctr + 16 + x, 1u);
                if (i < 512) it = ((63 - (i >> 3)) << 6) | (x + 8 * (i & 7));
                else if (i < 528) it = 4096 + (x + 8 * (i - 512));
                else it = DONE;
            }
            *s_item = it;
        }
        __syncthreads();
        const int item = __builtin_amdgcn_readfirstlane(*s_item);
        __syncthreads();
        if (item == DONE) break;
        if (item == -2) {
            asm volatile("s_waitcnt vmcnt(0) lgkmcnt(0)" ::: "memory");
            cg::this_grid().sync();
            stage = 1;
            ln_pass(p);
            continue;
        }
        if (item >= SCAN_BASE) {
            sidx += gridDim.x;
            const int sc = item - SCAN_BASE;
            const u16* si; int nch; const float* s0; float* sout; int m0, h, half;
            if (sc < 256) {
                const int chain = sc >> 1;
                half = sc & 1; h = chain & 7;
                si = SI + (size_t)chain * 4096 * 384; nch = 256; s0 = nullptr;
                sout = p.out + OFF_WP + (size_t)chain * 4096; m0 = (chain >> 3) * 4096;
            } else {
                const int t2 = sc - 256, chain = t2 >> 1;
                half = t2 & 1; h = chain & 7;
                si = SI + ((size_t)128 * 4096 + (size_t)chain * 32) * 384; nch = 2; s0 = p.state_wkv + (size_t)chain * 4096;
                sout = p.out + OFF_WS + (size_t)chain * 4096; m0 = TP + (chain >> 3) * 32;
            }
            scan_item(p, si, nch, s0, sout, m0, h, half, smem);
        } else {
            const u16 *Q, *K, *Vt; u16* O; int nq, ldv, nkt, lastvalid;
            if (item < 4096) {
                const int c = item >> 6, bh = item & 63, b = bh >> 2, h = bh & 3;
                const size_t m0 = (size_t)b * 4096 + (size_t)c * 64;
                Q = qb + m0 * 512 + h * 128; nq = 64; K = kP + (size_t)b * 4096 * 512 + h * 128;
                Vt = vtP + ((size_t)b * 512 + h * 128) * 4096; ldv = 4096; nkt = c + 1; lastvalid = 64; O = ob + m0 * 512 + h * 128;
            } else {
                const int idx = item - 4096;
                const int b = idx >> 2, h = idx & 3;
                const size_t m0 = (size_t)TP + (size_t)b * 32;
                Q = qb + m0 * 512 + h * 128; nq = 32; K = kS + (size_t)b * LKS * 512 + h * 128;
                Vt = vtS + ((size_t)b * 512 + h * 128) * LKS; ldv = LKS; nkt = 17; lastvalid = 32; O = ob + m0 * 512 + h * 128;
            }
            attn_item(Q, nq, K, Vt, ldv, nkt, lastvalid, O, lam, p.subln, smem);
        }
    }
}

__device__ __forceinline__ void phase4(const Params& p, unsigned char* smem) {
    unsigned char* ws = p.ws;
    const u16* ya = (const u16*)(ws + O_YA);
    const u16* ob = (const u16*)(ws + O_OB);
    const u16* Wa = (const u16*)(ws + O_WOA);
    const u16* Wb = (const u16*)(ws + O_WOB);
    const u16* gate = (const u16*)p.out;
    u16* mix = (u16*)(ws + O_MIX);
    const int tid = threadIdx.x, lane = tid & 63, wid = tid >> 6, wm = wid >> 1, wn = wid & 1, l16 = lane & 15, g = lane >> 4;
    constexpr int NT = 8;
    for (int t = blockIdx.x; t < 520 * NT; t += gridDim.x) {
        int mtile, ntile;
        tile_map(t, NT, mtile, ntile);
        const int m0 = mtile * 128, n0 = ntile * 128;
        f32x4 acc[4][4], acc2[4][4];
        zero_acc(acc);
        zero_acc(acc2);
        gemm_loop(ya + (size_t)m0 * 512, 512, Wa + (size_t)n0 * 512, 512, 8, (u16*)smem, acc);
        gemm_loop(ob + (size_t)m0 * 512, 512, Wb + (size_t)n0 * 512, 512, 8, (u16*)smem, acc2);
#pragma unroll
        for (int mt = 0; mt < 4; ++mt) {
            const int m = m0 + wm * 64 + mt * 16 + l16;
#pragma unroll
            for (int nt = 0; nt < 4; ++nt) {
                const int n = n0 + wn * 64 + nt * 16 + g * 4;
                const uint2 ga = *(const uint2*)(gate + (size_t)m * 2048 + n);
                const uint2 gb = *(const uint2*)(gate + (size_t)m * 2048 + 1024 + n);
                const f32x4 a = acc[nt][mt], b = acc2[nt][mt];
                *(uint2*)(mix + (size_t)m * 1024 + n) =
                    pk4(bflo(ga.x) * a[0] + bflo(gb.x) * b[0], bfhi(ga.x) * a[1] + bfhi(gb.x) * b[1],
                        bflo(ga.y) * a[2] + bflo(gb.y) * b[2], bfhi(ga.y) * a[3] + bfhi(gb.y) * b[3]);
            }
        }
    }
}

__device__ __forceinline__ void gemm_rowss(const u16* A, int K, const u16* W, u16* outb, float* ssq, unsigned char* smem) {
    const int tid = threadIdx.x, lane = tid & 63, wid = tid >> 6, wm = wid >> 1, wn = wid & 1, l16 = lane & 15, g = lane >> 4;
    constexpr int NT = 8;
    for (int t = blockIdx.x; t < 520 * NT; t += gridDim.x) {
        int mtile, ntile;
        tile_map(t, NT, mtile, ntile);
        const int m0 = mtile * 128, n0 = ntile * 128;
        f32x4 acc[4][4];
        zero_acc(acc);
        gemm_loop(A + (size_t)m0 * K, K, W + (size_t)n0 * K, K, K / 64, (u16*)smem, acc);
#pragma unroll
        for (int mt = 0; mt < 4; ++mt) {
            const int m = m0 + wm * 64 + mt * 16 + l16;
#pragma unroll
            for (int nt = 0; nt < 4; ++nt) {
                const int n = n0 + wn * 64 + nt * 16 + g * 4;
                const f32x4 a = acc[nt][mt];
                *(uint2*)(outb + (size_t)m * 1024 + n) = pk4(a[0], a[1], a[2], a[3]);
            }
        }
    }
}

__device__ __forceinline__ float sum16(const float* q) {
    const float4 a = *(const float4*)q, b = *(const float4*)(q + 4), c = *(const float4*)(q + 8), d = *(const float4*)(q + 12);
    return ((a.x + a.y) + (a.z + a.w)) + ((b.x + b.y) + (b.z + b.w)) + (((c.x + c.y) + (c.z + c.w)) + ((d.x + d.y) + (d.z + d.w)));
}
__device__ __forceinline__ void phase6(const Params& p) {
    unsigned char* ws = p.ws;
    const u16* m2 = (const u16*)(ws + O_M2);
    u16* x1b = (u16*)(ws + O_X1B);
    float* rs3 = (float*)(ws + O_RS3);
    const int lane = threadIdx.x & 63, wid = threadIdx.x >> 6;
    for (int m = blockIdx.x * 4 + wid; m < T; m += gridDim.x * 4) {
        const float* xr = (m < TP) ? p.x_prompt + (size_t)m * 1024 : p.x_sample + (size_t)(m - TP) * 1024;
        uint2 mvv[4];
        float s2 = 0.f;
#pragma unroll
        for (int i = 0; i < 4; ++i) {
            mvv[i] = *(const uint2*)(m2 + (size_t)m * 1024 + i * 256 + lane * 4);
            const float a = bflo(mvv[i].x), b = bfhi(mvv[i].x), c = bflo(mvv[i].y), d = bfhi(mvv[i].y);
            s2 += a * a + b * b + c * c + d * d;
        }
        s2 = wave_sum(s2);
        const float rs = rsqrtf(s2 * (1.f / 1024.f) + EPS);
        float ss = 0.f;
#pragma unroll
        for (int i = 0; i < 4; ++i) {
            const int col = i * 256 + lane * 4;
            const float4 xv = *(const float4*)(xr + col);
            const uint2 mv = mvv[i];
            const float4 gp = *(const float4*)(p.n_mix_post + col);
            float4 r;
            r.x = xv.x + bflo(mv.x) * rs * gp.x;
            r.y = xv.y + bfhi(mv.x) * rs * gp.y;
            r.z = xv.z + bflo(mv.y) * rs * gp.z;
            r.w = xv.w + bfhi(mv.y) * rs * gp.w;
            ss += r.x * r.x + r.y * r.y + r.z * r.z + r.w * r.w;
            *(float4*)(p.out + (size_t)m * 1024 + col) = r;
            *(uint2*)(x1b + (size_t)m * 1024 + col) = pk4(r.x, r.y, r.z, r.w);
        }
        ss = wave_sum(ss);
        if (lane == 0) rs3[m] = rsqrtf(ss * (1.f / 1024.f) + EPS);
    }
}

__device__ __forceinline__ void phase7(const Params& p, unsigned char* smem) {
    unsigned char* ws = p.ws;
    const u16* x1b = (const u16*)(ws + O_X1B);
    const u16* W = (const u16*)(ws + O_WFI);
    const float* rs3 = (const float*)(ws + O_RS3);
    u16* hb = (u16*)(ws + O_HB);
    const int tid = threadIdx.x, lane = tid & 63, wid = tid >> 6, wm = wid >> 1, wn = wid & 1, l16 = lane & 15, g = lane >> 4;
    constexpr int NT = 44;
    for (int t = blockIdx.x; t < 520 * NT; t += gridDim.x) {
        int mtile, ntile;
        tile_map(t, NT, mtile, ntile);
        const int m0 = mtile * 128, n0 = ntile * 128;
        f32x4 acc[4][4];
        zero_acc(acc);
        gemm_loop(x1b + (size_t)m0 * 1024, 1024, W + (size_t)n0 * 1024, 1024, 16, (u16*)smem, acc);
#pragma unroll
        for (int mt = 0; mt < 4; ++mt) {
            const int m = m0 + wm * 64 + mt * 16 + l16;
            const float rs = rs3[m];
#pragma unroll
            for (int pr = 0; pr < 2; ++pr) {
                const f32x4 ug = acc[2 * pr][mt], uv = acc[2 * pr + 1][mt];
                const int j = ((n0 + wn * 64) >> 5) * 16 + pr * 16 + g * 4;
                float hv[4];
#pragma unroll
                for (int r = 0; r < 4; ++r) {
                    const float a = ug[r] * rs, b = uv[r] * rs;
                    hv[r] = a * sigmoidf_(a) * b;
                }
                *(uint2*)(hb + (size_t)m * 2816 + j) = pk4(hv[0], hv[1], hv[2], hv[3]);
            }
        }
    }
}

__device__ __forceinline__ void phase9(const Params& p) {
    unsigned char* ws = p.ws;
    const u16* fb = (const u16*)(ws + O_FB);
    const int lane = threadIdx.x & 63, wid = threadIdx.x >> 6;
    for (int m = blockIdx.x * 4 + wid; m < T; m += gridDim.x * 4) {
        uint2 fvv[4];
        float s2 = 0.f;
#pragma unroll
        for (int i = 0; i < 4; ++i) {
            fvv[i] = *(const uint2*)(fb + (size_t)m * 1024 + i * 256 + lane * 4);
            const float a = bflo(fvv[i].x), b = bfhi(fvv[i].x), c = bflo(fvv[i].y), d = bfhi(fvv[i].y);
            s2 += a * a + b * b + c * c + d * d;
        }
        s2 = wave_sum(s2);
        const float rs = rsqrtf(s2 * (1.f / 1024.f) + EPS);
#pragma unroll
        for (int i = 0; i < 4; ++i) {
            const int col = i * 256 + lane * 4;
            float4 r = *(const float4*)(p.out + (size_t)m * 1024 + col);
            const uint2 fv = fvv[i];
            const float4 gp = *(const float4*)(p.n_ffn_post + col);
            r.x += bflo(fv.x) * rs * gp.x;
            r.y += bfhi(fv.x) * rs * gp.y;
            r.z += bflo(fv.y) * rs * gp.z;
            r.w += bfhi(fv.y) * rs * gp.w;
            *(float4*)(p.out + (size_t)m * 1024 + col) = r;
        }
    }
}

__global__ void __launch_bounds__(256, 2) mega(Params p) {
    extern __shared__ __attribute__((aligned(16))) unsigned char smem[];
    cg::grid_group grid = cg::this_grid();
#define IN(k) (p.ph_lo <= (k) && (k) < p.ph_hi)
#define SEAM(k) if (IN(k) && IN((k) + 1)) { asm volatile("s_waitcnt vmcnt(0) lgkmcnt(0)" ::: "memory"); grid.sync(); }
    unsigned char* ws = p.ws;
    if (IN(0)) phase0(p, smem);
    SEAM(0)
    if (IN(1)) phase1(p, smem);
    SEAM(1)
    if (IN(2)) phase2(p, smem);
    SEAM(2)
    if (IN(3)) phase3(p, smem);
    SEAM(3)
    if (IN(5)) phase4(p, smem);
    SEAM(5)
    if (IN(6)) gemm_rowss((const u16*)(ws + O_MIX), 1024, (const u16*)(ws + O_WO), (u16*)(ws + O_M2), (float*)(ws + O_SS2), smem);
    SEAM(6)
    if (IN(7)) phase6(p);
    SEAM(7)
    if (IN(8)) phase7(p, smem);
    SEAM(8)
    if (IN(9)) gemm_rowss((const u16*)(ws + O_HB), 2816, (const u16*)(ws + O_WFO), (u16*)(ws + O_FB), (float*)(ws + O_SS4), smem);
    SEAM(9)
    if (IN(10)) phase9(p);
}

extern "C" void kernel_launch(void* const* d_in, const int* in_sizes, int n_in, void* d_out, int out_size, void* d_ws, size_t ws_size,
                              hipStream_t stream) {
    static int grid_blocks = 0;
    if (!grid_blocks) {
        int dev = 0, cus = 0, per_cu = 0;
        hipGetDevice(&dev);
        hipDeviceGetAttribute(&cus, hipDeviceAttributeMultiprocessorCount, dev);
        hipFuncSetAttribute((const void*)mega, hipFuncAttributeMaxDynamicSharedMemorySize, LDS_BYTES);
        hipOccupancyMaxActiveBlocksPerMultiprocessor(&per_cu, (const void*)mega, 256, LDS_BYTES);
        if (per_cu < 1) per_cu = 1;
        if (per_cu > 2) per_cu = 2;
        grid_blocks = cus * per_cu;
        if (ws_size < WS_END) fprintf(stderr, "kernel_launch: workspace too small: %zu < %zu\n", ws_size, (size_t)WS_END);
    }
    Params p{};
    const float** pp = (const float**)&p;
    for (int i = 0; i < 33; ++i) pp[i] = (const float*)d_in[i];
    p.out = (float*)d_out;
    p.ws = (unsigned char*)d_ws;
#ifndef MULTI_LAUNCH
    p.ph_lo = 0;
    p.ph_hi = 11;
    void* args[] = {&p};
    hipError_t e = hipLaunchCooperativeKernel((const void*)mega, dim3(grid_blocks), dim3(256), args, LDS_BYTES, stream);
    if (e != hipSuccess) fprintf(stderr, "cooperative launch failed: %s (grid %d)\n", hipGetErrorString(e), grid_blocks);
#else
    for (int k = 0; k < 11; ++k) {
        p.ph_lo = k;
        p.ph_hi = k + 1;
        hipLaunchKernelGGL(mega, dim3(grid_blocks), dim3(256), LDS_BYTES, stream, p);
    }
#endif
}
```

```cpp
#include <hip/hip_runtime.h>
#include <hip/hip_cooperative_groups.h>
#include <cstdio>
#include <cstdint>
namespace cg = cooperative_groups;

typedef unsigned short u16;
typedef __attribute__((ext_vector_type(8))) short bf16x8;
typedef __attribute__((ext_vector_type(4))) float f32x4;

constexpr int TP = 65536, TS = 1024, T = TP + TS;
constexpr int ACOLS = 1824;
constexpr int LKS = 1088;
constexpr int LDS_BYTES = 73728;
constexpr float EPS = 1e-6f;

constexpr size_t OFF_YS = 67108864ull, OFF_KP = 68157440ull, OFF_VP = 101711872ull, OFF_WP = 135266304ull,
                 OFF_SHP = 135790592ull, OFF_KS = 135819776ull, OFF_VS = 136344064ull, OFF_WS = 136868352ull,
                 OFF_SHS = 137916928ull;

constexpr size_t al(size_t x) { return (x + 255) & ~(size_t)255; }
constexpr size_t O_WIN = 0;
constexpr size_t O_WOA = O_WIN + al(5504ull * 1024 * 2);
constexpr size_t O_WOB = O_WOA + al(1024ull * 512 * 2);
constexpr size_t O_WO = O_WOB + al(1024ull * 512 * 2);
constexpr size_t O_WFI = O_WO + al(1024ull * 1024 * 2);
constexpr size_t O_WFO = O_WFI + al(5632ull * 1024 * 2);
constexpr size_t O_W2 = O_WFO + al(1024ull * 2816 * 2);
constexpr size_t O_A2 = O_W2 + al(512 * 64 * 2);
constexpr size_t O_G2 = O_A2 + al(512 * 64 * 2);
constexpr size_t O_RS1 = O_G2 + al(512 * 160 * 2);
constexpr size_t O_SS2 = O_RS1 + al((size_t)T * 4);
constexpr size_t O_SS4 = O_SS2 + al((size_t)T * 16 * 4);
constexpr size_t O_RS3 = O_SS4 + al((size_t)T * 16 * 4);
constexpr size_t O_RK = O_RS3 + al((size_t)T * 4);
constexpr size_t O_SCAL = O_RK + al((size_t)T * 8 * 16);
constexpr size_t O_REGA = O_SCAL + 256;
constexpr size_t O_CA = O_REGA;
constexpr size_t O_YA = O_REGA;
constexpr size_t O_OB = O_YA + al((size_t)T * 512 * 2);
constexpr size_t O_YRAW = O_OB + al((size_t)T * 512 * 2);
constexpr size_t O_HB = O_REGA;
constexpr size_t O_REGB = O_REGA + al((size_t)(T + 48) * 1824 * 2);
constexpr size_t O_QB = O_REGB;
constexpr size_t O_KP = O_QB + al((size_t)T * 512 * 2);
constexpr size_t O_KS = O_KP + al((size_t)TP * 512 * 2);
constexpr size_t O_VTP = O_KS + al(32ull * LKS * 512 * 2);
constexpr size_t O_VTS = O_VTP + al(16ull * 512 * 4096 * 2);
constexpr size_t O_REGC = O_VTS + al(32ull * 512 * LKS * 2);
constexpr size_t O_GATE = O_REGB;
static_assert(O_GATE + (size_t)T * 2048 * 2 <= O_REGC, "gate overlaps region C");
constexpr size_t O_SI = O_REGC;
constexpr size_t O_G = O_SI + al((size_t)T * 8 * 384 * 2);
constexpr size_t O_XB = O_REGC;
constexpr size_t O_MIX = O_REGC;
constexpr size_t O_M2 = O_MIX + al((size_t)T * 1024 * 2);
constexpr size_t O_X1B = O_M2 + al((size_t)T * 1024 * 2);
constexpr size_t O_FB = O_REGC;
constexpr size_t WS_END = O_G + al((size_t)T * 512 * 2);
static_assert(O_HB + (size_t)T * 2816 * 2 <= O_REGC, "hb overlaps region C");
static_assert(O_YRAW + (size_t)T * 512 * 2 <= O_REGB, "yraw overlaps region B");
static_assert(O_X1B + (size_t)T * 1024 * 2 <= WS_END, "x1b beyond end");
static_assert(WS_END <= 1073741824ull, "workspace too large");

struct Params {
    const float *x_prompt, *x_sample, *cache_k, *cache_v, *state_wkv, *state_shift;
    const float *n_mix_pre, *n_mix_post, *n_ffn_pre, *n_ffn_post, *w_in, *b_gate;
    const float *mu, *w0, *w2, *a0, *a2, *g2, *k_k, *k_a, *r_k, *ln_w, *ln_b;
    const float *lq1, *lk1, *lq2, *lk2, *subln, *w_out_a, *w_out_b, *w_o, *w_ffn_in, *w_ffn_out;
    float* out;
    unsigned char* ws;
    int ph_lo, ph_hi;
};

__device__ __forceinline__ u16 f2bf(float f) {
    unsigned u = __float_as_uint(f);
    u += 0x7fffu + ((u >> 16) & 1u);
    return (u16)(u >> 16);
}
__device__ __forceinline__ unsigned pk2(float a, float b) { return (unsigned)f2bf(a) | ((unsigned)f2bf(b) << 16); }
__device__ __forceinline__ float bflo(unsigned u) { return __uint_as_float(u << 16); }
__device__ __forceinline__ float bfhi(unsigned u) { return __uint_as_float(u & 0xffff0000u); }
__device__ __forceinline__ uint2 pk4(float a, float b, float c, float d) { return make_uint2(pk2(a, b), pk2(c, d)); }
__device__ __forceinline__ float sigmoidf_(float x) { return 1.f / (1.f + __expf(-x)); }

template <int CTRL>
__device__ __forceinline__ float dppf(float x) {
    return __int_as_float(__builtin_amdgcn_update_dpp(0, __float_as_int(x), CTRL, 0xF, 0xF, true));
}
__device__ __forceinline__ float red8(float x) {
    x += dppf<0xB1>(x);
    x += dppf<0x4E>(x);
    x += dppf<0x141>(x);
    return x;
}
__device__ __forceinline__ float red16(float x) {
    x = red8(x);
    x += dppf<0x140>(x);
    return x;
}
__device__ __forceinline__ float red_g(float x) {
    x += __shfl_xor(x, 16);
    x += __shfl_xor(x, 32);
    return x;
}
__device__ __forceinline__ float wave_sum(float x) {
    x = red16(x);
    return red_g(x);
}
__device__ __forceinline__ bf16x8 as_frag(uint4 v) {
    union { uint4 u; bf16x8 f; } c;
    c.u = v;
    return c.f;
}
#define MFMA(a, b, c) __builtin_amdgcn_mfma_f32_16x16x32_bf16((a), (b), (c), 0, 0, 0)

constexpr int LDT = 72;
constexpr int STG = 128 * LDT;
__device__ __forceinline__ void gemm_loop(const u16* __restrict__ A, int lda, const u16* __restrict__ B, int ldb,
                                          int nkt, u16* smem, f32x4 (&acc)[4][4]) {
    const int tid = threadIdx.x, lane = tid & 63, wid = tid >> 6, wm = wid >> 1, wn = wid & 1, l16 = lane & 15, g = lane >> 4;
    const int lr = tid >> 3, lc = (tid & 7) * 8;
    u16* sA = smem;
    u16* sB = smem + 2 * STG;
    const u16* ap = A + (size_t)lr * lda + lc;
    const u16* bp = B + (size_t)lr * ldb + lc;
    uint4 ra0, ra1, ra2, ra3, rb0, rb1, rb2, rb3;
#define G_LOAD(ko)                                                   \
    ra0 = *(const uint4*)(ap + (ko));                                \
    ra1 = *(const uint4*)(ap + (size_t)32 * lda + (ko));             \
    ra2 = *(const uint4*)(ap + (size_t)64 * lda + (ko));             \
    ra3 = *(const uint4*)(ap + (size_t)96 * lda + (ko));             \
    rb0 = *(const uint4*)(bp + (ko));                                \
    rb1 = *(const uint4*)(bp + (size_t)32 * ldb + (ko));             \
    rb2 = *(const uint4*)(bp + (size_t)64 * ldb + (ko));             \
    rb3 = *(const uint4*)(bp + (size_t)96 * ldb + (ko));
#define G_STORE(bo)                                                  \
    *(uint4*)(sA + (bo) + (lr + 0) * LDT + lc) = ra0;                \
    *(uint4*)(sA + (bo) + (lr + 32) * LDT + lc) = ra1;               \
    *(uint4*)(sA + (bo) + (lr + 64) * LDT + lc) = ra2;               \
    *(uint4*)(sA + (bo) + (lr + 96) * LDT + lc) = ra3;               \
    *(uint4*)(sB + (bo) + (lr + 0) * LDT + lc) = rb0;                \
    *(uint4*)(sB + (bo) + (lr + 32) * LDT + lc) = rb1;               \
    *(uint4*)(sB + (bo) + (lr + 64) * LDT + lc) = rb2;               \
    *(uint4*)(sB + (bo) + (lr + 96) * LDT + lc) = rb3;
    G_LOAD(0)
    G_STORE(0)
    __syncthreads();
    for (int kt = 0; kt < nkt; ++kt) {
        const int buf = kt & 1;
        if (kt + 1 < nkt) { G_LOAD((kt + 1) * 64) }
        __builtin_amdgcn_sched_barrier(0);
        const u16* cA = sA + buf * STG + (wm * 64 + l16) * LDT + g * 8;
        const u16* cB = sB + buf * STG + (wn * 64 + l16) * LDT + g * 8;
#pragma unroll
        for (int ks = 0; ks < 2; ++ks) {
            bf16x8 xf[4], wf[4];
#pragma unroll
            for (int i = 0; i < 4; ++i) {
                xf[i] = *(const bf16x8*)(cA + i * 16 * LDT + ks * 32);
                wf[i] = *(const bf16x8*)(cB + i * 16 * LDT + ks * 32);
            }
#pragma unroll
            for (int nt = 0; nt < 4; ++nt)
#pragma unroll
                for (int mt = 0; mt < 4; ++mt) acc[nt][mt] = MFMA(wf[nt], xf[mt], acc[nt][mt]);
        }
        __builtin_amdgcn_sched_barrier(0);
        if (kt + 1 < nkt) { G_STORE((buf ^ 1) * STG) }
        __syncthreads();
    }
}
__device__ __forceinline__ void gemm_loop_xf32(const float* __restrict__ A, const u16* __restrict__ B, int ldb, int nkt, u16* smem,
                                               f32x4 (&acc)[4][4]) {
    const int tid = threadIdx.x, lane = tid & 63, wid = tid >> 6, wm = wid >> 1, wn = wid & 1, l16 = lane & 15, g = lane >> 4;
    const int lr = tid >> 3, lc = (tid & 7) * 8;
    u16* sA = smem;
    u16* sB = smem + 2 * STG;
    const float* ap = A + (size_t)lr * 1024 + lc;
    const u16* bp = B + (size_t)lr * ldb + lc;
    float4 fa0, fa1, fa2, fa3, fa4, fa5, fa6, fa7;
    uint4 rb0, rb1, rb2, rb3;
#define GX_LOAD(ko)                                                  \
    fa0 = *(const float4*)(ap + (ko));                               \
    fa1 = *(const float4*)(ap + (ko) + 4);                           \
    fa2 = *(const float4*)(ap + 32 * 1024 + (ko));                   \
    fa3 = *(const float4*)(ap + 32 * 1024 + (ko) + 4);               \
    fa4 = *(const float4*)(ap + 64 * 1024 + (ko));                   \
    fa5 = *(const float4*)(ap + 64 * 1024 + (ko) + 4);               \
    fa6 = *(const float4*)(ap + 96 * 1024 + (ko));                   \
    fa7 = *(const float4*)(ap + 96 * 1024 + (ko) + 4);               \
    rb0 = *(const uint4*)(bp + (ko));                                \
    rb1 = *(const uint4*)(bp + (size_t)32 * ldb + (ko));             \
    rb2 = *(const uint4*)(bp + (size_t)64 * ldb + (ko));             \
    rb3 = *(const uint4*)(bp + (size_t)96 * ldb + (ko));
#define PKF(a, b) make_uint4(pk2(a.x, a.y), pk2(a.z, a.w), pk2(b.x, b.y), pk2(b.z, b.w))
#define GX_STORE(bo)                                                 \
    *(uint4*)(sA + (bo) + (lr + 0) * LDT + lc) = PKF(fa0, fa1);      \
    *(uint4*)(sA + (bo) + (lr + 32) * LDT + lc) = PKF(fa2, fa3);     \
    *(uint4*)(sA + (bo) + (lr + 64) * LDT + lc) = PKF(fa4, fa5);     \
    *(uint4*)(sA + (bo) + (lr + 96) * LDT + lc) = PKF(fa6, fa7);     \
    *(uint4*)(sB + (bo) + (lr + 0) * LDT + lc) = rb0;                \
    *(uint4*)(sB + (bo) + (lr + 32) * LDT + lc) = rb1;               \
    *(uint4*)(sB + (bo) + (lr + 64) * LDT + lc) = rb2;               \
    *(uint4*)(sB + (bo) + (lr + 96) * LDT + lc) = rb3;
    GX_LOAD(0)
    GX_STORE(0)
    __syncthreads();
    for (int kt = 0; kt < nkt; ++kt) {
        const int buf = kt & 1;
        if (kt + 1 < nkt) { GX_LOAD((kt + 1) * 64) }
        __builtin_amdgcn_sched_barrier(0);
        const u16* cA = sA + buf * STG + (wm * 64 + l16) * LDT + g * 8;
        const u16* cB = sB + buf * STG + (wn * 64 + l16) * LDT + g * 8;
#pragma unroll
        for (int ks = 0; ks < 2; ++ks) {
            bf16x8 xf[4], wf[4];
#pragma unroll
            for (int i = 0; i < 4; ++i) {
                xf[i] = *(const bf16x8*)(cA + i * 16 * LDT + ks * 32);
                wf[i] = *(const bf16x8*)(cB + i * 16 * LDT + ks * 32);
            }
#pragma unroll
            for (int nt = 0; nt < 4; ++nt)
#pragma unroll
                for (int mt = 0; mt < 4; ++mt) acc[nt][mt] = MFMA(wf[nt], xf[mt], acc[nt][mt]);
        }
        __builtin_amdgcn_sched_barrier(0);
        if (kt + 1 < nkt) { GX_STORE((buf ^ 1) * STG) }
        __syncthreads();
    }
}
__device__ __forceinline__ void zero_acc(f32x4 (&acc)[4][4]) {
#pragma unroll
    for (int i = 0; i < 4; ++i)
#pragma unroll
        for (int j = 0; j < 4; ++j) acc[i][j] = (f32x4){0.f, 0.f, 0.f, 0.f};
}
__device__ __forceinline__ void tile_map(int t, int NT, int& mt, int& nt) {
    const int x = t & 7, u = t >> 3;
    const int gsz = 8 * NT;
    const int g = u / gsz;
    const int w = u - g * gsz;
    const int rows = (g < 8) ? 8 : 1;
    const int q = w / rows;
    mt = x * 65 + g * 8 + (w - q * rows);
    nt = q;
}

__device__ __forceinline__ void tr_tile(const float* __restrict__ in, int R, int C, int ldin, u16* __restrict__ out, int ldout,
                        const float* __restrict__ scale, int r0, int c0, int Cout, bool perm, float* tile) {
    const int tid = threadIdx.x;
    {
        const int tx = tid & 63, ty = tid >> 6;
        const int c = c0 + tx;
        for (int rr = ty; rr < 64; rr += 4) {
            const int r = r0 + rr;
            float v = 0.f;
            if (r < R && c < C) {
                v = in[(size_t)r * ldin + c];
                if (scale) v *= scale[r];
            }
            tile[rr * 65 + tx] = v;
        }
    }
    __syncthreads();
    {
        const int rch = (tid & 7) * 8;
#pragma unroll
        for (int pass = 0; pass < 2; ++pass) {
            const int cc = (tid >> 3) + pass * 32;
            const int c = c0 + cc;
            if (c < Cout && r0 + rch < R) {
                float v[8];
#pragma unroll
                for (int k = 0; k < 8; ++k) v[k] = tile[(rch + k) * 65 + cc];
                int orow = c;
                if (perm) {
                    const int type = c >= 2816 ? 1 : 0;
                    const int j = c - type * 2816;
                    orow = (j >> 4) * 32 + type * 16 + (j & 15);
                }
                uint4 o = make_uint4(pk2(v[0], v[1]), pk2(v[2], v[3]), pk2(v[4], v[5]), pk2(v[6], v[7]));
                *(uint4*)(out + (size_t)orow * ldout + r0 + rch) = o;
            }
        }
    }
    __syncthreads();
}

__device__ __forceinline__ void phase0(const Params& p, unsigned char* smem) {
    float* tile = (float*)smem;
    const int tid = threadIdx.x, lane = tid & 63, wid = tid >> 6;
    unsigned char* ws = p.ws;
    const int G = gridDim.x;
    for (int u = blockIdx.x; u < 8136; u += G) {
        const float* in;
        int R, C, Cout, ldout, tl;
        u16* out;
        const float* scale = nullptr;
        bool perm = false;
        if (u < 1376) { tl = u; in = p.w_in; R = 1024; C = 5408; Cout = 5504; out = (u16*)(ws + O_WIN); ldout = 1024; scale = p.n_mix_pre; }
        else if (u < 1504) { tl = u - 1376; in = p.w_out_a; R = 512; C = 1024; Cout = 1024; out = (u16*)(ws + O_WOA); ldout = 512; }
        else if (u < 1632) { tl = u - 1504; in = p.w_out_b; R = 512; C = 1024; Cout = 1024; out = (u16*)(ws + O_WOB); ldout = 512; }
        else if (u < 1888) { tl = u - 1632; in = p.w_o; R = 1024; C = 1024; Cout = 1024; out = (u16*)(ws + O_WO); ldout = 1024; }
        else if (u < 3296) { tl = u - 1888; in = p.w_ffn_in; R = 1024; C = 5632; Cout = 5632; out = (u16*)(ws + O_WFI); ldout = 1024; scale = p.n_ffn_pre; perm = true; }
        else if (u < 4000) { tl = u - 3296; in = p.w_ffn_out; R = 2816; C = 1024; Cout = 1024; out = (u16*)(ws + O_WFO); ldout = 2816; }
        else if (u < 4008) { tl = u - 4000; in = p.w2; R = 64; C = 512; Cout = 512; out = (u16*)(ws + O_W2); ldout = 64; }
        else if (u < 4016) { tl = u - 4008; in = p.a2; R = 64; C = 512; Cout = 512; out = (u16*)(ws + O_A2); ldout = 64; }
        else if (u < 4040) { tl = u - 4016; in = p.g2; R = 160; C = 512; Cout = 512; out = (u16*)(ws + O_G2); ldout = 160; }
        else {
            tl = u - 4040;
            const int b = tl >> 7;
            tl &= 127;
            in = p.cache_v + (size_t)b * 1024 * 512; R = 1024; C = 512; Cout = 512;
            out = (u16*)(ws + O_VTS) + (size_t)b * 512 * LKS; ldout = LKS;
        }
        const int ctiles = (Cout + 63) >> 6;
        const int rt = tl / ctiles, ct = tl - rt * ctiles;
        tr_tile(in, R, C, C, out, ldout, scale, rt * 64, ct * 64, Cout, perm, tile);
    }
    {
        u16* xb = (u16*)(ws + O_XB);
        float* rs1 = (float*)(ws + O_RS1);
        for (int m = blockIdx.x * 4 + wid; m < T; m += G * 4) {
            const float* xr = (m < TP) ? p.x_prompt + (size_t)m * 1024 : p.x_sample + (size_t)(m - TP) * 1024;
            float ss = 0.f;
#pragma unroll
            for (int i = 0; i < 4; ++i) {
                const float4 v = *(const float4*)(xr + i * 256 + lane * 4);
                ss += v.x * v.x + v.y * v.y + v.z * v.z + v.w * v.w;
                *(uint2*)(xb + (size_t)m * 1024 + i * 256 + lane * 4) = pk4(v.x, v.y, v.z, v.w);
            }
            ss = wave_sum(ss);
            if (lane == 0) rs1[m] = rsqrtf(ss * (1.f / 1024.f) + EPS);
        }
    }
    {
        u16* kS = (u16*)(ws + O_KS);
        const int n8 = 32 * 1024 * 64;
        for (int i = blockIdx.x * 256 + tid; i < n8; i += G * 256) {
            const int b = i >> 16, rem = i & 65535, key = rem >> 6, c8 = rem & 63;
            const float4 v0 = *(const float4*)(p.cache_k + (size_t)i * 8);
            const float4 v1 = *(const float4*)(p.cache_k + (size_t)i * 8 + 4);
            *(uint4*)(kS + ((size_t)b * LKS + key) * 512 + c8 * 8) =
                make_uint4(pk2(v0.x, v0.y), pk2(v0.z, v0.w), pk2(v1.x, v1.y), pk2(v1.z, v1.w));
        }
        for (int i = blockIdx.x * 256 + tid; i < 32 * 32 * 64; i += G * 256) {
            const int b = i >> 11, rem = i & 2047, row = rem >> 6, c8 = rem & 63;
            *(uint4*)(kS + ((size_t)b * LKS + 1056 + row) * 512 + c8 * 8) = make_uint4(0, 0, 0, 0);
        }
        u16* vtS = (u16*)(ws + O_VTS);
        for (int i = blockIdx.x * 256 + tid; i < 32 * 512 * 4; i += G * 256) {
            const int row = i >> 2, c8 = i & 3;
            *(uint4*)(vtS + (size_t)row * LKS + 1056 + c8 * 8) = make_uint4(0, 0, 0, 0);
        }
    }
    {
        u16* cA = (u16*)(ws + O_CA);
        for (int i = blockIdx.x * 256 + tid; i < 48 * ACOLS; i += G * 256) {
            const int s = i / ACOLS, c = i - s * ACOLS;
            float v = 0.f;
            size_t row;
            if (s < 16) row = (size_t)s * 4097;
            else { row = (size_t)16 * 4097 + (size_t)(s - 16) * 33; v = p.state_shift[(size_t)(s - 16) * ACOLS + c]; }
            cA[row * ACOLS + c] = f2bf(v);
        }
        if (blockIdx.x == 0 && tid == 0) {
            float d1 = 0.f, d2 = 0.f;
            for (int i = 0; i < 64; ++i) { d1 += p.lq1[i] * p.lk1[i]; d2 += p.lq2[i] * p.lk2[i]; }
            float* sc = (float*)(ws + O_SCAL);
            sc[0] = __expf(d1) - __expf(d2) + 0.2f;
            for (int i = 1; i < 32; ++i) ((unsigned*)sc)[i] = 0u;
        }
    }
}

__device__ __forceinline__ void phase1(const Params& p, unsigned char* smem) {
    unsigned char* ws = p.ws;
    const u16* xb = (const u16*)(ws + O_XB);
    const u16* W = (const u16*)(ws + O_WIN);
    const float* rs1 = (const float*)(ws + O_RS1);
    u16* cA = (u16*)(ws + O_CA);
    u16* qb = (u16*)(ws + O_QB);
    u16* kP = (u16*)(ws + O_KP);
    u16* kS = (u16*)(ws + O_KS);
    u16* vtP = (u16*)(ws + O_VTP);
    u16* vtS = (u16*)(ws + O_VTS);
    float* out = p.out;
    const int tid = threadIdx.x, lane = tid & 63, wid = tid >> 6, wm = wid >> 1, wn = wid & 1, l16 = lane & 15, g = lane >> 4;
    constexpr int NT = 43;
    u16* gate = (u16*)p.out;
    for (int t = blockIdx.x; t < 520 * NT; t += gridDim.x) {
        int mtile, ntile;
        tile_map(t, NT, mtile, ntile);
        const int m0 = mtile * 128, n0 = ntile * 128;
        f32x4 acc[4][4];
        zero_acc(acc);
        gemm_loop(xb + (size_t)m0 * 1024, 1024, W + (size_t)n0 * 1024, 1024, 16, (u16*)smem, acc);
#pragma unroll
        for (int mt = 0; mt < 4; ++mt) {
            const int m = m0 + wm * 64 + mt * 16 + l16;
            const float rs = rs1[m];
            const bool isP = m < TP;
            int seq, tt;
            if (isP) { seq = m >> 12; tt = m & 4095; }
            else { const int ms = m - TP; seq = 16 + (ms >> 5); tt = ms & 31; }
            const size_t carow = (size_t)m + seq + 1;
            const bool last = isP ? (tt == 4095) : (tt == 31);
#pragma unroll
            for (int nt = 0; nt < 4; ++nt) {
                const int n = n0 + wn * 64 + nt * 16 + g * 4;
                if (n >= 5408) continue;
                f32x4 v = acc[nt][mt];
                v[0] *= rs; v[1] *= rs; v[2] *= rs; v[3] *= rs;
                if (n < 1824) {
                    *(uint2*)(cA + carow * ACOLS + n) = pk4(v[0], v[1], v[2], v[3]);
                    if (last) {
                        float* so = isP ? out + OFF_SHP + (size_t)seq * ACOLS + n : out + OFF_SHS + (size_t)(seq - 16) * ACOLS + n;
                        *(float4*)so = make_float4(v[0], v[1], v[2], v[3]);
                    }
                } else if (n < 2336) {
                    *(uint2*)(qb + (size_t)m * 512 + (n - 1824)) = pk4(v[0], v[1], v[2], v[3]);
                } else if (n < 2848) {
                    const int c = n - 2336;
                    if (isP) {
                        *(uint2*)(kP + (size_t)m * 512 + c) = pk4(v[0], v[1], v[2], v[3]);
                        *(float4*)(out + OFF_KP + (size_t)m * 512 + c) = make_float4(v[0], v[1], v[2], v[3]);
                    } else {
                        *(uint2*)(kS + ((size_t)(seq - 16) * LKS + 1024 + tt) * 512 + c) = pk4(v[0], v[1], v[2], v[3]);
                        *(float4*)(out + OFF_KS + (size_t)(m - TP) * 512 + c) = make_float4(v[0], v[1], v[2], v[3]);
                    }
                } else if (n < 3360) {
                    const int c = n - 2848;
                    if (isP) {
                        *(float4*)(out + OFF_VP + (size_t)m * 512 + c) = make_float4(v[0], v[1], v[2], v[3]);
                        u16* d = vtP + ((size_t)seq * 512 + c) * 4096 + tt;
                        d[0] = f2bf(v[0]); d[4096] = f2bf(v[1]); d[2 * 4096] = f2bf(v[2]); d[3 * 4096] = f2bf(v[3]);
                    } else {
                        *(float4*)(out + OFF_VS + (size_t)(m - TP) * 512 + c) = make_float4(v[0], v[1], v[2], v[3]);
                        u16* d = vtS + ((size_t)(seq - 16) * 512 + c) * LKS + 1024 + tt;
                        d[0] = f2bf(v[0]); d[LKS] = f2bf(v[1]); d[2 * LKS] = f2bf(v[2]); d[3 * LKS] = f2bf(v[3]);
                    }
                } else {
                    const int c = n - 3360;
                    const float4 bg = *(const float4*)(p.b_gate + c);
                    *(uint2*)(gate + (size_t)m * 2048 + c) =
                        pk4(sigmoidf_(v[0] + bg.x), sigmoidf_(v[1] + bg.y), sigmoidf_(v[2] + bg.z), sigmoidf_(v[3] + bg.w));
                }
            }
        }
    }
}

__device__ __forceinline__ void lerp8(const u16* cur, const u16* prv, const float* mu, int col, float (&xs)[8]) {
    const uint4 cu = *(const uint4*)(cur + col);
    const uint4 pv = *(const uint4*)(prv + col);
    const float4 m0 = *(const float4*)(mu + col);
    const float4 m1 = *(const float4*)(mu + col + 4);
    const unsigned cw[4] = {cu.x, cu.y, cu.z, cu.w}, pw[4] = {pv.x, pv.y, pv.z, pv.w};
    const float mm[8] = {m0.x, m0.y, m0.z, m0.w, m1.x, m1.y, m1.z, m1.w};
#pragma unroll
    for (int i = 0; i < 4; ++i) {
        const float c0 = bflo(cw[i]), c1 = bfhi(cw[i]), p0 = bflo(pw[i]), p1 = bfhi(pw[i]);
        xs[2 * i] = c0 + (p0 - c0) * mm[2 * i];
        xs[2 * i + 1] = c1 + (p1 - c1) * mm[2 * i + 1];
    }
}
__device__ __forceinline__ void lerp4(const u16* cur, const u16* prv, const float* mu, int col, float (&xs)[4]) {
    const uint2 cu = *(const uint2*)(cur + col);
    const uint2 pv = *(const uint2*)(prv + col);
    const float4 m0 = *(const float4*)(mu + col);
    float c0 = bflo(cu.x), c1 = bfhi(cu.x), c2 = bflo(cu.y), c3 = bfhi(cu.y);
    xs[0] = c0 + (bflo(pv.x) - c0) * m0.x;
    xs[1] = c1 + (bfhi(pv.x) - c1) * m0.y;
    xs[2] = c2 + (bflo(pv.y) - c2) * m0.z;
    xs[3] = c3 + (bfhi(pv.y) - c3) * m0.w;
}
__device__ __forceinline__ void lerp4w(const uint2 cu, const uint2 pv, const float* mu, int col, float (&xs)[4]) {
    const float4 m0 = *(const float4*)(mu + col);
    const float c0 = bflo(cu.x), c1 = bfhi(cu.x), c2 = bflo(cu.y), c3 = bfhi(cu.y);
    xs[0] = c0 + (bflo(pv.x) - c0) * m0.x;
    xs[1] = c1 + (bfhi(pv.x) - c1) * m0.y;
    xs[2] = c2 + (bflo(pv.y) - c2) * m0.z;
    xs[3] = c3 + (bfhi(pv.y) - c3) * m0.w;
}
__device__ __forceinline__ bf16x8 packfrag(const float (&v)[8]) {
    return as_frag(make_uint4(pk2(v[0], v[1]), pk2(v[2], v[3]), pk2(v[4], v[5]), pk2(v[6], v[7])));
}

__device__ __forceinline__ void phase2(const Params& p, unsigned char* smem) {
    unsigned char* ws = p.ws;
    const u16* cA = (const u16*)(ws + O_CA);
    const u16* w2t = (const u16*)(ws + O_W2);
    const u16* a2t = (const u16*)(ws + O_A2);
    const u16* g2t = (const u16*)(ws + O_G2);
    u16* SI = (u16*)(ws + O_SI);
    u16* Gb = (u16*)(ws + O_G);
    float4* rk4 = (float4*)(ws + O_RK);
    const int tid = threadIdx.x, lane = tid & 63, wid = tid >> 6, l16 = lane & 15, g = lane >> 4;
    float* sp = (float*)smem;
    for (int i = tid; i < 1824; i += 256) sp[i] = p.mu[i];
    for (int i = tid; i < 512; i += 256) {
        sp[1824 + i] = p.w0[i]; sp[2336 + i] = p.a0[i]; sp[2848 + i] = p.k_k[i]; sp[3360 + i] = p.k_a[i]; sp[3872 + i] = p.r_k[i];
    }
    __syncthreads();
    const int NU = (T / 64) / (int)gridDim.x * (int)gridDim.x;
    const int NW = NU + (T / 64 - NU) * 8;
    for (int uu = blockIdx.x; uu < NW; uu += gridDim.x) {
        int u, h_lo, h_hi;
        if (uu < NU) { u = uu; h_lo = 0; h_hi = 8; }
        else { const int v = uu - NU; u = NU + (v >> 3); h_lo = v & 7; h_hi = h_lo + 1; }
        const int mw = u * 64 + wid * 16;
        const int m = mw + l16;
        const bool isP = mw < TP;
        int seq, tt;
        if (isP) { seq = m >> 12; tt = m & 4095; }
        else { const int ms = m - TP; seq = 16 + (ms >> 5); tt = ms & 31; }
        const u16* cur = cA + ((size_t)m + seq + 1) * ACOLS;
        const u16* prv = cur - ACOLS;
        bf16x8 xw[2], xa[2], xg[5];
#pragma unroll
        for (int s = 0; s < 9; ++s) {
            float xs[8];
            lerp8(cur, prv, sp, 1536 + s * 32 + g * 8, xs);
            if (s < 2) {
#pragma unroll
                for (int i = 0; i < 8; ++i) xs[i] = 1.f - 2.f / (__expf(2.f * xs[i]) + 1.f);
                xw[s] = packfrag(xs);
            } else if (s < 4) {
                xa[s - 2] = packfrag(xs);
            } else {
#pragma unroll
                for (int i = 0; i < 8; ++i) xs[i] = sigmoidf_(xs[i]);
                xg[s - 4] = packfrag(xs);
            }
        }
        bf16x8 nw0, nw1, na0, na1;
        uint2 ncr, npr, nck, npk, ncv, npv;
#define P2_FETCH(hh, ntt)                                                          \
        {                                                                          \
            const int wr_ = (hh) * 64 + (ntt) * 16 + l16;                          \
            nw0 = *(const bf16x8*)(w2t + wr_ * 64 + g * 8);                        \
            nw1 = *(const bf16x8*)(w2t + wr_ * 64 + 32 + g * 8);                   \
            na0 = *(const bf16x8*)(a2t + wr_ * 64 + g * 8);                        \
            na1 = *(const bf16x8*)(a2t + wr_ * 64 + 32 + g * 8);                   \
            const int ch_ = (hh) * 64 + (ntt) * 16 + g * 4;                        \
            ncr = *(const uint2*)(cur + ch_);        npr = *(const uint2*)(prv + ch_);        \
            nck = *(const uint2*)(cur + 512 + ch_);  npk = *(const uint2*)(prv + 512 + ch_);  \
            ncv = *(const uint2*)(cur + 1024 + ch_); npv = *(const uint2*)(prv + 1024 + ch_); \
        }
        P2_FETCH(h_lo, 0)
        for (int h = h_lo; h < h_hi; ++h) {
            float kkr[16], av[16];
            float ssq = 0.f, rkacc = 0.f, bracc = 0.f, kracc = 0.f;
            const size_t sirow = isP ? ((size_t)(seq * 8 + h) * 4096 + tt) : ((size_t)128 * 4096 + (size_t)((seq - 16) * 8 + h) * 32 + tt);
            u16* sib = SI + sirow * 384;
#pragma unroll
            for (int nt = 0; nt < 4; ++nt) {
                const bf16x8 cw0 = nw0, cw1 = nw1, ca0 = na0, ca1 = na1;
                const uint2 ccr = ncr, cpr = npr, cck = nck, cpk = npk, ccv = ncv, cpv = npv;
                if (nt < 3) { P2_FETCH(h, nt + 1) } else if (h + 1 < h_hi) { P2_FETCH(h + 1, 0) }
                const u16* gw_ = g2t + (h * 64 + nt * 16 + l16) * 160 + g * 8;
                const bf16x8 cg0 = *(const bf16x8*)(gw_), cg1 = *(const bf16x8*)(gw_ + 32), cg2 = *(const bf16x8*)(gw_ + 64),
                             cg3 = *(const bf16x8*)(gw_ + 96), cg4 = *(const bf16x8*)(gw_ + 128);
                __builtin_amdgcn_sched_barrier(0);
                f32x4 accw = {0.f, 0.f, 0.f, 0.f}, acca = accw;
                accw = MFMA(cw0, xw[0], accw); accw = MFMA(cw1, xw[1], accw);
                acca = MFMA(ca0, xa[0], acca); acca = MFMA(ca1, xa[1], acca);
                const int ch = h * 64 + nt * 16 + g * 4;
                float xr[4], xk[4], xv[4];
                lerp4w(ccr, cpr, sp, ch, xr);
                lerp4w(cck, cpk, sp, 512 + ch, xk);
                lerp4w(ccv, cpv, sp, 1024 + ch, xv);
                const float4 w0 = *(const float4*)(sp + 1824 + ch), a0 = *(const float4*)(sp + 2336 + ch), kk4 = *(const float4*)(sp + 2848 + ch),
                             ka4 = *(const float4*)(sp + 3360 + ch), rk4 = *(const float4*)(sp + 3872 + ch);
                const float w0a[4] = {w0.x, w0.y, w0.z, w0.w}, a0a[4] = {a0.x, a0.y, a0.z, a0.w}, kka[4] = {kk4.x, kk4.y, kk4.z, kk4.w},
                            kaa[4] = {ka4.x, ka4.y, ka4.z, ka4.w}, rka[4] = {rk4.x, rk4.y, rk4.z, rk4.w};
                float ev[4], kp[4], dr[4];
#pragma unroll
                for (int r = 0; r < 4; ++r) {
                    const float z = -(w0a[r] + accw[r]);
                    const float sp = (z > 20.f) ? z : __logf(1.f + __expf(z));
                    ev[r] = __expf(-sp - 0.5f);
                    const float a = sigmoidf_(a0a[r] + acca[r]);
                    const float kraw = xk[r] * kka[r];
                    ssq += kraw * kraw;
                    kp[r] = xk[r] * (1.f + (a - 1.f) * kaa[r]);
                    rkacc += xr[r] * kp[r] * rka[r];
                    kracc += xr[r] * kp[r];
                    bracc += kraw * a * xr[r];
                    dr[r] = xr[r] * __expf(-ev[r]);
                    kkr[nt * 4 + r] = kraw;
                    av[nt * 4 + r] = a;
                }
                const int co = nt * 16 + g * 4;
                *(uint2*)(sib + 0 * 64 + co) = pk4(dr[0], dr[1], dr[2], dr[3]);
                *(uint2*)(sib + 1 * 64 + co) = pk4(ev[0], ev[1], ev[2], ev[3]);
                *(uint2*)(sib + 2 * 64 + co) = pk4(kp[0], kp[1], kp[2], kp[3]);
                *(uint2*)(sib + 3 * 64 + co) = pk4(xv[0], xv[1], xv[2], xv[3]);
                f32x4 accg = {0.f, 0.f, 0.f, 0.f};
                accg = MFMA(cg0, xg[0], accg); accg = MFMA(cg1, xg[1], accg); accg = MFMA(cg2, xg[2], accg);
                accg = MFMA(cg3, xg[3], accg); accg = MFMA(cg4, xg[4], accg);
                *(uint2*)(Gb + (size_t)m * 512 + ch) = pk4(accg[0], accg[1], accg[2], accg[3]);
            }
            ssq = red_g(ssq);
            rkacc = red_g(rkacc);
            bracc = red_g(bracc);
            kracc = red_g(kracc);
            const float inv = rsqrtf(fmaxf(ssq, 1e-24f));
#pragma unroll
            for (int nt = 0; nt < 4; ++nt) {
                const int co = nt * 16 + g * 4;
                float k0 = kkr[nt * 4 + 0] * inv, k1 = kkr[nt * 4 + 1] * inv, k2 = kkr[nt * 4 + 2] * inv, k3 = kkr[nt * 4 + 3] * inv;
                *(uint2*)(sib + 4 * 64 + co) = pk4(k0, k1, k2, k3);
                *(uint2*)(sib + 5 * 64 + co) = pk4(k0 * av[nt * 4 + 0], k1 * av[nt * 4 + 1], k2 * av[nt * 4 + 2], k3 * av[nt * 4 + 3]);
            }
            if (g == 0) rk4[(size_t)m * 8 + h] = make_float4(rkacc, bracc * inv, kracc, 0.f);
        }
    }
}

typedef float v2f __attribute__((ext_vector_type(2)));
__device__ __forceinline__ void scan_item(const Params& p, const u16* __restrict__ si, int nch, const float* __restrict__ s0, float* __restrict__ sout,
                          int m0, int h, int half, unsigned char* smem) {
    float* inb = (float*)smem;
    float* ybuf = (float*)(smem + 49152);
    float* scal = (float*)(smem + 53248);
    unsigned char* ws = p.ws;
    const float4* rk4 = (const float4*)(ws + O_RK);
    u16* yraw = (u16*)(ws + O_YRAW);
    const int tid = threadIdx.x;
    const int vp = tid >> 3, kq = tid & 7;
    const int row = half * 32 + vp;
    v2f S[4];
    if (s0) {
        const float4 a = *(const float4*)(s0 + row * 64 + kq * 8), b = *(const float4*)(s0 + row * 64 + kq * 8 + 4);
        S[0] = (v2f){a.x, a.y}; S[1] = (v2f){a.z, a.w}; S[2] = (v2f){b.x, b.y}; S[3] = (v2f){b.z, b.w};
    } else {
#pragma unroll
        for (int j = 0; j < 4; ++j) S[j] = (v2f){0.f, 0.f};
    }
    uint4 st0, st1, st2;
    float4 sq = make_float4(0.f, 0.f, 0.f, 0.f);
    st0 = *(const uint4*)(si + (0 * 256 + tid) * 8);
    st1 = *(const uint4*)(si + (1 * 256 + tid) * 8);
    st2 = *(const uint4*)(si + (2 * 256 + tid) * 8);
    if (tid < 16) sq = rk4[(m0 + tid) * 8 + h];
#define S_WRITE1(sv, i, buf)                                                                                          \
    {                                                                                                                 \
        const int idx = (i) * 256 + tid;                                                                              \
        const int vec = (idx % 48) >> 3;                                                                              \
        float v[8] = {bflo(sv.x), bfhi(sv.x), bflo(sv.y), bfhi(sv.y), bflo(sv.z), bfhi(sv.z), bflo(sv.w), bfhi(sv.w)}; \
        if (vec == 1) {                                                                                               \
            _Pragma("unroll") for (int k = 0; k < 8; ++k) v[k] = __expf(-v[k]);                                       \
        }                                                                                                             \
        float* d = inb + (buf) * 6144 + idx * 8;                                                                      \
        *(float4*)d = make_float4(v[0], v[1], v[2], v[3]);                                                            \
        *(float4*)(d + 4) = make_float4(v[4], v[5], v[6], v[7]);                                                      \
    }
#define stage_write(buf) S_WRITE1(st0, 0, buf) S_WRITE1(st1, 1, buf) S_WRITE1(st2, 2, buf) if (tid < 16) *(float4*)(scal + (buf) * 64 + tid * 4) = sq;
    stage_write(0)
    __syncthreads();
    for (int c = 0; c < nch; ++c) {
        const int buf = c & 1;
        if (c + 1 < nch) {
            const u16* sn = si + (c + 1) * 6144 + tid * 8;
            st0 = *(const uint4*)(sn);
            st1 = *(const uint4*)(sn + 2048);
            st2 = *(const uint4*)(sn + 4096);
            if (tid < 16) sq = rk4[(m0 + (c + 1) * 16 + tid) * 8 + h];
        }
        const float* cb = inb + buf * 6144;
        const float* cs = scal + buf * 64;
#pragma unroll 2
        for (int tt = 0; tt < 16; ++tt) {
            const float* base = cb + tt * 384;
            v2f kk[4], dr[4], dd[4], bb[4], kv[4];
#define LD8(dst, off)                                                      \
    {                                                                      \
        const float4 q0 = *(const float4*)(base + (off) + kq * 8);         \
        const float4 q1 = *(const float4*)(base + (off) + kq * 8 + 4);     \
        dst[0] = (v2f){q0.x, q0.y}; dst[1] = (v2f){q0.z, q0.w};            \
        dst[2] = (v2f){q1.x, q1.y}; dst[3] = (v2f){q1.z, q1.w};            \
    }
            LD8(kk, 256) LD8(dr, 0) LD8(dd, 64) LD8(bb, 320) LD8(kv, 128)
            const float vv = base[192 + row];
            const float2 brkr = *(const float2*)(cs + tt * 4 + 1);
            v2f a0 = S[0] * kk[0], a1 = S[1] * kk[1], q0 = S[0] * dr[0], q1 = S[1] * dr[1];
            a0 = __builtin_elementwise_fma(S[2], kk[2], a0);
            a1 = __builtin_elementwise_fma(S[3], kk[3], a1);
            q0 = __builtin_elementwise_fma(S[2], dr[2], q0);
            q1 = __builtin_elementwise_fma(S[3], dr[3], q1);
            a0 += a1;
            q0 += q1;
            const float sa = -red8(a0.x + a0.y);
            const float pp = red8(q0.x + q0.y);
            const float y = pp + sa * brkr.x + vv * brkr.y;
            if (kq == 0) ybuf[tt * 32 + vp] = y;
            const v2f sav = (v2f){sa, sa}, vvv = (v2f){vv, vv};
#pragma unroll
            for (int j = 0; j < 4; ++j) S[j] = __builtin_elementwise_fma(S[j], dd[j], __builtin_elementwise_fma(vvv, kv[j], sav * bb[j]));
        }
        __syncthreads();
        {
            const int tt = tid >> 4, e2 = (tid & 15) * 2;
            const float2 y2 = *(const float2*)(ybuf + tt * 32 + e2);
            *(unsigned*)(yraw + (m0 + c * 16 + tt) * 512 + h * 64 + half * 32 + e2) = pk2(y2.x, y2.y);
        }
        if (c + 1 < nch) { stage_write(buf ^ 1) }
        __syncthreads();
    }
    {
        float* d0 = sout + row * 64 + kq * 8;
        *(float4*)d0 = make_float4(S[0].x, S[0].y, S[1].x, S[1].y);
        *(float4*)(d0 + 4) = make_float4(S[2].x, S[2].y, S[3].x, S[3].y);
    }
}

__device__ __forceinline__ void ln_pass(const Params& p) {
    unsigned char* ws = p.ws;
    const u16* yraw = (const u16*)(ws + O_YRAW);
    const u16* Gb = (const u16*)(ws + O_G);
    const u16* SI = (const u16*)(ws + O_SI);
    const float4* rk4 = (const float4*)(ws + O_RK);
    u16* ya = (u16*)(ws + O_YA);
    const int tid = threadIdx.x, cq = (tid & 15) * 4;
    for (int q0 = blockIdx.x * 16; q0 < T * 8; q0 += gridDim.x * 16) {
        const int q = q0 + (tid >> 4);
        const int m = q >> 3, h = q & 7;
        const int e = m * 512 + h * 64 + cq;
        const uint2 yv = *(const uint2*)(yraw + e);
        const float y0 = bflo(yv.x), y1 = bfhi(yv.x), y2 = bflo(yv.y), y3 = bfhi(yv.y);
        const float mean = red16(y0 + y1 + y2 + y3) * (1.f / 64.f);
        const float d0 = y0 - mean, d1 = y1 - mean, d2 = y2 - mean, d3 = y3 - mean;
        const float var = red16(d0 * d0 + d1 * d1 + d2 * d2 + d3 * d3) * (1.f / 64.f);
        const float rstd = rsqrtf(var + 64e-5f);
        const float rkv = rk4[q].x;
        int sirow;
        if (m < TP) sirow = ((m >> 12) * 8 + h) * 4096 + (m & 4095);
        else { const int ms = m - TP; sirow = 128 * 4096 + ((ms >> 5) * 8 + h) * 32 + (ms & 31); }
        const uint2 vq = *(const uint2*)(SI + (size_t)sirow * 384 + 192 + cq);
        const uint2 gg = *(const uint2*)(Gb + e);
        const float4 lw = *(const float4*)(p.ln_w + h * 64 + cq), lb = *(const float4*)(p.ln_b + h * 64 + cq);
        const float o0 = (d0 * rstd * lw.x + lb.x + rkv * bflo(vq.x)) * bflo(gg.x);
        const float o1 = (d1 * rstd * lw.y + lb.y + rkv * bfhi(vq.x)) * bfhi(gg.x);
        const float o2 = (d2 * rstd * lw.z + lb.z + rkv * bflo(vq.y)) * bflo(gg.y);
        const float o3 = (d3 * rstd * lw.w + lb.w + rkv * bfhi(vq.y)) * bfhi(gg.y);
        *(uint2*)(ya + e) = pk4(o0, o1, o2, o3);
    }
}

constexpr int KLD = 136, VLD = 72;
__device__ __forceinline__ void attn_item(const u16* __restrict__ Q, int nq, const u16* __restrict__ K, const u16* __restrict__ Vt, int ldv, int nkt,
                          int lastvalid, u16* __restrict__ O, float lam, const float* __restrict__ subln, unsigned char* smem) {
    u16* sK = (u16*)smem;
    u16* sV = (u16*)(smem + 2 * 64 * KLD * 2);
    float* ex = (float*)smem;
    const int tid = threadIdx.x, lane = tid & 63, wid = tid >> 6, l16 = lane & 15, g = lane >> 4;
    const int n = wid >> 1, qh = wid & 1;
    const bool active = (qh * 32) < nq;
    bf16x8 qf[2][2];
#pragma unroll
    for (int qt = 0; qt < 2; ++qt)
#pragma unroll
        for (int s = 0; s < 2; ++s) {
            const int row = qh * 32 + qt * 16 + l16;
            uint4 v = make_uint4(0, 0, 0, 0);
            if (row < nq) v = *(const uint4*)(Q + (row * 512 + n * 64 + s * 32 + g * 8));
            qf[qt][s] = as_frag(v);
        }
    f32x4 o[2][8];
#pragma unroll
    for (int qt = 0; qt < 2; ++qt)
#pragma unroll
        for (int et = 0; et < 8; ++et) o[qt][et] = (f32x4){0.f, 0.f, 0.f, 0.f};
    float mrow[2] = {-1e30f, -1e30f}, lrow[2] = {0.f, 0.f};
    uint4 kr0, kr1, kr2, kr3, vr0, vr1, vr2, vr3;
    const int krow = tid >> 4, kch = (tid & 15) * 8;
    const int vrow = tid >> 3, vch = (tid & 7) * 8;
    const int ko_ = krow * 512 + kch;
    const int vo_ = vrow * ldv + vch;
#define A_LOAD(key0)                                                      \
    kr0 = *(const uint4*)(K + (ko_ + ((key0) + 0) * 512));                \
    kr1 = *(const uint4*)(K + (ko_ + ((key0) + 16) * 512));               \
    kr2 = *(const uint4*)(K + (ko_ + ((key0) + 32) * 512));               \
    kr3 = *(const uint4*)(K + (ko_ + ((key0) + 48) * 512));               \
    vr0 = *(const uint4*)(Vt + (vo_ + (key0)));                           \
    vr1 = *(const uint4*)(Vt + (vo_ + 32 * ldv + (key0)));                \
    vr2 = *(const uint4*)(Vt + (vo_ + 64 * ldv + (key0)));                \
    vr3 = *(const uint4*)(Vt + (vo_ + 96 * ldv + (key0)));
#define A_STORE(nb)                                                       \
    *(uint4*)(sK + (nb) * 64 * KLD + (krow + 0) * KLD + kch) = kr0;       \
    *(uint4*)(sK + (nb) * 64 * KLD + (krow + 16) * KLD + kch) = kr1;      \
    *(uint4*)(sK + (nb) * 64 * KLD + (krow + 32) * KLD + kch) = kr2;      \
    *(uint4*)(sK + (nb) * 64 * KLD + (krow + 48) * KLD + kch) = kr3;      \
    *(uint4*)(sV + (nb) * 128 * VLD + (vrow + 0) * VLD + vch) = vr0;      \
    *(uint4*)(sV + (nb) * 128 * VLD + (vrow + 32) * VLD + vch) = vr1;     \
    *(uint4*)(sV + (nb) * 128 * VLD + (vrow + 64) * VLD + vch) = vr2;     \
    *(uint4*)(sV + (nb) * 128 * VLD + (vrow + 96) * VLD + vch) = vr3;
    A_LOAD(0)
    A_STORE(0)
    __syncthreads();
    constexpr float SC = 0.125f * 1.4426950408889634f;
    for (int kt = 0; kt < nkt; ++kt) {
        const int buf = kt & 1;
        if (kt + 1 < nkt) { A_LOAD((kt + 1) * 64) }
        __builtin_amdgcn_sched_barrier(0);
        if (active) {
            const int valid = (kt == nkt - 1) ? lastvalid : 64;
            const u16* cK = sK + buf * 64 * KLD + l16 * KLD + n * 64 + g * 8;
            const u16* cV = sV + buf * 128 * VLD + l16 * VLD + g * 4;
            f32x4 s[4][2];
#pragma unroll
            for (int k16 = 0; k16 < 4; ++k16) {
                const bf16x8 kf0 = *(const bf16x8*)(cK + k16 * 16 * KLD);
                const bf16x8 kf1 = *(const bf16x8*)(cK + k16 * 16 * KLD + 32);
#pragma unroll
                for (int qt = 0; qt < 2; ++qt) {
                    f32x4 z = {0.f, 0.f, 0.f, 0.f};
                    z = MFMA(kf0, qf[qt][0], z);
                    s[k16][qt] = MFMA(kf1, qf[qt][1], z);
                }
            }
            bf16x8 pf[2][2];
#pragma unroll
            for (int qt = 0; qt < 2; ++qt) {
                float mx = -1e30f;
#pragma unroll
                for (int k16 = 0; k16 < 4; ++k16)
#pragma unroll
                    for (int r = 0; r < 4; ++r) {
                        float v = s[k16][qt][r] * SC;
                        if (k16 * 16 >= valid) v = -1e30f;
                        s[k16][qt][r] = v;
                        mx = fmaxf(mx, v);
                    }
                mx = fmaxf(mx, __shfl_xor(mx, 16));
                mx = fmaxf(mx, __shfl_xor(mx, 32));
                const float mnew = fmaxf(mrow[qt], mx);
                const float alpha = exp2f(mrow[qt] - mnew);
                mrow[qt] = mnew;
                float psum = 0.f;
#pragma unroll
                for (int k16 = 0; k16 < 4; ++k16)
#pragma unroll
                    for (int r = 0; r < 4; ++r) {
                        const float pv = exp2f(s[k16][qt][r] - mnew);
                        s[k16][qt][r] = pv;
                        psum += pv;
                    }
                lrow[qt] = lrow[qt] * alpha + psum;
#pragma unroll
                for (int et = 0; et < 8; ++et) {
                    o[qt][et][0] *= alpha; o[qt][et][1] *= alpha; o[qt][et][2] *= alpha; o[qt][et][3] *= alpha;
                }
#pragma unroll
                for (int kb = 0; kb < 2; ++kb)
                    pf[qt][kb] = as_frag(make_uint4(pk2(s[2 * kb][qt][0], s[2 * kb][qt][1]), pk2(s[2 * kb][qt][2], s[2 * kb][qt][3]),
                                                    pk2(s[2 * kb + 1][qt][0], s[2 * kb + 1][qt][1]), pk2(s[2 * kb + 1][qt][2], s[2 * kb + 1][qt][3])));
            }
#pragma unroll
            for (int et = 0; et < 8; ++et)
#pragma unroll
                for (int kb = 0; kb < 2; ++kb) {
                    const uint2 lo = *(const uint2*)(cV + et * 16 * VLD + kb * 32);
                    const uint2 hi = *(const uint2*)(cV + et * 16 * VLD + kb * 32 + 16);
                    const bf16x8 vf = as_frag(make_uint4(lo.x, lo.y, hi.x, hi.y));
#pragma unroll
                    for (int qt = 0; qt < 2; ++qt) o[qt][et] = MFMA(vf, pf[qt][kb], o[qt][et]);
                }
        }
        __builtin_amdgcn_sched_barrier(0);
        if (kt + 1 < nkt) { A_STORE(buf ^ 1) }
        __syncthreads();
    }
    float inv[2];
#pragma unroll
    for (int qt = 0; qt < 2; ++qt) {
        const float l = red_g(lrow[qt]);
        inv[qt] = 1.f / fmaxf(l, 1e-30f);
    }
    if (active && n == 1) {
#pragma unroll
        for (int qt = 0; qt < 2; ++qt)
#pragma unroll
            for (int et = 0; et < 8; ++et) {
                const f32x4 v = o[qt][et];
                *(float4*)(ex + (qh * 32 + qt * 16 + l16) * 132 + et * 16 + g * 4) =
                    make_float4(v[0] * inv[qt], v[1] * inv[qt], v[2] * inv[qt], v[3] * inv[qt]);
            }
    }
    __syncthreads();
    if (active && n == 0) {
#pragma unroll
        for (int qt = 0; qt < 2; ++qt) {
            const int row = qh * 32 + qt * 16 + l16;
            float ss = 0.f;
#pragma unroll
            for (int et = 0; et < 8; ++et) {
                const float4 o2 = *(const float4*)(ex + row * 132 + et * 16 + g * 4);
                f32x4 v = o[qt][et];
                v[0] = v[0] * inv[qt] - lam * o2.x;
                v[1] = v[1] * inv[qt] - lam * o2.y;
                v[2] = v[2] * inv[qt] - lam * o2.z;
                v[3] = v[3] * inv[qt] - lam * o2.w;
                o[qt][et] = v;
                ss += v[0] * v[0] + v[1] * v[1] + v[2] * v[2] + v[3] * v[3];
            }
            ss = red_g(ss);
            const float rn = rsqrtf(ss * (1.f / 128.f) + EPS) * 0.8f;
            if (row < nq) {
#pragma unroll
                for (int et = 0; et < 8; ++et) {
                    const float4 sl = *(const float4*)(subln + et * 16 + g * 4);
                    const f32x4 v = o[qt][et];
                    *(uint2*)(O + (row * 512 + et * 16 + g * 4)) = pk4(v[0] * rn * sl.x, v[1] * rn * sl.y, v[2] * rn * sl.z, v[3] * rn * sl.w);
                }
            }
        }
    }
    __syncthreads();
}

__device__ __forceinline__ void phase3(const Params& p, unsigned char* smem) {
    unsigned char* ws = p.ws;
    int* s_item = (int*)(smem + LDS_BYTES - 16);
    unsigned* ctr = (unsigned*)(ws + O_SCAL) + 1;
    const float lam = ((const float*)(ws + O_SCAL))[0];
    const u16* SI = (const u16*)(ws + O_SI);
    const u16* qb = (const u16*)(ws + O_QB);
    const u16* kP = (const u16*)(ws + O_KP);
    const u16* kS = (const u16*)(ws + O_KS);
    const u16* vtP = (const u16*)(ws + O_VTP);
    const u16* vtS = (const u16*)(ws + O_VTS);
    u16* ob = (u16*)(ws + O_OB);
    int stage = 0, sidx = blockIdx.x;
    constexpr int SCAN_BASE = 100000, DONE = 1 << 30;
    for (;;) {
        if (threadIdx.x == 0) {
            int it;
            if (stage == 0) it = (sidx < 768) ? SCAN_BASE + sidx : -2;
            else {
                const int x = blockIdx.x & 7;
                const int i = (int)atomicAdd(ctr + 16 + x, 1u);
                if (i < 512) it = ((63 - (i >> 3)) << 6) | (x + 8 * (i & 7));
                else if (i < 528) it = 4096 + (x + 8 * (i - 512));
                else it = DONE;
            }
            *s_item = it;
        }
        __syncthreads();
        const int item = __builtin_amdgcn_readfirstlane(*s_item);
        __syncthreads();
        if (item == DONE) break;
        if (item == -2) {
            asm volatile("s_waitcnt vmcnt(0) lgkmcnt(0)" ::: "memory");
            cg::this_grid().sync();
            stage = 1;
            ln_pass(p);
            continue;
        }
        if (item >= SCAN_BASE) {
            sidx += gridDim.x;
            const int sc = item - SCAN_BASE;
            const u16* si; int nch; const float* s0; float* sout; int m0, h, half;
            if (sc < 256) {
                const int chain = sc >> 1;
                half = sc & 1; h = chain & 7;
                si = SI + (size_t)chain * 4096 * 384; nch = 256; s0 = nullptr;
                sout = p.out + OFF_WP + (size_t)chain * 4096; m0 = (chain >> 3) * 4096;
            } else {
                const int t2 = sc - 256, chain = t2 >> 1;
                half = t2 & 1; h = chain & 7;
                si = SI + ((size_t)128 * 4096 + (size_t)chain * 32) * 384; nch = 2; s0 = p.state_wkv + (size_t)chain * 4096;
                sout = p.out + OFF_WS + (size_t)chain * 4096; m0 = TP + (chain >> 3) * 32;
            }
            scan_item(p, si, nch, s0, sout, m0, h, half, smem);
        } else {
            const u16 *Q, *K, *Vt; u16* O; int nq, ldv, nkt, lastvalid;
            if (item < 4096) {
                const int c = item >> 6, bh = item & 63, b = bh >> 2, h = bh & 3;
                const size_t m0 = (size_t)b * 4096 + (size_t)c * 64;
                Q = qb + m0 * 512 + h * 128; nq = 64; K = kP + (size_t)b * 4096 * 512 + h * 128;
                Vt = vtP + ((size_t)b * 512 + h * 128) * 4096; ldv = 4096; nkt = c + 1; lastvalid = 64; O = ob + m0 * 512 + h * 128;
            } else {
                const int idx = item - 4096;
                const int b = idx >> 2, h = idx & 3;
                const size_t m0 = (size_t)TP + (size_t)b * 32;
                Q = qb + m0 * 512 + h * 128; nq = 32; K = kS + (size_t)b * LKS * 512 + h * 128;
                Vt = vtS + ((size_t)b * 512 + h * 128) * LKS; ldv = LKS; nkt = 17; lastvalid = 32; O = ob + m0 * 512 + h * 128;
            }
            attn_item(Q, nq, K, Vt, ldv, nkt, lastvalid, O, lam, p.subln, smem);
        }
    }
}

__device__ __forceinline__ void phase4(const Params& p, unsigned char* smem) {
    unsigned char* ws = p.ws;
    const u16* ya = (const u16*)(ws + O_YA);
    const u16* ob = (const u16*)(ws + O_OB);
    const u16* Wa = (const u16*)(ws + O_WOA);
    const u16* Wb = (const u16*)(ws + O_WOB);
    const u16* gate = (const u16*)p.out;
    u16* mix = (u16*)(ws + O_MIX);
    const int tid = threadIdx.x, lane = tid & 63, wid = tid >> 6, wm = wid >> 1, wn = wid & 1, l16 = lane & 15, g = lane >> 4;
    constexpr int NT = 8;
    for (int t = blockIdx.x; t < 520 * NT; t += gridDim.x) {
        int mtile, ntile;
        tile_map(t, NT, mtile, ntile);
        const int m0 = mtile * 128, n0 = ntile * 128;
        f32x4 acc[4][4], acc2[4][4];
        zero_acc(acc);
        zero_acc(acc2);
        gemm_loop(ya + (size_t)m0 * 512, 512, Wa + (size_t)n0 * 512, 512, 8, (u16*)smem, acc);
        gemm_loop(ob + (size_t)m0 * 512, 512, Wb + (size_t)n0 * 512, 512, 8, (u16*)smem, acc2);
#pragma unroll
        for (int mt = 0; mt < 4; ++mt) {
            const int m = m0 + wm * 64 + mt * 16 + l16;
#pragma unroll
            for (int nt = 0; nt < 4; ++nt) {
                const int n = n0 + wn * 64 + nt * 16 + g * 4;
                const uint2 ga = *(const uint2*)(gate + (size_t)m * 2048 + n);
                const uint2 gb = *(const uint2*)(gate + (size_t)m * 2048 + 1024 + n);
                const f32x4 a = acc[nt][mt], b = acc2[nt][mt];
                *(uint2*)(mix + (size_t)m * 1024 + n) =
                    pk4(bflo(ga.x) * a[0] + bflo(gb.x) * b[0], bfhi(ga.x) * a[1] + bfhi(gb.x) * b[1],
                        bflo(ga.y) * a[2] + bflo(gb.y) * b[2], bfhi(ga.y) * a[3] + bfhi(gb.y) * b[3]);
            }
        }
    }
}

__device__ __forceinline__ void gemm_rowss(const u16* A, int K, const u16* W, u16* outb, float* ssq, unsigned char* smem) {
    const int tid = threadIdx.x, lane = tid & 63, wid = tid >> 6, wm = wid >> 1, wn = wid & 1, l16 = lane & 15, g = lane >> 4;
    constexpr int NT = 8;
    for (int t = blockIdx.x; t < 520 * NT; t += gridDim.x) {
        int mtile, ntile;
        tile_map(t, NT, mtile, ntile);
        const int m0 = mtile * 128, n0 = ntile * 128;
        f32x4 acc[4][4];
        zero_acc(acc);
        gemm_loop(A + (size_t)m0 * K, K, W + (size_t)n0 * K, K, K / 64, (u16*)smem, acc);
#pragma unroll
        for (int mt = 0; mt < 4; ++mt) {
            const int m = m0 + wm * 64 + mt * 16 + l16;
#pragma unroll
            for (int nt = 0; nt < 4; ++nt) {
                const int n = n0 + wn * 64 + nt * 16 + g * 4;
                const f32x4 a = acc[nt][mt];
                *(uint2*)(outb + (size_t)m * 1024 + n) = pk4(a[0], a[1], a[2], a[3]);
            }
        }
    }
}

__device__ __forceinline__ float sum16(const float* q) {
    const float4 a = *(const float4*)q, b = *(const float4*)(q + 4), c = *(const float4*)(q + 8), d = *(const float4*)(q + 12);
    return ((a.x + a.y) + (a.z + a.w)) + ((b.x + b.y) + (b.z + b.w)) + (((c.x + c.y) + (c.z + c.w)) + ((d.x + d.y) + (d.z + d.w)));
}
__device__ __forceinline__ void phase6(const Params& p) {
    unsigned char* ws = p.ws;
    const u16* m2 = (const u16*)(ws + O_M2);
    u16* x1b = (u16*)(ws + O_X1B);
    float* rs3 = (float*)(ws + O_RS3);
    const int lane = threadIdx.x & 63, wid = threadIdx.x >> 6;
    for (int m = blockIdx.x * 4 + wid; m < T; m += gridDim.x * 4) {
        const float* xr = (m < TP) ? p.x_prompt + (size_t)m * 1024 : p.x_sample + (size_t)(m - TP) * 1024;
        uint2 mvv[4];
        float s2 = 0.f;
#pragma unroll
        for (int i = 0; i < 4; ++i) {
            mvv[i] = *(const uint2*)(m2 + (size_t)m * 1024 + i * 256 + lane * 4);
            const float a = bflo(mvv[i].x), b = bfhi(mvv[i].x), c = bflo(mvv[i].y), d = bfhi(mvv[i].y);
            s2 += a * a + b * b + c * c + d * d;
        }
        s2 = wave_sum(s2);
        const float rs = rsqrtf(s2 * (1.f / 1024.f) + EPS);
        float ss = 0.f;
#pragma unroll
        for (int i = 0; i < 4; ++i) {
            const int col = i * 256 + lane * 4;
            const float4 xv = *(const float4*)(xr + col);
            const uint2 mv = mvv[i];
            const float4 gp = *(const float4*)(p.n_mix_post + col);
            float4 r;
            r.x = xv.x + bflo(mv.x) * rs * gp.x;
            r.y = xv.y + bfhi(mv.x) * rs * gp.y;
            r.z = xv.z + bflo(mv.y) * rs * gp.z;
            r.w = xv.w + bfhi(mv.y) * rs * gp.w;
            ss += r.x * r.x + r.y * r.y + r.z * r.z + r.w * r.w;
            *(float4*)(p.out + (size_t)m * 1024 + col) = r;
            *(uint2*)(x1b + (size_t)m * 1024 + col) = pk4(r.x, r.y, r.z, r.w);
        }
        ss = wave_sum(ss);
        if (lane == 0) rs3[m] = rsqrtf(ss * (1.f / 1024.f) + EPS);
    }
}

__device__ __forceinline__ void phase7(const Params& p, unsigned char* smem) {
    unsigned char* ws = p.ws;
    const u16* x1b = (const u16*)(ws + O_X1B);
    const u16* W = (const u16*)(ws + O_WFI);
    const float* rs3 = (const float*)(ws + O_RS3);
    u16* hb = (u16*)(ws + O_HB);
    const int tid = threadIdx.x, lane = tid & 63, wid = tid >> 6, wm = wid >> 1, wn = wid & 1, l16 = lane & 15, g = lane >> 4;
    constexpr int NT = 44;
    for (int t = blockIdx.x; t < 520 * NT; t += gridDim.x) {
        int mtile, ntile;
        tile_map(t, NT, mtile, ntile);
        const int m0 = mtile * 128, n0 = ntile * 128;
        f32x4 acc[4][4];
        zero_acc(acc);
        gemm_loop(x1b + (size_t)m0 * 1024, 1024, W + (size_t)n0 * 1024, 1024, 16, (u16*)smem, acc);
#pragma unroll
        for (int mt = 0; mt < 4; ++mt) {
            const int m = m0 + wm * 64 + mt * 16 + l16;
            const float rs = rs3[m];
#pragma unroll
            for (int pr = 0; pr < 2; ++pr) {
                const f32x4 ug = acc[2 * pr][mt], uv = acc[2 * pr + 1][mt];
                const int j = ((n0 + wn * 64) >> 5) * 16 + pr * 16 + g * 4;
                float hv[4];
#pragma unroll
                for (int r = 0; r < 4; ++r) {
                    const float a = ug[r] * rs, b = uv[r] * rs;
                    hv[r] = a * sigmoidf_(a) * b;
                }
                *(uint2*)(hb + (size_t)m * 2816 + j) = pk4(hv[0], hv[1], hv[2], hv[3]);
            }
        }
    }
}

__device__ __forceinline__ void phase9(const Params& p) {
    unsigned char* ws = p.ws;
    const u16* fb = (const u16*)(ws + O_FB);
    const int lane = threadIdx.x & 63, wid = threadIdx.x >> 6;
    for (int m = blockIdx.x * 4 + wid; m < T; m += gridDim.x * 4) {
        uint2 fvv[4];
        float s2 = 0.f;
#pragma unroll
        for (int i = 0; i < 4; ++i) {
            fvv[i] = *(const uint2*)(fb + (size_t)m * 1024 + i * 256 + lane * 4);
            const float a = bflo(fvv[i].x), b = bfhi(fvv[i].x), c = bflo(fvv[i].y), d = bfhi(fvv[i].y);
            s2 += a * a + b * b + c * c + d * d;
        }
        s2 = wave_sum(s2);
        const float rs = rsqrtf(s2 * (1.f / 1024.f) + EPS);
#pragma unroll
        for (int i = 0; i < 4; ++i) {
            const int col = i * 256 + lane * 4;
            float4 r = *(const float4*)(p.out + (size_t)m * 1024 + col);
            const uint2 fv = fvv[i];
            const float4 gp = *(const float4*)(p.n_ffn_post + col);
            r.x += bflo(fv.x) * rs * gp.x;
            r.y += bfhi(fv.x) * rs * gp.y;
            r.z += bflo(fv.y) * rs * gp.z;
            r.w += bfhi(fv.y) * rs * gp.w;
            *(float4*)(p.out + (size_t)m * 1024 + col) = r;
        }
    }
}

__global__ void __launch_bounds__(256, 2) mega(Params p) {
    extern __shared__ __attribute__((aligned(16))) unsigned char smem[];
    cg::grid_group grid = cg::this_grid();
#define IN(k) (p.ph_lo <= (k) && (k) < p.ph_hi)
#define SEAM(k) if (IN(k) && IN((k) + 1)) { asm volatile("s_waitcnt vmcnt(0) lgkmcnt(0)" ::: "memory"); grid.sync(); }
    unsigned char* ws = p.ws;
    if (IN(0)) phase0(p, smem);
    SEAM(0)
    if (IN(1)) phase1(p, smem);
    SEAM(1)
    if (IN(2)) phase2(p, smem);
    SEAM(2)
    if (IN(3)) phase3(p, smem);
    SEAM(3)
    if (IN(5)) phase4(p, smem);
    SEAM(5)
    if (IN(6)) gemm_rowss((const u16*)(ws + O_MIX), 1024, (const u16*)(ws + O_WO), (u16*)(ws + O_M2), (float*)(ws + O_SS2), smem);
    SEAM(6)
    if (IN(7)) phase6(p);
    SEAM(7)
    if (IN(8)) phase7(p, smem);
    SEAM(8)
    if (IN(9)) gemm_rowss((const u16*)(ws + O_HB), 2816, (const u16*)(ws + O_WFO), (u16*)(ws + O_FB), (float*)(ws + O_SS4), smem);
    SEAM(9)
    if (IN(10)) phase9(p);
}

extern "C" void kernel_launch(void* const* d_in, const int* in_sizes, int n_in, void* d_out, int out_size, void* d_ws, size_t ws_size,
                              hipStream_t stream) {
    static int grid_blocks = 0;
    if (!grid_blocks) {
        int dev = 0, cus = 0, per_cu = 0;
        hipGetDevice(&dev);
        hipDeviceGetAttribute(&cus, hipDeviceAttributeMultiprocessorCount, dev);
        hipFuncSetAttribute((const void*)mega, hipFuncAttributeMaxDynamicSharedMemorySize, LDS_BYTES);
        hipOccupancyMaxActiveBlocksPerMultiprocessor(&per_cu, (const void*)mega, 256, LDS_BYTES);
        if (per_cu < 1) per_cu = 1;
        if (per_cu > 2) per_cu = 2;
        grid_blocks = cus * per_cu;
        if (ws_size < WS_END) fprintf(stderr, "kernel_launch: workspace too small: %zu < %zu\n", ws_size, (size_t)WS_END);
    }
    Params p{};
    const float** pp = (const float**)&p;
    for (int i = 0; i < 33; ++i) pp[i] = (const float*)d_in[i];
    p.out = (float*)d_out;
    p.ws = (unsigned char*)d_ws;
#ifndef MULTI_LAUNCH
    p.ph_lo = 0;
    p.ph_hi = 11;
    void* args[] = {&p};
    hipError_t e = hipLaunchCooperativeKernel((const void*)mega, dim3(grid_blocks), dim3(256), args, LDS_BYTES, stream);
    if (e != hipSuccess) fprintf(stderr, "cooperative launch failed: %s (grid %d)\n", hipGetErrorString(e), grid_blocks);
#else
    for (int k = 0; k < 11; ++k) {
        p.ph_lo = k;
        p.ph_hi = k + 1;
        hipLaunchKernelGGL(mega, dim3(grid_blocks), dim3(256), LDS_BYTES, stream, p);
    }
#endif
}
```

```cpp
#include <hip/hip_runtime.h>
#include <hip/hip_cooperative_groups.h>
#include <cstdio>
#include <cstdint>
namespace cg = cooperative_groups;

typedef unsigned short u16;
typedef __attribute__((ext_vector_type(8))) short bf16x8;
typedef __attribute__((ext_vector_type(4))) float f32x4;

constexpr int TP = 65536, TS = 1024, T = TP + TS;
constexpr int ACOLS = 1824;
constexpr int LKS = 1088;
constexpr int LDS_BYTES = 73728;
constexpr float EPS = 1e-6f;

constexpr size_t OFF_YS = 67108864ull, OFF_KP = 68157440ull, OFF_VP = 101711872ull, OFF_WP = 135266304ull,
                 OFF_SHP = 135790592ull, OFF_KS = 135819776ull, OFF_VS = 136344064ull, OFF_WS = 136868352ull,
                 OFF_SHS = 137916928ull;

constexpr size_t al(size_t x) { return (x + 255) & ~(size_t)255; }
constexpr size_t O_WIN = 0;
constexpr size_t O_WOA = O_WIN + al(5504ull * 1024 * 2);
constexpr size_t O_WOB = O_WOA + al(1024ull * 512 * 2);
constexpr size_t O_WO = O_WOB + al(1024ull * 512 * 2);
constexpr size_t O_WFI = O_WO + al(1024ull * 1024 * 2);
constexpr size_t O_WFO = O_WFI + al(5632ull * 1024 * 2);
constexpr size_t O_W2 = O_WFO + al(1024ull * 2816 * 2);
constexpr size_t O_A2 = O_W2 + al(512 * 64 * 2);
constexpr size_t O_G2 = O_A2 + al(512 * 64 * 2);
constexpr size_t O_RS1 = O_G2 + al(512 * 160 * 2);
constexpr size_t O_SS2 = O_RS1 + al((size_t)T * 4);
constexpr size_t O_SS4 = O_SS2 + al((size_t)T * 16 * 4);
constexpr size_t O_RS3 = O_SS4 + al((size_t)T * 16 * 4);
constexpr size_t O_RK = O_RS3 + al((size_t)T * 4);
constexpr size_t O_SCAL = O_RK + al((size_t)T * 8 * 16);
constexpr size_t O_REGA = O_SCAL + 256;
constexpr size_t O_CA = O_REGA;
constexpr size_t O_YA = O_REGA;
constexpr size_t O_OB = O_YA + al((size_t)T * 512 * 2);
constexpr size_t O_YRAW = O_OB + al((size_t)T * 512 * 2);
constexpr size_t O_HB = O_REGA;
constexpr size_t O_REGB = O_REGA + al((size_t)(T + 48) * 1824 * 2);
constexpr size_t O_QB = O_REGB;
constexpr size_t O_KP = O_QB + al((size_t)T * 512 * 2);
constexpr size_t O_KS = O_KP + al((size_t)TP * 512 * 2);
constexpr size_t O_VTP = O_KS + al(32ull * LKS * 512 * 2);
constexpr size_t O_VTS = O_VTP + al(16ull * 512 * 4096 * 2);
constexpr size_t O_REGC = O_VTS + al(32ull * 512 * LKS * 2);
constexpr size_t O_GATE = O_REGB;
static_assert(O_GATE + (size_t)T * 2048 * 2 <= O_REGC, "gate overlaps region C");
constexpr size_t O_SI = O_REGC;
constexpr size_t O_G = O_SI + al((size_t)T * 8 * 384 * 2);
constexpr size_t O_XB = O_REGC;
constexpr size_t O_MIX = O_REGC;
constexpr size_t O_M2 = O_MIX + al((size_t)T * 1024 * 2);
constexpr size_t O_X1B = O_M2 + al((size_t)T * 1024 * 2);
constexpr size_t O_FB = O_REGC;
constexpr size_t WS_END = O_G + al((size_t)T * 512 * 2);
static_assert(O_HB + (size_t)T * 2816 * 2 <= O_REGC, "hb overlaps region C");
static_assert(O_YRAW + (size_t)T * 512 * 2 <= O_REGB, "yraw overlaps region B");
static_assert(O_X1B + (size_t)T * 1024 * 2 <= WS_END, "x1b beyond end");
static_assert(WS_END <= 1073741824ull, "workspace too large");

struct Params {
    const float *x_prompt, *x_sample, *cache_k, *cache_v, *state_wkv, *state_shift;
    const float *n_mix_pre, *n_mix_post, *n_ffn_pre, *n_ffn_post, *w_in, *b_gate;
    const float *mu, *w0, *w2, *a0, *a2, *g2, *k_k, *k_a, *r_k, *ln_w, *ln_b;
    const float *lq1, *lk1, *lq2, *lk2, *subln, *w_out_a, *w_out_b, *w_o, *w_ffn_in, *w_ffn_out;
    float* out;
    unsigned char* ws;
    int ph_lo, ph_hi;
};

__device__ __forceinline__ u16 f2bf(float f) {
    unsigned u = __float_as_uint(f);
    u += 0x7fffu + ((u >> 16) & 1u);
    return (u16)(u >> 16);
}
__device__ __forceinline__ unsigned pk2(float a, float b) { return (unsigned)f2bf(a) | ((unsigned)f2bf(b) << 16); }
__device__ __forceinline__ float bflo(unsigned u) { return __uint_as_float(u << 16); }
__device__ __forceinline__ float bfhi(unsigned u) { return __uint_as_float(u & 0xffff0000u); }
__device__ __forceinline__ uint2 pk4(float a, float b, float c, float d) { return make_uint2(pk2(a, b), pk2(c, d)); }
__device__ __forceinline__ float sigmoidf_(float x) { return 1.f / (1.f + __expf(-x)); }

template <int CTRL>
__device__ __forceinline__ float dppf(float x) {
    return __int_as_float(__builtin_amdgcn_update_dpp(0, __float_as_int(x), CTRL, 0xF, 0xF, true));
}
__device__ __forceinline__ float red8(float x) {
    x += dppf<0xB1>(x);
    x += dppf<0x4E>(x);
    x += dppf<0x141>(x);
    return x;
}
__device__ __forceinline__ float red16(float x) {
    x = red8(x);
    x += dppf<0x140>(x);
    return x;
}
__device__ __forceinline__ float red_g(float x) {
    x += __shfl_xor(x, 16);
    x += __shfl_xor(x, 32);
    return x;
}
__device__ __forceinline__ float wave_sum(float x) {
    x = red16(x);
    return red_g(x);
}
__device__ __forceinline__ bf16x8 as_frag(uint4 v) {
    union { uint4 u; bf16x8 f; } c;
    c.u = v;
    return c.f;
}
#define MFMA(a, b, c) __builtin_amdgcn_mfma_f32_16x16x32_bf16((a), (b), (c), 0, 0, 0)

constexpr int LDT = 72;
constexpr int STG = 128 * LDT;
__device__ __forceinline__ void gemm_loop(const u16* __restrict__ A, int lda, const u16* __restrict__ B, int ldb,
                                          int nkt, u16* smem, f32x4 (&acc)[4][4]) {
    const int tid = threadIdx.x, lane = tid & 63, wid = tid >> 6, wm = wid >> 1, wn = wid & 1, l16 = lane & 15, g = lane >> 4;
    const int lr = tid >> 3, lc = (tid & 7) * 8;
    u16* sA = smem;
    u16* sB = smem + 2 * STG;
    const u16* ap = A + (size_t)lr * lda + lc;
    const u16* bp = B + (size_t)lr * ldb + lc;
    uint4 ra0, ra1, ra2, ra3, rb0, rb1, rb2, rb3;
#define G_LOAD(ko)                                                   \
    ra0 = *(const uint4*)(ap + (ko));                                \
    ra1 = *(const uint4*)(ap + (size_t)32 * lda + (ko));             \
    ra2 = *(const uint4*)(ap + (size_t)64 * lda + (ko));             \
    ra3 = *(const uint4*)(ap + (size_t)96 * lda + (ko));             \
    rb0 = *(const uint4*)(bp + (ko));                                \
    rb1 = *(const uint4*)(bp + (size_t)32 * ldb + (ko));             \
    rb2 = *(const uint4*)(bp + (size_t)64 * ldb + (ko));             \
    rb3 = *(const uint4*)(bp + (size_t)96 * ldb + (ko));
#define G_STORE(bo)                                                  \
    *(uint4*)(sA + (bo) + (lr + 0) * LDT + lc) = ra0;                \
    *(uint4*)(sA + (bo) + (lr + 32) * LDT + lc) = ra1;               \
    *(uint4*)(sA + (bo) + (lr + 64) * LDT + lc) = ra2;               \
    *(uint4*)(sA + (bo) + (lr + 96) * LDT + lc) = ra3;               \
    *(uint4*)(sB + (bo) + (lr + 0) * LDT + lc) = rb0;                \
    *(uint4*)(sB + (bo) + (lr + 32) * LDT + lc) = rb1;               \
    *(uint4*)(sB + (bo) + (lr + 64) * LDT + lc) = rb2;               \
    *(uint4*)(sB + (bo) + (lr + 96) * LDT + lc) = rb3;
    G_LOAD(0)
    G_STORE(0)
    __syncthreads();
    for (int kt = 0; kt < nkt; ++kt) {
        const int buf = kt & 1;
        if (kt + 1 < nkt) { G_LOAD((kt + 1) * 64) }
        __builtin_amdgcn_sched_barrier(0);
        const u16* cA = sA + buf * STG + (wm * 64 + l16) * LDT + g * 8;
        const u16* cB = sB + buf * STG + (wn * 64 + l16) * LDT + g * 8;
#pragma unroll
        for (int ks = 0; ks < 2; ++ks) {
            bf16x8 xf[4], wf[4];
#pragma unroll
            for (int i = 0; i < 4; ++i) {
                xf[i] = *(const bf16x8*)(cA + i * 16 * LDT + ks * 32);
                wf[i] = *(const bf16x8*)(cB + i * 16 * LDT + ks * 32);
            }
#pragma unroll
            for (int nt = 0; nt < 4; ++nt)
#pragma unroll
                for (int mt = 0; mt < 4; ++mt) acc[nt][mt] = MFMA(wf[nt], xf[mt], acc[nt][mt]);
        }
        __builtin_amdgcn_sched_barrier(0);
        if (kt + 1 < nkt) { G_STORE((buf ^ 1) * STG) }
        __syncthreads();
    }
}
__device__ __forceinline__ void gemm_loop_xf32(const float* __restrict__ A, const u16* __restrict__ B, int ldb, int nkt, u16* smem,
                                               f32x4 (&acc)[4][4]) {
    const int tid = threadIdx.x, lane = tid & 63, wid = tid >> 6, wm = wid >> 1, wn = wid & 1, l16 = lane & 15, g = lane >> 4;
    const int lr = tid >> 3, lc = (tid & 7) * 8;
    u16* sA = smem;
    u16* sB = smem + 2 * STG;
    const float* ap = A + (size_t)lr * 1024 + lc;
    const u16* bp = B + (size_t)lr * ldb + lc;
    float4 fa0, fa1, fa2, fa3, fa4, fa5, fa6, fa7;
    uint4 rb0, rb1, rb2, rb3;
#define GX_LOAD(ko)                                                  \
    fa0 = *(const float4*)(ap + (ko));                               \
    fa1 = *(const float4*)(ap + (ko) + 4);                           \
    fa2 = *(const float4*)(ap + 32 * 1024 + (ko));                   \
    fa3 = *(const float4*)(ap + 32 * 1024 + (ko) + 4);               \
    fa4 = *(const float4*)(ap + 64 * 1024 + (ko));                   \
    fa5 = *(const float4*)(ap + 64 * 1024 + (ko) + 4);               \
    fa6 = *(const float4*)(ap + 96 * 1024 + (ko));                   \
    fa7 = *(const float4*)(ap + 96 * 1024 + (ko) + 4);               \
    rb0 = *(const uint4*)(bp + (ko));                                \
    rb1 = *(const uint4*)(bp + (size_t)32 * ldb + (ko));             \
    rb2 = *(const uint4*)(bp + (size_t)64 * ldb + (ko));             \
    rb3 = *(const uint4*)(bp + (size_t)96 * ldb + (ko));
#define PKF(a, b) make_uint4(pk2(a.x, a.y), pk2(a.z, a.w), pk2(b.x, b.y), pk2(b.z, b.w))
#define GX_STORE(bo)                                                 \
    *(uint4*)(sA + (bo) + (lr + 0) * LDT + lc) = PKF(fa0, fa1);      \
    *(uint4*)(sA + (bo) + (lr + 32) * LDT + lc) = PKF(fa2, fa3);     \
    *(uint4*)(sA + (bo) + (lr + 64) * LDT + lc) = PKF(fa4, fa5);     \
    *(uint4*)(sA + (bo) + (lr + 96) * LDT + lc) = PKF(fa6, fa7);     \
    *(uint4*)(sB + (bo) + (lr + 0) * LDT + lc) = rb0;                \
    *(uint4*)(sB + (bo) + (lr + 32) * LDT + lc) = rb1;               \
    *(uint4*)(sB + (bo) + (lr + 64) * LDT + lc) = rb2;               \
    *(uint4*)(sB + (bo) + (lr + 96) * LDT + lc) = rb3;
    GX_LOAD(0)
    GX_STORE(0)
    __syncthreads();
    for (int kt = 0; kt < nkt; ++kt) {
        const int buf = kt & 1;
        if (kt + 1 < nkt) { GX_LOAD((kt + 1) * 64) }
        __builtin_amdgcn_sched_barrier(0);
        const u16* cA = sA + buf * STG + (wm * 64 + l16) * LDT + g * 8;
        const u16* cB = sB + buf * STG + (wn * 64 + l16) * LDT + g * 8;
#pragma unroll
        for (int ks = 0; ks < 2; ++ks) {
            bf16x8 xf[4], wf[4];
#pragma unroll
            for (int i = 0; i < 4; ++i) {
                xf[i] = *(const bf16x8*)(cA + i * 16 * LDT + ks * 32);
                wf[i] = *(const bf16x8*)(cB + i * 16 * LDT + ks * 32);
            }
#pragma unroll
            for (int nt = 0; nt < 4; ++nt)
#pragma unroll
                for (int mt = 0; mt < 4; ++mt) acc[nt][mt] = MFMA(wf[nt], xf[mt], acc[nt][mt]);
        }
        __builtin_amdgcn_sched_barrier(0);
        if (kt + 1 < nkt) { GX_STORE((buf ^ 1) * STG) }
        __syncthreads();
    }
}
__device__ __forceinline__ void zero_acc(f32x4 (&acc)[4][4]) {
#pragma unroll
    for (int i = 0; i < 4; ++i)
#pragma unroll
        for (int j = 0; j < 4; ++j) acc[i][j] = (f32x4){0.f, 0.f, 0.f, 0.f};
}
__device__ __forceinline__ void tile_map(int t, int NT, int& mt, int& nt) {
    const int x = t & 7, u = t >> 3;
    const int gsz = 8 * NT;
    const int g = u / gsz;
    const int w = u - g * gsz;
    const int rows = (g < 8) ? 8 : 1;
    const int q = w / rows;
    mt = x * 65 + g * 8 + (w - q * rows);
    nt = q;
}

__device__ __forceinline__ void tr_tile(const float* __restrict__ in, int R, int C, int ldin, u16* __restrict__ out, int ldout,
                        const float* __restrict__ scale, int r0, int c0, int Cout, bool perm, float* tile) {
    const int tid = threadIdx.x;
    {
        const int tx = tid & 63, ty = tid >> 6;
        const int c = c0 + tx;
        for (int rr = ty; rr < 64; rr += 4) {
            const int r = r0 + rr;
            float v = 0.f;
            if (r < R && c < C) {
                v = in[(size_t)r * ldin + c];
                if (scale) v *= scale[r];
            }
            tile[rr * 65 + tx] = v;
        }
    }
    __syncthreads();
    {
        const int rch = (tid & 7) * 8;
#pragma unroll
        for (int pass = 0; pass < 2; ++pass) {
            const int cc = (tid >> 3) + pass * 32;
            const int c = c0 + cc;
            if (c < Cout && r0 + rch < R) {
                float v[8];
#pragma unroll
                for (int k = 0; k < 8; ++k) v[k] = tile[(rch + k) * 65 + cc];
                int orow = c;
                if (perm) {
                    const int type = c >= 2816 ? 1 : 0;
                    const int j = c - type * 2816;
                    orow = (j >> 4) * 32 + type * 16 + (j & 15);
                }
                uint4 o = make_uint4(pk2(v[0], v[1]), pk2(v[2], v[3]), pk2(v[4], v[5]), pk2(v[6], v[7]));
                *(uint4*)(out + (size_t)orow * ldout + r0 + rch) = o;
            }
        }
    }
    __syncthreads();
}

__device__ __forceinline__ void phase0(const Params& p, unsigned char* smem) {
    float* tile = (float*)smem;
    const int tid = threadIdx.x, lane = tid & 63, wid = tid >> 6;
    unsigned char* ws = p.ws;
    const int G = gridDim.x;
    for (int u = blockIdx.x; u < 8136; u += G) {
        const float* in;
        int R, C, Cout, ldout, tl;
        u16* out;
        const float* scale = nullptr;
        bool perm = false;
        if (u < 1376) { tl = u; in = p.w_in; R = 1024; C = 5408; Cout = 5504; out = (u16*)(ws + O_WIN); ldout = 1024; scale = p.n_mix_pre; }
        else if (u < 1504) { tl = u - 1376; in = p.w_out_a; R = 512; C = 1024; Cout = 1024; out = (u16*)(ws + O_WOA); ldout = 512; }
        else if (u < 1632) { tl = u - 1504; in = p.w_out_b; R = 512; C = 1024; Cout = 1024; out = (u16*)(ws + O_WOB); ldout = 512; }
        else if (u < 1888) { tl = u - 1632; in = p.w_o; R = 1024; C = 1024; Cout = 1024; out = (u16*)(ws + O_WO); ldout = 1024; }
        else if (u < 3296) { tl = u - 1888; in = p.w_ffn_in; R = 1024; C = 5632; Cout = 5632; out = (u16*)(ws + O_WFI); ldout = 1024; scale = p.n_ffn_pre; perm = true; }
        else if (u < 4000) { tl = u - 3296; in = p.w_ffn_out; R = 2816; C = 1024; Cout = 1024; out = (u16*)(ws + O_WFO); ldout = 2816; }
        else if (u < 4008) { tl = u - 4000; in = p.w2; R = 64; C = 512; Cout = 512; out = (u16*)(ws + O_W2); ldout = 64; }
        else if (u < 4016) { tl = u - 4008; in = p.a2; R = 64; C = 512; Cout = 512; out = (u16*)(ws + O_A2); ldout = 64; }
        else if (u < 4040) { tl = u - 4016; in = p.g2; R = 160; C = 512; Cout = 512; out = (u16*)(ws + O_G2); ldout = 160; }
        else {
            tl = u - 4040;
            const int b = tl >> 7;
            tl &= 127;
            in = p.cache_v + (size_t)b * 1024 * 512; R = 1024; C = 512; Cout = 512;
            out = (u16*)(ws + O_VTS) + (size_t)b * 512 * LKS; ldout = LKS;
        }
        const int ctiles = (Cout + 63) >> 6;
        const int rt = tl / ctiles, ct = tl - rt * ctiles;
        tr_tile(in, R, C, C, out, ldout, scale, rt * 64, ct * 64, Cout, perm, tile);
    }
    {
        u16* xb = (u16*)(ws + O_XB);
        float* rs1 = (float*)(ws + O_RS1);
        for (int m = blockIdx.x * 4 + wid; m < T; m += G * 4) {
            const float* xr = (m < TP) ? p.x_prompt + (size_t)m * 1024 : p.x_sample + (size_t)(m - TP) * 1024;
            float ss = 0.f;
#pragma unroll
            for (int i = 0; i < 4; ++i) {
                const float4 v = *(const float4*)(xr + i * 256 + lane * 4);
                ss += v.x * v.x + v.y * v.y + v.z * v.z + v.w * v.w;
                *(uint2*)(xb + (size_t)m * 1024 + i * 256 + lane * 4) = pk4(v.x, v.y, v.z, v.w);
            }
            ss = wave_sum(ss);
            if (lane == 0) rs1[m] = rsqrtf(ss * (1.f / 1024.f) + EPS);
        }
    }
    {
        u16* kS = (u16*)(ws + O_KS);
        const int n8 = 32 * 1024 * 64;
        for (int i = blockIdx.x * 256 + tid; i < n8; i += G * 256) {
            const int b = i >> 16, rem = i & 65535, key = rem >> 6, c8 = rem & 63;
            const float4 v0 = *(const float4*)(p.cache_k + (size_t)i * 8);
            const float4 v1 = *(const float4*)(p.cache_k + (size_t)i * 8 + 4);
            *(uint4*)(kS + ((size_t)b * LKS + key) * 512 + c8 * 8) =
                make_uint4(pk2(v0.x, v0.y), pk2(v0.z, v0.w), pk2(v1.x, v1.y), pk2(v1.z, v1.w));
        }
        for (int i = blockIdx.x * 256 + tid; i < 32 * 32 * 64; i += G * 256) {
            const int b = i >> 11, rem = i & 2047, row = rem >> 6, c8 = rem & 63;
            *(uint4*)(kS + ((size_t)b * LKS + 1056 + row) * 512 + c8 * 8) = make_uint4(0, 0, 0, 0);
        }
        u16* vtS = (u16*)(ws + O_VTS);
        for (int i = blockIdx.x * 256 + tid; i < 32 * 512 * 4; i += G * 256) {
            const int row = i >> 2, c8 = i & 3;
            *(uint4*)(vtS + (size_t)row * LKS + 1056 + c8 * 8) = make_uint4(0, 0, 0, 0);
        }
    }
    {
        u16* cA = (u16*)(ws + O_CA);
        for (int i = blockIdx.x * 256 + tid; i < 48 * ACOLS; i += G * 256) {
            const int s = i / ACOLS, c = i - s * ACOLS;
            float v = 0.f;
            size_t row;
            if (s < 16) row = (size_t)s * 4097;
            else { row = (size_t)16 * 4097 + (size_t)(s - 16) * 33; v = p.state_shift[(size_t)(s - 16) * ACOLS + c]; }
            cA[row * ACOLS + c] = f2bf(v);
        }
        if (blockIdx.x == 0 && tid == 0) {
            float d1 = 0.f, d2 = 0.f;
            for (int i = 0; i < 64; ++i) { d1 += p.lq1[i] * p.lk1[i]; d2 += p.lq2[i] * p.lk2[i]; }
            float* sc = (float*)(ws + O_SCAL);
            sc[0] = __expf(d1) - __expf(d2) + 0.2f;
            for (int i = 1; i < 32; ++i) ((unsigned*)sc)[i] = 0u;
        }
    }
}

__device__ __forceinline__ void phase1(const Params& p, unsigned char* smem) {
    unsigned char* ws = p.ws;
    const u16* xb = (const u16*)(ws + O_XB);
    const u16* W = (const u16*)(ws + O_WIN);
    const float* rs1 = (const float*)(ws + O_RS1);
    u16* cA = (u16*)(ws + O_CA);
    u16* qb = (u16*)(ws + O_QB);
    u16* kP = (u16*)(ws + O_KP);
    u16* kS = (u16*)(ws + O_KS);
    u16* vtP = (u16*)(ws + O_VTP);
    u16* vtS = (u16*)(ws + O_VTS);
    float* out = p.out;
    const int tid = threadIdx.x, lane = tid & 63, wid = tid >> 6, wm = wid >> 1, wn = wid & 1, l16 = lane & 15, g = lane >> 4;
    constexpr int NT = 43;
    u16* gate = (u16*)p.out;
    for (int t = blockIdx.x; t < 520 * NT; t += gridDim.x) {
        int mtile, ntile;
        tile_map(t, NT, mtile, ntile);
        const int m0 = mtile * 128, n0 = ntile * 128;
        f32x4 acc[4][4];
        zero_acc(acc);
        gemm_loop(xb + (size_t)m0 * 1024, 1024, W + (size_t)n0 * 1024, 1024, 16, (u16*)smem, acc);
#pragma unroll
        for (int mt = 0; mt < 4; ++mt) {
            const int m = m0 + wm * 64 + mt * 16 + l16;
            const float rs = rs1[m];
            const bool isP = m < TP;
            int seq, tt;
            if (isP) { seq = m >> 12; tt = m & 4095; }
            else { const int ms = m - TP; seq = 16 + (ms >> 5); tt = ms & 31; }
            const size_t carow = (size_t)m + seq + 1;
            const bool last = isP ? (tt == 4095) : (tt == 31);
#pragma unroll
            for (int nt = 0; nt < 4; ++nt) {
                const int n = n0 + wn * 64 + nt * 16 + g * 4;
                if (n >= 5408) continue;
                f32x4 v = acc[nt][mt];
                v[0] *= rs; v[1] *= rs; v[2] *= rs; v[3] *= rs;
                if (n < 1824) {
                    *(uint2*)(cA + carow * ACOLS + n) = pk4(v[0], v[1], v[2], v[3]);
                    if (last) {
                        float* so = isP ? out + OFF_SHP + (size_t)seq * ACOLS + n : out + OFF_SHS + (size_t)(seq - 16) * ACOLS + n;
                        *(float4*)so = make_float4(v[0], v[1], v[2], v[3]);
                    }
                } else if (n < 2336) {
                    *(uint2*)(qb + (size_t)m * 512 + (n - 1824)) = pk4(v[0], v[1], v[2], v[3]);
                } else if (n < 2848) {
                    const int c = n - 2336;
                    if (isP) {
                        *(uint2*)(kP + (size_t)m * 512 + c) = pk4(v[0], v[1], v[2], v[3]);
                        *(float4*)(out + OFF_KP + (size_t)m * 512 + c) = make_float4(v[0], v[1], v[2], v[3]);
                    } else {
                        *(uint2*)(kS + ((size_t)(seq - 16) * LKS + 1024 + tt) * 512 + c) = pk4(v[0], v[1], v[2], v[3]);
                        *(float4*)(out + OFF_KS + (size_t)(m - TP) * 512 + c) = make_float4(v[0], v[1], v[2], v[3]);
                    }
                } else if (n < 3360) {
                    const int c = n - 2848;
                    if (isP) {
                        *(float4*)(out + OFF_VP + (size_t)m * 512 + c) = make_float4(v[0], v[1], v[2], v[3]);
                        u16* d = vtP + ((size_t)seq * 512 + c) * 4096 + tt;
                        d[0] = f2bf(v[0]); d[4096] = f2bf(v[1]); d[2 * 4096] = f2bf(v[2]); d[3 * 4096] = f2bf(v[3]);
                    } else {
                        *(float4*)(out + OFF_VS + (size_t)(m - TP) * 512 + c) = make_float4(v[0], v[1], v[2], v[3]);
                        u16* d = vtS + ((size_t)(seq - 16) * 512 + c) * LKS + 1024 + tt;
                        d[0] = f2bf(v[0]); d[LKS] = f2bf(v[1]); d[2 * LKS] = f2bf(v[2]); d[3 * LKS] = f2bf(v[3]);
                    }
                } else {
                    const int c = n - 3360;
                    const float4 bg = *(const float4*)(p.b_gate + c);
                    *(uint2*)(gate + (size_t)m * 2048 + c) =
                        pk4(sigmoidf_(v[0] + bg.x), sigmoidf_(v[1] + bg.y), sigmoidf_(v[2] + bg.z), sigmoidf_(v[3] + bg.w));
                }
            }
        }
    }
}

__device__ __forceinline__ void lerp8(const u16* cur, const u16* prv, const float* mu, int col, float (&xs)[8]) {
    const uint4 cu = *(const uint4*)(cur + col);
    const uint4 pv = *(const uint4*)(prv + col);
    const float4 m0 = *(const float4*)(mu + col);
    const float4 m1 = *(const float4*)(mu + col + 4);
    const unsigned cw[4] = {cu.x, cu.y, cu.z, cu.w}, pw[4] = {pv.x, pv.y, pv.z, pv.w};
    const float mm[8] = {m0.x, m0.y, m0.z, m0.w, m1.x, m1.y, m1.z, m1.w};
#pragma unroll
    for (int i = 0; i < 4; ++i) {
        const float c0 = bflo(cw[i]), c1 = bfhi(cw[i]), p0 = bflo(pw[i]), p1 = bfhi(pw[i]);
        xs[2 * i] = c0 + (p0 - c0) * mm[2 * i];
        xs[2 * i + 1] = c1 + (p1 - c1) * mm[2 * i + 1];
    }
}
__device__ __forceinline__ void lerp4(const u16* cur, const u16* prv, const float* mu, int col, float (&xs)[4]) {
    const uint2 cu = *(const uint2*)(cur + col);
    const uint2 pv = *(const uint2*)(prv + col);
    const float4 m0 = *(const float4*)(mu + col);
    float c0 = bflo(cu.x), c1 = bfhi(cu.x), c2 = bflo(cu.y), c3 = bfhi(cu.y);
    xs[0] = c0 + (bflo(pv.x) - c0) * m0.x;
    xs[1] = c1 + (bfhi(pv.x) - c1) * m0.y;
    xs[2] = c2 + (bflo(pv.y) - c2) * m0.z;
    xs[3] = c3 + (bfhi(pv.y) - c3) * m0.w;
}
__device__ __forceinline__ void lerp4w(const uint2 cu, const uint2 pv, const float* mu, int col, float (&xs)[4]) {
    const float4 m0 = *(const float4*)(mu + col);
    const float c0 = bflo(cu.x), c1 = bfhi(cu.x), c2 = bflo(cu.y), c3 = bfhi(cu.y);
    xs[0] = c0 + (bflo(pv.x) - c0) * m0.x;
    xs[1] = c1 + (bfhi(pv.x) - c1) * m0.y;
    xs[2] = c2 + (bflo(pv.y) - c2) * m0.z;
    xs[3] = c3 + (bfhi(pv.y) - c3) * m0.w;
}
__device__ __forceinline__ bf16x8 packfrag(const float (&v)[8]) {
    return as_frag(make_uint4(pk2(v[0], v[1]), pk2(v[2], v[3]), pk2(v[4], v[5]), pk2(v[6], v[7])));
}

__device__ __forceinline__ void phase2(const Params& p, unsigned char* smem) {
    unsigned char* ws = p.ws;
    const u16* cA = (const u16*)(ws + O_CA);
    const u16* w2t = (const u16*)(ws + O_W2);
    const u16* a2t = (const u16*)(ws + O_A2);
    const u16* g2t = (const u16*)(ws + O_G2);
    u16* SI = (u16*)(ws + O_SI);
    u16* Gb = (u16*)(ws + O_G);
    float4* rk4 = (float4*)(ws + O_RK);
    const int tid = threadIdx.x, lane = tid & 63, wid = tid >> 6, l16 = lane & 15, g = lane >> 4;
    float* sp = (float*)smem;
    for (int i = tid; i < 1824; i += 256) sp[i] = p.mu[i];
    for (int i = tid; i < 512; i += 256) {
        sp[1824 + i] = p.w0[i]; sp[2336 + i] = p.a0[i]; sp[2848 + i] = p.k_k[i]; sp[3360 + i] = p.k_a[i]; sp[3872 + i] = p.r_k[i];
    }
    __syncthreads();
    const int NU = (T / 64) / (int)gridDim.x * (int)gridDim.x;
    const int NW = NU + (T / 64 - NU) * 8;
    for (int uu = blockIdx.x; uu < NW; uu += gridDim.x) {
        int u, h_lo, h_hi;
        if (uu < NU) { u = uu; h_lo = 0; h_hi = 8; }
        else { const int v = uu - NU; u = NU + (v >> 3); h_lo = v & 7; h_hi = h_lo + 1; }
        const int mw = u * 64 + wid * 16;
        const int m = mw + l16;
        const bool isP = mw < TP;
        int seq, tt;
        if (isP) { seq = m >> 12; tt = m & 4095; }
        else { const int ms = m - TP; seq = 16 + (ms >> 5); tt = ms & 31; }
        const u16* cur = cA + ((size_t)m + seq + 1) * ACOLS;
        const u16* prv = cur - ACOLS;
        bf16x8 xw[2], xa[2], xg[5];
#pragma unroll
        for (int s = 0; s < 9; ++s) {
            float xs[8];
            lerp8(cur, prv, sp, 1536 + s * 32 + g * 8, xs);
            if (s < 2) {
#pragma unroll
                for (int i = 0; i < 8; ++i) xs[i] = 1.f - 2.f / (__expf(2.f * xs[i]) + 1.f);
                xw[s] = packfrag(xs);
            } else if (s < 4) {
                xa[s - 2] = packfrag(xs);
            } else {
#pragma unroll
                for (int i = 0; i < 8; ++i) xs[i] = sigmoidf_(xs[i]);
                xg[s - 4] = packfrag(xs);
            }
        }
        bf16x8 nw0, nw1, na0, na1;
        uint2 ncr, npr, nck, npk, ncv, npv;
#define P2_FETCH(hh, ntt)                                                          \
        {                                                                          \
            const int wr_ = (hh) * 64 + (ntt) * 16 + l16;                          \
            nw0 = *(const bf16x8*)(w2t + wr_ * 64 + g * 8);                        \
            nw1 = *(const bf16x8*)(w2t + wr_ * 64 + 32 + g * 8);                   \
            na0 = *(const bf16x8*)(a2t + wr_ * 64 + g * 8);                        \
            na1 = *(const bf16x8*)(a2t + wr_ * 64 + 32 + g * 8);                   \
            const int ch_ = (hh) * 64 + (ntt) * 16 + g * 4;                        \
            ncr = *(const uint2*)(cur + ch_);        npr = *(const uint2*)(prv + ch_);        \
            nck = *(const uint2*)(cur + 512 + ch_);  npk = *(const uint2*)(prv + 512 + ch_);  \
            ncv = *(const uint2*)(cur + 1024 + ch_); npv = *(const uint2*)(prv + 1024 + ch_); \
        }
        P2_FETCH(h_lo, 0)
        for (int h = h_lo; h < h_hi; ++h) {
            float kkr[16], av[16];
            float ssq = 0.f, rkacc = 0.f, bracc = 0.f, kracc = 0.f;
            const size_t sirow = isP ? ((size_t)(seq * 8 + h) * 4096 + tt) : ((size_t)128 * 4096 + (size_t)((seq - 16) * 8 + h) * 32 + tt);
            u16* sib = SI + sirow * 384;
#pragma unroll
            for (int nt = 0; nt < 4; ++nt) {
                const bf16x8 cw0 = nw0, cw1 = nw1, ca0 = na0, ca1 = na1;
                const uint2 ccr = ncr, cpr = npr, cck = nck, cpk = npk, ccv = ncv, cpv = npv;
                if (nt < 3) { P2_FETCH(h, nt + 1) } else if (h + 1 < h_hi) { P2_FETCH(h + 1, 0) }
                const u16* gw_ = g2t + (h * 64 + nt * 16 + l16) * 160 + g * 8;
                const bf16x8 cg0 = *(const bf16x8*)(gw_), cg1 = *(const bf16x8*)(gw_ + 32), cg2 = *(const bf16x8*)(gw_ + 64),
                             cg3 = *(const bf16x8*)(gw_ + 96), cg4 = *(const bf16x8*)(gw_ + 128);
                __builtin_amdgcn_sched_barrier(0);
                f32x4 accw = {0.f, 0.f, 0.f, 0.f}, acca = accw;
                accw = MFMA(cw0, xw[0], accw); accw = MFMA(cw1, xw[1], accw);
                acca = MFMA(ca0, xa[0], acca); acca = MFMA(ca1, xa[1], acca);
                const int ch = h * 64 + nt * 16 + g * 4;
                float xr[4], xk[4], xv[4];
                lerp4w(ccr, cpr, sp, ch, xr);
                lerp4w(cck, cpk, sp, 512 + ch, xk);
                lerp4w(ccv, cpv, sp, 1024 + ch, xv);
                const float4 w0 = *(const float4*)(sp + 1824 + ch), a0 = *(const float4*)(sp + 2336 + ch), kk4 = *(const float4*)(sp + 2848 + ch),
                             ka4 = *(const float4*)(sp + 3360 + ch), rk4 = *(const float4*)(sp + 3872 + ch);
                const float w0a[4] = {w0.x, w0.y, w0.z, w0.w}, a0a[4] = {a0.x, a0.y, a0.z, a0.w}, kka[4] = {kk4.x, kk4.y, kk4.z, kk4.w},
                            kaa[4] = {ka4.x, ka4.y, ka4.z, ka4.w}, rka[4] = {rk4.x, rk4.y, rk4.z, rk4.w};
                float ev[4], kp[4], dr[4];
#pragma unroll
                for (int r = 0; r < 4; ++r) {
                    const float z = -(w0a[r] + accw[r]);
                    const float sp = (z > 20.f) ? z : __logf(1.f + __expf(z));
                    ev[r] = __expf(-sp - 0.5f);
                    const float a = sigmoidf_(a0a[r] + acca[r]);
                    const float kraw = xk[r] * kka[r];
                    ssq += kraw * kraw;
                    kp[r] = xk[r] * (1.f + (a - 1.f) * kaa[r]);
                    rkacc += xr[r] * kp[r] * rka[r];
                    kracc += xr[r] * kp[r];
                    bracc += kraw * a * xr[r];
                    dr[r] = xr[r] * __expf(-ev[r]);
                    kkr[nt * 4 + r] = kraw;
                    av[nt * 4 + r] = a;
                }
                const int co = nt * 16 + g * 4;
                *(uint2*)(sib + 0 * 64 + co) = pk4(dr[0], dr[1], dr[2], dr[3]);
                *(uint2*)(sib + 1 * 64 + co) = pk4(ev[0], ev[1], ev[2], ev[3]);
                *(uint2*)(sib + 2 * 64 + co) = pk4(kp[0], kp[1], kp[2], kp[3]);
                *(uint2*)(sib + 3 * 64 + co) = pk4(xv[0], xv[1], xv[2], xv[3]);
                f32x4 accg = {0.f, 0.f, 0.f, 0.f};
                accg = MFMA(cg0, xg[0], accg); accg = MFMA(cg1, xg[1], accg); accg = MFMA(cg2, xg[2], accg);
                accg = MFMA(cg3, xg[3], accg); accg = MFMA(cg4, xg[4], accg);
                *(uint2*)(Gb + (size_t)m * 512 + ch) = pk4(accg[0], accg[1], accg[2], accg[3]);
            }
            ssq = red_g(ssq);
            rkacc = red_g(rkacc);
            bracc = red_g(bracc);
            kracc = red_g(kracc);
            const float inv = rsqrtf(fmaxf(ssq, 1e-24f));
#pragma unroll
            for (int nt = 0; nt < 4; ++nt) {
                const int co = nt * 16 + g * 4;
                float k0 = kkr[nt * 4 + 0] * inv, k1 = kkr[nt * 4 + 1] * inv, k2 = kkr[nt * 4 + 2] * inv, k3 = kkr[nt * 4 + 3] * inv;
                *(uint2*)(sib + 4 * 64 + co) = pk4(k0, k1, k2, k3);
                *(uint2*)(sib + 5 * 64 + co) = pk4(k0 * av[nt * 4 + 0], k1 * av[nt * 4 + 1], k2 * av[nt * 4 + 2], k3 * av[nt * 4 + 3]);
            }
            if (g == 0) rk4[(size_t)m * 8 + h] = make_float4(rkacc, bracc * inv, kracc, 0.f);
        }
    }
}

typedef float v2f __attribute__((ext_vector_type(2)));
__device__ __forceinline__ void scan_item(const Params& p, const u16* __restrict__ si, int nch, const float* __restrict__ s0, float* __restrict__ sout,
                          int m0, int h, int half, unsigned char* smem) {
    float* inb = (float*)smem;
    float* ybuf = (float*)(smem + 49152);
    float* scal = (float*)(smem + 53248);
    unsigned char* ws = p.ws;
    const float4* rk4 = (const float4*)(ws + O_RK);
    u16* yraw = (u16*)(ws + O_YRAW);
    const int tid = threadIdx.x;
    const int vp = tid >> 3, kq = tid & 7;
    const int row = half * 32 + vp;
    v2f S[4];
    if (s0) {
        const float4 a = *(const float4*)(s0 + row * 64 + kq * 8), b = *(const float4*)(s0 + row * 64 + kq * 8 + 4);
        S[0] = (v2f){a.x, a.y}; S[1] = (v2f){a.z, a.w}; S[2] = (v2f){b.x, b.y}; S[3] = (v2f){b.z, b.w};
    } else {
#pragma unroll
        for (int j = 0; j < 4; ++j) S[j] = (v2f){0.f, 0.f};
    }
    uint4 st0, st1, st2;
    float4 sq = make_float4(0.f, 0.f, 0.f, 0.f);
    st0 = *(const uint4*)(si + (0 * 256 + tid) * 8);
    st1 = *(const uint4*)(si + (1 * 256 + tid) * 8);
    st2 = *(const uint4*)(si + (2 * 256 + tid) * 8);
    if (tid < 16) sq = rk4[(m0 + tid) * 8 + h];
#define S_WRITE1(sv, i, buf)                                                                                          \
    {                                                                                                                 \
        const int idx = (i) * 256 + tid;                                                                              \
        const int vec = (idx % 48) >> 3;                                                                              \
        float v[8] = {bflo(sv.x), bfhi(sv.x), bflo(sv.y), bfhi(sv.y), bflo(sv.z), bfhi(sv.z), bflo(sv.w), bfhi(sv.w)}; \
        if (vec == 1) {                                                                                               \
            _Pragma("unroll") for (int k = 0; k < 8; ++k) v[k] = __expf(-v[k]);                                       \
        }                                                                                                             \
        float* d = inb + (buf) * 6144 + idx * 8;                                                                      \
        *(float4*)d = make_float4(v[0], v[1], v[2], v[3]);                                                            \
        *(float4*)(d + 4) = make_float4(v[4], v[5], v[6], v[7]);                                                      \
    }
#define stage_write(buf) S_WRITE1(st0, 0, buf) S_WRITE1(st1, 1, buf) S_WRITE1(st2, 2, buf) if (tid < 16) *(float4*)(scal + (buf) * 64 + tid * 4) = sq;
    stage_write(0)
    __syncthreads();
    for (int c = 0; c < nch; ++c) {
        const int buf = c & 1;
        if (c + 1 < nch) {
            const u16* sn = si + (c + 1) * 6144 + tid * 8;
            st0 = *(const uint4*)(sn);
            st1 = *(const uint4*)(sn + 2048);
            st2 = *(const uint4*)(sn + 4096);
            if (tid < 16) sq = rk4[(m0 + (c + 1) * 16 + tid) * 8 + h];
        }
        const float* cb = inb + buf * 6144;
        const float* cs = scal + buf * 64;
#pragma unroll 2
        for (int tt = 0; tt < 16; ++tt) {
            const float* base = cb + tt * 384;
            v2f kk[4], dr[4], dd[4], bb[4], kv[4];
#define LD8(dst, off)                                                      \
    {                                                                      \
        const float4 q0 = *(const float4*)(base + (off) + kq * 8);         \
        const float4 q1 = *(const float4*)(base + (off) + kq * 8 + 4);     \
        dst[0] = (v2f){q0.x, q0.y}; dst[1] = (v2f){q0.z, q0.w};            \
        dst[2] = (v2f){q1.x, q1.y}; dst[3] = (v2f){q1.z, q1.w};            \
    }
            LD8(kk, 256) LD8(dr, 0) LD8(dd, 64) LD8(bb, 320) LD8(kv, 128)
            const float vv = base[192 + row];
            const float2 brkr = *(const float2*)(cs + tt * 4 + 1);
            v2f a0 = S[0] * kk[0], a1 = S[1] * kk[1], q0 = S[0] * dr[0], q1 = S[1] * dr[1];
            a0 = __builtin_elementwise_fma(S[2], kk[2], a0);
            a1 = __builtin_elementwise_fma(S[3], kk[3], a1);
            q0 = __builtin_elementwise_fma(S[2], dr[2], q0);
            q1 = __builtin_elementwise_fma(S[3], dr[3], q1);
            a0 += a1;
            q0 += q1;
            const float sa = -red8(a0.x + a0.y);
            const float pp = red8(q0.x + q0.y);
            const float y = pp + sa * brkr.x + vv * brkr.y;
            if (kq == 0) ybuf[tt * 32 + vp] = y;
            const v2f sav = (v2f){sa, sa}, vvv = (v2f){vv, vv};
#pragma unroll
            for (int j = 0; j < 4; ++j) S[j] = __builtin_elementwise_fma(S[j], dd[j], __builtin_elementwise_fma(vvv, kv[j], sav * bb[j]));
        }
        __syncthreads();
        {
            const int tt = tid >> 4, e2 = (tid & 15) * 2;
            const float2 y2 = *(const float2*)(ybuf + tt * 32 + e2);
            *(unsigned*)(yraw + (m0 + c * 16 + tt) * 512 + h * 64 + half * 32 + e2) = pk2(y2.x, y2.y);
        }
        if (c + 1 < nch) { stage_write(buf ^ 1) }
        __syncthreads();
    }
    {
        float* d0 = sout + row * 64 + kq * 8;
        *(float4*)d0 = make_float4(S[0].x, S[0].y, S[1].x, S[1].y);
        *(float4*)(d0 + 4) = make_float4(S[2].x, S[2].y, S[3].x, S[3].y);
    }
}

__device__ __forceinline__ void ln_pass(const Params& p) {
    unsigned char* ws = p.ws;
    const u16* yraw = (const u16*)(ws + O_YRAW);
    const u16* Gb = (const u16*)(ws + O_G);
    const u16* SI = (const u16*)(ws + O_SI);
    const float4* rk4 = (const float4*)(ws + O_RK);
    u16* ya = (u16*)(ws + O_YA);
    const int tid = threadIdx.x, cq = (tid & 15) * 4;
    for (int q0 = blockIdx.x * 16; q0 < T * 8; q0 += gridDim.x * 16) {
        const int q = q0 + (tid >> 4);
        const int m = q >> 3, h = q & 7;
        const int e = m * 512 + h * 64 + cq;
        const uint2 yv = *(const uint2*)(yraw + e);
        const float y0 = bflo(yv.x), y1 = bfhi(yv.x), y2 = bflo(yv.y), y3 = bfhi(yv.y);
        const float mean = red16(y0 + y1 + y2 + y3) * (1.f / 64.f);
        const float d0 = y0 - mean, d1 = y1 - mean, d2 = y2 - mean, d3 = y3 - mean;
        const float var = red16(d0 * d0 + d1 * d1 + d2 * d2 + d3 * d3) * (1.f / 64.f);
        const float rstd = rsqrtf(var + 64e-5f);
        const float rkv = rk4[q].x;
        int sirow;
        if (m < TP) sirow = ((m >> 12) * 8 + h) * 4096 + (m & 4095);
        else { const int ms = m - TP; sirow = 128 * 4096 + ((ms >> 5) * 8 + h) * 32 + (ms & 31); }
        const uint2 vq = *(const uint2*)(SI + (size_t)sirow * 384 + 192 + cq);
        const uint2 gg = *(const uint2*)(Gb + e);
        const float4 lw = *(const float4*)(p.ln_w + h * 64 + cq), lb = *(const float4*)(p.ln_b + h * 64 + cq);
        const float o0 = (d0 * rstd * lw.x + lb.x + rkv * bflo(vq.x)) * bflo(gg.x);
        const float o1 = (d1 * rstd * lw.y + lb.y + rkv * bfhi(vq.x)) * bfhi(gg.x);
        const float o2 = (d2 * rstd * lw.z + lb.z + rkv * bflo(vq.y)) * bflo(gg.y);
        const float o3 = (d3 * rstd * lw.w + lb.w + rkv * bfhi(vq.y)) * bfhi(gg.y);
        *(uint2*)(ya + e) = pk4(o0, o1, o2, o3);
    }
}

constexpr int KLD = 136, VLD = 72;
__device__ __forceinline__ void attn_item(const u16* __restrict__ Q, int nq, const u16* __restrict__ K, const u16* __restrict__ Vt, int ldv, int nkt,
                          int lastvalid, u16* __restrict__ O, float lam, const float* __restrict__ subln, unsigned char* smem) {
    u16* sK = (u16*)smem;
    u16* sV = (u16*)(smem + 2 * 64 * KLD * 2);
    float* ex = (float*)smem;
    const int tid = threadIdx.x, lane = tid & 63, wid = tid >> 6, l16 = lane & 15, g = lane >> 4;
    const int n = wid >> 1, qh = wid & 1;
    const bool active = (qh * 32) < nq;
    bf16x8 qf[2][2];
#pragma unroll
    for (int qt = 0; qt < 2; ++qt)
#pragma unroll
        for (int s = 0; s < 2; ++s) {
            const int row = qh * 32 + qt * 16 + l16;
            uint4 v = make_uint4(0, 0, 0, 0);
            if (row < nq) v = *(const uint4*)(Q + (row * 512 + n * 64 + s * 32 + g * 8));
            qf[qt][s] = as_frag(v);
        }
    f32x4 o[2][8];
#pragma unroll
    for (int qt = 0; qt < 2; ++qt)
#pragma unroll
        for (int et = 0; et < 8; ++et) o[qt][et] = (f32x4){0.f, 0.f, 0.f, 0.f};
    float mrow[2] = {-1e30f, -1e30f}, lrow[2] = {0.f, 0.f};
    uint4 kr0, kr1, kr2, kr3, vr0, vr1, vr2, vr3;
    const int krow = tid >> 4, kch = (tid & 15) * 8;
    const int vrow = tid >> 3, vch = (tid & 7) * 8;
    const int ko_ = krow * 512 + kch;
    const int vo_ = vrow * ldv + vch;
#define A_LOAD(key0)                                                      \
    kr0 = *(const uint4*)(K + (ko_ + ((key0) + 0) * 512));                \
    kr1 = *(const uint4*)(K + (ko_ + ((key0) + 16) * 512));               \
    kr2 = *(const uint4*)(K + (ko_ + ((key0) + 32) * 512));               \
    kr3 = *(const uint4*)(K + (ko_ + ((key0) + 48) * 512));               \
    vr0 = *(const uint4*)(Vt + (vo_ + (key0)));                           \
    vr1 = *(const uint4*)(Vt + (vo_ + 32 * ldv + (key0)));                \
    vr2 = *(const uint4*)(Vt + (vo_ + 64 * ldv + (key0)));                \
    vr3 = *(const uint4*)(Vt + (vo_ + 96 * ldv + (key0)));
#define A_STORE(nb)                                                       \
    *(uint4*)(sK + (nb) * 64 * KLD + (krow + 0) * KLD + kch) = kr0;       \
    *(uint4*)(sK + (nb) * 64 * KLD + (krow + 16) * KLD + kch) = kr1;      \
    *(uint4*)(sK + (nb) * 64 * KLD + (krow + 32) * KLD + kch) = kr2;      \
    *(uint4*)(sK + (nb) * 64 * KLD + (krow + 48) * KLD + kch) = kr3;      \
    *(uint4*)(sV + (nb) * 128 * VLD + (vrow + 0) * VLD + vch) = vr0;      \
    *(uint4*)(sV + (nb) * 128 * VLD + (vrow + 32) * VLD + vch) = vr1;     \
    *(uint4*)(sV + (nb) * 128 * VLD + (vrow + 64) * VLD + vch) = vr2;     \
    *(uint4*)(sV + (nb) * 128 * VLD + (vrow + 96) * VLD + vch) = vr3;
    A_LOAD(0)
    A_STORE(0)
    __syncthreads();
    constexpr float SC = 0.125f * 1.4426950408889634f;
    for (int kt = 0; kt < nkt; ++kt) {
        const int buf = kt & 1;
        if (kt + 1 < nkt) { A_LOAD((kt + 1) * 64) }
        __builtin_amdgcn_sched_barrier(0);
        if (active) {
            const int valid = (kt == nkt - 1) ? lastvalid : 64;
            const u16* cK = sK + buf * 64 * KLD + l16 * KLD + n * 64 + g * 8;
            const u16* cV = sV + buf * 128 * VLD + l16 * VLD + g * 4;
            f32x4 s[4][2];
#pragma unroll
            for (int k16 = 0; k16 < 4; ++k16) {
                const bf16x8 kf0 = *(const bf16x8*)(cK + k16 * 16 * KLD);
                const bf16x8 kf1 = *(const bf16x8*)(cK + k16 * 16 * KLD + 32);
#pragma unroll
                for (int qt = 0; qt < 2; ++qt) {
                    f32x4 z = {0.f, 0.f, 0.f, 0.f};
                    z = MFMA(kf0, qf[qt][0], z);
                    s[k16][qt] = MFMA(kf1, qf[qt][1], z);
                }
            }
            bf16x8 pf[2][2];
#pragma unroll
            for (int qt = 0; qt < 2; ++qt) {
                float mx = -1e30f;
#pragma unroll
                for (int k16 = 0; k16 < 4; ++k16)
#pragma unroll
                    for (int r = 0; r < 4; ++r) {
                        float v = s[k16][qt][r] * SC;
                        if (k16 * 16 >= valid) v = -1e30f;
                        s[k16][qt][r] = v;
                        mx = fmaxf(mx, v);
                    }
                mx = fmaxf(mx, __shfl_xor(mx, 16));
                mx = fmaxf(mx, __shfl_xor(mx, 32));
                const float mnew = fmaxf(mrow[qt], mx);
                const float alpha = __builtin_amdgcn_exp2f(mrow[qt] - mnew);
                mrow[qt] = mnew;
                float psum = 0.f;
#pragma unroll
                for (int k16 = 0; k16 < 4; ++k16)
#pragma unroll
                    for (int r = 0; r < 4; ++r) {
                        const float pv = __builtin_amdgcn_exp2f(s[k16][qt][r] - mnew);
                        s[k16][qt][r] = pv;
                        psum += pv;
                    }
                lrow[qt] = lrow[qt] * alpha + psum;
#pragma unroll
                for (int et = 0; et < 8; ++et) {
                    o[qt][et][0] *= alpha; o[qt][et][1] *= alpha; o[qt][et][2] *= alpha; o[qt][et][3] *= alpha;
                }
#pragma unroll
                for (int kb = 0; kb < 2; ++kb)
                    pf[qt][kb] = as_frag(make_uint4(pk2(s[2 * kb][qt][0], s[2 * kb][qt][1]), pk2(s[2 * kb][qt][2], s[2 * kb][qt][3]),
                                                    pk2(s[2 * kb + 1][qt][0], s[2 * kb + 1][qt][1]), pk2(s[2 * kb + 1][qt][2], s[2 * kb + 1][qt][3])));
            }
#pragma unroll
            for (int et = 0; et < 8; ++et)
#pragma unroll
                for (int kb = 0; kb < 2; ++kb) {
                    const uint2 lo = *(const uint2*)(cV + et * 16 * VLD + kb * 32);
                    const uint2 hi = *(const uint2*)(cV + et * 16 * VLD + kb * 32 + 16);
                    const bf16x8 vf = as_frag(make_uint4(lo.x, lo.y, hi.x, hi.y));
#pragma unroll
                    for (int qt = 0; qt < 2; ++qt) o[qt][et] = MFMA(vf, pf[qt][kb], o[qt][et]);
                }
        }
        __builtin_amdgcn_sched_barrier(0);
        if (kt + 1 < nkt) { A_STORE(buf ^ 1) }
        __syncthreads();
    }
    float inv[2];
#pragma unroll
    for (int qt = 0; qt < 2; ++qt) {
        const float l = red_g(lrow[qt]);
        inv[qt] = 1.f / fmaxf(l, 1e-30f);
    }
    if (active && n == 1) {
#pragma unroll
        for (int qt = 0; qt < 2; ++qt)
#pragma unroll
            for (int et = 0; et < 8; ++et) {
                const f32x4 v = o[qt][et];
                *(float4*)(ex + (qh * 32 + qt * 16 + l16) * 132 + et * 16 + g * 4) =
                    make_float4(v[0] * inv[qt], v[1] * inv[qt], v[2] * inv[qt], v[3] * inv[qt]);
            }
    }
    __syncthreads();
    if (active && n == 0) {
#pragma unroll
        for (int qt = 0; qt < 2; ++qt) {
            const int row = qh * 32 + qt * 16 + l16;
            float ss = 0.f;
#pragma unroll
            for (int et = 0; et < 8; ++et) {
                const float4 o2 = *(const float4*)(ex + row * 132 + et * 16 + g * 4);
                f32x4 v = o[qt][et];
                v[0] = v[0] * inv[qt] - lam * o2.x;
                v[1] = v[1] * inv[qt] - lam * o2.y;
                v[2] = v[2] * inv[qt] - lam * o2.z;
                v[3] = v[3] * inv[qt] - lam * o2.w;
                o[qt][et] = v;
                ss += v[0] * v[0] + v[1] * v[1] + v[2] * v[2] + v[3] * v[3];
            }
            ss = red_g(ss);
            const float rn = rsqrtf(ss * (1.f / 128.f) + EPS) * 0.8f;
            if (row < nq) {
#pragma unroll
                for (int et = 0; et < 8; ++et) {
                    const float4 sl = *(const float4*)(subln + et * 16 + g * 4);
                    const f32x4 v = o[qt][et];
                    *(uint2*)(O + (row * 512 + et * 16 + g * 4)) = pk4(v[0] * rn * sl.x, v[1] * rn * sl.y, v[2] * rn * sl.z, v[3] * rn * sl.w);
                }
            }
        }
    }
    __syncthreads();
}

__device__ __forceinline__ void phase3(const Params& p, unsigned char* smem) {
    unsigned char* ws = p.ws;
    int* s_item = (int*)(smem + LDS_BYTES - 16);
    unsigned* ctr = (unsigned*)(ws + O_SCAL) + 1;
    const float lam = ((const float*)(ws + O_SCAL))[0];
    const u16* SI = (const u16*)(ws + O_SI);
    const u16* qb = (const u16*)(ws + O_QB);
    const u16* kP = (const u16*)(ws + O_KP);
    const u16* kS = (const u16*)(ws + O_KS);
    const u16* vtP = (const u16*)(ws + O_VTP);
    const u16* vtS = (const u16*)(ws + O_VTS);
    u16* ob = (u16*)(ws + O_OB);
    int stage = 0, sidx = blockIdx.x;
    constexpr int SCAN_BASE = 100000, DONE = 1 << 30;
    for (;;) {
        if (threadIdx.x == 0) {
            int it;
            if (stage == 0) it = (sidx < 768) ? SCAN_BASE + sidx : -2;
            else {
                const int x = blockIdx.x & 7;
                const int i = (int)atomicAdd(ctr + 16 + x, 1u);
                if (i < 512) it = ((63 - (i >> 3)) << 6) | (x + 8 * (i & 7));
                else if (i < 528) it = 4096 + (x + 8 * (i - 512));
                else it = DONE;
            }
            *s_item = it;
        }
        __syncthreads();
        const int item = __builtin_amdgcn_readfirstlane(*s_item);
        __syncthreads();
        if (item == DONE) break;
        if (item == -2) {
            asm volatile("s_waitcnt vmcnt(0) lgkmcnt(0)" ::: "memory");
            cg::this_grid().sync();
            stage = 1;
            ln_pass(p);
            continue;
        }
        if (item >= SCAN_BASE) {
            sidx += gridDim.x;
            const int sc = item - SCAN_BASE;
            const u16* si; int nch; const float* s0; float* sout; int m0, h, half;
            if (sc < 256) {
                const int chain = sc >> 1;
                half = sc & 1; h = chain & 7;
                si = SI + (size_t)chain * 4096 * 384; nch = 256; s0 = nullptr;
                sout = p.out + OFF_WP + (size_t)chain * 4096; m0 = (chain >> 3) * 4096;
            } else {
                const int t2 = sc - 256, chain = t2 >> 1;
                half = t2 & 1; h = chain & 7;
                si = SI + ((size_t)128 * 4096 + (size_t)chain * 32) * 384; nch = 2; s0 = p.state_wkv + (size_t)chain * 4096;
                sout = p.out + OFF_WS + (size_t)chain * 4096; m0 = TP + (chain >> 3) * 32;
            }
            scan_item(p, si, nch, s0, sout, m0, h, half, smem);
        } else {
            const u16 *Q, *K, *Vt; u16* O; int nq, ldv, nkt, lastvalid;
            if (item < 4096) {
                const int c = item >> 6, bh = item & 63, b = bh >> 2, h = bh & 3;
                const size_t m0 = (size_t)b * 4096 + (size_t)c * 64;
                Q = qb + m0 * 512 + h * 128; nq = 64; K = kP + (size_t)b * 4096 * 512 + h * 128;
                Vt = vtP + ((size_t)b * 512 + h * 128) * 4096; ldv = 4096; nkt = c + 1; lastvalid = 64; O = ob + m0 * 512 + h * 128;
            } else {
                const int idx = item - 4096;
                const int b = idx >> 2, h = idx & 3;
                const size_t m0 = (size_t)TP + (size_t)b * 32;
                Q = qb + m0 * 512 + h * 128; nq = 32; K = kS + (size_t)b * LKS * 512 + h * 128;
                Vt = vtS + ((size_t)b * 512 + h * 128) * LKS; ldv = LKS; nkt = 17; lastvalid = 32; O = ob + m0 * 512 + h * 128;
            }
            attn_item(Q, nq, K, Vt, ldv, nkt, lastvalid, O, lam, p.subln, smem);
        }
    }
}

__device__ __forceinline__ void phase4(const Params& p, unsigned char* smem) {
    unsigned char* ws = p.ws;
    const u16* ya = (const u16*)(ws + O_YA);
    const u16* ob = (const u16*)(ws + O_OB);
    const u16* Wa = (const u16*)(ws + O_WOA);
    const u16* Wb = (const u16*)(ws + O_WOB);
    const u16* gate = (const u16*)p.out;
    u16* mix = (u16*)(ws + O_MIX);
    const int tid = threadIdx.x, lane = tid & 63, wid = tid >> 6, wm = wid >> 1, wn = wid & 1, l16 = lane & 15, g = lane >> 4;
    constexpr int NT = 8;
    for (int t = blockIdx.x; t < 520 * NT; t += gridDim.x) {
        int mtile, ntile;
        tile_map(t, NT, mtile, ntile);
        const int m0 = mtile * 128, n0 = ntile * 128;
        f32x4 acc[4][4], acc2[4][4];
        zero_acc(acc);
        zero_acc(acc2);
        gemm_loop(ya + (size_t)m0 * 512, 512, Wa + (size_t)n0 * 512, 512, 8, (u16*)smem, acc);
        gemm_loop(ob + (size_t)m0 * 512, 512, Wb + (size_t)n0 * 512, 512, 8, (u16*)smem, acc2);
#pragma unroll
        for (int mt = 0; mt < 4; ++mt) {
            const int m = m0 + wm * 64 + mt * 16 + l16;
#pragma unroll
            for (int nt = 0; nt < 4; ++nt) {
                const int n = n0 + wn * 64 + nt * 16 + g * 4;
                const uint2 ga = *(const uint2*)(gate + (size_t)m * 2048 + n);
                const uint2 gb = *(const uint2*)(gate + (size_t)m * 2048 + 1024 + n);
                const f32x4 a = acc[nt][mt], b = acc2[nt][mt];
                *(uint2*)(mix + (size_t)m * 1024 + n) =
                    pk4(bflo(ga.x) * a[0] + bflo(gb.x) * b[0], bfhi(ga.x) * a[1] + bfhi(gb.x) * b[1],
                        bflo(ga.y) * a[2] + bflo(gb.y) * b[2], bfhi(ga.y) * a[3] + bfhi(gb.y) * b[3]);
            }
        }
    }
}

__device__ __forceinline__ void gemm_rowss(const u16* A, int K, const u16* W, u16* outb, float* ssq, unsigned char* smem) {
    const int tid = threadIdx.x, lane = tid & 63, wid = tid >> 6, wm = wid >> 1, wn = wid & 1, l16 = lane & 15, g = lane >> 4;
    constexpr int NT = 8;
    for (int t = blockIdx.x; t < 520 * NT; t += gridDim.x) {
        int mtile, ntile;
        tile_map(t, NT, mtile, ntile);
        const int m0 = mtile * 128, n0 = ntile * 128;
        f32x4 acc[4][4];
        zero_acc(acc);
        gemm_loop(A + (size_t)m0 * K, K, W + (size_t)n0 * K, K, K / 64, (u16*)smem, acc);
#pragma unroll
        for (int mt = 0; mt < 4; ++mt) {
            const int m = m0 + wm * 64 + mt * 16 + l16;
#pragma unroll
            for (int nt = 0; nt < 4; ++nt) {
                const int n = n0 + wn * 64 + nt * 16 + g * 4;
                const f32x4 a = acc[nt][mt];
                *(uint2*)(outb + (size_t)m * 1024 + n) = pk4(a[0], a[1], a[2], a[3]);
            }
        }
    }
}

__device__ __forceinline__ float sum16(const float* q) {
    const float4 a = *(const float4*)q, b = *(const float4*)(q + 4), c = *(const float4*)(q + 8), d = *(const float4*)(q + 12);
    return ((a.x + a.y) + (a.z + a.w)) + ((b.x + b.y) + (b.z + b.w)) + (((c.x + c.y) + (c.z + c.w)) + ((d.x + d.y) + (d.z + d.w)));
}
__device__ __forceinline__ void phase6(const Params& p) {
    unsigned char* ws = p.ws;
    const u16* m2 = (const u16*)(ws + O_M2);
    u16* x1b = (u16*)(ws + O_X1B);
    float* rs3 = (float*)(ws + O_RS3);
    const int lane = threadIdx.x & 63, wid = threadIdx.x >> 6;
    for (int m = blockIdx.x * 4 + wid; m < T; m += gridDim.x * 4) {
        const float* xr = (m < TP) ? p.x_prompt + (size_t)m * 1024 : p.x_sample + (size_t)(m - TP) * 1024;
        uint2 mvv[4];
        float s2 = 0.f;
#pragma unroll
        for (int i = 0; i < 4; ++i) {
            mvv[i] = *(const uint2*)(m2 + (size_t)m * 1024 + i * 256 + lane * 4);
            const float a = bflo(mvv[i].x), b = bfhi(mvv[i].x), c = bflo(mvv[i].y), d = bfhi(mvv[i].y);
            s2 += a * a + b * b + c * c + d * d;
        }
        s2 = wave_sum(s2);
        const float rs = rsqrtf(s2 * (1.f / 1024.f) + EPS);
        float ss = 0.f;
#pragma unroll
        for (int i = 0; i < 4; ++i) {
            const int col = i * 256 + lane * 4;
            const float4 xv = *(const float4*)(xr + col);
            const uint2 mv = mvv[i];
            const float4 gp = *(const float4*)(p.n_mix_post + col);
            float4 r;
            r.x = xv.x + bflo(mv.x) * rs * gp.x;
            r.y = xv.y + bfhi(mv.x) * rs * gp.y;
            r.z = xv.z + bflo(mv.y) * rs * gp.z;
            r.w = xv.w + bfhi(mv.y) * rs * gp.w;
            ss += r.x * r.x + r.y * r.y + r.z * r.z + r.w * r.w;
            *(float4*)(p.out + (size_t)m * 1024 + col) = r;
            *(uint2*)(x1b + (size_t)m * 1024 + col) = pk4(r.x, r.y, r.z, r.w);
        }
        ss = wave_sum(ss);
        if (lane == 0) rs3[m] = rsqrtf(ss * (1.f / 1024.f) + EPS);
    }
}

__device__ __forceinline__ void phase7(const Params& p, unsigned char* smem) {
    unsigned char* ws = p.ws;
    const u16* x1b = (const u16*)(ws + O_X1B);
    const u16* W = (const u16*)(ws + O_WFI);
    const float* rs3 = (const float*)(ws + O_RS3);
    u16* hb = (u16*)(ws + O_HB);
    const int tid = threadIdx.x, lane = tid & 63, wid = tid >> 6, wm = wid >> 1, wn = wid & 1, l16 = lane & 15, g = lane >> 4;
    constexpr int NT = 44;
    for (int t = blockIdx.x; t < 520 * NT; t += gridDim.x) {
        int mtile, ntile;
        tile_map(t, NT, mtile, ntile);
        const int m0 = mtile * 128, n0 = ntile * 128;
        f32x4 acc[4][4];
        zero_acc(acc);
        gemm_loop(x1b + (size_t)m0 * 1024, 1024, W + (size_t)n0 * 1024, 1024, 16, (u16*)smem, acc);
#pragma unroll
        for (int mt = 0; mt < 4; ++mt) {
            const int m = m0 + wm * 64 + mt * 16 + l16;
            const float rs = rs3[m];
#pragma unroll
            for (int pr = 0; pr < 2; ++pr) {
                const f32x4 ug = acc[2 * pr][mt], uv = acc[2 * pr + 1][mt];
                const int j = ((n0 + wn * 64) >> 5) * 16 + pr * 16 + g * 4;
                float hv[4];
#pragma unroll
                for (int r = 0; r < 4; ++r) {
                    const float a = ug[r] * rs, b = uv[r] * rs;
                    hv[r] = a * sigmoidf_(a) * b;
                }
                *(uint2*)(hb + (size_t)m * 2816 + j) = pk4(hv[0], hv[1], hv[2], hv[3]);
            }
        }
    }
}

__device__ __forceinline__ void phase9(const Params& p) {
    unsigned char* ws = p.ws;
    const u16* fb = (const u16*)(ws + O_FB);
    const int lane = threadIdx.x & 63, wid = threadIdx.x >> 6;
    for (int m = blockIdx.x * 4 + wid; m < T; m += gridDim.x * 4) {
        uint2 fvv[4];
        float s2 = 0.f;
#pragma unroll
        for (int i = 0; i < 4; ++i) {
            fvv[i] = *(const uint2*)(fb + (size_t)m * 1024 + i * 256 + lane * 4);
            const float a = bflo(fvv[i].x), b = bfhi(fvv[i].x), c = bflo(fvv[i].y), d = bfhi(fvv[i].y);
            s2 += a * a + b * b + c * c + d * d;
        }
        s2 = wave_sum(s2);
        const float rs = rsqrtf(s2 * (1.f / 1024.f) + EPS);
#pragma unroll
        for (int i = 0; i < 4; ++i) {
            const int col = i * 256 + lane * 4;
            float4 r = *(const float4*)(p.out + (size_t)m * 1024 + col);
            const uint2 fv = fvv[i];
            const float4 gp = *(const float4*)(p.n_ffn_post + col);
            r.x += bflo(fv.x) * rs * gp.x;
            r.y += bfhi(fv.x) * rs * gp.y;
            r.z += bflo(fv.y) * rs * gp.z;
            r.w += bfhi(fv.y) * rs * gp.w;
            *(float4*)(p.out + (size_t)m * 1024 + col) = r;
        }
    }
}

__global__ void __launch_bounds__(256, 2) mega(Params p) {
    extern __shared__ __attribute__((aligned(16))) unsigned char smem[];
    cg::grid_group grid = cg::this_grid();
#define IN(k) (p.ph_lo <= (k) && (k) < p.ph_hi)
#define SEAM(k) if (IN(k) && IN((k) + 1)) { asm volatile("s_waitcnt vmcnt(0) lgkmcnt(0)" ::: "memory"); grid.sync(); }
    unsigned char* ws = p.ws;
    if (IN(0)) phase0(p, smem);
    SEAM(0)
    if (IN(1)) phase1(p, smem);
    SEAM(1)
    if (IN(2)) phase2(p, smem);
    SEAM(2)
    if (IN(3)) phase3(p, smem);
    SEAM(3)
    if (IN(5)) phase4(p, smem);
    SEAM(5)
    if (IN(6)) gemm_rowss((const u16*)(ws + O_MIX), 1024, (const u16*)(ws + O_WO), (u16*)(ws + O_M2), (float*)(ws + O_SS2), smem);
    SEAM(6)
    if (IN(7)) phase6(p);
    SEAM(7)
    if (IN(8)) phase7(p, smem);
    SEAM(8)
    if (IN(9)) gemm_rowss((const u16*)(ws + O_HB), 2816, (const u16*)(ws + O_WFO), (u16*)(ws + O_FB), (float*)(ws + O_SS4), smem);
    SEAM(9)
    if (IN(10)) phase9(p);
}

extern "C" void kernel_launch(void* const* d_in, const int* in_sizes, int n_in, void* d_out, int out_size, void* d_ws, size_t ws_size,
                              hipStream_t stream) {
    static int grid_blocks = 0;
    if (!grid_blocks) {
        int dev = 0, cus = 0, per_cu = 0;
        hipGetDevice(&dev);
        hipDeviceGetAttribute(&cus, hipDeviceAttributeMultiprocessorCount, dev);
        hipFuncSetAttribute((const void*)mega, hipFuncAttributeMaxDynamicSharedMemorySize, LDS_BYTES);
        hipOccupancyMaxActiveBlocksPerMultiprocessor(&per_cu, (const void*)mega, 256, LDS_BYTES);
        if (per_cu < 1) per_cu = 1;
        if (per_cu > 2) per_cu = 2;
        grid_blocks = cus * per_cu;
        if (ws_size < WS_END) fprintf(stderr, "kernel_launch: workspace too small: %zu < %zu\n", ws_size, (size_t)WS_END);
    }
    Params p{};
    const float** pp = (const float**)&p;
    for (int i = 0; i < 33; ++i) pp[i] = (const float*)d_in[i];
    p.out = (float*)d_out;
    p.ws = (unsigned char*)d_ws;
#ifndef MULTI_LAUNCH
    p.ph_lo = 0;
    p.ph_hi = 11;
    void* args[] = {&p};
    hipError_t e = hipLaunchCooperativeKernel((const void*)mega, dim3(grid_blocks), dim3(256), args, LDS_BYTES, stream);
    if (e != hipSuccess) fprintf(stderr, "cooperative launch failed: %s (grid %d)\n", hipGetErrorString(e), grid_blocks);
#else
    for (int k = 0; k < 11; ++k) {
        p.ph_lo = k;
        p.ph_hi = k + 1;
        hipLaunchKernelGGL(mega, dim3(grid_blocks), dim3(256), LDS_BYTES, stream, p);
    }
#endif
}
```

```cpp
#include <hip/hip_runtime.h>
#include <hip/hip_cooperative_groups.h>
#include <cstdio>
#include <cstdint>
namespace cg = cooperative_groups;

typedef unsigned short u16;
typedef __attribute__((ext_vector_type(8))) short bf16x8;
typedef __attribute__((ext_vector_type(4))) float f32x4;

constexpr int TP = 65536, TS = 1024, T = TP + TS;
constexpr int ACOLS = 1824;
constexpr int LKS = 1088;
constexpr int LDS_BYTES = 73728;
constexpr float EPS = 1e-6f;

constexpr size_t OFF_YS = 67108864ull, OFF_KP = 68157440ull, OFF_VP = 101711872ull, OFF_WP = 135266304ull,
                 OFF_SHP = 135790592ull, OFF_KS = 135819776ull, OFF_VS = 136344064ull, OFF_WS = 136868352ull,
                 OFF_SHS = 137916928ull;

constexpr size_t al(size_t x) { return (x + 255) & ~(size_t)255; }
constexpr size_t O_WIN = 0;
constexpr size_t O_WOA = O_WIN + al(5504ull * 1024 * 2);
constexpr size_t O_WOB = O_WOA + al(1024ull * 512 * 2);
constexpr size_t O_WO = O_WOB + al(1024ull * 512 * 2);
constexpr size_t O_WFI = O_WO + al(1024ull * 1024 * 2);
constexpr size_t O_WFO = O_WFI + al(5632ull * 1024 * 2);
constexpr size_t O_W2 = O_WFO + al(1024ull * 2816 * 2);
constexpr size_t O_A2 = O_W2 + al(512 * 64 * 2);
constexpr size_t O_G2 = O_A2 + al(512 * 64 * 2);
constexpr size_t O_RS1 = O_G2 + al(512 * 160 * 2);
constexpr size_t O_SS2 = O_RS1 + al((size_t)T * 4);
constexpr size_t O_SS4 = O_SS2 + al((size_t)T * 16 * 4);
constexpr size_t O_RS3 = O_SS4 + al((size_t)T * 16 * 4);
constexpr size_t O_RK = O_RS3 + al((size_t)T * 4);
constexpr size_t O_SCAL = O_RK + al((size_t)T * 8 * 16);
constexpr size_t O_REGA = O_SCAL + 256;
constexpr size_t O_CA = O_REGA;
constexpr size_t O_YA = O_REGA;
constexpr size_t O_OB = O_YA + al((size_t)T * 512 * 2);
constexpr size_t O_YRAW = O_OB + al((size_t)T * 512 * 2);
constexpr size_t O_HB = O_REGA;
constexpr size_t O_REGB = O_REGA + al((size_t)(T + 48) * 1824 * 2);
constexpr size_t O_QB = O_REGB;
constexpr size_t O_KP = O_QB + al((size_t)T * 512 * 2);
constexpr size_t O_KS = O_KP + al((size_t)TP * 512 * 2);
constexpr size_t O_VTP = O_KS + al(32ull * LKS * 512 * 2);
constexpr size_t O_VTS = O_VTP + al(16ull * 512 * 4096 * 2);
constexpr size_t O_REGC = O_VTS + al(32ull * 512 * LKS * 2);
constexpr size_t O_GATE = O_REGB;
static_assert(O_GATE + (size_t)T * 2048 * 2 <= O_REGC, "gate overlaps region C");
constexpr size_t O_SI = O_REGC;
constexpr size_t O_G = O_SI + al((size_t)T * 8 * 384 * 2);
constexpr size_t O_XB = O_REGC;
constexpr size_t O_MIX = O_REGC;
constexpr size_t O_M2 = O_MIX + al((size_t)T * 1024 * 2);
constexpr size_t O_X1B = O_M2 + al((size_t)T * 1024 * 2);
constexpr size_t O_FB = O_REGC;
constexpr size_t WS_END = O_G + al((size_t)T * 512 * 2);
static_assert(O_HB + (size_t)T * 2816 * 2 <= O_REGC, "hb overlaps region C");
static_assert(O_YRAW + (size_t)T * 512 * 2 <= O_REGB, "yraw overlaps region B");
static_assert(O_X1B + (size_t)T * 1024 * 2 <= WS_END, "x1b beyond end");
static_assert(WS_END <= 1073741824ull, "workspace too large");

struct Params {
    const float *x_prompt, *x_sample, *cache_k, *cache_v, *state_wkv, *state_shift;
    const float *n_mix_pre, *n_mix_post, *n_ffn_pre, *n_ffn_post, *w_in, *b_gate;
    const float *mu, *w0, *w2, *a0, *a2, *g2, *k_k, *k_a, *r_k, *ln_w, *ln_b;
    const float *lq1, *lk1, *lq2, *lk2, *subln, *w_out_a, *w_out_b, *w_o, *w_ffn_in, *w_ffn_out;
    float* out;
    unsigned char* ws;
    int ph_lo, ph_hi;
};

__device__ __forceinline__ u16 f2bf(float f) {
    unsigned u = __float_as_uint(f);
    u += 0x7fffu + ((u >> 16) & 1u);
    return (u16)(u >> 16);
}
__device__ __forceinline__ unsigned pk2(float a, float b) { return (unsigned)f2bf(a) | ((unsigned)f2bf(b) << 16); }
__device__ __forceinline__ float bflo(unsigned u) { return __uint_as_float(u << 16); }
__device__ __forceinline__ float bfhi(unsigned u) { return __uint_as_float(u & 0xffff0000u); }
__device__ __forceinline__ uint2 pk4(float a, float b, float c, float d) { return make_uint2(pk2(a, b), pk2(c, d)); }
__device__ __forceinline__ float sigmoidf_(float x) { return 1.f / (1.f + __expf(-x)); }

template <int CTRL>
__device__ __forceinline__ float dppf(float x) {
    return __int_as_float(__builtin_amdgcn_update_dpp(0, __float_as_int(x), CTRL, 0xF, 0xF, true));
}
__device__ __forceinline__ float red8(float x) {
    x += dppf<0xB1>(x);
    x += dppf<0x4E>(x);
    x += dppf<0x141>(x);
    return x;
}
__device__ __forceinline__ float red16(float x) {
    x = red8(x);
    x += dppf<0x140>(x);
    return x;
}
__device__ __forceinline__ float red_g(float x) {
    x += __shfl_xor(x, 16);
    x += __shfl_xor(x, 32);
    return x;
}
__device__ __forceinline__ float wave_sum(float x) {
    x = red16(x);
    return red_g(x);
}
__device__ __forceinline__ bf16x8 as_frag(uint4 v) {
    union { uint4 u; bf16x8 f; } c;
    c.u = v;
    return c.f;
}
#define MFMA(a, b, c) __builtin_amdgcn_mfma_f32_16x16x32_bf16((a), (b), (c), 0, 0, 0)

constexpr int LDT = 72;
constexpr int STG = 128 * LDT;
__device__ __forceinline__ void gemm_loop(const u16* __restrict__ A, int lda, const u16* __restrict__ B, int ldb,
                                          int nkt, u16* smem, f32x4 (&acc)[4][4]) {
    const int tid = threadIdx.x, lane = tid & 63, wid = tid >> 6, wm = wid >> 1, wn = wid & 1, l16 = lane & 15, g = lane >> 4;
    const int lr = tid >> 3, lc = (tid & 7) * 8;
    u16* sA = smem;
    u16* sB = smem + 2 * STG;
    const u16* ap = A + (size_t)lr * lda + lc;
    const u16* bp = B + (size_t)lr * ldb + lc;
    uint4 ra0, ra1, ra2, ra3, rb0, rb1, rb2, rb3;
#define G_LOAD(ko)                                                   \
    ra0 = *(const uint4*)(ap + (ko));                                \
    ra1 = *(const uint4*)(ap + (size_t)32 * lda + (ko));             \
    ra2 = *(const uint4*)(ap + (size_t)64 * lda + (ko));             \
    ra3 = *(const uint4*)(ap + (size_t)96 * lda + (ko));             \
    rb0 = *(const uint4*)(bp + (ko));                                \
    rb1 = *(const uint4*)(bp + (size_t)32 * ldb + (ko));             \
    rb2 = *(const uint4*)(bp + (size_t)64 * ldb + (ko));             \
    rb3 = *(const uint4*)(bp + (size_t)96 * ldb + (ko));
#define G_STORE(bo)                                                  \
    *(uint4*)(sA + (bo) + (lr + 0) * LDT + lc) = ra0;                \
    *(uint4*)(sA + (bo) + (lr + 32) * LDT + lc) = ra1;               \
    *(uint4*)(sA + (bo) + (lr + 64) * LDT + lc) = ra2;               \
    *(uint4*)(sA + (bo) + (lr + 96) * LDT + lc) = ra3;               \
    *(uint4*)(sB + (bo) + (lr + 0) * LDT + lc) = rb0;                \
    *(uint4*)(sB + (bo) + (lr + 32) * LDT + lc) = rb1;               \
    *(uint4*)(sB + (bo) + (lr + 64) * LDT + lc) = rb2;               \
    *(uint4*)(sB + (bo) + (lr + 96) * LDT + lc) = rb3;
    G_LOAD(0)
    G_STORE(0)
    __syncthreads();
    for (int kt = 0; kt < nkt; ++kt) {
        const int buf = kt & 1;
        if (kt + 1 < nkt) { G_LOAD((kt + 1) * 64) }
        __builtin_amdgcn_sched_barrier(0);
        const u16* cA = sA + buf * STG + (wm * 64 + l16) * LDT + g * 8;
        const u16* cB = sB + buf * STG + (wn * 64 + l16) * LDT + g * 8;
#pragma unroll
        for (int ks = 0; ks < 2; ++ks) {
            bf16x8 xf[4], wf[4];
#pragma unroll
            for (int i = 0; i < 4; ++i) {
                xf[i] = *(const bf16x8*)(cA + i * 16 * LDT + ks * 32);
                wf[i] = *(const bf16x8*)(cB + i * 16 * LDT + ks * 32);
            }
#pragma unroll
            for (int nt = 0; nt < 4; ++nt)
#pragma unroll
                for (int mt = 0; mt < 4; ++mt) acc[nt][mt] = MFMA(wf[nt], xf[mt], acc[nt][mt]);
        }
        __builtin_amdgcn_sched_barrier(0);
        if (kt + 1 < nkt) { G_STORE((buf ^ 1) * STG) }
        __syncthreads();
    }
}
__device__ __forceinline__ void gemm_loop_xf32(const float* __restrict__ A, const u16* __restrict__ B, int ldb, int nkt, u16* smem,
                                               f32x4 (&acc)[4][4]) {
    const int tid = threadIdx.x, lane = tid & 63, wid = tid >> 6, wm = wid >> 1, wn = wid & 1, l16 = lane & 15, g = lane >> 4;
    const int lr = tid >> 3, lc = (tid & 7) * 8;
    u16* sA = smem;
    u16* sB = smem + 2 * STG;
    const float* ap = A + (size_t)lr * 1024 + lc;
    const u16* bp = B + (size_t)lr * ldb + lc;
    float4 fa0, fa1, fa2, fa3, fa4, fa5, fa6, fa7;
    uint4 rb0, rb1, rb2, rb3;
#define GX_LOAD(ko)                                                  \
    fa0 = *(const float4*)(ap + (ko));                               \
    fa1 = *(const float4*)(ap + (ko) + 4);                           \
    fa2 = *(const float4*)(ap + 32 * 1024 + (ko));                   \
    fa3 = *(const float4*)(ap + 32 * 1024 + (ko) + 4);               \
    fa4 = *(const float4*)(ap + 64 * 1024 + (ko));                   \
    fa5 = *(const float4*)(ap + 64 * 1024 + (ko) + 4);               \
    fa6 = *(const float4*)(ap + 96 * 1024 + (ko));                   \
    fa7 = *(const float4*)(ap + 96 * 1024 + (ko) + 4);               \
    rb0 = *(const uint4*)(bp + (ko));                                \
    rb1 = *(const uint4*)(bp + (size_t)32 * ldb + (ko));             \
    rb2 = *(const uint4*)(bp + (size_t)64 * ldb + (ko));             \
    rb3 = *(const uint4*)(bp + (size_t)96 * ldb + (ko));
#define PKF(a, b) make_uint4(pk2(a.x, a.y), pk2(a.z, a.w), pk2(b.x, b.y), pk2(b.z, b.w))
#define GX_STORE(bo)                                                 \
    *(uint4*)(sA + (bo) + (lr + 0) * LDT + lc) = PKF(fa0, fa1);      \
    *(uint4*)(sA + (bo) + (lr + 32) * LDT + lc) = PKF(fa2, fa3);     \
    *(uint4*)(sA + (bo) + (lr + 64) * LDT + lc) = PKF(fa4, fa5);     \
    *(uint4*)(sA + (bo) + (lr + 96) * LDT + lc) = PKF(fa6, fa7);     \
    *(uint4*)(sB + (bo) + (lr + 0) * LDT + lc) = rb0;                \
    *(uint4*)(sB + (bo) + (lr + 32) * LDT + lc) = rb1;               \
    *(uint4*)(sB + (bo) + (lr + 64) * LDT + lc) = rb2;               \
    *(uint4*)(sB + (bo) + (lr + 96) * LDT + lc) = rb3;
    GX_LOAD(0)
    GX_STORE(0)
    __syncthreads();
    for (int kt = 0; kt < nkt; ++kt) {
        const int buf = kt & 1;
        if (kt + 1 < nkt) { GX_LOAD((kt + 1) * 64) }
        __builtin_amdgcn_sched_barrier(0);
        const u16* cA = sA + buf * STG + (wm * 64 + l16) * LDT + g * 8;
        const u16* cB = sB + buf * STG + (wn * 64 + l16) * LDT + g * 8;
#pragma unroll
        for (int ks = 0; ks < 2; ++ks) {
            bf16x8 xf[4], wf[4];
#pragma unroll
            for (int i = 0; i < 4; ++i) {
                xf[i] = *(const bf16x8*)(cA + i * 16 * LDT + ks * 32);
                wf[i] = *(const bf16x8*)(cB + i * 16 * LDT + ks * 32);
            }
#pragma unroll
            for (int nt = 0; nt < 4; ++nt)
#pragma unroll
                for (int mt = 0; mt < 4; ++mt) acc[nt][mt] = MFMA(wf[nt], xf[mt], acc[nt][mt]);
        }
        __builtin_amdgcn_sched_barrier(0);
        if (kt + 1 < nkt) { GX_STORE((buf ^ 1) * STG) }
        __syncthreads();
    }
}
__device__ __forceinline__ void zero_acc(f32x4 (&acc)[4][4]) {
#pragma unroll
    for (int i = 0; i < 4; ++i)
#pragma unroll
        for (int j = 0; j < 4; ++j) acc[i][j] = (f32x4){0.f, 0.f, 0.f, 0.f};
}
__device__ __forceinline__ void tile_map(int t, int NT, int& mt, int& nt) {
    const int x = t & 7, u = t >> 3;
    const int gsz = 8 * NT;
    const int g = u / gsz;
    const int w = u - g * gsz;
    const int rows = (g < 8) ? 8 : 1;
    const int q = w / rows;
    mt = x * 65 + g * 8 + (w - q * rows);
    nt = q;
}

__device__ __forceinline__ void tr_tile(const float* __restrict__ in, int R, int C, int ldin, u16* __restrict__ out, int ldout,
                        const float* __restrict__ scale, int r0, int c0, int Cout, bool perm, float* tile) {
    const int tid = threadIdx.x;
    {
        const int tx = tid & 63, ty = tid >> 6;
        const int c = c0 + tx;
        for (int rr = ty; rr < 64; rr += 4) {
            const int r = r0 + rr;
            float v = 0.f;
            if (r < R && c < C) {
                v = in[(size_t)r * ldin + c];
                if (scale) v *= scale[r];
            }
            tile[rr * 65 + tx] = v;
        }
    }
    __syncthreads();
    {
        const int rch = (tid & 7) * 8;
#pragma unroll
        for (int pass = 0; pass < 2; ++pass) {
            const int cc = (tid >> 3) + pass * 32;
            const int c = c0 + cc;
            if (c < Cout && r0 + rch < R) {
                float v[8];
#pragma unroll
                for (int k = 0; k < 8; ++k) v[k] = tile[(rch + k) * 65 + cc];
                int orow = c;
                if (perm) {
                    const int type = c >= 2816 ? 1 : 0;
                    const int j = c - type * 2816;
                    orow = (j >> 4) * 32 + type * 16 + (j & 15);
                }
                uint4 o = make_uint4(pk2(v[0], v[1]), pk2(v[2], v[3]), pk2(v[4], v[5]), pk2(v[6], v[7]));
                *(uint4*)(out + (size_t)orow * ldout + r0 + rch) = o;
            }
        }
    }
    __syncthreads();
}

__device__ __forceinline__ void phase0(const Params& p, unsigned char* smem) {
    float* tile = (float*)smem;
    const int tid = threadIdx.x, lane = tid & 63, wid = tid >> 6;
    unsigned char* ws = p.ws;
    const int G = gridDim.x;
    for (int u = blockIdx.x; u < 8136; u += G) {
        const float* in;
        int R, C, Cout, ldout, tl;
        u16* out;
        const float* scale = nullptr;
        bool perm = false;
        if (u < 1376) { tl = u; in = p.w_in; R = 1024; C = 5408; Cout = 5504; out = (u16*)(ws + O_WIN); ldout = 1024; scale = p.n_mix_pre; }
        else if (u < 1504) { tl = u - 1376; in = p.w_out_a; R = 512; C = 1024; Cout = 1024; out = (u16*)(ws + O_WOA); ldout = 512; }
        else if (u < 1632) { tl = u - 1504; in = p.w_out_b; R = 512; C = 1024; Cout = 1024; out = (u16*)(ws + O_WOB); ldout = 512; }
        else if (u < 1888) { tl = u - 1632; in = p.w_o; R = 1024; C = 1024; Cout = 1024; out = (u16*)(ws + O_WO); ldout = 1024; }
        else if (u < 3296) { tl = u - 1888; in = p.w_ffn_in; R = 1024; C = 5632; Cout = 5632; out = (u16*)(ws + O_WFI); ldout = 1024; scale = p.n_ffn_pre; perm = true; }
        else if (u < 4000) { tl = u - 3296; in = p.w_ffn_out; R = 2816; C = 1024; Cout = 1024; out = (u16*)(ws + O_WFO); ldout = 2816; }
        else if (u < 4008) { tl = u - 4000; in = p.w2; R = 64; C = 512; Cout = 512; out = (u16*)(ws + O_W2); ldout = 64; }
        else if (u < 4016) { tl = u - 4008; in = p.a2; R = 64; C = 512; Cout = 512; out = (u16*)(ws + O_A2); ldout = 64; }
        else if (u < 4040) { tl = u - 4016; in = p.g2; R = 160; C = 512; Cout = 512; out = (u16*)(ws + O_G2); ldout = 160; }
        else {
            tl = u - 4040;
            const int b = tl >> 7;
            tl &= 127;
            in = p.cache_v + (size_t)b * 1024 * 512; R = 1024; C = 512; Cout = 512;
            out = (u16*)(ws + O_VTS) + (size_t)b * 512 * LKS; ldout = LKS;
        }
        const int ctiles = (Cout + 63) >> 6;
        const int rt = tl / ctiles, ct = tl - rt * ctiles;
        tr_tile(in, R, C, C, out, ldout, scale, rt * 64, ct * 64, Cout, perm, tile);
    }
    {
        u16* xb = (u16*)(ws + O_XB);
        float* rs1 = (float*)(ws + O_RS1);
        for (int m = blockIdx.x * 4 + wid; m < T; m += G * 4) {
            const float* xr = (m < TP) ? p.x_prompt + (size_t)m * 1024 : p.x_sample + (size_t)(m - TP) * 1024;
            float ss = 0.f;
#pragma unroll
            for (int i = 0; i < 4; ++i) {
                const float4 v = *(const float4*)(xr + i * 256 + lane * 4);
                ss += v.x * v.x + v.y * v.y + v.z * v.z + v.w * v.w;
                *(uint2*)(xb + (size_t)m * 1024 + i * 256 + lane * 4) = pk4(v.x, v.y, v.z, v.w);
            }
            ss = wave_sum(ss);
            if (lane == 0) rs1[m] = rsqrtf(ss * (1.f / 1024.f) + EPS);
        }
    }
    {
        u16* kS = (u16*)(ws + O_KS);
        const int n8 = 32 * 1024 * 64;
        for (int i = blockIdx.x * 256 + tid; i < n8; i += G * 256) {
            const int b = i >> 16, rem = i & 65535, key = rem >> 6, c8 = rem & 63;
            const float4 v0 = *(const float4*)(p.cache_k + (size_t)i * 8);
            const float4 v1 = *(const float4*)(p.cache_k + (size_t)i * 8 + 4);
            *(uint4*)(kS + ((size_t)b * LKS + key) * 512 + c8 * 8) =
                make_uint4(pk2(v0.x, v0.y), pk2(v0.z, v0.w), pk2(v1.x, v1.y), pk2(v1.z, v1.w));
        }
        for (int i = blockIdx.x * 256 + tid; i < 32 * 32 * 64; i += G * 256) {
            const int b = i >> 11, rem = i & 2047, row = rem >> 6, c8 = rem & 63;
            *(uint4*)(kS + ((size_t)b * LKS + 1056 + row) * 512 + c8 * 8) = make_uint4(0, 0, 0, 0);
        }
        u16* vtS = (u16*)(ws + O_VTS);
        for (int i = blockIdx.x * 256 + tid; i < 32 * 512 * 4; i += G * 256) {
            const int row = i >> 2, c8 = i & 3;
            *(uint4*)(vtS + (size_t)row * LKS + 1056 + c8 * 8) = make_uint4(0, 0, 0, 0);
        }
    }
    {
        u16* cA = (u16*)(ws + O_CA);
        for (int i = blockIdx.x * 256 + tid; i < 48 * ACOLS; i += G * 256) {
            const int s = i / ACOLS, c = i - s * ACOLS;
            float v = 0.f;
            size_t row;
            if (s < 16) row = (size_t)s * 4097;
            else { row = (size_t)16 * 4097 + (size_t)(s - 16) * 33; v = p.state_shift[(size_t)(s - 16) * ACOLS + c]; }
            cA[row * ACOLS + c] = f2bf(v);
        }
        if (blockIdx.x == 0 && tid == 0) {
            float d1 = 0.f, d2 = 0.f;
            for (int i = 0; i < 64; ++i) { d1 += p.lq1[i] * p.lk1[i]; d2 += p.lq2[i] * p.lk2[i]; }
            float* sc = (float*)(ws + O_SCAL);
            sc[0] = __expf(d1) - __expf(d2) + 0.2f;
            for (int i = 1; i < 32; ++i) ((unsigned*)sc)[i] = 0u;
        }
    }
}

__device__ __forceinline__ void phase1(const Params& p, unsigned char* smem) {
    unsigned char* ws = p.ws;
    const u16* xb = (const u16*)(ws + O_XB);
    const u16* W = (const u16*)(ws + O_WIN);
    const float* rs1 = (const float*)(ws + O_RS1);
    u16* cA = (u16*)(ws + O_CA);
    u16* qb = (u16*)(ws + O_QB);
    u16* kP = (u16*)(ws + O_KP);
    u16* kS = (u16*)(ws + O_KS);
    u16* vtP = (u16*)(ws + O_VTP);
    u16* vtS = (u16*)(ws + O_VTS);
    float* out = p.out;
    const int tid = threadIdx.x, lane = tid & 63, wid = tid >> 6, wm = wid >> 1, wn = wid & 1, l16 = lane & 15, g = lane >> 4;
    constexpr int NT = 43;
    u16* gate = (u16*)p.out;
    for (int t = blockIdx.x; t < 520 * NT; t += gridDim.x) {
        int mtile, ntile;
        tile_map(t, NT, mtile, ntile);
        const int m0 = mtile * 128, n0 = ntile * 128;
        f32x4 acc[4][4];
        zero_acc(acc);
        gemm_loop(xb + (size_t)m0 * 1024, 1024, W + (size_t)n0 * 1024, 1024, 16, (u16*)smem, acc);
#pragma unroll
        for (int mt = 0; mt < 4; ++mt) {
            const int m = m0 + wm * 64 + mt * 16 + l16;
            const float rs = rs1[m];
            const bool isP = m < TP;
            int seq, tt;
            if (isP) { seq = m >> 12; tt = m & 4095; }
            else { const int ms = m - TP; seq = 16 + (ms >> 5); tt = ms & 31; }
            const size_t carow = (size_t)m + seq + 1;
            const bool last = isP ? (tt == 4095) : (tt == 31);
#pragma unroll
            for (int nt = 0; nt < 4; ++nt) {
                const int n = n0 + wn * 64 + nt * 16 + g * 4;
                if (n >= 5408) continue;
                f32x4 v = acc[nt][mt];
                v[0] *= rs; v[1] *= rs; v[2] *= rs; v[3] *= rs;
                if (n < 1824) {
                    *(uint2*)(cA + carow * ACOLS + n) = pk4(v[0], v[1], v[2], v[3]);
                    if (last) {
                        float* so = isP ? out + OFF_SHP + (size_t)seq * ACOLS + n : out + OFF_SHS + (size_t)(seq - 16) * ACOLS + n;
                        *(float4*)so = make_float4(v[0], v[1], v[2], v[3]);
                    }
                } else if (n < 2336) {
                    *(uint2*)(qb + (size_t)m * 512 + (n - 1824)) = pk4(v[0], v[1], v[2], v[3]);
                } else if (n < 2848) {
                    const int c = n - 2336;
                    if (isP) {
                        *(uint2*)(kP + (size_t)m * 512 + c) = pk4(v[0], v[1], v[2], v[3]);
                        *(float4*)(out + OFF_KP + (size_t)m * 512 + c) = make_float4(v[0], v[1], v[2], v[3]);
                    } else {
                        *(uint2*)(kS + ((size_t)(seq - 16) * LKS + 1024 + tt) * 512 + c) = pk4(v[0], v[1], v[2], v[3]);
                        *(float4*)(out + OFF_KS + (size_t)(m - TP) * 512 + c) = make_float4(v[0], v[1], v[2], v[3]);
                    }
                } else if (n < 3360) {
                    const int c = n - 2848;
                    if (isP) {
                        *(float4*)(out + OFF_VP + (size_t)m * 512 + c) = make_float4(v[0], v[1], v[2], v[3]);
                        u16* d = vtP + ((size_t)seq * 512 + c) * 4096 + tt;
                        d[0] = f2bf(v[0]); d[4096] = f2bf(v[1]); d[2 * 4096] = f2bf(v[2]); d[3 * 4096] = f2bf(v[3]);
                    } else {
                        *(float4*)(out + OFF_VS + (size_t)(m - TP) * 512 + c) = make_float4(v[0], v[1], v[2], v[3]);
                        u16* d = vtS + ((size_t)(seq - 16) * 512 + c) * LKS + 1024 + tt;
                        d[0] = f2bf(v[0]); d[LKS] = f2bf(v[1]); d[2 * LKS] = f2bf(v[2]); d[3 * LKS] = f2bf(v[3]);
                    }
                } else {
                    const int c = n - 3360;
                    const float4 bg = *(const float4*)(p.b_gate + c);
                    *(uint2*)(gate + (size_t)m * 2048 + c) =
                        pk4(sigmoidf_(v[0] + bg.x), sigmoidf_(v[1] + bg.y), sigmoidf_(v[2] + bg.z), sigmoidf_(v[3] + bg.w));
                }
            }
        }
    }
}

__device__ __forceinline__ void lerp8(const u16* cur, const u16* prv, const float* mu, int col, float (&xs)[8]) {
    const uint4 cu = *(const uint4*)(cur + col);
    const uint4 pv = *(const uint4*)(prv + col);
    const float4 m0 = *(const float4*)(mu + col);
    const float4 m1 = *(const float4*)(mu + col + 4);
    const unsigned cw[4] = {cu.x, cu.y, cu.z, cu.w}, pw[4] = {pv.x, pv.y, pv.z, pv.w};
    const float mm[8] = {m0.x, m0.y, m0.z, m0.w, m1.x, m1.y, m1.z, m1.w};
#pragma unroll
    for (int i = 0; i < 4; ++i) {
        const float c0 = bflo(cw[i]), c1 = bfhi(cw[i]), p0 = bflo(pw[i]), p1 = bfhi(pw[i]);
        xs[2 * i] = c0 + (p0 - c0) * mm[2 * i];
        xs[2 * i + 1] = c1 + (p1 - c1) * mm[2 * i + 1];
    }
}
__device__ __forceinline__ void lerp4(const u16* cur, const u16* prv, const float* mu, int col, float (&xs)[4]) {
    const uint2 cu = *(const uint2*)(cur + col);
    const uint2 pv = *(const uint2*)(prv + col);
    const float4 m0 = *(const float4*)(mu + col);
    float c0 = bflo(cu.x), c1 = bfhi(cu.x), c2 = bflo(cu.y), c3 = bfhi(cu.y);
    xs[0] = c0 + (bflo(pv.x) - c0) * m0.x;
    xs[1] = c1 + (bfhi(pv.x) - c1) * m0.y;
    xs[2] = c2 + (bflo(pv.y) - c2) * m0.z;
    xs[3] = c3 + (bfhi(pv.y) - c3) * m0.w;
}
__device__ __forceinline__ void lerp4w(const uint2 cu, const uint2 pv, const float* mu, int col, float (&xs)[4]) {
    const float4 m0 = *(const float4*)(mu + col);
    const float c0 = bflo(cu.x), c1 = bfhi(cu.x), c2 = bflo(cu.y), c3 = bfhi(cu.y);
    xs[0] = c0 + (bflo(pv.x) - c0) * m0.x;
    xs[1] = c1 + (bfhi(pv.x) - c1) * m0.y;
    xs[2] = c2 + (bflo(pv.y) - c2) * m0.z;
    xs[3] = c3 + (bfhi(pv.y) - c3) * m0.w;
}
__device__ __forceinline__ bf16x8 packfrag(const float (&v)[8]) {
    return as_frag(make_uint4(pk2(v[0], v[1]), pk2(v[2], v[3]), pk2(v[4], v[5]), pk2(v[6], v[7])));
}

__device__ __forceinline__ void phase2(const Params& p, unsigned char* smem) {
    unsigned char* ws = p.ws;
    const u16* cA = (const u16*)(ws + O_CA);
    const u16* w2t = (const u16*)(ws + O_W2);
    const u16* a2t = (const u16*)(ws + O_A2);
    const u16* g2t = (const u16*)(ws + O_G2);
    u16* SI = (u16*)(ws + O_SI);
    u16* Gb = (u16*)(ws + O_G);
    float4* rk4 = (float4*)(ws + O_RK);
    const int tid = threadIdx.x, lane = tid & 63, wid = tid >> 6, l16 = lane & 15, g = lane >> 4;
    float* sp = (float*)smem;
    for (int i = tid; i < 1824; i += 256) sp[i] = p.mu[i];
    for (int i = tid; i < 512; i += 256) {
        sp[1824 + i] = p.w0[i]; sp[2336 + i] = p.a0[i]; sp[2848 + i] = p.k_k[i]; sp[3360 + i] = p.k_a[i]; sp[3872 + i] = p.r_k[i];
    }
    __syncthreads();
    const int NU = (T / 64) / (int)gridDim.x * (int)gridDim.x;
    const int NW = NU + (T / 64 - NU) * 8;
    for (int uu = blockIdx.x; uu < NW; uu += gridDim.x) {
        int u, h_lo, h_hi;
        if (uu < NU) { u = uu; h_lo = 0; h_hi = 8; }
        else { const int v = uu - NU; u = NU + (v >> 3); h_lo = v & 7; h_hi = h_lo + 1; }
        const int mw = u * 64 + wid * 16;
        const int m = mw + l16;
        const bool isP = mw < TP;
        int seq, tt;
        if (isP) { seq = m >> 12; tt = m & 4095; }
        else { const int ms = m - TP; seq = 16 + (ms >> 5); tt = ms & 31; }
        const u16* cur = cA + ((size_t)m + seq + 1) * ACOLS;
        const u16* prv = cur - ACOLS;
        bf16x8 xw[2], xa[2], xg[5];
#pragma unroll
        for (int s = 0; s < 9; ++s) {
            float xs[8];
            lerp8(cur, prv, sp, 1536 + s * 32 + g * 8, xs);
            if (s < 2) {
#pragma unroll
                for (int i = 0; i < 8; ++i) xs[i] = 1.f - 2.f / (__expf(2.f * xs[i]) + 1.f);
                xw[s] = packfrag(xs);
            } else if (s < 4) {
                xa[s - 2] = packfrag(xs);
            } else {
#pragma unroll
                for (int i = 0; i < 8; ++i) xs[i] = sigmoidf_(xs[i]);
                xg[s - 4] = packfrag(xs);
            }
        }
        bf16x8 nw0, nw1, na0, na1;
        uint2 ncr, npr, nck, npk, ncv, npv;
#define P2_FETCH(hh, ntt)                                                          \
        {                                                                          \
            const int wr_ = (hh) * 64 + (ntt) * 16 + l16;                          \
            nw0 = *(const bf16x8*)(w2t + wr_ * 64 + g * 8);                        \
            nw1 = *(const bf16x8*)(w2t + wr_ * 64 + 32 + g * 8);                   \
            na0 = *(const bf16x8*)(a2t + wr_ * 64 + g * 8);                        \
            na1 = *(const bf16x8*)(a2t + wr_ * 64 + 32 + g * 8);                   \
            const int ch_ = (hh) * 64 + (ntt) * 16 + g * 4;                        \
            ncr = *(const uint2*)(cur + ch_);        npr = *(const uint2*)(prv + ch_);        \
            nck = *(const uint2*)(cur + 512 + ch_);  npk = *(const uint2*)(prv + 512 + ch_);  \
            ncv = *(const uint2*)(cur + 1024 + ch_); npv = *(const uint2*)(prv + 1024 + ch_); \
        }
        P2_FETCH(h_lo, 0)
        for (int h = h_lo; h < h_hi; ++h) {
            float kkr[16], av[16];
            float ssq = 0.f, rkacc = 0.f, bracc = 0.f, kracc = 0.f;
            const size_t sirow = isP ? ((size_t)(seq * 8 + h) * 4096 + tt) : ((size_t)128 * 4096 + (size_t)((seq - 16) * 8 + h) * 32 + tt);
            u16* sib = SI + sirow * 384;
#pragma unroll
            for (int nt = 0; nt < 4; ++nt) {
                const bf16x8 cw0 = nw0, cw1 = nw1, ca0 = na0, ca1 = na1;
                const uint2 ccr = ncr, cpr = npr, cck = nck, cpk = npk, ccv = ncv, cpv = npv;
                if (nt < 3) { P2_FETCH(h, nt + 1) } else if (h + 1 < h_hi) { P2_FETCH(h + 1, 0) }
                const u16* gw_ = g2t + (h * 64 + nt * 16 + l16) * 160 + g * 8;
                const bf16x8 cg0 = *(const bf16x8*)(gw_), cg1 = *(const bf16x8*)(gw_ + 32), cg2 = *(const bf16x8*)(gw_ + 64),
                             cg3 = *(const bf16x8*)(gw_ + 96), cg4 = *(const bf16x8*)(gw_ + 128);
                __builtin_amdgcn_sched_barrier(0);
                f32x4 accw = {0.f, 0.f, 0.f, 0.f}, acca = accw;
                accw = MFMA(cw0, xw[0], accw); accw = MFMA(cw1, xw[1], accw);
                acca = MFMA(ca0, xa[0], acca); acca = MFMA(ca1, xa[1], acca);
                const int ch = h * 64 + nt * 16 + g * 4;
                float xr[4], xk[4], xv[4];
                lerp4w(ccr, cpr, sp, ch, xr);
                lerp4w(cck, cpk, sp, 512 + ch, xk);
                lerp4w(ccv, cpv, sp, 1024 + ch, xv);
                const float4 w0 = *(const float4*)(sp + 1824 + ch), a0 = *(const float4*)(sp + 2336 + ch), kk4 = *(const float4*)(sp + 2848 + ch),
                             ka4 = *(const float4*)(sp + 3360 + ch), rk4 = *(const float4*)(sp + 3872 + ch);
                const float w0a[4] = {w0.x, w0.y, w0.z, w0.w}, a0a[4] = {a0.x, a0.y, a0.z, a0.w}, kka[4] = {kk4.x, kk4.y, kk4.z, kk4.w},
                            kaa[4] = {ka4.x, ka4.y, ka4.z, ka4.w}, rka[4] = {rk4.x, rk4.y, rk4.z, rk4.w};
                float ev[4], kp[4], dr[4];
#pragma unroll
                for (int r = 0; r < 4; ++r) {
                    const float z = -(w0a[r] + accw[r]);
                    const float sp = (z > 20.f) ? z : __logf(1.f + __expf(z));
                    ev[r] = __expf(-sp - 0.5f);
                    const float a = sigmoidf_(a0a[r] + acca[r]);
                    const float kraw = xk[r] * kka[r];
                    ssq += kraw * kraw;
                    kp[r] = xk[r] * (1.f + (a - 1.f) * kaa[r]);
                    rkacc += xr[r] * kp[r] * rka[r];
                    kracc += xr[r] * kp[r];
                    bracc += kraw * a * xr[r];
                    dr[r] = xr[r] * __expf(-ev[r]);
                    kkr[nt * 4 + r] = kraw;
                    av[nt * 4 + r] = a;
                }
                const int co = nt * 16 + g * 4;
                *(uint2*)(sib + 0 * 64 + co) = pk4(dr[0], dr[1], dr[2], dr[3]);
                *(uint2*)(sib + 1 * 64 + co) = pk4(ev[0], ev[1], ev[2], ev[3]);
                *(uint2*)(sib + 2 * 64 + co) = pk4(kp[0], kp[1], kp[2], kp[3]);
                *(uint2*)(sib + 3 * 64 + co) = pk4(xv[0], xv[1], xv[2], xv[3]);
                f32x4 accg = {0.f, 0.f, 0.f, 0.f};
                accg = MFMA(cg0, xg[0], accg); accg = MFMA(cg1, xg[1], accg); accg = MFMA(cg2, xg[2], accg);
                accg = MFMA(cg3, xg[3], accg); accg = MFMA(cg4, xg[4], accg);
                *(uint2*)(Gb + (size_t)m * 512 + ch) = pk4(accg[0], accg[1], accg[2], accg[3]);
            }
            ssq = red_g(ssq);
            rkacc = red_g(rkacc);
            bracc = red_g(bracc);
            kracc = red_g(kracc);
            const float inv = rsqrtf(fmaxf(ssq, 1e-24f));
#pragma unroll
            for (int nt = 0; nt < 4; ++nt) {
                const int co = nt * 16 + g * 4;
                float k0 = kkr[nt * 4 + 0] * inv, k1 = kkr[nt * 4 + 1] * inv, k2 = kkr[nt * 4 + 2] * inv, k3 = kkr[nt * 4 + 3] * inv;
                *(uint2*)(sib + 4 * 64 + co) = pk4(k0, k1, k2, k3);
                *(uint2*)(sib + 5 * 64 + co) = pk4(k0 * av[nt * 4 + 0], k1 * av[nt * 4 + 1], k2 * av[nt * 4 + 2], k3 * av[nt * 4 + 3]);
            }
            if (g == 0) rk4[(size_t)m * 8 + h] = make_float4(rkacc, bracc * inv, kracc, 0.f);
        }
    }
}

typedef float v2f __attribute__((ext_vector_type(2)));
__device__ __forceinline__ void scan_item(const Params& p, const u16* __restrict__ si, int nch, const float* __restrict__ s0, float* __restrict__ sout,
                          int m0, int h, int half, unsigned char* smem) {
    float* inb = (float*)smem;
    float* ybuf = (float*)(smem + 49152);
    float* scal = (float*)(smem + 53248);
    unsigned char* ws = p.ws;
    const float4* rk4 = (const float4*)(ws + O_RK);
    u16* yraw = (u16*)(ws + O_YRAW);
    const int tid = threadIdx.x;
    const int vp = tid >> 3, kq = tid & 7;
    const int row = half * 32 + vp;
    v2f S[4];
    if (s0) {
        const float4 a = *(const float4*)(s0 + row * 64 + kq * 8), b = *(const float4*)(s0 + row * 64 + kq * 8 + 4);
        S[0] = (v2f){a.x, a.y}; S[1] = (v2f){a.z, a.w}; S[2] = (v2f){b.x, b.y}; S[3] = (v2f){b.z, b.w};
    } else {
#pragma unroll
        for (int j = 0; j < 4; ++j) S[j] = (v2f){0.f, 0.f};
    }
    uint4 st0, st1, st2;
    float4 sq = make_float4(0.f, 0.f, 0.f, 0.f);
    st0 = *(const uint4*)(si + (0 * 256 + tid) * 8);
    st1 = *(const uint4*)(si + (1 * 256 + tid) * 8);
    st2 = *(const uint4*)(si + (2 * 256 + tid) * 8);
    if (tid < 16) sq = rk4[(m0 + tid) * 8 + h];
#define S_WRITE1(sv, i, buf)                                                                                          \
    {                                                                                                                 \
        const int idx = (i) * 256 + tid;                                                                              \
        const int vec = (idx % 48) >> 3;                                                                              \
        float v[8] = {bflo(sv.x), bfhi(sv.x), bflo(sv.y), bfhi(sv.y), bflo(sv.z), bfhi(sv.z), bflo(sv.w), bfhi(sv.w)}; \
        if (vec == 1) {                                                                                               \
            _Pragma("unroll") for (int k = 0; k < 8; ++k) v[k] = __expf(-v[k]);                                       \
        }                                                                                                             \
        float* d = inb + (buf) * 6144 + idx * 8;                                                                      \
        *(float4*)d = make_float4(v[0], v[1], v[2], v[3]);                                                            \
        *(float4*)(d + 4) = make_float4(v[4], v[5], v[6], v[7]);                                                      \
    }
#define stage_write(buf) S_WRITE1(st0, 0, buf) S_WRITE1(st1, 1, buf) S_WRITE1(st2, 2, buf) if (tid < 16) *(float4*)(scal + (buf) * 64 + tid * 4) = sq;
    stage_write(0)
    __syncthreads();
    for (int c = 0; c < nch; ++c) {
        const int buf = c & 1;
        if (c + 1 < nch) {
            const u16* sn = si + (c + 1) * 6144 + tid * 8;
            st0 = *(const uint4*)(sn);
            st1 = *(const uint4*)(sn + 2048);
            st2 = *(const uint4*)(sn + 4096);
            if (tid < 16) sq = rk4[(m0 + (c + 1) * 16 + tid) * 8 + h];
        }
        const float* cb = inb + buf * 6144;
        const float* cs = scal + buf * 64;
#pragma unroll 2
        for (int tt = 0; tt < 16; ++tt) {
            const float* base = cb + tt * 384;
            v2f kk[4], dr[4], dd[4], bb[4], kv[4];
#define LD8(dst, off)                                                      \
    {                                                                      \
        const float4 q0 = *(const float4*)(base + (off) + kq * 8);         \
        const float4 q1 = *(const float4*)(base + (off) + kq * 8 + 4);     \
        dst[0] = (v2f){q0.x, q0.y}; dst[1] = (v2f){q0.z, q0.w};            \
        dst[2] = (v2f){q1.x, q1.y}; dst[3] = (v2f){q1.z, q1.w};            \
    }
            LD8(kk, 256) LD8(dr, 0) LD8(dd, 64) LD8(bb, 320) LD8(kv, 128)
            const float vv = base[192 + row];
            const float2 brkr = *(const float2*)(cs + tt * 4 + 1);
            v2f a0 = S[0] * kk[0], a1 = S[1] * kk[1], q0 = S[0] * dr[0], q1 = S[1] * dr[1];
            a0 = __builtin_elementwise_fma(S[2], kk[2], a0);
            a1 = __builtin_elementwise_fma(S[3], kk[3], a1);
            q0 = __builtin_elementwise_fma(S[2], dr[2], q0);
            q1 = __builtin_elementwise_fma(S[3], dr[3], q1);
            a0 += a1;
            q0 += q1;
            const float sa = -red8(a0.x + a0.y);
            const float pp = red8(q0.x + q0.y);
            const float y = pp + sa * brkr.x + vv * brkr.y;
            if (kq == 0) ybuf[tt * 32 + vp] = y;
            const v2f sav = (v2f){sa, sa}, vvv = (v2f){vv, vv};
#pragma unroll
            for (int j = 0; j < 4; ++j) S[j] = __builtin_elementwise_fma(S[j], dd[j], __builtin_elementwise_fma(vvv, kv[j], sav * bb[j]));
        }
        __syncthreads();
        {
            const int tt = tid >> 4, e2 = (tid & 15) * 2;
            const float2 y2 = *(const float2*)(ybuf + tt * 32 + e2);
            *(unsigned*)(yraw + (m0 + c * 16 + tt) * 512 + h * 64 + half * 32 + e2) = pk2(y2.x, y2.y);
        }
        if (c + 1 < nch) { stage_write(buf ^ 1) }
        __syncthreads();
    }
    {
        float* d0 = sout + row * 64 + kq * 8;
        *(float4*)d0 = make_float4(S[0].x, S[0].y, S[1].x, S[1].y);
        *(float4*)(d0 + 4) = make_float4(S[2].x, S[2].y, S[3].x, S[3].y);
    }
}

__device__ __forceinline__ void ln_pass(const Params& p) {
    unsigned char* ws = p.ws;
    const u16* yraw = (const u16*)(ws + O_YRAW);
    const u16* Gb = (const u16*)(ws + O_G);
    const u16* SI = (const u16*)(ws + O_SI);
    const float4* rk4 = (const float4*)(ws + O_RK);
    u16* ya = (u16*)(ws + O_YA);
    const int tid = threadIdx.x, cq = (tid & 15) * 4;
    for (int q0 = blockIdx.x * 16; q0 < T * 8; q0 += gridDim.x * 16) {
        const int q = q0 + (tid >> 4);
        const int m = q >> 3, h = q & 7;
        const int e = m * 512 + h * 64 + cq;
        const uint2 yv = *(const uint2*)(yraw + e);
        const float y0 = bflo(yv.x), y1 = bfhi(yv.x), y2 = bflo(yv.y), y3 = bfhi(yv.y);
        const float mean = red16(y0 + y1 + y2 + y3) * (1.f / 64.f);
        const float d0 = y0 - mean, d1 = y1 - mean, d2 = y2 - mean, d3 = y3 - mean;
        const float var = red16(d0 * d0 + d1 * d1 + d2 * d2 + d3 * d3) * (1.f / 64.f);
        const float rstd = rsqrtf(var + 64e-5f);
        const float rkv = rk4[q].x;
        int sirow;
        if (m < TP) sirow = ((m >> 12) * 8 + h) * 4096 + (m & 4095);
        else { const int ms = m - TP; sirow = 128 * 4096 + ((ms >> 5) * 8 + h) * 32 + (ms & 31); }
        const uint2 vq = *(const uint2*)(SI + (size_t)sirow * 384 + 192 + cq);
        const uint2 gg = *(const uint2*)(Gb + e);
        const float4 lw = *(const float4*)(p.ln_w + h * 64 + cq), lb = *(const float4*)(p.ln_b + h * 64 + cq);
        const float o0 = (d0 * rstd * lw.x + lb.x + rkv * bflo(vq.x)) * bflo(gg.x);
        const float o1 = (d1 * rstd * lw.y + lb.y + rkv * bfhi(vq.x)) * bfhi(gg.x);
        const float o2 = (d2 * rstd * lw.z + lb.z + rkv * bflo(vq.y)) * bflo(gg.y);
        const float o3 = (d3 * rstd * lw.w + lb.w + rkv * bfhi(vq.y)) * bfhi(gg.y);
        *(uint2*)(ya + e) = pk4(o0, o1, o2, o3);
    }
}

constexpr int KLD = 136, VLD = 72;
__device__ __forceinline__ void attn_item(const u16* __restrict__ Q, int nq, const u16* __restrict__ K, const u16* __restrict__ Vt, int ldv, int nkt,
                          int lastvalid, u16* __restrict__ O, float lam, const float* __restrict__ subln, unsigned char* smem) {
    u16* sK = (u16*)smem;
    u16* sV = (u16*)(smem + 2 * 64 * KLD * 2);
    float* ex = (float*)smem;
    const int tid = threadIdx.x, lane = tid & 63, wid = tid >> 6, l16 = lane & 15, g = lane >> 4;
    const int n = wid >> 1, qh = wid & 1;
    const bool active = (qh * 32) < nq;
    bf16x8 qf[2][2];
#pragma unroll
    for (int qt = 0; qt < 2; ++qt)
#pragma unroll
        for (int s = 0; s < 2; ++s) {
            const int row = qh * 32 + qt * 16 + l16;
            uint4 v = make_uint4(0, 0, 0, 0);
            if (row < nq) v = *(const uint4*)(Q + (row * 512 + n * 64 + s * 32 + g * 8));
            qf[qt][s] = as_frag(v);
        }
    f32x4 o[2][8];
#pragma unroll
    for (int qt = 0; qt < 2; ++qt)
#pragma unroll
        for (int et = 0; et < 8; ++et) o[qt][et] = (f32x4){0.f, 0.f, 0.f, 0.f};
    float mrow[2] = {-1e30f, -1e30f}, lrow[2] = {0.f, 0.f};
    uint4 kr0, kr1, kr2, kr3, vr0, vr1, vr2, vr3;
    const int krow = tid >> 4, kch = (tid & 15) * 8;
    const int vrow = tid >> 3, vch = (tid & 7) * 8;
    const int ko_ = krow * 512 + kch;
    const int vo_ = vrow * ldv + vch;
#define A_LOAD(key0)                                                      \
    kr0 = *(const uint4*)(K + (ko_ + ((key0) + 0) * 512));                \
    kr1 = *(const uint4*)(K + (ko_ + ((key0) + 16) * 512));               \
    kr2 = *(const uint4*)(K + (ko_ + ((key0) + 32) * 512));               \
    kr3 = *(const uint4*)(K + (ko_ + ((key0) + 48) * 512));               \
    vr0 = *(const uint4*)(Vt + (vo_ + (key0)));                           \
    vr1 = *(const uint4*)(Vt + (vo_ + 32 * ldv + (key0)));                \
    vr2 = *(const uint4*)(Vt + (vo_ + 64 * ldv + (key0)));                \
    vr3 = *(const uint4*)(Vt + (vo_ + 96 * ldv + (key0)));
#define A_STORE(nb)                                                       \
    *(uint4*)(sK + (nb) * 64 * KLD + (krow + 0) * KLD + kch) = kr0;       \
    *(uint4*)(sK + (nb) * 64 * KLD + (krow + 16) * KLD + kch) = kr1;      \
    *(uint4*)(sK + (nb) * 64 * KLD + (krow + 32) * KLD + kch) = kr2;      \
    *(uint4*)(sK + (nb) * 64 * KLD + (krow + 48) * KLD + kch) = kr3;      \
    *(uint4*)(sV + (nb) * 128 * VLD + (vrow + 0) * VLD + vch) = vr0;      \
    *(uint4*)(sV + (nb) * 128 * VLD + (vrow + 32) * VLD + vch) = vr1;     \
    *(uint4*)(sV + (nb) * 128 * VLD + (vrow + 64) * VLD + vch) = vr2;     \
    *(uint4*)(sV + (nb) * 128 * VLD + (vrow + 96) * VLD + vch) = vr3;
    A_LOAD(0)
    A_STORE(0)
    __syncthreads();
    constexpr float SC = 0.125f * 1.4426950408889634f;
    for (int kt = 0; kt < nkt; ++kt) {
        const int buf = kt & 1;
        if (kt + 1 < nkt) { A_LOAD((kt + 1) * 64) }
        __builtin_amdgcn_sched_barrier(0);
        if (active) {
            const int valid = (kt == nkt - 1) ? lastvalid : 64;
            const u16* cK = sK + buf * 64 * KLD + l16 * KLD + n * 64 + g * 8;
            const u16* cV = sV + buf * 128 * VLD + l16 * VLD + g * 4;
            f32x4 s[4][2];
#pragma unroll
            for (int k16 = 0; k16 < 4; ++k16) {
                const bf16x8 kf0 = *(const bf16x8*)(cK + k16 * 16 * KLD);
                const bf16x8 kf1 = *(const bf16x8*)(cK + k16 * 16 * KLD + 32);
#pragma unroll
                for (int qt = 0; qt < 2; ++qt) {
                    f32x4 z = {0.f, 0.f, 0.f, 0.f};
                    z = MFMA(kf0, qf[qt][0], z);
                    s[k16][qt] = MFMA(kf1, qf[qt][1], z);
                }
            }
            bf16x8 pf[2][2];
#pragma unroll
            for (int qt = 0; qt < 2; ++qt) {
                float mx = -1e30f;
                if (valid < 64) {
#pragma unroll
                    for (int k16 = 0; k16 < 4; ++k16)
#pragma unroll
                        for (int r = 0; r < 4; ++r) {
                            float v = s[k16][qt][r] * SC;
                            if (k16 * 16 >= valid) v = -1e30f;
                            s[k16][qt][r] = v;
                            mx = fmaxf(mx, v);
                        }
                } else {
#pragma unroll
                    for (int k16 = 0; k16 < 4; ++k16)
#pragma unroll
                        for (int r = 0; r < 4; ++r) {
                            const float v = s[k16][qt][r] * SC;
                            s[k16][qt][r] = v;
                            mx = fmaxf(mx, v);
                        }
                }
                mx = fmaxf(mx, __shfl_xor(mx, 16));
                mx = fmaxf(mx, __shfl_xor(mx, 32));
                const float mold = mrow[qt];
                const float mnew = fmaxf(mold, mx);
                mrow[qt] = mnew;
                if (__builtin_amdgcn_ballot_w64(mnew > mold) != 0ull) {
                    const float alpha = __builtin_amdgcn_exp2f(mold - mnew);
                    lrow[qt] *= alpha;
#pragma unroll
                    for (int et = 0; et < 8; ++et) {
                        o[qt][et][0] *= alpha; o[qt][et][1] *= alpha; o[qt][et][2] *= alpha; o[qt][et][3] *= alpha;
                    }
                }
                float psum = 0.f;
#pragma unroll
                for (int k16 = 0; k16 < 4; ++k16)
#pragma unroll
                    for (int r = 0; r < 4; ++r) {
                        const float pv = __builtin_amdgcn_exp2f(s[k16][qt][r] - mnew);
                        s[k16][qt][r] = pv;
                        psum += pv;
                    }
                lrow[qt] += psum;
#pragma unroll
                for (int kb = 0; kb < 2; ++kb)
                    pf[qt][kb] = as_frag(make_uint4(pk2(s[2 * kb][qt][0], s[2 * kb][qt][1]), pk2(s[2 * kb][qt][2], s[2 * kb][qt][3]),
                                                    pk2(s[2 * kb + 1][qt][0], s[2 * kb + 1][qt][1]), pk2(s[2 * kb + 1][qt][2], s[2 * kb + 1][qt][3])));
            }
#pragma unroll
            for (int et = 0; et < 8; ++et)
#pragma unroll
                for (int kb = 0; kb < 2; ++kb) {
                    const uint2 lo = *(const uint2*)(cV + et * 16 * VLD + kb * 32);
                    const uint2 hi = *(const uint2*)(cV + et * 16 * VLD + kb * 32 + 16);
                    const bf16x8 vf = as_frag(make_uint4(lo.x, lo.y, hi.x, hi.y));
#pragma unroll
                    for (int qt = 0; qt < 2; ++qt) o[qt][et] = MFMA(vf, pf[qt][kb], o[qt][et]);
                }
        }
        __builtin_amdgcn_sched_barrier(0);
        if (kt + 1 < nkt) { A_STORE(buf ^ 1) }
        __syncthreads();
    }
    float inv[2];
#pragma unroll
    for (int qt = 0; qt < 2; ++qt) {
        const float l = red_g(lrow[qt]);
        inv[qt] = 1.f / fmaxf(l, 1e-30f);
    }
    if (active && n == 1) {
#pragma unroll
        for (int qt = 0; qt < 2; ++qt)
#pragma unroll
            for (int et = 0; et < 8; ++et) {
                const f32x4 v = o[qt][et];
                *(float4*)(ex + (qh * 32 + qt * 16 + l16) * 132 + et * 16 + g * 4) =
                    make_float4(v[0] * inv[qt], v[1] * inv[qt], v[2] * inv[qt], v[3] * inv[qt]);
            }
    }
    __syncthreads();
    if (active && n == 0) {
#pragma unroll
        for (int qt = 0; qt < 2; ++qt) {
            const int row = qh * 32 + qt * 16 + l16;
            float ss = 0.f;
#pragma unroll
            for (int et = 0; et < 8; ++et) {
                const float4 o2 = *(const float4*)(ex + row * 132 + et * 16 + g * 4);
                f32x4 v = o[qt][et];
                v[0] = v[0] * inv[qt] - lam * o2.x;
                v[1] = v[1] * inv[qt] - lam * o2.y;
                v[2] = v[2] * inv[qt] - lam * o2.z;
                v[3] = v[3] * inv[qt] - lam * o2.w;
                o[qt][et] = v;
                ss += v[0] * v[0] + v[1] * v[1] + v[2] * v[2] + v[3] * v[3];
            }
            ss = red_g(ss);
            const float rn = rsqrtf(ss * (1.f / 128.f) + EPS) * 0.8f;
            if (row < nq) {
#pragma unroll
                for (int et = 0; et < 8; ++et) {
                    const float4 sl = *(const float4*)(subln + et * 16 + g * 4);
                    const f32x4 v = o[qt][et];
                    *(uint2*)(O + (row * 512 + et * 16 + g * 4)) = pk4(v[0] * rn * sl.x, v[1] * rn * sl.y, v[2] * rn * sl.z, v[3] * rn * sl.w);
                }
            }
        }
    }
    __syncthreads();
}

__device__ __forceinline__ void phase3(const Params& p, unsigned char* smem) {
    unsigned char* ws = p.ws;
    int* s_item = (int*)(smem + LDS_BYTES - 16);
    unsigned* ctr = (unsigned*)(ws + O_SCAL) + 1;
    const float lam = ((const float*)(ws + O_SCAL))[0];
    const u16* SI = (const u16*)(ws + O_SI);
    const u16* qb = (const u16*)(ws + O_QB);
    const u16* kP = (const u16*)(ws + O_KP);
    const u16* kS = (const u16*)(ws + O_KS);
    const u16* vtP = (const u16*)(ws + O_VTP);
    const u16* vtS = (const u16*)(ws + O_VTS);
    u16* ob = (u16*)(ws + O_OB);
    int stage = 0, sidx = blockIdx.x;
    constexpr int SCAN_BASE = 100000, DONE = 1 << 30;
    for (;;) {
        if (threadIdx.x == 0) {
            int it;
            if (stage == 0) it = (sidx < 768) ? SCAN_BASE + sidx : -2;
            else {
                const int x = blockIdx.x & 7;
                const int i = (int)atomicAdd(ctr + 16 + x, 1u);
                if (i < 512) it = ((63 - (i >> 3)) << 6) | (x + 8 * (i & 7));
                else if (i < 528) it = 4096 + (x + 8 * (i - 512));
                else it = DONE;
            }
            *s_item = it;
        }
        __syncthreads();
        const int item = __builtin_amdgcn_readfirstlane(*s_item);
        __syncthreads();
        if (item == DONE) break;
        if (item == -2) {
            asm volatile("s_waitcnt vmcnt(0) lgkmcnt(0)" ::: "memory");
            cg::this_grid().sync();
            stage = 1;
            ln_pass(p);
            continue;
        }
        if (item >= SCAN_BASE) {
            sidx += gridDim.x;
            const int sc = item - SCAN_BASE;
            const u16* si; int nch; const float* s0; float* sout; int m0, h, half;
            if (sc < 256) {
                const int chain = sc >> 1;
                half = sc & 1; h = chain & 7;
                si = SI + (size_t)chain * 4096 * 384; nch = 256; s0 = nullptr;
                sout = p.out + OFF_WP + (size_t)chain * 4096; m0 = (chain >> 3) * 4096;
            } else {
                const int t2 = sc - 256, chain = t2 >> 1;
                half = t2 & 1; h = chain & 7;
                si = SI + ((size_t)128 * 4096 + (size_t)chain * 32) * 384; nch = 2; s0 = p.state_wkv + (size_t)chain * 4096;
                sout = p.out + OFF_WS + (size_t)chain * 4096; m0 = TP + (chain >> 3) * 32;
            }
            scan_item(p, si, nch, s0, sout, m0, h, half, smem);
        } else {
            const u16 *Q, *K, *Vt; u16* O; int nq, ldv, nkt, lastvalid;
            if (item < 4096) {
                const int c = item >> 6, bh = item & 63, b = bh >> 2, h = bh & 3;
                const size_t m0 = (size_t)b * 4096 + (size_t)c * 64;
                Q = qb + m0 * 512 + h * 128; nq = 64; K = kP + (size_t)b * 4096 * 512 + h * 128;
                Vt = vtP + ((size_t)b * 512 + h * 128) * 4096; ldv = 4096; nkt = c + 1; lastvalid = 64; O = ob + m0 * 512 + h * 128;
            } else {
                const int idx = item - 4096;
                const int b = idx >> 2, h = idx & 3;
                const size_t m0 = (size_t)TP + (size_t)b * 32;
                Q = qb + m0 * 512 + h * 128; nq = 32; K = kS + (size_t)b * LKS * 512 + h * 128;
                Vt = vtS + ((size_t)b * 512 + h * 128) * LKS; ldv = LKS; nkt = 17; lastvalid = 32; O = ob + m0 * 512 + h * 128;
            }
            attn_item(Q, nq, K, Vt, ldv, nkt, lastvalid, O, lam, p.subln, smem);
        }
    }
}

__device__ __forceinline__ void phase4(const Params& p, unsigned char* smem) {
    unsigned char* ws = p.ws;
    const u16* ya = (const u16*)(ws + O_YA);
    const u16* ob = (const u16*)(ws + O_OB);
    const u16* Wa = (const u16*)(ws + O_WOA);
    const u16* Wb = (const u16*)(ws + O_WOB);
    const u16* gate = (const u16*)p.out;
    u16* mix = (u16*)(ws + O_MIX);
    const int tid = threadIdx.x, lane = tid & 63, wid = tid >> 6, wm = wid >> 1, wn = wid & 1, l16 = lane & 15, g = lane >> 4;
    constexpr int NT = 8;
    for (int t = blockIdx.x; t < 520 * NT; t += gridDim.x) {
        int mtile, ntile;
        tile_map(t, NT, mtile, ntile);
        const int m0 = mtile * 128, n0 = ntile * 128;
        f32x4 acc[4][4], acc2[4][4];
        zero_acc(acc);
        zero_acc(acc2);
        gemm_loop(ya + (size_t)m0 * 512, 512, Wa + (size_t)n0 * 512, 512, 8, (u16*)smem, acc);
        gemm_loop(ob + (size_t)m0 * 512, 512, Wb + (size_t)n0 * 512, 512, 8, (u16*)smem, acc2);
#pragma unroll
        for (int mt = 0; mt < 4; ++mt) {
            const int m = m0 + wm * 64 + mt * 16 + l16;
#pragma unroll
            for (int nt = 0; nt < 4; ++nt) {
                const int n = n0 + wn * 64 + nt * 16 + g * 4;
                const uint2 ga = *(const uint2*)(gate + (size_t)m * 2048 + n);
                const uint2 gb = *(const uint2*)(gate + (size_t)m * 2048 + 1024 + n);
                const f32x4 a = acc[nt][mt], b = acc2[nt][mt];
                *(uint2*)(mix + (size_t)m * 1024 + n) =
                    pk4(bflo(ga.x) * a[0] + bflo(gb.x) * b[0], bfhi(ga.x) * a[1] + bfhi(gb.x) * b[1],
                        bflo(ga.y) * a[2] + bflo(gb.y) * b[2], bfhi(ga.y) * a[3] + bfhi(gb.y) * b[3]);
            }
        }
    }
}

__device__ __forceinline__ void gemm_rowss(const u16* A, int K, const u16* W, u16* outb, float* ssq, unsigned char* smem) {
    const int tid = threadIdx.x, lane = tid & 63, wid = tid >> 6, wm = wid >> 1, wn = wid & 1, l16 = lane & 15, g = lane >> 4;
    constexpr int NT = 8;
    for (int t = blockIdx.x; t < 520 * NT; t += gridDim.x) {
        int mtile, ntile;
        tile_map(t, NT, mtile, ntile);
        const int m0 = mtile * 128, n0 = ntile * 128;
        f32x4 acc[4][4];
        zero_acc(acc);
        gemm_loop(A + (size_t)m0 * K, K, W + (size_t)n0 * K, K, K / 64, (u16*)smem, acc);
#pragma unroll
        for (int mt = 0; mt < 4; ++mt) {
            const int m = m0 + wm * 64 + mt * 16 + l16;
#pragma unroll
            for (int nt = 0; nt < 4; ++nt) {
                const int n = n0 + wn * 64 + nt * 16 + g * 4;
                const f32x4 a = acc[nt][mt];
                *(uint2*)(outb + (size_t)m * 1024 + n) = pk4(a[0], a[1], a[2], a[3]);
            }
        }
    }
}

__device__ __forceinline__ float sum16(const float* q) {
    const float4 a = *(const float4*)q, b = *(const float4*)(q + 4), c = *(const float4*)(q + 8), d = *(const float4*)(q + 12);
    return ((a.x + a.y) + (a.z + a.w)) + ((b.x + b.y) + (b.z + b.w)) + (((c.x + c.y) + (c.z + c.w)) + ((d.x + d.y) + (d.z + d.w)));
}
__device__ __forceinline__ void phase6(const Params& p) {
    unsigned char* ws = p.ws;
    const u16* m2 = (const u16*)(ws + O_M2);
    u16* x1b = (u16*)(ws + O_X1B);
    float* rs3 = (float*)(ws + O_RS3);
    const int lane = threadIdx.x & 63, wid = threadIdx.x >> 6;
    for (int m = blockIdx.x * 4 + wid; m < T; m += gridDim.x * 4) {
        const float* xr = (m < TP) ? p.x_prompt + (size_t)m * 1024 : p.x_sample + (size_t)(m - TP) * 1024;
        uint2 mvv[4];
        float s2 = 0.f;
#pragma unroll
        for (int i = 0; i < 4; ++i) {
            mvv[i] = *(const uint2*)(m2 + (size_t)m * 1024 + i * 256 + lane * 4);
            const float a = bflo(mvv[i].x), b = bfhi(mvv[i].x), c = bflo(mvv[i].y), d = bfhi(mvv[i].y);
            s2 += a * a + b * b + c * c + d * d;
        }
        s2 = wave_sum(s2);
        const float rs = rsqrtf(s2 * (1.f / 1024.f) + EPS);
        float ss = 0.f;
#pragma unroll
        for (int i = 0; i < 4; ++i) {
            const int col = i * 256 + lane * 4;
            const float4 xv = *(const float4*)(xr + col);
            const uint2 mv = mvv[i];
            const float4 gp = *(const float4*)(p.n_mix_post + col);
            float4 r;
            r.x = xv.x + bflo(mv.x) * rs * gp.x;
            r.y = xv.y + bfhi(mv.x) * rs * gp.y;
            r.z = xv.z + bflo(mv.y) * rs * gp.z;
            r.w = xv.w + bfhi(mv.y) * rs * gp.w;
            ss += r.x * r.x + r.y * r.y + r.z * r.z + r.w * r.w;
            *(float4*)(p.out + (size_t)m * 1024 + col) = r;
            *(uint2*)(x1b + (size_t)m * 1024 + col) = pk4(r.x, r.y, r.z, r.w);
        }
        ss = wave_sum(ss);
        if (lane == 0) rs3[m] = rsqrtf(ss * (1.f / 1024.f) + EPS);
    }
}

__device__ __forceinline__ void phase7(const Params& p, unsigned char* smem) {
    unsigned char* ws = p.ws;
    const u16* x1b = (const u16*)(ws + O_X1B);
    const u16* W = (const u16*)(ws + O_WFI);
    const float* rs3 = (const float*)(ws + O_RS3);
    u16* hb = (u16*)(ws + O_HB);
    const int tid = threadIdx.x, lane = tid & 63, wid = tid >> 6, wm = wid >> 1, wn = wid & 1, l16 = lane & 15, g = lane >> 4;
    constexpr int NT = 44;
    for (int t = blockIdx.x; t < 520 * NT; t += gridDim.x) {
        int mtile, ntile;
        tile_map(t, NT, mtile, ntile);
        const int m0 = mtile * 128, n0 = ntile * 128;
        f32x4 acc[4][4];
        zero_acc(acc);
        gemm_loop(x1b + (size_t)m0 * 1024, 1024, W + (size_t)n0 * 1024, 1024, 16, (u16*)smem, acc);
#pragma unroll
        for (int mt = 0; mt < 4; ++mt) {
            const int m = m0 + wm * 64 + mt * 16 + l16;
            const float rs = rs3[m];
#pragma unroll
            for (int pr = 0; pr < 2; ++pr) {
                const f32x4 ug = acc[2 * pr][mt], uv = acc[2 * pr + 1][mt];
                const int j = ((n0 + wn * 64) >> 5) * 16 + pr * 16 + g * 4;
                float hv[4];
#pragma unroll
                for (int r = 0; r < 4; ++r) {
                    const float a = ug[r] * rs, b = uv[r] * rs;
                    hv[r] = a * sigmoidf_(a) * b;
                }
                *(uint2*)(hb + (size_t)m * 2816 + j) = pk4(hv[0], hv[1], hv[2], hv[3]);
            }
        }
    }
}

__device__ __forceinline__ void phase9(const Params& p) {
    unsigned char* ws = p.ws;
    const u16* fb = (const u16*)(ws + O_FB);
    const int lane = threadIdx.x & 63, wid = threadIdx.x >> 6;
    for (int m = blockIdx.x * 4 + wid; m < T; m += gridDim.x * 4) {
        uint2 fvv[4];
        float s2 = 0.f;
#pragma unroll
        for (int i = 0; i < 4; ++i) {
            fvv[i] = *(const uint2*)(fb + (size_t)m * 1024 + i * 256 + lane * 4);
            const float a = bflo(fvv[i].x), b = bfhi(fvv[i].x), c = bflo(fvv[i].y), d = bfhi(fvv[i].y);
            s2 += a * a + b * b + c * c + d * d;
        }
        s2 = wave_sum(s2);
        const float rs = rsqrtf(s2 * (1.f / 1024.f) + EPS);
#pragma unroll
        for (int i = 0; i < 4; ++i) {
            const int col = i * 256 + lane * 4;
            float4 r = *(const float4*)(p.out + (size_t)m * 1024 + col);
            const uint2 fv = fvv[i];
            const float4 gp = *(const float4*)(p.n_ffn_post + col);
            r.x += bflo(fv.x) * rs * gp.x;
            r.y += bfhi(fv.x) * rs * gp.y;
            r.z += bflo(fv.y) * rs * gp.z;
            r.w += bfhi(fv.y) * rs * gp.w;
            *(float4*)(p.out + (size_t)m * 1024 + col) = r;
        }
    }
}

__global__ void __launch_bounds__(256, 2) mega(Params p) {
    extern __shared__ __attribute__((aligned(16))) unsigned char smem[];
    cg::grid_group grid = cg::this_grid();
#define IN(k) (p.ph_lo <= (k) && (k) < p.ph_hi)
#define SEAM(k) if (IN(k) && IN((k) + 1)) { asm volatile("s_waitcnt vmcnt(0) lgkmcnt(0)" ::: "memory"); grid.sync(); }
    unsigned char* ws = p.ws;
    if (IN(0)) phase0(p, smem);
    SEAM(0)
    if (IN(1)) phase1(p, smem);
    SEAM(1)
    if (IN(2)) phase2(p, smem);
    SEAM(2)
    if (IN(3)) phase3(p, smem);
    SEAM(3)
    if (IN(5)) phase4(p, smem);
    SEAM(5)
    if (IN(6)) gemm_rowss((const u16*)(ws + O_MIX), 1024, (const u16*)(ws + O_WO), (u16*)(ws + O_M2), (float*)(ws + O_SS2), smem);
    SEAM(6)
    if (IN(7)) phase6(p);
    SEAM(7)
    if (IN(8)) phase7(p, smem);
    SEAM(8)
    if (IN(9)) gemm_rowss((const u16*)(ws + O_HB), 2816, (const u16*)(ws + O_WFO), (u16*)(ws + O_FB), (float*)(ws + O_SS4), smem);
    SEAM(9)
    if (IN(10)) phase9(p);
}

extern "C" void kernel_launch(void* const* d_in, const int* in_sizes, int n_in, void* d_out, int out_size, void* d_ws, size_t ws_size,
                              hipStream_t stream) {
    static int grid_blocks = 0;
    if (!grid_blocks) {
        int dev = 0, cus = 0, per_cu = 0;
        hipGetDevice(&dev);
        hipDeviceGetAttribute(&cus, hipDeviceAttributeMultiprocessorCount, dev);
        hipFuncSetAttribute((const void*)mega, hipFuncAttributeMaxDynamicSharedMemorySize, LDS_BYTES);
        hipOccupancyMaxActiveBlocksPerMultiprocessor(&per_cu, (const void*)mega, 256, LDS_BYTES);
        if (per_cu < 1) per_cu = 1;
        if (per_cu > 2) per_cu = 2;
        grid_blocks = cus * per_cu;
        if (ws_size < WS_END) fprintf(stderr, "kernel_launch: workspace too small: %zu < %zu\n", ws_size, (size_t)WS_END);
    }
    Params p{};
    const float** pp = (const float**)&p;
    for (int i = 0; i < 33; ++i) pp[i] = (const float*)d_in[i];
    p.out = (float*)d_out;
    p.ws = (unsigned char*)d_ws;
#ifndef MULTI_LAUNCH
    p.ph_lo = 0;
    p.ph_hi = 11;
    void* args[] = {&p};
    hipError_t e = hipLaunchCooperativeKernel((const void*)mega, dim3(grid_blocks), dim3(256), args, LDS_BYTES, stream);
    if (e != hipSuccess) fprintf(stderr, "cooperative launch failed: %s (grid %d)\n", hipGetErrorString(e), grid_blocks);
#else
    for (int k = 0; k < 11; ++k) {
        p.ph_lo = k;
        p.ph_hi = k + 1;
        hipLaunchKernelGGL(mega, dim3(grid_blocks), dim3(256), LDS_BYTES, stream, p);
    }
#endif
}
```

```cpp
#include <hip/hip_runtime.h>
#include <hip/hip_cooperative_groups.h>
#include <cstdio>
#include <cstdint>
namespace cg = cooperative_groups;

typedef unsigned short u16;
typedef __attribute__((ext_vector_type(8))) short bf16x8;
typedef __attribute__((ext_vector_type(4))) float f32x4;

constexpr int TP = 65536, TS = 1024, T = TP + TS;
constexpr int ACOLS = 1824;
constexpr int LKS = 1088;
constexpr int LDS_BYTES = 73728;
constexpr float EPS = 1e-6f;

constexpr size_t OFF_YS = 67108864ull, OFF_KP = 68157440ull, OFF_VP = 101711872ull, OFF_WP = 135266304ull,
                 OFF_SHP = 135790592ull, OFF_KS = 135819776ull, OFF_VS = 136344064ull, OFF_WS = 136868352ull,
                 OFF_SHS = 137916928ull;

constexpr size_t al(size_t x) { return (x + 255) & ~(size_t)255; }
constexpr size_t O_WIN = 0;
constexpr size_t O_WOA = O_WIN + al(5504ull * 1024 * 2);
constexpr size_t O_WOB = O_WOA + al(1024ull * 512 * 2);
constexpr size_t O_WO = O_WOB + al(1024ull * 512 * 2);
constexpr size_t O_WFI = O_WO + al(1024ull * 1024 * 2);
constexpr size_t O_WFO = O_WFI + al(5632ull * 1024 * 2);
constexpr size_t O_W2 = O_WFO + al(1024ull * 2816 * 2);
constexpr size_t O_A2 = O_W2 + al(512 * 64 * 2);
constexpr size_t O_G2 = O_A2 + al(512 * 64 * 2);
constexpr size_t O_RS1 = O_G2 + al(512 * 160 * 2);
constexpr size_t O_SS2 = O_RS1 + al((size_t)T * 4);
constexpr size_t O_SS4 = O_SS2 + al((size_t)T * 16 * 4);
constexpr size_t O_RS3 = O_SS4 + al((size_t)T * 16 * 4);
constexpr size_t O_RK = O_RS3 + al((size_t)T * 4);
constexpr size_t O_SCAL = O_RK + al((size_t)T * 8 * 16);
constexpr size_t O_REGA = O_SCAL + 256;
constexpr size_t O_CA = O_REGA;
constexpr size_t O_YA = O_REGA;
constexpr size_t O_OB = O_YA + al((size_t)T * 512 * 2);
constexpr size_t O_YRAW = O_OB + al((size_t)T * 512 * 2);
constexpr size_t O_HB = O_REGA;
constexpr size_t O_REGB = O_REGA + al((size_t)(T + 48) * 1824 * 2);
constexpr size_t O_QB = O_REGB;
constexpr size_t O_KP = O_QB + al((size_t)T * 512 * 2);
constexpr size_t O_KS = O_KP + al((size_t)TP * 512 * 2);
constexpr size_t O_VTP = O_KS + al(32ull * LKS * 512 * 2);
constexpr size_t O_VTS = O_VTP + al(16ull * 512 * 4096 * 2);
constexpr size_t O_REGC = O_VTS + al(32ull * 512 * LKS * 2);
constexpr size_t O_GATE = O_REGB;
static_assert(O_GATE + (size_t)T * 2048 * 2 <= O_REGC, "gate overlaps region C");
constexpr size_t O_SI = O_REGC;
constexpr size_t O_G = O_SI + al((size_t)T * 8 * 384 * 2);
constexpr size_t O_XB = O_REGC;
constexpr size_t O_MIX = O_REGC;
constexpr size_t O_M2 = O_MIX + al((size_t)T * 1024 * 2);
constexpr size_t O_X1B = O_M2 + al((size_t)T * 1024 * 2);
constexpr size_t O_FB = O_REGC;
constexpr size_t WS_END = O_G + al((size_t)T * 512 * 2);
static_assert(O_HB + (size_t)T * 2816 * 2 <= O_REGC, "hb overlaps region C");
static_assert(O_YRAW + (size_t)T * 512 * 2 <= O_REGB, "yraw overlaps region B");
static_assert(O_X1B + (size_t)T * 1024 * 2 <= WS_END, "x1b beyond end");
static_assert(WS_END <= 1073741824ull, "workspace too large");

struct Params {
    const float *x_prompt, *x_sample, *cache_k, *cache_v, *state_wkv, *state_shift;
    const float *n_mix_pre, *n_mix_post, *n_ffn_pre, *n_ffn_post, *w_in, *b_gate;
    const float *mu, *w0, *w2, *a0, *a2, *g2, *k_k, *k_a, *r_k, *ln_w, *ln_b;
    const float *lq1, *lk1, *lq2, *lk2, *subln, *w_out_a, *w_out_b, *w_o, *w_ffn_in, *w_ffn_out;
    float* out;
    unsigned char* ws;
    int ph_lo, ph_hi;
};

typedef float v2f_ __attribute__((ext_vector_type(2)));
typedef __bf16 bf2_ __attribute__((ext_vector_type(2)));
__device__ __forceinline__ unsigned pk2(float a, float b) {
    const v2f_ v = {a, b};
    const bf2_ r = __builtin_convertvector(v, bf2_);
    return __builtin_bit_cast(unsigned, r);
}
__device__ __forceinline__ u16 f2bf(float f) { return (u16)(pk2(f, 0.f) & 0xffffu); }
__device__ __forceinline__ float bflo(unsigned u) { return __uint_as_float(u << 16); }
__device__ __forceinline__ float bfhi(unsigned u) { return __uint_as_float(u & 0xffff0000u); }
__device__ __forceinline__ uint2 pk4(float a, float b, float c, float d) { return make_uint2(pk2(a, b), pk2(c, d)); }
__device__ __forceinline__ float sigmoidf_(float x) { return 1.f / (1.f + __expf(-x)); }

template <int CTRL>
__device__ __forceinline__ float dppf(float x) {
    return __int_as_float(__builtin_amdgcn_update_dpp(0, __float_as_int(x), CTRL, 0xF, 0xF, true));
}
__device__ __forceinline__ float red8(float x) {
    x += dppf<0xB1>(x);
    x += dppf<0x4E>(x);
    x += dppf<0x141>(x);
    return x;
}
__device__ __forceinline__ float red16(float x) {
    x = red8(x);
    x += dppf<0x140>(x);
    return x;
}
__device__ __forceinline__ float red_g(float x) {
    x += __shfl_xor(x, 16);
    x += __shfl_xor(x, 32);
    return x;
}
__device__ __forceinline__ float wave_sum(float x) {
    x = red16(x);
    return red_g(x);
}
__device__ __forceinline__ bf16x8 as_frag(uint4 v) {
    union { uint4 u; bf16x8 f; } c;
    c.u = v;
    return c.f;
}
#define MFMA(a, b, c) __builtin_amdgcn_mfma_f32_16x16x32_bf16((a), (b), (c), 0, 0, 0)

constexpr int LDT = 72;
constexpr int STG = 128 * LDT;
__device__ __forceinline__ void gemm_loop(const u16* __restrict__ A, int lda, const u16* __restrict__ B, int ldb,
                                          int nkt, u16* smem, f32x4 (&acc)[4][4]) {
    const int tid = threadIdx.x, lane = tid & 63, wid = tid >> 6, wm = wid >> 1, wn = wid & 1, l16 = lane & 15, g = lane >> 4;
    const int lr = tid >> 3, lc = (tid & 7) * 8;
    u16* sA = smem;
    u16* sB = smem + 2 * STG;
    const u16* ap = A + (size_t)lr * lda + lc;
    const u16* bp = B + (size_t)lr * ldb + lc;
    uint4 ra0, ra1, ra2, ra3, rb0, rb1, rb2, rb3;
#define G_LOAD(ko)                                                   \
    ra0 = *(const uint4*)(ap + (ko));                                \
    ra1 = *(const uint4*)(ap + (size_t)32 * lda + (ko));             \
    ra2 = *(const uint4*)(ap + (size_t)64 * lda + (ko));             \
    ra3 = *(const uint4*)(ap + (size_t)96 * lda + (ko));             \
    rb0 = *(const uint4*)(bp + (ko));                                \
    rb1 = *(const uint4*)(bp + (size_t)32 * ldb + (ko));             \
    rb2 = *(const uint4*)(bp + (size_t)64 * ldb + (ko));             \
    rb3 = *(const uint4*)(bp + (size_t)96 * ldb + (ko));
#define G_STORE(bo)                                                  \
    *(uint4*)(sA + (bo) + (lr + 0) * LDT + lc) = ra0;                \
    *(uint4*)(sA + (bo) + (lr + 32) * LDT + lc) = ra1;               \
    *(uint4*)(sA + (bo) + (lr + 64) * LDT + lc) = ra2;               \
    *(uint4*)(sA + (bo) + (lr + 96) * LDT + lc) = ra3;               \
    *(uint4*)(sB + (bo) + (lr + 0) * LDT + lc) = rb0;                \
    *(uint4*)(sB + (bo) + (lr + 32) * LDT + lc) = rb1;               \
    *(uint4*)(sB + (bo) + (lr + 64) * LDT + lc) = rb2;               \
    *(uint4*)(sB + (bo) + (lr + 96) * LDT + lc) = rb3;
    G_LOAD(0)
    G_STORE(0)
    __syncthreads();
    for (int kt = 0; kt < nkt; ++kt) {
        const int buf = kt & 1;
        if (kt + 1 < nkt) { G_LOAD((kt + 1) * 64) }
        __builtin_amdgcn_sched_barrier(0);
        const u16* cA = sA + buf * STG + (wm * 64 + l16) * LDT + g * 8;
        const u16* cB = sB + buf * STG + (wn * 64 + l16) * LDT + g * 8;
#pragma unroll
        for (int ks = 0; ks < 2; ++ks) {
            bf16x8 xf[4], wf[4];
#pragma unroll
            for (int i = 0; i < 4; ++i) {
                xf[i] = *(const bf16x8*)(cA + i * 16 * LDT + ks * 32);
                wf[i] = *(const bf16x8*)(cB + i * 16 * LDT + ks * 32);
            }
#pragma unroll
            for (int nt = 0; nt < 4; ++nt)
#pragma unroll
                for (int mt = 0; mt < 4; ++mt) acc[nt][mt] = MFMA(wf[nt], xf[mt], acc[nt][mt]);
        }
        __builtin_amdgcn_sched_barrier(0);
        if (kt + 1 < nkt) { G_STORE((buf ^ 1) * STG) }
        __syncthreads();
    }
}
__device__ __forceinline__ void gemm_loop_xf32(const float* __restrict__ A, const u16* __restrict__ B, int ldb, int nkt, u16* smem,
                                               f32x4 (&acc)[4][4]) {
    const int tid = threadIdx.x, lane = tid & 63, wid = tid >> 6, wm = wid >> 1, wn = wid & 1, l16 = lane & 15, g = lane >> 4;
    const int lr = tid >> 3, lc = (tid & 7) * 8;
    u16* sA = smem;
    u16* sB = smem + 2 * STG;
    const float* ap = A + (size_t)lr * 1024 + lc;
    const u16* bp = B + (size_t)lr * ldb + lc;
    float4 fa0, fa1, fa2, fa3, fa4, fa5, fa6, fa7;
    uint4 rb0, rb1, rb2, rb3;
#define GX_LOAD(ko)                                                  \
    fa0 = *(const float4*)(ap + (ko));                               \
    fa1 = *(const float4*)(ap + (ko) + 4);                           \
    fa2 = *(const float4*)(ap + 32 * 1024 + (ko));                   \
    fa3 = *(const float4*)(ap + 32 * 1024 + (ko) + 4);               \
    fa4 = *(const float4*)(ap + 64 * 1024 + (ko));                   \
    fa5 = *(const float4*)(ap + 64 * 1024 + (ko) + 4);               \
    fa6 = *(const float4*)(ap + 96 * 1024 + (ko));                   \
    fa7 = *(const float4*)(ap + 96 * 1024 + (ko) + 4);               \
    rb0 = *(const uint4*)(bp + (ko));                                \
    rb1 = *(const uint4*)(bp + (size_t)32 * ldb + (ko));             \
    rb2 = *(const uint4*)(bp + (size_t)64 * ldb + (ko));             \
    rb3 = *(const uint4*)(bp + (size_t)96 * ldb + (ko));
#define PKF(a, b) make_uint4(pk2(a.x, a.y), pk2(a.z, a.w), pk2(b.x, b.y), pk2(b.z, b.w))
#define GX_STORE(bo)                                                 \
    *(uint4*)(sA + (bo) + (lr + 0) * LDT + lc) = PKF(fa0, fa1);      \
    *(uint4*)(sA + (bo) + (lr + 32) * LDT + lc) = PKF(fa2, fa3);     \
    *(uint4*)(sA + (bo) + (lr + 64) * LDT + lc) = PKF(fa4, fa5);     \
    *(uint4*)(sA + (bo) + (lr + 96) * LDT + lc) = PKF(fa6, fa7);     \
    *(uint4*)(sB + (bo) + (lr + 0) * LDT + lc) = rb0;                \
    *(uint4*)(sB + (bo) + (lr + 32) * LDT + lc) = rb1;               \
    *(uint4*)(sB + (bo) + (lr + 64) * LDT + lc) = rb2;               \
    *(uint4*)(sB + (bo) + (lr + 96) * LDT + lc) = rb3;
    GX_LOAD(0)
    GX_STORE(0)
    __syncthreads();
    for (int kt = 0; kt < nkt; ++kt) {
        const int buf = kt & 1;
        if (kt + 1 < nkt) { GX_LOAD((kt + 1) * 64) }
        __builtin_amdgcn_sched_barrier(0);
        const u16* cA = sA + buf * STG + (wm * 64 + l16) * LDT + g * 8;
        const u16* cB = sB + buf * STG + (wn * 64 + l16) * LDT + g * 8;
#pragma unroll
        for (int ks = 0; ks < 2; ++ks) {
            bf16x8 xf[4], wf[4];
#pragma unroll
            for (int i = 0; i < 4; ++i) {
                xf[i] = *(const bf16x8*)(cA + i * 16 * LDT + ks * 32);
                wf[i] = *(const bf16x8*)(cB + i * 16 * LDT + ks * 32);
            }
#pragma unroll
            for (int nt = 0; nt < 4; ++nt)
#pragma unroll
                for (int mt = 0; mt < 4; ++mt) acc[nt][mt] = MFMA(wf[nt], xf[mt], acc[nt][mt]);
        }
        __builtin_amdgcn_sched_barrier(0);
        if (kt + 1 < nkt) { GX_STORE((buf ^ 1) * STG) }
        __syncthreads();
    }
}
__device__ __forceinline__ void zero_acc(f32x4 (&acc)[4][4]) {
#pragma unroll
    for (int i = 0; i < 4; ++i)
#pragma unroll
        for (int j = 0; j < 4; ++j) acc[i][j] = (f32x4){0.f, 0.f, 0.f, 0.f};
}
__device__ __forceinline__ void tile_map(int t, int NT, int& mt, int& nt) {
    const int x = t & 7, u = t >> 3;
    const int gsz = 8 * NT;
    const int g = u / gsz;
    const int w = u - g * gsz;
    const int rows = (g < 8) ? 8 : 1;
    const int q = w / rows;
    mt = x * 65 + g * 8 + (w - q * rows);
    nt = q;
}

__device__ __forceinline__ void tr_tile(const float* __restrict__ in, int R, int C, int ldin, u16* __restrict__ out, int ldout,
                        const float* __restrict__ scale, int r0, int c0, int Cout, bool perm, float* tile) {
    const int tid = threadIdx.x;
    {
        const int tx = tid & 63, ty = tid >> 6;
        const int c = c0 + tx;
        for (int rr = ty; rr < 64; rr += 4) {
            const int r = r0 + rr;
            float v = 0.f;
            if (r < R && c < C) {
                v = in[(size_t)r * ldin + c];
                if (scale) v *= scale[r];
            }
            tile[rr * 65 + tx] = v;
        }
    }
    __syncthreads();
    {
        const int rch = (tid & 7) * 8;
#pragma unroll
        for (int pass = 0; pass < 2; ++pass) {
            const int cc = (tid >> 3) + pass * 32;
            const int c = c0 + cc;
            if (c < Cout && r0 + rch < R) {
                float v[8];
#pragma unroll
                for (int k = 0; k < 8; ++k) v[k] = tile[(rch + k) * 65 + cc];
                int orow = c;
                if (perm) {
                    const int type = c >= 2816 ? 1 : 0;
                    const int j = c - type * 2816;
                    orow = (j >> 4) * 32 + type * 16 + (j & 15);
                }
                uint4 o = make_uint4(pk2(v[0], v[1]), pk2(v[2], v[3]), pk2(v[4], v[5]), pk2(v[6], v[7]));
                *(uint4*)(out + (size_t)orow * ldout + r0 + rch) = o;
            }
        }
    }
    __syncthreads();
}

__device__ __forceinline__ void phase0(const Params& p, unsigned char* smem) {
    float* tile = (float*)smem;
    const int tid = threadIdx.x, lane = tid & 63, wid = tid >> 6;
    unsigned char* ws = p.ws;
    const int G = gridDim.x;
    for (int u = blockIdx.x; u < 8136; u += G) {
        const float* in;
        int R, C, Cout, ldout, tl;
        u16* out;
        const float* scale = nullptr;
        bool perm = false;
        if (u < 1376) { tl = u; in = p.w_in; R = 1024; C = 5408; Cout = 5504; out = (u16*)(ws + O_WIN); ldout = 1024; scale = p.n_mix_pre; }
        else if (u < 1504) { tl = u - 1376; in = p.w_out_a; R = 512; C = 1024; Cout = 1024; out = (u16*)(ws + O_WOA); ldout = 512; }
        else if (u < 1632) { tl = u - 1504; in = p.w_out_b; R = 512; C = 1024; Cout = 1024; out = (u16*)(ws + O_WOB); ldout = 512; }
        else if (u < 1888) { tl = u - 1632; in = p.w_o; R = 1024; C = 1024; Cout = 1024; out = (u16*)(ws + O_WO); ldout = 1024; }
        else if (u < 3296) { tl = u - 1888; in = p.w_ffn_in; R = 1024; C = 5632; Cout = 5632; out = (u16*)(ws + O_WFI); ldout = 1024; scale = p.n_ffn_pre; perm = true; }
        else if (u < 4000) { tl = u - 3296; in = p.w_ffn_out; R = 2816; C = 1024; Cout = 1024; out = (u16*)(ws + O_WFO); ldout = 2816; }
        else if (u < 4008) { tl = u - 4000; in = p.w2; R = 64; C = 512; Cout = 512; out = (u16*)(ws + O_W2); ldout = 64; }
        else if (u < 4016) { tl = u - 4008; in = p.a2; R = 64; C = 512; Cout = 512; out = (u16*)(ws + O_A2); ldout = 64; }
        else if (u < 4040) { tl = u - 4016; in = p.g2; R = 160; C = 512; Cout = 512; out = (u16*)(ws + O_G2); ldout = 160; }
        else {
            tl = u - 4040;
            const int b = tl >> 7;
            tl &= 127;
            in = p.cache_v + (size_t)b * 1024 * 512; R = 1024; C = 512; Cout = 512;
            out = (u16*)(ws + O_VTS) + (size_t)b * 512 * LKS; ldout = LKS;
        }
        const int ctiles = (Cout + 63) >> 6;
        const int rt = tl / ctiles, ct = tl - rt * ctiles;
        tr_tile(in, R, C, C, out, ldout, scale, rt * 64, ct * 64, Cout, perm, tile);
    }
    {
        u16* xb = (u16*)(ws + O_XB);
        float* rs1 = (float*)(ws + O_RS1);
        for (int m = blockIdx.x * 4 + wid; m < T; m += G * 4) {
            const float* xr = (m < TP) ? p.x_prompt + (size_t)m * 1024 : p.x_sample + (size_t)(m - TP) * 1024;
            float ss = 0.f;
#pragma unroll
            for (int i = 0; i < 4; ++i) {
                const float4 v = *(const float4*)(xr + i * 256 + lane * 4);
                ss += v.x * v.x + v.y * v.y + v.z * v.z + v.w * v.w;
                *(uint2*)(xb + (size_t)m * 1024 + i * 256 + lane * 4) = pk4(v.x, v.y, v.z, v.w);
            }
            ss = wave_sum(ss);
            if (lane == 0) rs1[m] = rsqrtf(ss * (1.f / 1024.f) + EPS);
        }
    }
    {
        u16* kS = (u16*)(ws + O_KS);
        const int n8 = 32 * 1024 * 64;
        for (int i = blockIdx.x * 256 + tid; i < n8; i += G * 256) {
            const int b = i >> 16, rem = i & 65535, key = rem >> 6, c8 = rem & 63;
            const float4 v0 = *(const float4*)(p.cache_k + (size_t)i * 8);
            const float4 v1 = *(const float4*)(p.cache_k + (size_t)i * 8 + 4);
            *(uint4*)(kS + ((size_t)b * LKS + key) * 512 + c8 * 8) =
                make_uint4(pk2(v0.x, v0.y), pk2(v0.z, v0.w), pk2(v1.x, v1.y), pk2(v1.z, v1.w));
        }
        for (int i = blockIdx.x * 256 + tid; i < 32 * 32 * 64; i += G * 256) {
            const int b = i >> 11, rem = i & 2047, row = rem >> 6, c8 = rem & 63;
            *(uint4*)(kS + ((size_t)b * LKS + 1056 + row) * 512 + c8 * 8) = make_uint4(0, 0, 0, 0);
        }
        u16* vtS = (u16*)(ws + O_VTS);
        for (int i = blockIdx.x * 256 + tid; i < 32 * 512 * 4; i += G * 256) {
            const int row = i >> 2, c8 = i & 3;
            *(uint4*)(vtS + (size_t)row * LKS + 1056 + c8 * 8) = make_uint4(0, 0, 0, 0);
        }
    }
    {
        u16* cA = (u16*)(ws + O_CA);
        for (int i = blockIdx.x * 256 + tid; i < 48 * ACOLS; i += G * 256) {
            const int s = i / ACOLS, c = i - s * ACOLS;
            float v = 0.f;
            size_t row;
            if (s < 16) row = (size_t)s * 4097;
            else { row = (size_t)16 * 4097 + (size_t)(s - 16) * 33; v = p.state_shift[(size_t)(s - 16) * ACOLS + c]; }
            cA[row * ACOLS + c] = f2bf(v);
        }
        if (blockIdx.x == 0 && tid == 0) {
            float d1 = 0.f, d2 = 0.f;
            for (int i = 0; i < 64; ++i) { d1 += p.lq1[i] * p.lk1[i]; d2 += p.lq2[i] * p.lk2[i]; }
            float* sc = (float*)(ws + O_SCAL);
            sc[0] = __expf(d1) - __expf(d2) + 0.2f;
            for (int i = 1; i < 32; ++i) ((unsigned*)sc)[i] = 0u;
        }
    }
}

__device__ __forceinline__ void phase1(const Params& p, unsigned char* smem) {
    unsigned char* ws = p.ws;
    const u16* xb = (const u16*)(ws + O_XB);
    const u16* W = (const u16*)(ws + O_WIN);
    const float* rs1 = (const float*)(ws + O_RS1);
    u16* cA = (u16*)(ws + O_CA);
    u16* qb = (u16*)(ws + O_QB);
    u16* kP = (u16*)(ws + O_KP);
    u16* kS = (u16*)(ws + O_KS);
    u16* vtP = (u16*)(ws + O_VTP);
    u16* vtS = (u16*)(ws + O_VTS);
    float* out = p.out;
    const int tid = threadIdx.x, lane = tid & 63, wid = tid >> 6, wm = wid >> 1, wn = wid & 1, l16 = lane & 15, g = lane >> 4;
    constexpr int NT = 43;
    u16* gate = (u16*)p.out;
    for (int t = blockIdx.x; t < 520 * NT; t += gridDim.x) {
        int mtile, ntile;
        tile_map(t, NT, mtile, ntile);
        const int m0 = mtile * 128, n0 = ntile * 128;
        f32x4 acc[4][4];
        zero_acc(acc);
        gemm_loop(xb + (size_t)m0 * 1024, 1024, W + (size_t)n0 * 1024, 1024, 16, (u16*)smem, acc);
#pragma unroll
        for (int mt = 0; mt < 4; ++mt) {
            const int m = m0 + wm * 64 + mt * 16 + l16;
            const float rs = rs1[m];
            const bool isP = m < TP;
            int seq, tt;
            if (isP) { seq = m >> 12; tt = m & 4095; }
            else { const int ms = m - TP; seq = 16 + (ms >> 5); tt = ms & 31; }
            const size_t carow = (size_t)m + seq + 1;
            const bool last = isP ? (tt == 4095) : (tt == 31);
#pragma unroll
            for (int nt = 0; nt < 4; ++nt) {
                const int n = n0 + wn * 64 + nt * 16 + g * 4;
                if (n >= 5408) continue;
                f32x4 v = acc[nt][mt];
                v[0] *= rs; v[1] *= rs; v[2] *= rs; v[3] *= rs;
                if (n < 1824) {
                    *(uint2*)(cA + carow * ACOLS + n) = pk4(v[0], v[1], v[2], v[3]);
                    if (last) {
                        float* so = isP ? out + OFF_SHP + (size_t)seq * ACOLS + n : out + OFF_SHS + (size_t)(seq - 16) * ACOLS + n;
                        *(float4*)so = make_float4(v[0], v[1], v[2], v[3]);
                    }
                } else if (n < 2336) {
                    *(uint2*)(qb + (size_t)m * 512 + (n - 1824)) = pk4(v[0], v[1], v[2], v[3]);
                } else if (n < 2848) {
                    const int c = n - 2336;
                    if (isP) {
                        *(uint2*)(kP + (size_t)m * 512 + c) = pk4(v[0], v[1], v[2], v[3]);
                        *(float4*)(out + OFF_KP + (size_t)m * 512 + c) = make_float4(v[0], v[1], v[2], v[3]);
                    } else {
                        *(uint2*)(kS + ((size_t)(seq - 16) * LKS + 1024 + tt) * 512 + c) = pk4(v[0], v[1], v[2], v[3]);
                        *(float4*)(out + OFF_KS + (size_t)(m - TP) * 512 + c) = make_float4(v[0], v[1], v[2], v[3]);
                    }
                } else if (n < 3360) {
                    const int c = n - 2848;
                    if (isP) {
                        *(float4*)(out + OFF_VP + (size_t)m * 512 + c) = make_float4(v[0], v[1], v[2], v[3]);
                        u16* d = vtP + ((size_t)seq * 512 + c) * 4096 + tt;
                        d[0] = f2bf(v[0]); d[4096] = f2bf(v[1]); d[2 * 4096] = f2bf(v[2]); d[3 * 4096] = f2bf(v[3]);
                    } else {
                        *(float4*)(out + OFF_VS + (size_t)(m - TP) * 512 + c) = make_float4(v[0], v[1], v[2], v[3]);
                        u16* d = vtS + ((size_t)(seq - 16) * 512 + c) * LKS + 1024 + tt;
                        d[0] = f2bf(v[0]); d[LKS] = f2bf(v[1]); d[2 * LKS] = f2bf(v[2]); d[3 * LKS] = f2bf(v[3]);
                    }
                } else {
                    const int c = n - 3360;
                    const float4 bg = *(const float4*)(p.b_gate + c);
                    *(uint2*)(gate + (size_t)m * 2048 + c) =
                        pk4(sigmoidf_(v[0] + bg.x), sigmoidf_(v[1] + bg.y), sigmoidf_(v[2] + bg.z), sigmoidf_(v[3] + bg.w));
                }
            }
        }
    }
}

__device__ __forceinline__ void lerp8(const u16* cur, const u16* prv, const float* mu, int col, float (&xs)[8]) {
    const uint4 cu = *(const uint4*)(cur + col);
    const uint4 pv = *(const uint4*)(prv + col);
    const float4 m0 = *(const float4*)(mu + col);
    const float4 m1 = *(const float4*)(mu + col + 4);
    const unsigned cw[4] = {cu.x, cu.y, cu.z, cu.w}, pw[4] = {pv.x, pv.y, pv.z, pv.w};
    const float mm[8] = {m0.x, m0.y, m0.z, m0.w, m1.x, m1.y, m1.z, m1.w};
#pragma unroll
    for (int i = 0; i < 4; ++i) {
        const float c0 = bflo(cw[i]), c1 = bfhi(cw[i]), p0 = bflo(pw[i]), p1 = bfhi(pw[i]);
        xs[2 * i] = c0 + (p0 - c0) * mm[2 * i];
        xs[2 * i + 1] = c1 + (p1 - c1) * mm[2 * i + 1];
    }
}
__device__ __forceinline__ void lerp4(const u16* cur, const u16* prv, const float* mu, int col, float (&xs)[4]) {
    const uint2 cu = *(const uint2*)(cur + col);
    const uint2 pv = *(const uint2*)(prv + col);
    const float4 m0 = *(const float4*)(mu + col);
    float c0 = bflo(cu.x), c1 = bfhi(cu.x), c2 = bflo(cu.y), c3 = bfhi(cu.y);
    xs[0] = c0 + (bflo(pv.x) - c0) * m0.x;
    xs[1] = c1 + (bfhi(pv.x) - c1) * m0.y;
    xs[2] = c2 + (bflo(pv.y) - c2) * m0.z;
    xs[3] = c3 + (bfhi(pv.y) - c3) * m0.w;
}
__device__ __forceinline__ void lerp4w(const uint2 cu, const uint2 pv, const float* mu, int col, float (&xs)[4]) {
    const float4 m0 = *(const float4*)(mu + col);
    const float c0 = bflo(cu.x), c1 = bfhi(cu.x), c2 = bflo(cu.y), c3 = bfhi(cu.y);
    xs[0] = c0 + (bflo(pv.x) - c0) * m0.x;
    xs[1] = c1 + (bfhi(pv.x) - c1) * m0.y;
    xs[2] = c2 + (bflo(pv.y) - c2) * m0.z;
    xs[3] = c3 + (bfhi(pv.y) - c3) * m0.w;
}
__device__ __forceinline__ bf16x8 packfrag(const float (&v)[8]) {
    return as_frag(make_uint4(pk2(v[0], v[1]), pk2(v[2], v[3]), pk2(v[4], v[5]), pk2(v[6], v[7])));
}

__device__ __forceinline__ void phase2(const Params& p, unsigned char* smem) {
    unsigned char* ws = p.ws;
    const u16* cA = (const u16*)(ws + O_CA);
    const u16* w2t = (const u16*)(ws + O_W2);
    const u16* a2t = (const u16*)(ws + O_A2);
    const u16* g2t = (const u16*)(ws + O_G2);
    u16* SI = (u16*)(ws + O_SI);
    u16* Gb = (u16*)(ws + O_G);
    float4* rk4 = (float4*)(ws + O_RK);
    const int tid = threadIdx.x, lane = tid & 63, wid = tid >> 6, l16 = lane & 15, g = lane >> 4;
    float* sp = (float*)smem;
    for (int i = tid; i < 1824; i += 256) sp[i] = p.mu[i];
    for (int i = tid; i < 512; i += 256) {
        sp[1824 + i] = p.w0[i]; sp[2336 + i] = p.a0[i]; sp[2848 + i] = p.k_k[i]; sp[3360 + i] = p.k_a[i]; sp[3872 + i] = p.r_k[i];
    }
    __syncthreads();
    const int NU = (T / 64) / (int)gridDim.x * (int)gridDim.x;
    const int NW = NU + (T / 64 - NU) * 8;
    for (int uu = blockIdx.x; uu < NW; uu += gridDim.x) {
        int u, h_lo, h_hi;
        if (uu < NU) { u = uu; h_lo = 0; h_hi = 8; }
        else { const int v = uu - NU; u = NU + (v >> 3); h_lo = v & 7; h_hi = h_lo + 1; }
        const int mw = u * 64 + wid * 16;
        const int m = mw + l16;
        const bool isP = mw < TP;
        int seq, tt;
        if (isP) { seq = m >> 12; tt = m & 4095; }
        else { const int ms = m - TP; seq = 16 + (ms >> 5); tt = ms & 31; }
        const u16* cur = cA + ((size_t)m + seq + 1) * ACOLS;
        const u16* prv = cur - ACOLS;
        bf16x8 xw[2], xa[2], xg[5];
#pragma unroll
        for (int s = 0; s < 9; ++s) {
            float xs[8];
            lerp8(cur, prv, sp, 1536 + s * 32 + g * 8, xs);
            if (s < 2) {
#pragma unroll
                for (int i = 0; i < 8; ++i) xs[i] = 1.f - 2.f / (__expf(2.f * xs[i]) + 1.f);
                xw[s] = packfrag(xs);
            } else if (s < 4) {
                xa[s - 2] = packfrag(xs);
            } else {
#pragma unroll
                for (int i = 0; i < 8; ++i) xs[i] = sigmoidf_(xs[i]);
                xg[s - 4] = packfrag(xs);
            }
        }
        bf16x8 nw0, nw1, na0, na1;
        uint2 ncr, npr, nck, npk, ncv, npv;
#define P2_FETCH(hh, ntt)                                                          \
        {                                                                          \
            const int wr_ = (hh) * 64 + (ntt) * 16 + l16;                          \
            nw0 = *(const bf16x8*)(w2t + wr_ * 64 + g * 8);                        \
            nw1 = *(const bf16x8*)(w2t + wr_ * 64 + 32 + g * 8);                   \
            na0 = *(const bf16x8*)(a2t + wr_ * 64 + g * 8);                        \
            na1 = *(const bf16x8*)(a2t + wr_ * 64 + 32 + g * 8);                   \
            const int ch_ = (hh) * 64 + (ntt) * 16 + g * 4;                        \
            ncr = *(const uint2*)(cur + ch_);        npr = *(const uint2*)(prv + ch_);        \
            nck = *(const uint2*)(cur + 512 + ch_);  npk = *(const uint2*)(prv + 512 + ch_);  \
            ncv = *(const uint2*)(cur + 1024 + ch_); npv = *(const uint2*)(prv + 1024 + ch_); \
        }
        P2_FETCH(h_lo, 0)
        for (int h = h_lo; h < h_hi; ++h) {
            float kkr[16], av[16];
            float ssq = 0.f, rkacc = 0.f, bracc = 0.f, kracc = 0.f;
            const size_t sirow = isP ? ((size_t)(seq * 8 + h) * 4096 + tt) : ((size_t)128 * 4096 + (size_t)((seq - 16) * 8 + h) * 32 + tt);
            u16* sib = SI + sirow * 384;
#pragma unroll
            for (int nt = 0; nt < 4; ++nt) {
                const bf16x8 cw0 = nw0, cw1 = nw1, ca0 = na0, ca1 = na1;
                const uint2 ccr = ncr, cpr = npr, cck = nck, cpk = npk, ccv = ncv, cpv = npv;
                if (nt < 3) { P2_FETCH(h, nt + 1) } else if (h + 1 < h_hi) { P2_FETCH(h + 1, 0) }
                const u16* gw_ = g2t + (h * 64 + nt * 16 + l16) * 160 + g * 8;
                const bf16x8 cg0 = *(const bf16x8*)(gw_), cg1 = *(const bf16x8*)(gw_ + 32), cg2 = *(const bf16x8*)(gw_ + 64),
                             cg3 = *(const bf16x8*)(gw_ + 96), cg4 = *(const bf16x8*)(gw_ + 128);
                __builtin_amdgcn_sched_barrier(0);
                f32x4 accw = {0.f, 0.f, 0.f, 0.f}, acca = accw;
                accw = MFMA(cw0, xw[0], accw); accw = MFMA(cw1, xw[1], accw);
                acca = MFMA(ca0, xa[0], acca); acca = MFMA(ca1, xa[1], acca);
                const int ch = h * 64 + nt * 16 + g * 4;
                float xr[4], xk[4], xv[4];
                lerp4w(ccr, cpr, sp, ch, xr);
                lerp4w(cck, cpk, sp, 512 + ch, xk);
                lerp4w(ccv, cpv, sp, 1024 + ch, xv);
                const float4 w0 = *(const float4*)(sp + 1824 + ch), a0 = *(const float4*)(sp + 2336 + ch), kk4 = *(const float4*)(sp + 2848 + ch),
                             ka4 = *(const float4*)(sp + 3360 + ch), rk4 = *(const float4*)(sp + 3872 + ch);
                const float w0a[4] = {w0.x, w0.y, w0.z, w0.w}, a0a[4] = {a0.x, a0.y, a0.z, a0.w}, kka[4] = {kk4.x, kk4.y, kk4.z, kk4.w},
                            kaa[4] = {ka4.x, ka4.y, ka4.z, ka4.w}, rka[4] = {rk4.x, rk4.y, rk4.z, rk4.w};
                float ev[4], kp[4], dr[4];
#pragma unroll
                for (int r = 0; r < 4; ++r) {
                    const float z = -(w0a[r] + accw[r]);
                    const float sp = (z > 20.f) ? z : __logf(1.f + __expf(z));
                    ev[r] = __expf(-sp - 0.5f);
                    const float a = sigmoidf_(a0a[r] + acca[r]);
                    const float kraw = xk[r] * kka[r];
                    ssq += kraw * kraw;
                    kp[r] = xk[r] * (1.f + (a - 1.f) * kaa[r]);
                    rkacc += xr[r] * kp[r] * rka[r];
                    kracc += xr[r] * kp[r];
                    bracc += kraw * a * xr[r];
                    dr[r] = xr[r] * __expf(-ev[r]);
                    kkr[nt * 4 + r] = kraw;
                    av[nt * 4 + r] = a;
                }
                const int co = nt * 16 + g * 4;
                *(uint2*)(sib + 0 * 64 + co) = pk4(dr[0], dr[1], dr[2], dr[3]);
                *(uint2*)(sib + 1 * 64 + co) = pk4(ev[0], ev[1], ev[2], ev[3]);
                *(uint2*)(sib + 2 * 64 + co) = pk4(kp[0], kp[1], kp[2], kp[3]);
                *(uint2*)(sib + 3 * 64 + co) = pk4(xv[0], xv[1], xv[2], xv[3]);
                f32x4 accg = {0.f, 0.f, 0.f, 0.f};
                accg = MFMA(cg0, xg[0], accg); accg = MFMA(cg1, xg[1], accg); accg = MFMA(cg2, xg[2], accg);
                accg = MFMA(cg3, xg[3], accg); accg = MFMA(cg4, xg[4], accg);
                *(uint2*)(Gb + (size_t)m * 512 + ch) = pk4(accg[0], accg[1], accg[2], accg[3]);
            }
            ssq = red_g(ssq);
            rkacc = red_g(rkacc);
            bracc = red_g(bracc);
            kracc = red_g(kracc);
            const float inv = rsqrtf(fmaxf(ssq, 1e-24f));
#pragma unroll
            for (int nt = 0; nt < 4; ++nt) {
                const int co = nt * 16 + g * 4;
                float k0 = kkr[nt * 4 + 0] * inv, k1 = kkr[nt * 4 + 1] * inv, k2 = kkr[nt * 4 + 2] * inv, k3 = kkr[nt * 4 + 3] * inv;
                *(uint2*)(sib + 4 * 64 + co) = pk4(k0, k1, k2, k3);
                *(uint2*)(sib + 5 * 64 + co) = pk4(k0 * av[nt * 4 + 0], k1 * av[nt * 4 + 1], k2 * av[nt * 4 + 2], k3 * av[nt * 4 + 3]);
            }
            if (g == 0) rk4[(size_t)m * 8 + h] = make_float4(rkacc, bracc * inv, kracc, 0.f);
        }
    }
}

typedef float v2f __attribute__((ext_vector_type(2)));
__device__ __forceinline__ void scan_item(const Params& p, const u16* __restrict__ si, int nch, const float* __restrict__ s0, float* __restrict__ sout,
                          int m0, int h, int half, unsigned char* smem) {
    float* inb = (float*)smem;
    float* ybuf = (float*)(smem + 49152);
    float* scal = (float*)(smem + 53248);
    unsigned char* ws = p.ws;
    const float4* rk4 = (const float4*)(ws + O_RK);
    u16* yraw = (u16*)(ws + O_YRAW);
    const int tid = threadIdx.x;
    const int vp = tid >> 3, kq = tid & 7;
    const int row = half * 32 + vp;
    v2f S[4];
    if (s0) {
        const float4 a = *(const float4*)(s0 + row * 64 + kq * 8), b = *(const float4*)(s0 + row * 64 + kq * 8 + 4);
        S[0] = (v2f){a.x, a.y}; S[1] = (v2f){a.z, a.w}; S[2] = (v2f){b.x, b.y}; S[3] = (v2f){b.z, b.w};
    } else {
#pragma unroll
        for (int j = 0; j < 4; ++j) S[j] = (v2f){0.f, 0.f};
    }
    uint4 st0, st1, st2;
    float4 sq = make_float4(0.f, 0.f, 0.f, 0.f);
    st0 = *(const uint4*)(si + (0 * 256 + tid) * 8);
    st1 = *(const uint4*)(si + (1 * 256 + tid) * 8);
    st2 = *(const uint4*)(si + (2 * 256 + tid) * 8);
    if (tid < 16) sq = rk4[(m0 + tid) * 8 + h];
#define S_WRITE1(sv, i, buf)                                                                                          \
    {                                                                                                                 \
        const int idx = (i) * 256 + tid;                                                                              \
        const int vec = (idx % 48) >> 3;                                                                              \
        float v[8] = {bflo(sv.x), bfhi(sv.x), bflo(sv.y), bfhi(sv.y), bflo(sv.z), bfhi(sv.z), bflo(sv.w), bfhi(sv.w)}; \
        if (vec == 1) {                                                                                               \
            _Pragma("unroll") for (int k = 0; k < 8; ++k) v[k] = __expf(-v[k]);                                       \
        }                                                                                                             \
        float* d = inb + (buf) * 6144 + idx * 8;                                                                      \
        *(float4*)d = make_float4(v[0], v[1], v[2], v[3]);                                                            \
        *(float4*)(d + 4) = make_float4(v[4], v[5], v[6], v[7]);                                                      \
    }
#define stage_write(buf) S_WRITE1(st0, 0, buf) S_WRITE1(st1, 1, buf) S_WRITE1(st2, 2, buf) if (tid < 16) *(float4*)(scal + (buf) * 64 + tid * 4) = sq;
    stage_write(0)
    __syncthreads();
    for (int c = 0; c < nch; ++c) {
        const int buf = c & 1;
        if (c + 1 < nch) {
            const u16* sn = si + (c + 1) * 6144 + tid * 8;
            st0 = *(const uint4*)(sn);
            st1 = *(const uint4*)(sn + 2048);
            st2 = *(const uint4*)(sn + 4096);
            if (tid < 16) sq = rk4[(m0 + (c + 1) * 16 + tid) * 8 + h];
        }
        const float* cb = inb + buf * 6144;
        const float* cs = scal + buf * 64;
#pragma unroll 2
        for (int tt = 0; tt < 16; ++tt) {
            const float* base = cb + tt * 384;
            v2f kk[4], dr[4], dd[4], bb[4], kv[4];
#define LD8(dst, off)                                                      \
    {                                                                      \
        const float4 q0 = *(const float4*)(base + (off) + kq * 8);         \
        const float4 q1 = *(const float4*)(base + (off) + kq * 8 + 4);     \
        dst[0] = (v2f){q0.x, q0.y}; dst[1] = (v2f){q0.z, q0.w};            \
        dst[2] = (v2f){q1.x, q1.y}; dst[3] = (v2f){q1.z, q1.w};            \
    }
            LD8(kk, 256) LD8(dr, 0) LD8(dd, 64) LD8(bb, 320) LD8(kv, 128)
            const float vv = base[192 + row];
            const float2 brkr = *(const float2*)(cs + tt * 4 + 1);
            v2f a0 = S[0] * kk[0], a1 = S[1] * kk[1], q0 = S[0] * dr[0], q1 = S[1] * dr[1];
            a0 = __builtin_elementwise_fma(S[2], kk[2], a0);
            a1 = __builtin_elementwise_fma(S[3], kk[3], a1);
            q0 = __builtin_elementwise_fma(S[2], dr[2], q0);
            q1 = __builtin_elementwise_fma(S[3], dr[3], q1);
            a0 += a1;
            q0 += q1;
            const float sa = -red8(a0.x + a0.y);
            const float pp = red8(q0.x + q0.y);
            const float y = pp + sa * brkr.x + vv * brkr.y;
            if (kq == 0) ybuf[tt * 32 + vp] = y;
            const v2f sav = (v2f){sa, sa}, vvv = (v2f){vv, vv};
#pragma unroll
            for (int j = 0; j < 4; ++j) S[j] = __builtin_elementwise_fma(S[j], dd[j], __builtin_elementwise_fma(vvv, kv[j], sav * bb[j]));
        }
        __syncthreads();
        {
            const int tt = tid >> 4, e2 = (tid & 15) * 2;
            const float2 y2 = *(const float2*)(ybuf + tt * 32 + e2);
            *(unsigned*)(yraw + (m0 + c * 16 + tt) * 512 + h * 64 + half * 32 + e2) = pk2(y2.x, y2.y);
        }
        if (c + 1 < nch) { stage_write(buf ^ 1) }
        __syncthreads();
    }
    {
        float* d0 = sout + row * 64 + kq * 8;
        *(float4*)d0 = make_float4(S[0].x, S[0].y, S[1].x, S[1].y);
        *(float4*)(d0 + 4) = make_float4(S[2].x, S[2].y, S[3].x, S[3].y);
    }
}

__device__ __forceinline__ void ln_pass(const Params& p) {
    unsigned char* ws = p.ws;
    const u16* yraw = (const u16*)(ws + O_YRAW);
    const u16* Gb = (const u16*)(ws + O_G);
    const u16* SI = (const u16*)(ws + O_SI);
    const float4* rk4 = (const float4*)(ws + O_RK);
    u16* ya = (u16*)(ws + O_YA);
    const int tid = threadIdx.x, cq = (tid & 15) * 4;
    for (int q0 = blockIdx.x * 16; q0 < T * 8; q0 += gridDim.x * 16) {
        const int q = q0 + (tid >> 4);
        const int m = q >> 3, h = q & 7;
        const int e = m * 512 + h * 64 + cq;
        const uint2 yv = *(const uint2*)(yraw + e);
        const float y0 = bflo(yv.x), y1 = bfhi(yv.x), y2 = bflo(yv.y), y3 = bfhi(yv.y);
        const float mean = red16(y0 + y1 + y2 + y3) * (1.f / 64.f);
        const float d0 = y0 - mean, d1 = y1 - mean, d2 = y2 - mean, d3 = y3 - mean;
        const float var = red16(d0 * d0 + d1 * d1 + d2 * d2 + d3 * d3) * (1.f / 64.f);
        const float rstd = rsqrtf(var + 64e-5f);
        const float rkv = rk4[q].x;
        int sirow;
        if (m < TP) sirow = ((m >> 12) * 8 + h) * 4096 + (m & 4095);
        else { const int ms = m - TP; sirow = 128 * 4096 + ((ms >> 5) * 8 + h) * 32 + (ms & 31); }
        const uint2 vq = *(const uint2*)(SI + (size_t)sirow * 384 + 192 + cq);
        const uint2 gg = *(const uint2*)(Gb + e);
        const float4 lw = *(const float4*)(p.ln_w + h * 64 + cq), lb = *(const float4*)(p.ln_b + h * 64 + cq);
        const float o0 = (d0 * rstd * lw.x + lb.x + rkv * bflo(vq.x)) * bflo(gg.x);
        const float o1 = (d1 * rstd * lw.y + lb.y + rkv * bfhi(vq.x)) * bfhi(gg.x);
        const float o2 = (d2 * rstd * lw.z + lb.z + rkv * bflo(vq.y)) * bflo(gg.y);
        const float o3 = (d3 * rstd * lw.w + lb.w + rkv * bfhi(vq.y)) * bfhi(gg.y);
        *(uint2*)(ya + e) = pk4(o0, o1, o2, o3);
    }
}

constexpr int KLD = 136, VLD = 72;
__device__ __forceinline__ void attn_item(const u16* __restrict__ Q, int nq, const u16* __restrict__ K, const u16* __restrict__ Vt, int ldv, int nkt,
                          int lastvalid, u16* __restrict__ O, float lam, const float* __restrict__ subln, unsigned char* smem) {
    u16* sK = (u16*)smem;
    u16* sV = (u16*)(smem + 2 * 64 * KLD * 2);
    float* ex = (float*)smem;
    const int tid = threadIdx.x, lane = tid & 63, wid = tid >> 6, l16 = lane & 15, g = lane >> 4;
    const int n = wid >> 1, qh = wid & 1;
    const bool active = (qh * 32) < nq;
    bf16x8 qf[2][2];
#pragma unroll
    for (int qt = 0; qt < 2; ++qt)
#pragma unroll
        for (int s = 0; s < 2; ++s) {
            const int row = qh * 32 + qt * 16 + l16;
            uint4 v = make_uint4(0, 0, 0, 0);
            if (row < nq) v = *(const uint4*)(Q + (row * 512 + n * 64 + s * 32 + g * 8));
            qf[qt][s] = as_frag(v);
        }
    f32x4 o[2][8];
#pragma unroll
    for (int qt = 0; qt < 2; ++qt)
#pragma unroll
        for (int et = 0; et < 8; ++et) o[qt][et] = (f32x4){0.f, 0.f, 0.f, 0.f};
    float mrow[2] = {-1e30f, -1e30f}, lrow[2] = {0.f, 0.f};
    uint4 kr0, kr1, kr2, kr3, vr0, vr1, vr2, vr3;
    const int krow = tid >> 4, kch = (tid & 15) * 8;
    const int vrow = tid >> 3, vch = (tid & 7) * 8;
    const int ko_ = krow * 512 + kch;
    const int vo_ = vrow * ldv + vch;
#define A_LOAD(key0)                                                      \
    kr0 = *(const uint4*)(K + (ko_ + ((key0) + 0) * 512));                \
    kr1 = *(const uint4*)(K + (ko_ + ((key0) + 16) * 512));               \
    kr2 = *(const uint4*)(K + (ko_ + ((key0) + 32) * 512));               \
    kr3 = *(const uint4*)(K + (ko_ + ((key0) + 48) * 512));               \
    vr0 = *(const uint4*)(Vt + (vo_ + (key0)));                           \
    vr1 = *(const uint4*)(Vt + (vo_ + 32 * ldv + (key0)));                \
    vr2 = *(const uint4*)(Vt + (vo_ + 64 * ldv + (key0)));                \
    vr3 = *(const uint4*)(Vt + (vo_ + 96 * ldv + (key0)));
#define A_STORE(nb)                                                       \
    *(uint4*)(sK + (nb) * 64 * KLD + (krow + 0) * KLD + kch) = kr0;       \
    *(uint4*)(sK + (nb) * 64 * KLD + (krow + 16) * KLD + kch) = kr1;      \
    *(uint4*)(sK + (nb) * 64 * KLD + (krow + 32) * KLD + kch) = kr2;      \
    *(uint4*)(sK + (nb) * 64 * KLD + (krow + 48) * KLD + kch) = kr3;      \
    *(uint4*)(sV + (nb) * 128 * VLD + (vrow + 0) * VLD + vch) = vr0;      \
    *(uint4*)(sV + (nb) * 128 * VLD + (vrow + 32) * VLD + vch) = vr1;     \
    *(uint4*)(sV + (nb) * 128 * VLD + (vrow + 64) * VLD + vch) = vr2;     \
    *(uint4*)(sV + (nb) * 128 * VLD + (vrow + 96) * VLD + vch) = vr3;
    A_LOAD(0)
    A_STORE(0)
    __syncthreads();
    constexpr float SC = 0.125f * 1.4426950408889634f;
    for (int kt = 0; kt < nkt; ++kt) {
        const int buf = kt & 1;
        if (kt + 1 < nkt) { A_LOAD((kt + 1) * 64) }
        __builtin_amdgcn_sched_barrier(0);
        if (active) {
            const int valid = (kt == nkt - 1) ? lastvalid : 64;
            const u16* cK = sK + buf * 64 * KLD + l16 * KLD + n * 64 + g * 8;
            const u16* cV = sV + buf * 128 * VLD + l16 * VLD + g * 4;
            f32x4 s[4][2];
#pragma unroll
            for (int k16 = 0; k16 < 4; ++k16) {
                const bf16x8 kf0 = *(const bf16x8*)(cK + k16 * 16 * KLD);
                const bf16x8 kf1 = *(const bf16x8*)(cK + k16 * 16 * KLD + 32);
#pragma unroll
                for (int qt = 0; qt < 2; ++qt) {
                    f32x4 z = {0.f, 0.f, 0.f, 0.f};
                    z = MFMA(kf0, qf[qt][0], z);
                    s[k16][qt] = MFMA(kf1, qf[qt][1], z);
                }
            }
            bf16x8 pf[2][2];
#pragma unroll
            for (int qt = 0; qt < 2; ++qt) {
                float mx = -1e30f;
                if (valid < 64) {
#pragma unroll
                    for (int k16 = 0; k16 < 4; ++k16)
#pragma unroll
                        for (int r = 0; r < 4; ++r) {
                            float v = s[k16][qt][r] * SC;
                            if (k16 * 16 >= valid) v = -1e30f;
                            s[k16][qt][r] = v;
                            mx = fmaxf(mx, v);
                        }
                } else {
#pragma unroll
                    for (int k16 = 0; k16 < 4; ++k16)
#pragma unroll
                        for (int r = 0; r < 4; ++r) {
                            const float v = s[k16][qt][r] * SC;
                            s[k16][qt][r] = v;
                            mx = fmaxf(mx, v);
                        }
                }
                mx = fmaxf(mx, __shfl_xor(mx, 16));
                mx = fmaxf(mx, __shfl_xor(mx, 32));
                const float mold = mrow[qt];
                const float mnew = fmaxf(mold, mx);
                mrow[qt] = mnew;
                if (__builtin_amdgcn_ballot_w64(mnew > mold) != 0ull) {
                    const float alpha = __builtin_amdgcn_exp2f(mold - mnew);
                    lrow[qt] *= alpha;
#pragma unroll
                    for (int et = 0; et < 8; ++et) {
                        o[qt][et][0] *= alpha; o[qt][et][1] *= alpha; o[qt][et][2] *= alpha; o[qt][et][3] *= alpha;
                    }
                }
                float psum = 0.f;
#pragma unroll
                for (int k16 = 0; k16 < 4; ++k16)
#pragma unroll
                    for (int r = 0; r < 4; ++r) {
                        const float pv = __builtin_amdgcn_exp2f(s[k16][qt][r] - mnew);
                        s[k16][qt][r] = pv;
                        psum += pv;
                    }
                lrow[qt] += psum;
#pragma unroll
                for (int kb = 0; kb < 2; ++kb)
                    pf[qt][kb] = as_frag(make_uint4(pk2(s[2 * kb][qt][0], s[2 * kb][qt][1]), pk2(s[2 * kb][qt][2], s[2 * kb][qt][3]),
                                                    pk2(s[2 * kb + 1][qt][0], s[2 * kb + 1][qt][1]), pk2(s[2 * kb + 1][qt][2], s[2 * kb + 1][qt][3])));
            }
#pragma unroll
            for (int et = 0; et < 8; ++et)
#pragma unroll
                for (int kb = 0; kb < 2; ++kb) {
                    const uint2 lo = *(const uint2*)(cV + et * 16 * VLD + kb * 32);
                    const uint2 hi = *(const uint2*)(cV + et * 16 * VLD + kb * 32 + 16);
                    const bf16x8 vf = as_frag(make_uint4(lo.x, lo.y, hi.x, hi.y));
#pragma unroll
                    for (int qt = 0; qt < 2; ++qt) o[qt][et] = MFMA(vf, pf[qt][kb], o[qt][et]);
                }
        }
        __builtin_amdgcn_sched_barrier(0);
        if (kt + 1 < nkt) { A_STORE(buf ^ 1) }
        __syncthreads();
    }
    float inv[2];
#pragma unroll
    for (int qt = 0; qt < 2; ++qt) {
        const float l = red_g(lrow[qt]);
        inv[qt] = 1.f / fmaxf(l, 1e-30f);
    }
    if (active && n == 1) {
#pragma unroll
        for (int qt = 0; qt < 2; ++qt)
#pragma unroll
            for (int et = 0; et < 8; ++et) {
                const f32x4 v = o[qt][et];
                *(float4*)(ex + (qh * 32 + qt * 16 + l16) * 132 + et * 16 + g * 4) =
                    make_float4(v[0] * inv[qt], v[1] * inv[qt], v[2] * inv[qt], v[3] * inv[qt]);
            }
    }
    __syncthreads();
    if (active && n == 0) {
#pragma unroll
        for (int qt = 0; qt < 2; ++qt) {
            const int row = qh * 32 + qt * 16 + l16;
            float ss = 0.f;
#pragma unroll
            for (int et = 0; et < 8; ++et) {
                const float4 o2 = *(const float4*)(ex + row * 132 + et * 16 + g * 4);
                f32x4 v = o[qt][et];
                v[0] = v[0] * inv[qt] - lam * o2.x;
                v[1] = v[1] * inv[qt] - lam * o2.y;
                v[2] = v[2] * inv[qt] - lam * o2.z;
                v[3] = v[3] * inv[qt] - lam * o2.w;
                o[qt][et] = v;
                ss += v[0] * v[0] + v[1] * v[1] + v[2] * v[2] + v[3] * v[3];
            }
            ss = red_g(ss);
            const float rn = rsqrtf(ss * (1.f / 128.f) + EPS) * 0.8f;
            if (row < nq) {
#pragma unroll
                for (int et = 0; et < 8; ++et) {
                    const float4 sl = *(const float4*)(subln + et * 16 + g * 4);
                    const f32x4 v = o[qt][et];
                    *(uint2*)(O + (row * 512 + et * 16 + g * 4)) = pk4(v[0] * rn * sl.x, v[1] * rn * sl.y, v[2] * rn * sl.z, v[3] * rn * sl.w);
                }
            }
        }
    }
    __syncthreads();
}

__device__ __forceinline__ void phase3(const Params& p, unsigned char* smem) {
    unsigned char* ws = p.ws;
    int* s_item = (int*)(smem + LDS_BYTES - 16);
    unsigned* ctr = (unsigned*)(ws + O_SCAL) + 1;
    const float lam = ((const float*)(ws + O_SCAL))[0];
    const u16* SI = (const u16*)(ws + O_SI);
    const u16* qb = (const u16*)(ws + O_QB);
    const u16* kP = (const u16*)(ws + O_KP);
    const u16* kS = (const u16*)(ws + O_KS);
    const u16* vtP = (const u16*)(ws + O_VTP);
    const u16* vtS = (const u16*)(ws + O_VTS);
    u16* ob = (u16*)(ws + O_OB);
    int stage = 0, sidx = blockIdx.x;
    constexpr int SCAN_BASE = 100000, DONE = 1 << 30;
    for (;;) {
        if (threadIdx.x == 0) {
            int it;
            if (stage == 0) it = (sidx < 768) ? SCAN_BASE + sidx : -2;
            else {
                const int x = blockIdx.x & 7;
                const int i = (int)atomicAdd(ctr + 16 + x, 1u);
                if (i < 512) it = ((63 - (i >> 3)) << 6) | (x + 8 * (i & 7));
                else if (i < 528) it = 4096 + (x + 8 * (i - 512));
                else it = DONE;
            }
            *s_item = it;
        }
        __syncthreads();
        const int item = __builtin_amdgcn_readfirstlane(*s_item);
        __syncthreads();
        if (item == DONE) break;
        if (item == -2) {
            asm volatile("s_waitcnt vmcnt(0) lgkmcnt(0)" ::: "memory");
            cg::this_grid().sync();
            stage = 1;
            ln_pass(p);
            continue;
        }
        if (item >= SCAN_BASE) {
            sidx += gridDim.x;
            const int sc = item - SCAN_BASE;
            const u16* si; int nch; const float* s0; float* sout; int m0, h, half;
            if (sc < 256) {
                const int chain = sc >> 1;
                half = sc & 1; h = chain & 7;
                si = SI + (size_t)chain * 4096 * 384; nch = 256; s0 = nullptr;
                sout = p.out + OFF_WP + (size_t)chain * 4096; m0 = (chain >> 3) * 4096;
            } else {
                const int t2 = sc - 256, chain = t2 >> 1;
                half = t2 & 1; h = chain & 7;
                si = SI + ((size_t)128 * 4096 + (size_t)chain * 32) * 384; nch = 2; s0 = p.state_wkv + (size_t)chain * 4096;
                sout = p.out + OFF_WS + (size_t)chain * 4096; m0 = TP + (chain >> 3) * 32;
            }
            scan_item(p, si, nch, s0, sout, m0, h, half, smem);
        } else {
            const u16 *Q, *K, *Vt; u16* O; int nq, ldv, nkt, lastvalid;
            if (item < 4096) {
                const int c = item >> 6, bh = item & 63, b = bh >> 2, h = bh & 3;
                const size_t m0 = (size_t)b * 4096 + (size_t)c * 64;
                Q = qb + m0 * 512 + h * 128; nq = 64; K = kP + (size_t)b * 4096 * 512 + h * 128;
                Vt = vtP + ((size_t)b * 512 + h * 128) * 4096; ldv = 4096; nkt = c + 1; lastvalid = 64; O = ob + m0 * 512 + h * 128;
            } else {
                const int idx = item - 4096;
                const int b = idx >> 2, h = idx & 3;
                const size_t m0 = (size_t)TP + (size_t)b * 32;
                Q = qb + m0 * 512 + h * 128; nq = 32; K = kS + (size_t)b * LKS * 512 + h * 128;
                Vt = vtS + ((size_t)b * 512 + h * 128) * LKS; ldv = LKS; nkt = 17; lastvalid = 32; O = ob + m0 * 512 + h * 128;
            }
            attn_item(Q, nq, K, Vt, ldv, nkt, lastvalid, O, lam, p.subln, smem);
        }
    }
}

__device__ __forceinline__ void phase4(const Params& p, unsigned char* smem) {
    unsigned char* ws = p.ws;
    const u16* ya = (const u16*)(ws + O_YA);
    const u16* ob = (const u16*)(ws + O_OB);
    const u16* Wa = (const u16*)(ws + O_WOA);
    const u16* Wb = (const u16*)(ws + O_WOB);
    const u16* gate = (const u16*)p.out;
    u16* mix = (u16*)(ws + O_MIX);
    const int tid = threadIdx.x, lane = tid & 63, wid = tid >> 6, wm = wid >> 1, wn = wid & 1, l16 = lane & 15, g = lane >> 4;
    constexpr int NT = 8;
    for (int t = blockIdx.x; t < 520 * NT; t += gridDim.x) {
        int mtile, ntile;
        tile_map(t, NT, mtile, ntile);
        const int m0 = mtile * 128, n0 = ntile * 128;
        f32x4 acc[4][4], acc2[4][4];
        zero_acc(acc);
        zero_acc(acc2);
        gemm_loop(ya + (size_t)m0 * 512, 512, Wa + (size_t)n0 * 512, 512, 8, (u16*)smem, acc);
        gemm_loop(ob + (size_t)m0 * 512, 512, Wb + (size_t)n0 * 512, 512, 8, (u16*)smem, acc2);
#pragma unroll
        for (int mt = 0; mt < 4; ++mt) {
            const int m = m0 + wm * 64 + mt * 16 + l16;
#pragma unroll
            for (int nt = 0; nt < 4; ++nt) {
                const int n = n0 + wn * 64 + nt * 16 + g * 4;
                const uint2 ga = *(const uint2*)(gate + (size_t)m * 2048 + n);
                const uint2 gb = *(const uint2*)(gate + (size_t)m * 2048 + 1024 + n);
                const f32x4 a = acc[nt][mt], b = acc2[nt][mt];
                *(uint2*)(mix + (size_t)m * 1024 + n) =
                    pk4(bflo(ga.x) * a[0] + bflo(gb.x) * b[0], bfhi(ga.x) * a[1] + bfhi(gb.x) * b[1],
                        bflo(ga.y) * a[2] + bflo(gb.y) * b[2], bfhi(ga.y) * a[3] + bfhi(gb.y) * b[3]);
            }
        }
    }
}

__device__ __forceinline__ void gemm_rowss(const u16* A, int K, const u16* W, u16* outb, float* ssq, unsigned char* smem) {
    const int tid = threadIdx.x, lane = tid & 63, wid = tid >> 6, wm = wid >> 1, wn = wid & 1, l16 = lane & 15, g = lane >> 4;
    constexpr int NT = 8;
    for (int t = blockIdx.x; t < 520 * NT; t += gridDim.x) {
        int mtile, ntile;
        tile_map(t, NT, mtile, ntile);
        const int m0 = mtile * 128, n0 = ntile * 128;
        f32x4 acc[4][4];
        zero_acc(acc);
        gemm_loop(A + (size_t)m0 * K, K, W + (size_t)n0 * K, K, K / 64, (u16*)smem, acc);
#pragma unroll
        for (int mt = 0; mt < 4; ++mt) {
            const int m = m0 + wm * 64 + mt * 16 + l16;
#pragma unroll
            for (int nt = 0; nt < 4; ++nt) {
                const int n = n0 + wn * 64 + nt * 16 + g * 4;
                const f32x4 a = acc[nt][mt];
                *(uint2*)(outb + (size_t)m * 1024 + n) = pk4(a[0], a[1], a[2], a[3]);
            }
        }
    }
}

__device__ __forceinline__ float sum16(const float* q) {
    const float4 a = *(const float4*)q, b = *(const float4*)(q + 4), c = *(const float4*)(q + 8), d = *(const float4*)(q + 12);
    return ((a.x + a.y) + (a.z + a.w)) + ((b.x + b.y) + (b.z + b.w)) + (((c.x + c.y) + (c.z + c.w)) + ((d.x + d.y) + (d.z + d.w)));
}
__device__ __forceinline__ void phase6(const Params& p) {
    unsigned char* ws = p.ws;
    const u16* m2 = (const u16*)(ws + O_M2);
    u16* x1b = (u16*)(ws + O_X1B);
    float* rs3 = (float*)(ws + O_RS3);
    const int lane = threadIdx.x & 63, wid = threadIdx.x >> 6;
    for (int m = blockIdx.x * 4 + wid; m < T; m += gridDim.x * 4) {
        const float* xr = (m < TP) ? p.x_prompt + (size_t)m * 1024 : p.x_sample + (size_t)(m - TP) * 1024;
        uint2 mvv[4];
        float s2 = 0.f;
#pragma unroll
        for (int i = 0; i < 4; ++i) {
            mvv[i] = *(const uint2*)(m2 + (size_t)m * 1024 + i * 256 + lane * 4);
            const float a = bflo(mvv[i].x), b = bfhi(mvv[i].x), c = bflo(mvv[i].y), d = bfhi(mvv[i].y);
            s2 += a * a + b * b + c * c + d * d;
        }
        s2 = wave_sum(s2);
        const float rs = rsqrtf(s2 * (1.f / 1024.f) + EPS);
        float ss = 0.f;
#pragma unroll
        for (int i = 0; i < 4; ++i) {
            const int col = i * 256 + lane * 4;
            const float4 xv = *(const float4*)(xr + col);
            const uint2 mv = mvv[i];
            const float4 gp = *(const float4*)(p.n_mix_post + col);
            float4 r;
            r.x = xv.x + bflo(mv.x) * rs * gp.x;
            r.y = xv.y + bfhi(mv.x) * rs * gp.y;
            r.z = xv.z + bflo(mv.y) * rs * gp.z;
            r.w = xv.w + bfhi(mv.y) * rs * gp.w;
            ss += r.x * r.x + r.y * r.y + r.z * r.z + r.w * r.w;
            *(float4*)(p.out + (size_t)m * 1024 + col) = r;
            *(uint2*)(x1b + (size_t)m * 1024 + col) = pk4(r.x, r.y, r.z, r.w);
        }
        ss = wave_sum(ss);
        if (lane == 0) rs3[m] = rsqrtf(ss * (1.f / 1024.f) + EPS);
    }
}

__device__ __forceinline__ void phase7(const Params& p, unsigned char* smem) {
    unsigned char* ws = p.ws;
    const u16* x1b = (const u16*)(ws + O_X1B);
    const u16* W = (const u16*)(ws + O_WFI);
    const float* rs3 = (const float*)(ws + O_RS3);
    u16* hb = (u16*)(ws + O_HB);
    const int tid = threadIdx.x, lane = tid & 63, wid = tid >> 6, wm = wid >> 1, wn = wid & 1, l16 = lane & 15, g = lane >> 4;
    constexpr int NT = 44;
    for (int t = blockIdx.x; t < 520 * NT; t += gridDim.x) {
        int mtile, ntile;
        tile_map(t, NT, mtile, ntile);
        const int m0 = mtile * 128, n0 = ntile * 128;
        f32x4 acc[4][4];
        zero_acc(acc);
        gemm_loop(x1b + (size_t)m0 * 1024, 1024, W + (size_t)n0 * 1024, 1024, 16, (u16*)smem, acc);
#pragma unroll
        for (int mt = 0; mt < 4; ++mt) {
            const int m = m0 + wm * 64 + mt * 16 + l16;
            const float rs = rs3[m];
#pragma unroll
            for (int pr = 0; pr < 2; ++pr) {
                const f32x4 ug = acc[2 * pr][mt], uv = acc[2 * pr + 1][mt];
                const int j = ((n0 + wn * 64) >> 5) * 16 + pr * 16 + g * 4;
                float hv[4];
#pragma unroll
                for (int r = 0; r < 4; ++r) {
                    const float a = ug[r] * rs, b = uv[r] * rs;
                    hv[r] = a * sigmoidf_(a) * b;
                }
                *(uint2*)(hb + (size_t)m * 2816 + j) = pk4(hv[0], hv[1], hv[2], hv[3]);
            }
        }
    }
}

__device__ __forceinline__ void phase9(const Params& p) {
    unsigned char* ws = p.ws;
    const u16* fb = (const u16*)(ws + O_FB);
    const int lane = threadIdx.x & 63, wid = threadIdx.x >> 6;
    for (int m = blockIdx.x * 4 + wid; m < T; m += gridDim.x * 4) {
        uint2 fvv[4];
        float s2 = 0.f;
#pragma unroll
        for (int i = 0; i < 4; ++i) {
            fvv[i] = *(const uint2*)(fb + (size_t)m * 1024 + i * 256 + lane * 4);
            const float a = bflo(fvv[i].x), b = bfhi(fvv[i].x), c = bflo(fvv[i].y), d = bfhi(fvv[i].y);
            s2 += a * a + b * b + c * c + d * d;
        }
        s2 = wave_sum(s2);
        const float rs = rsqrtf(s2 * (1.f / 1024.f) + EPS);
#pragma unroll
        for (int i = 0; i < 4; ++i) {
            const int col = i * 256 + lane * 4;
            float4 r = *(const float4*)(p.out + (size_t)m * 1024 + col);
            const uint2 fv = fvv[i];
            const float4 gp = *(const float4*)(p.n_ffn_post + col);
            r.x += bflo(fv.x) * rs * gp.x;
            r.y += bfhi(fv.x) * rs * gp.y;
            r.z += bflo(fv.y) * rs * gp.z;
            r.w += bfhi(fv.y) * rs * gp.w;
            *(float4*)(p.out + (size_t)m * 1024 + col) = r;
        }
    }
}

__global__ void __launch_bounds__(256, 2) mega(Params p) {
    extern __shared__ __attribute__((aligned(16))) unsigned char smem[];
    cg::grid_group grid = cg::this_grid();
#define IN(k) (p.ph_lo <= (k) && (k) < p.ph_hi)
#define SEAM(k) if (IN(k) && IN((k) + 1)) { asm volatile("s_waitcnt vmcnt(0) lgkmcnt(0)" ::: "memory"); grid.sync(); }
    unsigned char* ws = p.ws;
    if (IN(0)) phase0(p, smem);
    SEAM(0)
    if (IN(1)) phase1(p, smem);
    SEAM(1)
    if (IN(2)) phase2(p, smem);
    SEAM(2)
    if (IN(3)) phase3(p, smem);
    SEAM(3)
    if (IN(5)) phase4(p, smem);
    SEAM(5)
    if (IN(6)) gemm_rowss((const u16*)(ws + O_MIX), 1024, (const u16*)(ws + O_WO), (u16*)(ws + O_M2), (float*)(ws + O_SS2), smem);
    SEAM(6)
    if (IN(7)) phase6(p);
    SEAM(7)
    if (IN(8)) phase7(p, smem);
    SEAM(8)
    if (IN(9)) gemm_rowss((const u16*)(ws + O_HB), 2816, (const u16*)(ws + O_WFO), (u16*)(ws + O_FB), (float*)(ws + O_SS4), smem);
    SEAM(9)
    if (IN(10)) phase9(p);
}

extern "C" void kernel_launch(void* const* d_in, const int* in_sizes, int n_in, void* d_out, int out_size, void* d_ws, size_t ws_size,
                              hipStream_t stream) {
    static int grid_blocks = 0;
    if (!grid_blocks) {
        int dev = 0, cus = 0, per_cu = 0;
        hipGetDevice(&dev);
        hipDeviceGetAttribute(&cus, hipDeviceAttributeMultiprocessorCount, dev);
        hipFuncSetAttribute((const void*)mega, hipFuncAttributeMaxDynamicSharedMemorySize, LDS_BYTES);
        hipOccupancyMaxActiveBlocksPerMultiprocessor(&per_cu, (const void*)mega, 256, LDS_BYTES);
        if (per_cu < 1) per_cu = 1;
        if (per_cu > 2) per_cu = 2;
        grid_blocks = cus * per_cu;
        if (ws_size < WS_END) fprintf(stderr, "kernel_launch: workspace too small: %zu < %zu\n", ws_size, (size_t)WS_END);
    }
    Params p{};
    const float** pp = (const float**)&p;
    for (int i = 0; i < 33; ++i) pp[i] = (const float*)d_in[i];
    p.out = (float*)d_out;
    p.ws = (unsigned char*)d_ws;
#ifndef MULTI_LAUNCH
    p.ph_lo = 0;
    p.ph_hi = 11;
    void* args[] = {&p};
    hipError_t e = hipLaunchCooperativeKernel((const void*)mega, dim3(grid_blocks), dim3(256), args, LDS_BYTES, stream);
    if (e != hipSuccess) fprintf(stderr, "cooperative launch failed: %s (grid %d)\n", hipGetErrorString(e), grid_blocks);
#else
    for (int k = 0; k < 11; ++k) {
        p.ph_lo = k;
        p.ph_hi = k + 1;
        hipLaunchKernelGGL(mega, dim3(grid_blocks), dim3(256), LDS_BYTES, stream, p);
    }
#endif
}
```

```cpp
#include <hip/hip_runtime.h>
#include <hip/hip_cooperative_groups.h>
#include <cstdio>
#include <cstdint>
namespace cg = cooperative_groups;

typedef unsigned short u16;
typedef __attribute__((ext_vector_type(8))) short bf16x8;
typedef __attribute__((ext_vector_type(4))) float f32x4;

constexpr int TP = 65536, TS = 1024, T = TP + TS;
constexpr int ACOLS = 1824;
constexpr int LKS = 1088;
constexpr int LDS_BYTES = 73728;
constexpr float EPS = 1e-6f;

constexpr size_t OFF_YS = 67108864ull, OFF_KP = 68157440ull, OFF_VP = 101711872ull, OFF_WP = 135266304ull,
                 OFF_SHP = 135790592ull, OFF_KS = 135819776ull, OFF_VS = 136344064ull, OFF_WS = 136868352ull,
                 OFF_SHS = 137916928ull;

constexpr size_t al(size_t x) { return (x + 255) & ~(size_t)255; }
constexpr size_t O_WIN = 0;
constexpr size_t O_WOA = O_WIN + al(5504ull * 1024 * 2);
constexpr size_t O_WOB = O_WOA + al(1024ull * 512 * 2);
constexpr size_t O_WO = O_WOB + al(1024ull * 512 * 2);
constexpr size_t O_WFI = O_WO + al(1024ull * 1024 * 2);
constexpr size_t O_WFO = O_WFI + al(5632ull * 1024 * 2);
constexpr size_t O_W2 = O_WFO + al(1024ull * 2816 * 2);
constexpr size_t O_A2 = O_W2 + al(512 * 64 * 2);
constexpr size_t O_G2 = O_A2 + al(512 * 64 * 2);
constexpr size_t O_RS1 = O_G2 + al(512 * 160 * 2);
constexpr size_t O_SS2 = O_RS1 + al((size_t)T * 4);
constexpr size_t O_SS4 = O_SS2 + al((size_t)T * 16 * 4);
constexpr size_t O_RS3 = O_SS4 + al((size_t)T * 16 * 4);
constexpr size_t O_RK = O_RS3 + al((size_t)T * 4);
constexpr size_t O_SCAL = O_RK + al((size_t)T * 8 * 16);
constexpr size_t O_REGA = O_SCAL + 256;
constexpr size_t O_CA = O_REGA;
constexpr size_t O_YA = O_REGA;
constexpr size_t O_OB = O_YA + al((size_t)T * 512 * 2);
constexpr size_t O_YRAW = O_OB + al((size_t)T * 512 * 2);
constexpr size_t O_HB = O_REGA;
constexpr size_t O_REGB = O_REGA + al((size_t)(T + 48) * 1824 * 2);
constexpr size_t O_QB = O_REGB;
constexpr size_t O_KP = O_QB + al((size_t)T * 512 * 2);
constexpr size_t O_KS = O_KP + al((size_t)TP * 512 * 2);
constexpr size_t O_VTP = O_KS + al(32ull * LKS * 512 * 2);
constexpr size_t O_VTS = O_VTP + al(16ull * 512 * 4096 * 2);
constexpr size_t O_REGC = O_VTS + al(32ull * 512 * LKS * 2);
constexpr size_t O_GATE = O_REGB;
static_assert(O_GATE + (size_t)T * 2048 * 2 <= O_REGC, "gate overlaps region C");
constexpr size_t O_SI = O_REGC;
constexpr size_t O_G = O_SI + al((size_t)T * 8 * 384 * 2);
constexpr size_t O_XB = O_REGC;
constexpr size_t O_MIX = O_REGC;
constexpr size_t O_M2 = O_MIX + al((size_t)T * 1024 * 2);
constexpr size_t O_X1B = O_M2 + al((size_t)T * 1024 * 2);
constexpr size_t O_FB = O_REGC;
constexpr size_t WS_END = O_G + al((size_t)T * 512 * 2);
static_assert(O_HB + (size_t)T * 2816 * 2 <= O_REGC, "hb overlaps region C");
static_assert(O_YRAW + (size_t)T * 512 * 2 <= O_REGB, "yraw overlaps region B");
static_assert(O_X1B + (size_t)T * 1024 * 2 <= WS_END, "x1b beyond end");
static_assert(WS_END <= 1073741824ull, "workspace too large");

struct Params {
    const float *x_prompt, *x_sample, *cache_k, *cache_v, *state_wkv, *state_shift;
    const float *n_mix_pre, *n_mix_post, *n_ffn_pre, *n_ffn_post, *w_in, *b_gate;
    const float *mu, *w0, *w2, *a0, *a2, *g2, *k_k, *k_a, *r_k, *ln_w, *ln_b;
    const float *lq1, *lk1, *lq2, *lk2, *subln, *w_out_a, *w_out_b, *w_o, *w_ffn_in, *w_ffn_out;
    float* out;
    unsigned char* ws;
    int ph_lo, ph_hi;
};

typedef float v2f_ __attribute__((ext_vector_type(2)));
typedef __bf16 bf2_ __attribute__((ext_vector_type(2)));
__device__ __forceinline__ unsigned pk2(float a, float b) {
    const v2f_ v = {a, b};
    const bf2_ r = __builtin_convertvector(v, bf2_);
    return __builtin_bit_cast(unsigned, r);
}
__device__ __forceinline__ u16 f2bf(float f) { return (u16)(pk2(f, 0.f) & 0xffffu); }
__device__ __forceinline__ float bflo(unsigned u) { return __uint_as_float(u << 16); }
__device__ __forceinline__ float bfhi(unsigned u) { return __uint_as_float(u & 0xffff0000u); }
__device__ __forceinline__ uint2 pk4(float a, float b, float c, float d) { return make_uint2(pk2(a, b), pk2(c, d)); }
__device__ __forceinline__ float sigmoidf_(float x) { return 1.f / (1.f + __expf(-x)); }

template <int CTRL>
__device__ __forceinline__ float dppf(float x) {
    return __int_as_float(__builtin_amdgcn_update_dpp(0, __float_as_int(x), CTRL, 0xF, 0xF, true));
}
__device__ __forceinline__ float red8(float x) {
    x += dppf<0xB1>(x);
    x += dppf<0x4E>(x);
    x += dppf<0x141>(x);
    return x;
}
__device__ __forceinline__ float red16(float x) {
    x = red8(x);
    x += dppf<0x140>(x);
    return x;
}
typedef unsigned u2_ __attribute__((ext_vector_type(2)));
__device__ __forceinline__ float red_g(float x) {
    u2_ r = __builtin_amdgcn_permlane16_swap(__float_as_uint(x), __float_as_uint(x), false, false);
    x = __uint_as_float(r[0]) + __uint_as_float(r[1]);
    r = __builtin_amdgcn_permlane32_swap(__float_as_uint(x), __float_as_uint(x), false, false);
    return __uint_as_float(r[0]) + __uint_as_float(r[1]);
}
__device__ __forceinline__ float max_g(float x) {
    u2_ r = __builtin_amdgcn_permlane16_swap(__float_as_uint(x), __float_as_uint(x), false, false);
    x = fmaxf(__uint_as_float(r[0]), __uint_as_float(r[1]));
    r = __builtin_amdgcn_permlane32_swap(__float_as_uint(x), __float_as_uint(x), false, false);
    return fmaxf(__uint_as_float(r[0]), __uint_as_float(r[1]));
}
__device__ __forceinline__ float wave_sum(float x) {
    x = red16(x);
    return red_g(x);
}
__device__ __forceinline__ bf16x8 as_frag(uint4 v) {
    union { uint4 u; bf16x8 f; } c;
    c.u = v;
    return c.f;
}
#define MFMA(a, b, c) __builtin_amdgcn_mfma_f32_16x16x32_bf16((a), (b), (c), 0, 0, 0)

constexpr int LDT = 72;
constexpr int STG = 128 * LDT;
__device__ __forceinline__ void gemm_loop(const u16* __restrict__ A, int lda, const u16* __restrict__ B, int ldb,
                                          int nkt, u16* smem, f32x4 (&acc)[4][4]) {
    const int tid = threadIdx.x, lane = tid & 63, wid = tid >> 6, wm = wid >> 1, wn = wid & 1, l16 = lane & 15, g = lane >> 4;
    const int lr = tid >> 3, lc = (tid & 7) * 8;
    u16* sA = smem;
    u16* sB = smem + 2 * STG;
    const u16* ap = A + (size_t)lr * lda + lc;
    const u16* bp = B + (size_t)lr * ldb + lc;
    uint4 ra0, ra1, ra2, ra3, rb0, rb1, rb2, rb3;
#define G_LOAD(ko)                                                   \
    ra0 = *(const uint4*)(ap + (ko));                                \
    ra1 = *(const uint4*)(ap + (size_t)32 * lda + (ko));             \
    ra2 = *(const uint4*)(ap + (size_t)64 * lda + (ko));             \
    ra3 = *(const uint4*)(ap + (size_t)96 * lda + (ko));             \
    rb0 = *(const uint4*)(bp + (ko));                                \
    rb1 = *(const uint4*)(bp + (size_t)32 * ldb + (ko));             \
    rb2 = *(const uint4*)(bp + (size_t)64 * ldb + (ko));             \
    rb3 = *(const uint4*)(bp + (size_t)96 * ldb + (ko));
#define G_STORE(bo)                                                  \
    *(uint4*)(sA + (bo) + (lr + 0) * LDT + lc) = ra0;                \
    *(uint4*)(sA + (bo) + (lr + 32) * LDT + lc) = ra1;               \
    *(uint4*)(sA + (bo) + (lr + 64) * LDT + lc) = ra2;               \
    *(uint4*)(sA + (bo) + (lr + 96) * LDT + lc) = ra3;               \
    *(uint4*)(sB + (bo) + (lr + 0) * LDT + lc) = rb0;                \
    *(uint4*)(sB + (bo) + (lr + 32) * LDT + lc) = rb1;               \
    *(uint4*)(sB + (bo) + (lr + 64) * LDT + lc) = rb2;               \
    *(uint4*)(sB + (bo) + (lr + 96) * LDT + lc) = rb3;
    G_LOAD(0)
    G_STORE(0)
    __syncthreads();
    for (int kt = 0; kt < nkt; ++kt) {
        const int buf = kt & 1;
        if (kt + 1 < nkt) { G_LOAD((kt + 1) * 64) }
        __builtin_amdgcn_sched_barrier(0);
        const u16* cA = sA + buf * STG + (wm * 64 + l16) * LDT + g * 8;
        const u16* cB = sB + buf * STG + (wn * 64 + l16) * LDT + g * 8;
#pragma unroll
        for (int ks = 0; ks < 2; ++ks) {
            bf16x8 xf[4], wf[4];
#pragma unroll
            for (int i = 0; i < 4; ++i) {
                xf[i] = *(const bf16x8*)(cA + i * 16 * LDT + ks * 32);
                wf[i] = *(const bf16x8*)(cB + i * 16 * LDT + ks * 32);
            }
#pragma unroll
            for (int nt = 0; nt < 4; ++nt)
#pragma unroll
                for (int mt = 0; mt < 4; ++mt) acc[nt][mt] = MFMA(wf[nt], xf[mt], acc[nt][mt]);
        }
        __builtin_amdgcn_sched_barrier(0);
        if (kt + 1 < nkt) { G_STORE((buf ^ 1) * STG) }
        __syncthreads();
    }
}
__device__ __forceinline__ void gemm_loop_xf32(const float* __restrict__ A, const u16* __restrict__ B, int ldb, int nkt, u16* smem,
                                               f32x4 (&acc)[4][4]) {
    const int tid = threadIdx.x, lane = tid & 63, wid = tid >> 6, wm = wid >> 1, wn = wid & 1, l16 = lane & 15, g = lane >> 4;
    const int lr = tid >> 3, lc = (tid & 7) * 8;
    u16* sA = smem;
    u16* sB = smem + 2 * STG;
    const float* ap = A + (size_t)lr * 1024 + lc;
    const u16* bp = B + (size_t)lr * ldb + lc;
    float4 fa0, fa1, fa2, fa3, fa4, fa5, fa6, fa7;
    uint4 rb0, rb1, rb2, rb3;
#define GX_LOAD(ko)                                                  \
    fa0 = *(const float4*)(ap + (ko));                               \
    fa1 = *(const float4*)(ap + (ko) + 4);                           \
    fa2 = *(const float4*)(ap + 32 * 1024 + (ko));                   \
    fa3 = *(const float4*)(ap + 32 * 1024 + (ko) + 4);               \
    fa4 = *(const float4*)(ap + 64 * 1024 + (ko));                   \
    fa5 = *(const float4*)(ap + 64 * 1024 + (ko) + 4);               \
    fa6 = *(const float4*)(ap + 96 * 1024 + (ko));                   \
    fa7 = *(const float4*)(ap + 96 * 1024 + (ko) + 4);               \
    rb0 = *(const uint4*)(bp + (ko));                                \
    rb1 = *(const uint4*)(bp + (size_t)32 * ldb + (ko));             \
    rb2 = *(const uint4*)(bp + (size_t)64 * ldb + (ko));             \
    rb3 = *(const uint4*)(bp + (size_t)96 * ldb + (ko));
#define PKF(a, b) make_uint4(pk2(a.x, a.y), pk2(a.z, a.w), pk2(b.x, b.y), pk2(b.z, b.w))
#define GX_STORE(bo)                                                 \
    *(uint4*)(sA + (bo) + (lr + 0) * LDT + lc) = PKF(fa0, fa1);      \
    *(uint4*)(sA + (bo) + (lr + 32) * LDT + lc) = PKF(fa2, fa3);     \
    *(uint4*)(sA + (bo) + (lr + 64) * LDT + lc) = PKF(fa4, fa5);     \
    *(uint4*)(sA + (bo) + (lr + 96) * LDT + lc) = PKF(fa6, fa7);     \
    *(uint4*)(sB + (bo) + (lr + 0) * LDT + lc) = rb0;                \
    *(uint4*)(sB + (bo) + (lr + 32) * LDT + lc) = rb1;               \
    *(uint4*)(sB + (bo) + (lr + 64) * LDT + lc) = rb2;               \
    *(uint4*)(sB + (bo) + (lr + 96) * LDT + lc) = rb3;
    GX_LOAD(0)
    GX_STORE(0)
    __syncthreads();
    for (int kt = 0; kt < nkt; ++kt) {
        const int buf = kt & 1;
        if (kt + 1 < nkt) { GX_LOAD((kt + 1) * 64) }
        __builtin_amdgcn_sched_barrier(0);
        const u16* cA = sA + buf * STG + (wm * 64 + l16) * LDT + g * 8;
        const u16* cB = sB + buf * STG + (wn * 64 + l16) * LDT + g * 8;
#pragma unroll
        for (int ks = 0; ks < 2; ++ks) {
            bf16x8 xf[4], wf[4];
#pragma unroll
            for (int i = 0; i < 4; ++i) {
                xf[i] = *(const bf16x8*)(cA + i * 16 * LDT + ks * 32);
                wf[i] = *(const bf16x8*)(cB + i * 16 * LDT + ks * 32);
            }
#pragma unroll
            for (int nt = 0; nt < 4; ++nt)
#pragma unroll
                for (int mt = 0; mt < 4; ++mt) acc[nt][mt] = MFMA(wf[nt], xf[mt], acc[nt][mt]);
        }
        __builtin_amdgcn_sched_barrier(0);
        if (kt + 1 < nkt) { GX_STORE((buf ^ 1) * STG) }
        __syncthreads();
    }
}
__device__ __forceinline__ void zero_acc(f32x4 (&acc)[4][4]) {
#pragma unroll
    for (int i = 0; i < 4; ++i)
#pragma unroll
        for (int j = 0; j < 4; ++j) acc[i][j] = (f32x4){0.f, 0.f, 0.f, 0.f};
}
__device__ __forceinline__ void tile_map(int t, int NT, int& mt, int& nt) {
    const int x = t & 7, u = t >> 3;
    const int gsz = 8 * NT;
    const int g = u / gsz;
    const int w = u - g * gsz;
    const int rows = (g < 8) ? 8 : 1;
    const int q = w / rows;
    mt = x * 65 + g * 8 + (w - q * rows);
    nt = q;
}

__device__ __forceinline__ void tr_tile(const float* __restrict__ in, int R, int C, int ldin, u16* __restrict__ out, int ldout,
                        const float* __restrict__ scale, int r0, int c0, int Cout, bool perm, float* tile) {
    const int tid = threadIdx.x;
    {
        const int tx = tid & 63, ty = tid >> 6;
        const int c = c0 + tx;
        for (int rr = ty; rr < 64; rr += 4) {
            const int r = r0 + rr;
            float v = 0.f;
            if (r < R && c < C) {
                v = in[(size_t)r * ldin + c];
                if (scale) v *= scale[r];
            }
            tile[rr * 65 + tx] = v;
        }
    }
    __syncthreads();
    {
        const int rch = (tid & 7) * 8;
#pragma unroll
        for (int pass = 0; pass < 2; ++pass) {
            const int cc = (tid >> 3) + pass * 32;
            const int c = c0 + cc;
            if (c < Cout && r0 + rch < R) {
                float v[8];
#pragma unroll
                for (int k = 0; k < 8; ++k) v[k] = tile[(rch + k) * 65 + cc];
                int orow = c;
                if (perm) {
                    const int type = c >= 2816 ? 1 : 0;
                    const int j = c - type * 2816;
                    orow = (j >> 4) * 32 + type * 16 + (j & 15);
                }
                uint4 o = make_uint4(pk2(v[0], v[1]), pk2(v[2], v[3]), pk2(v[4], v[5]), pk2(v[6], v[7]));
                *(uint4*)(out + (size_t)orow * ldout + r0 + rch) = o;
            }
        }
    }
    __syncthreads();
}

__device__ __forceinline__ void phase0(const Params& p, unsigned char* smem) {
    float* tile = (float*)smem;
    const int tid = threadIdx.x, lane = tid & 63, wid = tid >> 6;
    unsigned char* ws = p.ws;
    const int G = gridDim.x;
    for (int u = blockIdx.x; u < 8136; u += G) {
        const float* in;
        int R, C, Cout, ldout, tl;
        u16* out;
        const float* scale = nullptr;
        bool perm = false;
        if (u < 1376) { tl = u; in = p.w_in; R = 1024; C = 5408; Cout = 5504; out = (u16*)(ws + O_WIN); ldout = 1024; scale = p.n_mix_pre; }
        else if (u < 1504) { tl = u - 1376; in = p.w_out_a; R = 512; C = 1024; Cout = 1024; out = (u16*)(ws + O_WOA); ldout = 512; }
        else if (u < 1632) { tl = u - 1504; in = p.w_out_b; R = 512; C = 1024; Cout = 1024; out = (u16*)(ws + O_WOB); ldout = 512; }
        else if (u < 1888) { tl = u - 1632; in = p.w_o; R = 1024; C = 1024; Cout = 1024; out = (u16*)(ws + O_WO); ldout = 1024; }
        else if (u < 3296) { tl = u - 1888; in = p.w_ffn_in; R = 1024; C = 5632; Cout = 5632; out = (u16*)(ws + O_WFI); ldout = 1024; scale = p.n_ffn_pre; perm = true; }
        else if (u < 4000) { tl = u - 3296; in = p.w_ffn_out; R = 2816; C = 1024; Cout = 1024; out = (u16*)(ws + O_WFO); ldout = 2816; }
        else if (u < 4008) { tl = u - 4000; in = p.w2; R = 64; C = 512; Cout = 512; out = (u16*)(ws + O_W2); ldout = 64; }
        else if (u < 4016) { tl = u - 4008; in = p.a2; R = 64; C = 512; Cout = 512; out = (u16*)(ws + O_A2); ldout = 64; }
        else if (u < 4040) { tl = u - 4016; in = p.g2; R = 160; C = 512; Cout = 512; out = (u16*)(ws + O_G2); ldout = 160; }
        else {
            tl = u - 4040;
            const int b = tl >> 7;
            tl &= 127;
            in = p.cache_v + (size_t)b * 1024 * 512; R = 1024; C = 512; Cout = 512;
            out = (u16*)(ws + O_VTS) + (size_t)b * 512 * LKS; ldout = LKS;
        }
        const int ctiles = (Cout + 63) >> 6;
        const int rt = tl / ctiles, ct = tl - rt * ctiles;
        tr_tile(in, R, C, C, out, ldout, scale, rt * 64, ct * 64, Cout, perm, tile);
    }
    {
        u16* xb = (u16*)(ws + O_XB);
        float* rs1 = (float*)(ws + O_RS1);
        for (int m = blockIdx.x * 4 + wid; m < T; m += G * 4) {
            const float* xr = (m < TP) ? p.x_prompt + (size_t)m * 1024 : p.x_sample + (size_t)(m - TP) * 1024;
            float ss = 0.f;
#pragma unroll
            for (int i = 0; i < 4; ++i) {
                const float4 v = *(const float4*)(xr + i * 256 + lane * 4);
                ss += v.x * v.x + v.y * v.y + v.z * v.z + v.w * v.w;
                *(uint2*)(xb + (size_t)m * 1024 + i * 256 + lane * 4) = pk4(v.x, v.y, v.z, v.w);
            }
            ss = wave_sum(ss);
            if (lane == 0) rs1[m] = rsqrtf(ss * (1.f / 1024.f) + EPS);
        }
    }
    {
        u16* kS = (u16*)(ws + O_KS);
        const int n8 = 32 * 1024 * 64;
        for (int i = blockIdx.x * 256 + tid; i < n8; i += G * 256) {
            const int b = i >> 16, rem = i & 65535, key = rem >> 6, c8 = rem & 63;
            const float4 v0 = *(const float4*)(p.cache_k + (size_t)i * 8);
            const float4 v1 = *(const float4*)(p.cache_k + (size_t)i * 8 + 4);
            *(uint4*)(kS + ((size_t)b * LKS + key) * 512 + c8 * 8) =
                make_uint4(pk2(v0.x, v0.y), pk2(v0.z, v0.w), pk2(v1.x, v1.y), pk2(v1.z, v1.w));
        }
        for (int i = blockIdx.x * 256 + tid; i < 32 * 32 * 64; i += G * 256) {
            const int b = i >> 11, rem = i & 2047, row = rem >> 6, c8 = rem & 63;
            *(uint4*)(kS + ((size_t)b * LKS + 1056 + row) * 512 + c8 * 8) = make_uint4(0, 0, 0, 0);
        }
        u16* vtS = (u16*)(ws + O_VTS);
        for (int i = blockIdx.x * 256 + tid; i < 32 * 512 * 4; i += G * 256) {
            const int row = i >> 2, c8 = i & 3;
            *(uint4*)(vtS + (size_t)row * LKS + 1056 + c8 * 8) = make_uint4(0, 0, 0, 0);
        }
    }
    {
        u16* cA = (u16*)(ws + O_CA);
        for (int i = blockIdx.x * 256 + tid; i < 48 * ACOLS; i += G * 256) {
            const int s = i / ACOLS, c = i - s * ACOLS;
            float v = 0.f;
            size_t row;
            if (s < 16) row = (size_t)s * 4097;
            else { row = (size_t)16 * 4097 + (size_t)(s - 16) * 33; v = p.state_shift[(size_t)(s - 16) * ACOLS + c]; }
            cA[row * ACOLS + c] = f2bf(v);
        }
        if (blockIdx.x == 0 && tid == 0) {
            float d1 = 0.f, d2 = 0.f;
            for (int i = 0; i < 64; ++i) { d1 += p.lq1[i] * p.lk1[i]; d2 += p.lq2[i] * p.lk2[i]; }
            float* sc = (float*)(ws + O_SCAL);
            sc[0] = __expf(d1) - __expf(d2) + 0.2f;
            for (int i = 1; i < 32; ++i) ((unsigned*)sc)[i] = 0u;
        }
    }
}

__device__ __forceinline__ void phase1(const Params& p, unsigned char* smem) {
    unsigned char* ws = p.ws;
    const u16* xb = (const u16*)(ws + O_XB);
    const u16* W = (const u16*)(ws + O_WIN);
    const float* rs1 = (const float*)(ws + O_RS1);
    u16* cA = (u16*)(ws + O_CA);
    u16* qb = (u16*)(ws + O_QB);
    u16* kP = (u16*)(ws + O_KP);
    u16* kS = (u16*)(ws + O_KS);
    u16* vtP = (u16*)(ws + O_VTP);
    u16* vtS = (u16*)(ws + O_VTS);
    float* out = p.out;
    const int tid = threadIdx.x, lane = tid & 63, wid = tid >> 6, wm = wid >> 1, wn = wid & 1, l16 = lane & 15, g = lane >> 4;
    constexpr int NT = 43;
    u16* gate = (u16*)p.out;
    for (int t = blockIdx.x; t < 520 * NT; t += gridDim.x) {
        int mtile, ntile;
        tile_map(t, NT, mtile, ntile);
        const int m0 = mtile * 128, n0 = ntile * 128;
        f32x4 acc[4][4];
        zero_acc(acc);
        gemm_loop(xb + (size_t)m0 * 1024, 1024, W + (size_t)n0 * 1024, 1024, 16, (u16*)smem, acc);
#pragma unroll
        for (int mt = 0; mt < 4; ++mt) {
            const int m = m0 + wm * 64 + mt * 16 + l16;
            const float rs = rs1[m];
            const bool isP = m < TP;
            int seq, tt;
            if (isP) { seq = m >> 12; tt = m & 4095; }
            else { const int ms = m - TP; seq = 16 + (ms >> 5); tt = ms & 31; }
            const size_t carow = (size_t)m + seq + 1;
            const bool last = isP ? (tt == 4095) : (tt == 31);
#pragma unroll
            for (int nt = 0; nt < 4; ++nt) {
                const int n = n0 + wn * 64 + nt * 16 + g * 4;
                if (n >= 5408) continue;
                f32x4 v = acc[nt][mt];
                v[0] *= rs; v[1] *= rs; v[2] *= rs; v[3] *= rs;
                if (n < 1824) {
                    *(uint2*)(cA + carow * ACOLS + n) = pk4(v[0], v[1], v[2], v[3]);
                    if (last) {
                        float* so = isP ? out + OFF_SHP + (size_t)seq * ACOLS + n : out + OFF_SHS + (size_t)(seq - 16) * ACOLS + n;
                        *(float4*)so = make_float4(v[0], v[1], v[2], v[3]);
                    }
                } else if (n < 2336) {
                    *(uint2*)(qb + (size_t)m * 512 + (n - 1824)) = pk4(v[0], v[1], v[2], v[3]);
                } else if (n < 2848) {
                    const int c = n - 2336;
                    if (isP) {
                        *(uint2*)(kP + (size_t)m * 512 + c) = pk4(v[0], v[1], v[2], v[3]);
                        *(float4*)(out + OFF_KP + (size_t)m * 512 + c) = make_float4(v[0], v[1], v[2], v[3]);
                    } else {
                        *(uint2*)(kS + ((size_t)(seq - 16) * LKS + 1024 + tt) * 512 + c) = pk4(v[0], v[1], v[2], v[3]);
                        *(float4*)(out + OFF_KS + (size_t)(m - TP) * 512 + c) = make_float4(v[0], v[1], v[2], v[3]);
                    }
                } else if (n < 3360) {
                    const int c = n - 2848;
                    if (isP) {
                        *(float4*)(out + OFF_VP + (size_t)m * 512 + c) = make_float4(v[0], v[1], v[2], v[3]);
                        u16* d = vtP + ((size_t)seq * 512 + c) * 4096 + tt;
                        d[0] = f2bf(v[0]); d[4096] = f2bf(v[1]); d[2 * 4096] = f2bf(v[2]); d[3 * 4096] = f2bf(v[3]);
                    } else {
                        *(float4*)(out + OFF_VS + (size_t)(m - TP) * 512 + c) = make_float4(v[0], v[1], v[2], v[3]);
                        u16* d = vtS + ((size_t)(seq - 16) * 512 + c) * LKS + 1024 + tt;
                        d[0] = f2bf(v[0]); d[LKS] = f2bf(v[1]); d[2 * LKS] = f2bf(v[2]); d[3 * LKS] = f2bf(v[3]);
                    }
                } else {
                    const int c = n - 3360;
                    const float4 bg = *(const float4*)(p.b_gate + c);
                    *(uint2*)(gate + (size_t)m * 2048 + c) =
                        pk4(sigmoidf_(v[0] + bg.x), sigmoidf_(v[1] + bg.y), sigmoidf_(v[2] + bg.z), sigmoidf_(v[3] + bg.w));
                }
            }
        }
    }
}

__device__ __forceinline__ void lerp8(const u16* cur, const u16* prv, const float* mu, int col, float (&xs)[8]) {
    const uint4 cu = *(const uint4*)(cur + col);
    const uint4 pv = *(const uint4*)(prv + col);
    const float4 m0 = *(const float4*)(mu + col);
    const float4 m1 = *(const float4*)(mu + col + 4);
    const unsigned cw[4] = {cu.x, cu.y, cu.z, cu.w}, pw[4] = {pv.x, pv.y, pv.z, pv.w};
    const float mm[8] = {m0.x, m0.y, m0.z, m0.w, m1.x, m1.y, m1.z, m1.w};
#pragma unroll
    for (int i = 0; i < 4; ++i) {
        const float c0 = bflo(cw[i]), c1 = bfhi(cw[i]), p0 = bflo(pw[i]), p1 = bfhi(pw[i]);
        xs[2 * i] = c0 + (p0 - c0) * mm[2 * i];
        xs[2 * i + 1] = c1 + (p1 - c1) * mm[2 * i + 1];
    }
}
__device__ __forceinline__ void lerp4(const u16* cur, const u16* prv, const float* mu, int col, float (&xs)[4]) {
    const uint2 cu = *(const uint2*)(cur + col);
    const uint2 pv = *(const uint2*)(prv + col);
    const float4 m0 = *(const float4*)(mu + col);
    float c0 = bflo(cu.x), c1 = bfhi(cu.x), c2 = bflo(cu.y), c3 = bfhi(cu.y);
    xs[0] = c0 + (bflo(pv.x) - c0) * m0.x;
    xs[1] = c1 + (bfhi(pv.x) - c1) * m0.y;
    xs[2] = c2 + (bflo(pv.y) - c2) * m0.z;
    xs[3] = c3 + (bfhi(pv.y) - c3) * m0.w;
}
__device__ __forceinline__ void lerp4w(const uint2 cu, const uint2 pv, const float* mu, int col, float (&xs)[4]) {
    const float4 m0 = *(const float4*)(mu + col);
    const float c0 = bflo(cu.x), c1 = bfhi(cu.x), c2 = bflo(cu.y), c3 = bfhi(cu.y);
    xs[0] = c0 + (bflo(pv.x) - c0) * m0.x;
    xs[1] = c1 + (bfhi(pv.x) - c1) * m0.y;
    xs[2] = c2 + (bflo(pv.y) - c2) * m0.z;
    xs[3] = c3 + (bfhi(pv.y) - c3) * m0.w;
}
__device__ __forceinline__ bf16x8 packfrag(const float (&v)[8]) {
    return as_frag(make_uint4(pk2(v[0], v[1]), pk2(v[2], v[3]), pk2(v[4], v[5]), pk2(v[6], v[7])));
}

__device__ __forceinline__ void phase2(const Params& p, unsigned char* smem) {
    unsigned char* ws = p.ws;
    const u16* cA = (const u16*)(ws + O_CA);
    const u16* w2t = (const u16*)(ws + O_W2);
    const u16* a2t = (const u16*)(ws + O_A2);
    const u16* g2t = (const u16*)(ws + O_G2);
    u16* SI = (u16*)(ws + O_SI);
    u16* Gb = (u16*)(ws + O_G);
    float4* rk4 = (float4*)(ws + O_RK);
    const int tid = threadIdx.x, lane = tid & 63, wid = tid >> 6, l16 = lane & 15, g = lane >> 4;
    float* sp = (float*)smem;
    for (int i = tid; i < 1824; i += 256) sp[i] = p.mu[i];
    for (int i = tid; i < 512; i += 256) {
        sp[1824 + i] = p.w0[i]; sp[2336 + i] = p.a0[i]; sp[2848 + i] = p.k_k[i]; sp[3360 + i] = p.k_a[i]; sp[3872 + i] = p.r_k[i];
    }
    __syncthreads();
    const int NU = (T / 64) / (int)gridDim.x * (int)gridDim.x;
    const int NW = NU + (T / 64 - NU) * 8;
    for (int uu = blockIdx.x; uu < NW; uu += gridDim.x) {
        int u, h_lo, h_hi;
        if (uu < NU) { u = uu; h_lo = 0; h_hi = 8; }
        else { const int v = uu - NU; u = NU + (v >> 3); h_lo = v & 7; h_hi = h_lo + 1; }
        const int mw = u * 64 + wid * 16;
        const int m = mw + l16;
        const bool isP = mw < TP;
        int seq, tt;
        if (isP) { seq = m >> 12; tt = m & 4095; }
        else { const int ms = m - TP; seq = 16 + (ms >> 5); tt = ms & 31; }
        const u16* cur = cA + ((size_t)m + seq + 1) * ACOLS;
        const u16* prv = cur - ACOLS;
        bf16x8 xw[2], xa[2], xg[5];
#pragma unroll
        for (int s = 0; s < 9; ++s) {
            float xs[8];
            lerp8(cur, prv, sp, 1536 + s * 32 + g * 8, xs);
            if (s < 2) {
#pragma unroll
                for (int i = 0; i < 8; ++i) xs[i] = 1.f - 2.f / (__expf(2.f * xs[i]) + 1.f);
                xw[s] = packfrag(xs);
            } else if (s < 4) {
                xa[s - 2] = packfrag(xs);
            } else {
#pragma unroll
                for (int i = 0; i < 8; ++i) xs[i] = sigmoidf_(xs[i]);
                xg[s - 4] = packfrag(xs);
            }
        }
        bf16x8 nw0, nw1, na0, na1;
        uint2 ncr, npr, nck, npk, ncv, npv;
#define P2_FETCH(hh, ntt)                                                          \
        {                                                                          \
            const int wr_ = (hh) * 64 + (ntt) * 16 + l16;                          \
            nw0 = *(const bf16x8*)(w2t + wr_ * 64 + g * 8);                        \
            nw1 = *(const bf16x8*)(w2t + wr_ * 64 + 32 + g * 8);                   \
            na0 = *(const bf16x8*)(a2t + wr_ * 64 + g * 8);                        \
            na1 = *(const bf16x8*)(a2t + wr_ * 64 + 32 + g * 8);                   \
            const int ch_ = (hh) * 64 + (ntt) * 16 + g * 4;                        \
            ncr = *(const uint2*)(cur + ch_);        npr = *(const uint2*)(prv + ch_);        \
            nck = *(const uint2*)(cur + 512 + ch_);  npk = *(const uint2*)(prv + 512 + ch_);  \
            ncv = *(const uint2*)(cur + 1024 + ch_); npv = *(const uint2*)(prv + 1024 + ch_); \
        }
        P2_FETCH(h_lo, 0)
        for (int h = h_lo; h < h_hi; ++h) {
            float kkr[16], av[16];
            float ssq = 0.f, rkacc = 0.f, bracc = 0.f, kracc = 0.f;
            const size_t sirow = isP ? ((size_t)(seq * 8 + h) * 4096 + tt) : ((size_t)128 * 4096 + (size_t)((seq - 16) * 8 + h) * 32 + tt);
            u16* sib = SI + sirow * 384;
#pragma unroll
            for (int nt = 0; nt < 4; ++nt) {
                const bf16x8 cw0 = nw0, cw1 = nw1, ca0 = na0, ca1 = na1;
                const uint2 ccr = ncr, cpr = npr, cck = nck, cpk = npk, ccv = ncv, cpv = npv;
                if (nt < 3) { P2_FETCH(h, nt + 1) } else if (h + 1 < h_hi) { P2_FETCH(h + 1, 0) }
                const u16* gw_ = g2t + (h * 64 + nt * 16 + l16) * 160 + g * 8;
                const bf16x8 cg0 = *(const bf16x8*)(gw_), cg1 = *(const bf16x8*)(gw_ + 32), cg2 = *(const bf16x8*)(gw_ + 64),
                             cg3 = *(const bf16x8*)(gw_ + 96), cg4 = *(const bf16x8*)(gw_ + 128);
                __builtin_amdgcn_sched_barrier(0);
                f32x4 accw = {0.f, 0.f, 0.f, 0.f}, acca = accw;
                accw = MFMA(cw0, xw[0], accw); accw = MFMA(cw1, xw[1], accw);
                acca = MFMA(ca0, xa[0], acca); acca = MFMA(ca1, xa[1], acca);
                const int ch = h * 64 + nt * 16 + g * 4;
                float xr[4], xk[4], xv[4];
                lerp4w(ccr, cpr, sp, ch, xr);
                lerp4w(cck, cpk, sp, 512 + ch, xk);
                lerp4w(ccv, cpv, sp, 1024 + ch, xv);
                const float4 w0 = *(const float4*)(sp + 1824 + ch), a0 = *(const float4*)(sp + 2336 + ch), kk4 = *(const float4*)(sp + 2848 + ch),
                             ka4 = *(const float4*)(sp + 3360 + ch), rk4 = *(const float4*)(sp + 3872 + ch);
                const float w0a[4] = {w0.x, w0.y, w0.z, w0.w}, a0a[4] = {a0.x, a0.y, a0.z, a0.w}, kka[4] = {kk4.x, kk4.y, kk4.z, kk4.w},
                            kaa[4] = {ka4.x, ka4.y, ka4.z, ka4.w}, rka[4] = {rk4.x, rk4.y, rk4.z, rk4.w};
                float ev[4], kp[4], dr[4];
#pragma unroll
                for (int r = 0; r < 4; ++r) {
                    const float z = -(w0a[r] + accw[r]);
                    const float sp = (z > 20.f) ? z : __logf(1.f + __expf(z));
                    ev[r] = __expf(-sp - 0.5f);
                    const float a = sigmoidf_(a0a[r] + acca[r]);
                    const float kraw = xk[r] * kka[r];
                    ssq += kraw * kraw;
                    kp[r] = xk[r] * (1.f + (a - 1.f) * kaa[r]);
                    rkacc += xr[r] * kp[r] * rka[r];
                    kracc += xr[r] * kp[r];
                    bracc += kraw * a * xr[r];
                    dr[r] = xr[r] * __expf(-ev[r]);
                    kkr[nt * 4 + r] = kraw;
                    av[nt * 4 + r] = a;
                }
                const int co = nt * 16 + g * 4;
                *(uint2*)(sib + 0 * 64 + co) = pk4(dr[0], dr[1], dr[2], dr[3]);
                *(uint2*)(sib + 1 * 64 + co) = pk4(ev[0], ev[1], ev[2], ev[3]);
                *(uint2*)(sib + 2 * 64 + co) = pk4(kp[0], kp[1], kp[2], kp[3]);
                *(uint2*)(sib + 3 * 64 + co) = pk4(xv[0], xv[1], xv[2], xv[3]);
                f32x4 accg = {0.f, 0.f, 0.f, 0.f};
                accg = MFMA(cg0, xg[0], accg); accg = MFMA(cg1, xg[1], accg); accg = MFMA(cg2, xg[2], accg);
                accg = MFMA(cg3, xg[3], accg); accg = MFMA(cg4, xg[4], accg);
                *(uint2*)(Gb + (size_t)m * 512 + ch) = pk4(accg[0], accg[1], accg[2], accg[3]);
            }
            ssq = red_g(ssq);
            rkacc = red_g(rkacc);
            bracc = red_g(bracc);
            kracc = red_g(kracc);
            const float inv = rsqrtf(fmaxf(ssq, 1e-24f));
#pragma unroll
            for (int nt = 0; nt < 4; ++nt) {
                const int co = nt * 16 + g * 4;
                float k0 = kkr[nt * 4 + 0] * inv, k1 = kkr[nt * 4 + 1] * inv, k2 = kkr[nt * 4 + 2] * inv, k3 = kkr[nt * 4 + 3] * inv;
                *(uint2*)(sib + 4 * 64 + co) = pk4(k0, k1, k2, k3);
                *(uint2*)(sib + 5 * 64 + co) = pk4(k0 * av[nt * 4 + 0], k1 * av[nt * 4 + 1], k2 * av[nt * 4 + 2], k3 * av[nt * 4 + 3]);
            }
            if (g == 0) rk4[(size_t)m * 8 + h] = make_float4(rkacc, bracc * inv, kracc, 0.f);
        }
    }
}

typedef float v2f __attribute__((ext_vector_type(2)));
__device__ __forceinline__ void scan_item(const Params& p, const u16* __restrict__ si, int nch, const float* __restrict__ s0, float* __restrict__ sout,
                          int m0, int h, int half, unsigned char* smem) {
    float* inb = (float*)smem;
    float* ybuf = (float*)(smem + 49152);
    float* scal = (float*)(smem + 53248);
    unsigned char* ws = p.ws;
    const float4* rk4 = (const float4*)(ws + O_RK);
    u16* yraw = (u16*)(ws + O_YRAW);
    const int tid = threadIdx.x;
    const int vp = tid >> 3, kq = tid & 7;
    const int row = half * 32 + vp;
    v2f S[4];
    if (s0) {
        const float4 a = *(const float4*)(s0 + row * 64 + kq * 8), b = *(const float4*)(s0 + row * 64 + kq * 8 + 4);
        S[0] = (v2f){a.x, a.y}; S[1] = (v2f){a.z, a.w}; S[2] = (v2f){b.x, b.y}; S[3] = (v2f){b.z, b.w};
    } else {
#pragma unroll
        for (int j = 0; j < 4; ++j) S[j] = (v2f){0.f, 0.f};
    }
    uint4 st0, st1, st2;
    float4 sq = make_float4(0.f, 0.f, 0.f, 0.f);
    st0 = *(const uint4*)(si + (0 * 256 + tid) * 8);
    st1 = *(const uint4*)(si + (1 * 256 + tid) * 8);
    st2 = *(const uint4*)(si + (2 * 256 + tid) * 8);
    if (tid < 16) sq = rk4[(m0 + tid) * 8 + h];
#define S_WRITE1(sv, i, buf)                                                                                          \
    {                                                                                                                 \
        const int idx = (i) * 256 + tid;                                                                              \
        const int vec = (idx % 48) >> 3;                                                                              \
        float v[8] = {bflo(sv.x), bfhi(sv.x), bflo(sv.y), bfhi(sv.y), bflo(sv.z), bfhi(sv.z), bflo(sv.w), bfhi(sv.w)}; \
        if (vec == 1) {                                                                                               \
            _Pragma("unroll") for (int k = 0; k < 8; ++k) v[k] = __expf(-v[k]);                                       \
        }                                                                                                             \
        float* d = inb + (buf) * 6144 + idx * 8;                                                                      \
        *(float4*)d = make_float4(v[0], v[1], v[2], v[3]);                                                            \
        *(float4*)(d + 4) = make_float4(v[4], v[5], v[6], v[7]);                                                      \
    }
#define stage_write(buf) S_WRITE1(st0, 0, buf) S_WRITE1(st1, 1, buf) S_WRITE1(st2, 2, buf) if (tid < 16) *(float4*)(scal + (buf) * 64 + tid * 4) = sq;
    stage_write(0)
    __syncthreads();
    for (int c = 0; c < nch; ++c) {
        const int buf = c & 1;
        if (c + 1 < nch) {
            const u16* sn = si + (c + 1) * 6144 + tid * 8;
            st0 = *(const uint4*)(sn);
            st1 = *(const uint4*)(sn + 2048);
            st2 = *(const uint4*)(sn + 4096);
            if (tid < 16) sq = rk4[(m0 + (c + 1) * 16 + tid) * 8 + h];
        }
        const float* cb = inb + buf * 6144;
        const float* cs = scal + buf * 64;
#pragma unroll 2
        for (int tt = 0; tt < 16; ++tt) {
            const float* base = cb + tt * 384;
            v2f kk[4], dr[4], dd[4], bb[4], kv[4];
#define LD8(dst, off)                                                      \
    {                                                                      \
        const float4 q0 = *(const float4*)(base + (off) + kq * 8);         \
        const float4 q1 = *(const float4*)(base + (off) + kq * 8 + 4);     \
        dst[0] = (v2f){q0.x, q0.y}; dst[1] = (v2f){q0.z, q0.w};            \
        dst[2] = (v2f){q1.x, q1.y}; dst[3] = (v2f){q1.z, q1.w};            \
    }
            LD8(kk, 256) LD8(dr, 0) LD8(dd, 64) LD8(bb, 320) LD8(kv, 128)
            const float vv = base[192 + row];
            const float2 brkr = *(const float2*)(cs + tt * 4 + 1);
            v2f a0 = S[0] * kk[0], a1 = S[1] * kk[1], q0 = S[0] * dr[0], q1 = S[1] * dr[1];
            a0 = __builtin_elementwise_fma(S[2], kk[2], a0);
            a1 = __builtin_elementwise_fma(S[3], kk[3], a1);
            q0 = __builtin_elementwise_fma(S[2], dr[2], q0);
            q1 = __builtin_elementwise_fma(S[3], dr[3], q1);
            a0 += a1;
            q0 += q1;
            const float sa = -red8(a0.x + a0.y);
            const float pp = red8(q0.x + q0.y);
            const float y = pp + sa * brkr.x + vv * brkr.y;
            if (kq == 0) ybuf[tt * 32 + vp] = y;
            const v2f sav = (v2f){sa, sa}, vvv = (v2f){vv, vv};
#pragma unroll
            for (int j = 0; j < 4; ++j) S[j] = __builtin_elementwise_fma(S[j], dd[j], __builtin_elementwise_fma(vvv, kv[j], sav * bb[j]));
        }
        __syncthreads();
        {
            const int tt = tid >> 4, e2 = (tid & 15) * 2;
            const float2 y2 = *(const float2*)(ybuf + tt * 32 + e2);
            *(unsigned*)(yraw + (m0 + c * 16 + tt) * 512 + h * 64 + half * 32 + e2) = pk2(y2.x, y2.y);
        }
        if (c + 1 < nch) { stage_write(buf ^ 1) }
        __syncthreads();
    }
    {
        float* d0 = sout + row * 64 + kq * 8;
        *(float4*)d0 = make_float4(S[0].x, S[0].y, S[1].x, S[1].y);
        *(float4*)(d0 + 4) = make_float4(S[2].x, S[2].y, S[3].x, S[3].y);
    }
}

__device__ __forceinline__ void ln_pass(const Params& p) {
    unsigned char* ws = p.ws;
    const u16* yraw = (const u16*)(ws + O_YRAW);
    const u16* Gb = (const u16*)(ws + O_G);
    const u16* SI = (const u16*)(ws + O_SI);
    const float4* rk4 = (const float4*)(ws + O_RK);
    u16* ya = (u16*)(ws + O_YA);
    const int tid = threadIdx.x, cq = (tid & 15) * 4;
    for (int q0 = blockIdx.x * 16; q0 < T * 8; q0 += gridDim.x * 16) {
        const int q = q0 + (tid >> 4);
        const int m = q >> 3, h = q & 7;
        const int e = m * 512 + h * 64 + cq;
        const uint2 yv = *(const uint2*)(yraw + e);
        const float y0 = bflo(yv.x), y1 = bfhi(yv.x), y2 = bflo(yv.y), y3 = bfhi(yv.y);
        const float mean = red16(y0 + y1 + y2 + y3) * (1.f / 64.f);
        const float d0 = y0 - mean, d1 = y1 - mean, d2 = y2 - mean, d3 = y3 - mean;
        const float var = red16(d0 * d0 + d1 * d1 + d2 * d2 + d3 * d3) * (1.f / 64.f);
        const float rstd = rsqrtf(var + 64e-5f);
        const float rkv = rk4[q].x;
        int sirow;
        if (m < TP) sirow = ((m >> 12) * 8 + h) * 4096 + (m & 4095);
        else { const int ms = m - TP; sirow = 128 * 4096 + ((ms >> 5) * 8 + h) * 32 + (ms & 31); }
        const uint2 vq = *(const uint2*)(SI + (size_t)sirow * 384 + 192 + cq);
        const uint2 gg = *(const uint2*)(Gb + e);
        const float4 lw = *(const float4*)(p.ln_w + h * 64 + cq), lb = *(const float4*)(p.ln_b + h * 64 + cq);
        const float o0 = (d0 * rstd * lw.x + lb.x + rkv * bflo(vq.x)) * bflo(gg.x);
        const float o1 = (d1 * rstd * lw.y + lb.y + rkv * bfhi(vq.x)) * bfhi(gg.x);
        const float o2 = (d2 * rstd * lw.z + lb.z + rkv * bflo(vq.y)) * bflo(gg.y);
        const float o3 = (d3 * rstd * lw.w + lb.w + rkv * bfhi(vq.y)) * bfhi(gg.y);
        *(uint2*)(ya + e) = pk4(o0, o1, o2, o3);
    }
}

constexpr int KLD = 136, VLD = 72;
__device__ __forceinline__ void attn_item(const u16* __restrict__ Q, int nq, const u16* __restrict__ K, const u16* __restrict__ Vt, int ldv, int nkt,
                          int lastvalid, u16* __restrict__ O, float lam, const float* __restrict__ subln, unsigned char* smem) {
    u16* sK = (u16*)smem;
    u16* sV = (u16*)(smem + 2 * 64 * KLD * 2);
    float* ex = (float*)smem;
    const int tid = threadIdx.x, lane = tid & 63, wid = tid >> 6, l16 = lane & 15, g = lane >> 4;
    const int n = wid >> 1, qh = wid & 1;
    const bool active = (qh * 32) < nq;
    bf16x8 qf[2][2];
#pragma unroll
    for (int qt = 0; qt < 2; ++qt)
#pragma unroll
        for (int s = 0; s < 2; ++s) {
            const int row = qh * 32 + qt * 16 + l16;
            uint4 v = make_uint4(0, 0, 0, 0);
            if (row < nq) v = *(const uint4*)(Q + (row * 512 + n * 64 + s * 32 + g * 8));
            qf[qt][s] = as_frag(v);
        }
    f32x4 o[2][8];
#pragma unroll
    for (int qt = 0; qt < 2; ++qt)
#pragma unroll
        for (int et = 0; et < 8; ++et) o[qt][et] = (f32x4){0.f, 0.f, 0.f, 0.f};
    float mrow[2] = {-1e30f, -1e30f}, lrow[2] = {0.f, 0.f};
    uint4 kr0, kr1, kr2, kr3, vr0, vr1, vr2, vr3;
    const int krow = tid >> 4, kch = (tid & 15) * 8;
    const int vrow = tid >> 3, vch = (tid & 7) * 8;
    const int ko_ = krow * 512 + kch;
    const int vo_ = vrow * ldv + vch;
#define A_LOAD(key0)                                                      \
    kr0 = *(const uint4*)(K + (ko_ + ((key0) + 0) * 512));                \
    kr1 = *(const uint4*)(K + (ko_ + ((key0) + 16) * 512));               \
    kr2 = *(const uint4*)(K + (ko_ + ((key0) + 32) * 512));               \
    kr3 = *(const uint4*)(K + (ko_ + ((key0) + 48) * 512));               \
    vr0 = *(const uint4*)(Vt + (vo_ + (key0)));                           \
    vr1 = *(const uint4*)(Vt + (vo_ + 32 * ldv + (key0)));                \
    vr2 = *(const uint4*)(Vt + (vo_ + 64 * ldv + (key0)));                \
    vr3 = *(const uint4*)(Vt + (vo_ + 96 * ldv + (key0)));
#define A_STORE(nb)                                                       \
    *(uint4*)(sK + (nb) * 64 * KLD + (krow + 0) * KLD + kch) = kr0;       \
    *(uint4*)(sK + (nb) * 64 * KLD + (krow + 16) * KLD + kch) = kr1;      \
    *(uint4*)(sK + (nb) * 64 * KLD + (krow + 32) * KLD + kch) = kr2;      \
    *(uint4*)(sK + (nb) * 64 * KLD + (krow + 48) * KLD + kch) = kr3;      \
    *(uint4*)(sV + (nb) * 128 * VLD + (vrow + 0) * VLD + vch) = vr0;      \
    *(uint4*)(sV + (nb) * 128 * VLD + (vrow + 32) * VLD + vch) = vr1;     \
    *(uint4*)(sV + (nb) * 128 * VLD + (vrow + 64) * VLD + vch) = vr2;     \
    *(uint4*)(sV + (nb) * 128 * VLD + (vrow + 96) * VLD + vch) = vr3;
    A_LOAD(0)
    A_STORE(0)
    __syncthreads();
    constexpr float SC = 0.125f * 1.4426950408889634f;
    for (int kt = 0; kt < nkt; ++kt) {
        const int buf = kt & 1;
        if (kt + 1 < nkt) { A_LOAD((kt + 1) * 64) }
        __builtin_amdgcn_sched_barrier(0);
        if (active) {
            const int valid = (kt == nkt - 1) ? lastvalid : 64;
            const u16* cK = sK + buf * 64 * KLD + l16 * KLD + n * 64 + g * 8;
            const u16* cV = sV + buf * 128 * VLD + l16 * VLD + g * 4;
            f32x4 s[4][2];
#pragma unroll
            for (int k16 = 0; k16 < 4; ++k16) {
                const bf16x8 kf0 = *(const bf16x8*)(cK + k16 * 16 * KLD);
                const bf16x8 kf1 = *(const bf16x8*)(cK + k16 * 16 * KLD + 32);
#pragma unroll
                for (int qt = 0; qt < 2; ++qt) {
                    f32x4 z = {0.f, 0.f, 0.f, 0.f};
                    z = MFMA(kf0, qf[qt][0], z);
                    s[k16][qt] = MFMA(kf1, qf[qt][1], z);
                }
            }
            bf16x8 pf[2][2];
#pragma unroll
            for (int qt = 0; qt < 2; ++qt) {
                float mx = -1e30f;
                if (valid < 64) {
#pragma unroll
                    for (int k16 = 0; k16 < 4; ++k16)
#pragma unroll
                        for (int r = 0; r < 4; ++r) {
                            float v = s[k16][qt][r] * SC;
                            if (k16 * 16 >= valid) v = -1e30f;
                            s[k16][qt][r] = v;
                            mx = fmaxf(mx, v);
                        }
                } else {
#pragma unroll
                    for (int k16 = 0; k16 < 4; ++k16)
#pragma unroll
                        for (int r = 0; r < 4; ++r) {
                            const float v = s[k16][qt][r] * SC;
                            s[k16][qt][r] = v;
                            mx = fmaxf(mx, v);
                        }
                }
                mx = max_g(mx);
                const float mold = mrow[qt];
                const float mnew = fmaxf(mold, mx);
                mrow[qt] = mnew;
                if (__builtin_amdgcn_ballot_w64(mnew > mold) != 0ull) {
                    const float alpha = __builtin_amdgcn_exp2f(mold - mnew);
                    lrow[qt] *= alpha;
#pragma unroll
                    for (int et = 0; et < 8; ++et) {
                        o[qt][et][0] *= alpha; o[qt][et][1] *= alpha; o[qt][et][2] *= alpha; o[qt][et][3] *= alpha;
                    }
                }
                float psum = 0.f;
#pragma unroll
                for (int k16 = 0; k16 < 4; ++k16)
#pragma unroll
                    for (int r = 0; r < 4; ++r) {
                        const float pv = __builtin_amdgcn_exp2f(s[k16][qt][r] - mnew);
                        s[k16][qt][r] = pv;
                        psum += pv;
                    }
                lrow[qt] += psum;
#pragma unroll
                for (int kb = 0; kb < 2; ++kb)
                    pf[qt][kb] = as_frag(make_uint4(pk2(s[2 * kb][qt][0], s[2 * kb][qt][1]), pk2(s[2 * kb][qt][2], s[2 * kb][qt][3]),
                                                    pk2(s[2 * kb + 1][qt][0], s[2 * kb + 1][qt][1]), pk2(s[2 * kb + 1][qt][2], s[2 * kb + 1][qt][3])));
            }
#pragma unroll
            for (int et = 0; et < 8; ++et)
#pragma unroll
                for (int kb = 0; kb < 2; ++kb) {
                    const uint2 lo = *(const uint2*)(cV + et * 16 * VLD + kb * 32);
                    const uint2 hi = *(const uint2*)(cV + et * 16 * VLD + kb * 32 + 16);
                    const bf16x8 vf = as_frag(make_uint4(lo.x, lo.y, hi.x, hi.y));
#pragma unroll
                    for (int qt = 0; qt < 2; ++qt) o[qt][et] = MFMA(vf, pf[qt][kb], o[qt][et]);
                }
        }
        __builtin_amdgcn_sched_barrier(0);
        if (kt + 1 < nkt) { A_STORE(buf ^ 1) }
        __syncthreads();
    }
    float inv[2];
#pragma unroll
    for (int qt = 0; qt < 2; ++qt) {
        const float l = red_g(lrow[qt]);
        inv[qt] = 1.f / fmaxf(l, 1e-30f);
    }
    if (active && n == 1) {
#pragma unroll
        for (int qt = 0; qt < 2; ++qt)
#pragma unroll
            for (int et = 0; et < 8; ++et) {
                const f32x4 v = o[qt][et];
                *(float4*)(ex + (qh * 32 + qt * 16 + l16) * 132 + et * 16 + g * 4) =
                    make_float4(v[0] * inv[qt], v[1] * inv[qt], v[2] * inv[qt], v[3] * inv[qt]);
            }
    }
    __syncthreads();
    if (active && n == 0) {
#pragma unroll
        for (int qt = 0; qt < 2; ++qt) {
            const int row = qh * 32 + qt * 16 + l16;
            float ss = 0.f;
#pragma unroll
            for (int et = 0; et < 8; ++et) {
                const float4 o2 = *(const float4*)(ex + row * 132 + et * 16 + g * 4);
                f32x4 v = o[qt][et];
                v[0] = v[0] * inv[qt] - lam * o2.x;
                v[1] = v[1] * inv[qt] - lam * o2.y;
                v[2] = v[2] * inv[qt] - lam * o2.z;
                v[3] = v[3] * inv[qt] - lam * o2.w;
                o[qt][et] = v;
                ss += v[0] * v[0] + v[1] * v[1] + v[2] * v[2] + v[3] * v[3];
            }
            ss = red_g(ss);
            const float rn = rsqrtf(ss * (1.f / 128.f) + EPS) * 0.8f;
            if (row < nq) {
#pragma unroll
                for (int et = 0; et < 8; ++et) {
                    const float4 sl = *(const float4*)(subln + et * 16 + g * 4);
                    const f32x4 v = o[qt][et];
                    *(uint2*)(O + (row * 512 + et * 16 + g * 4)) = pk4(v[0] * rn * sl.x, v[1] * rn * sl.y, v[2] * rn * sl.z, v[3] * rn * sl.w);
                }
            }
        }
    }
    __syncthreads();
}

__device__ __forceinline__ void phase3(const Params& p, unsigned char* smem) {
    unsigned char* ws = p.ws;
    int* s_item = (int*)(smem + LDS_BYTES - 16);
    unsigned* ctr = (unsigned*)(ws + O_SCAL) + 1;
    const float lam = ((const float*)(ws + O_SCAL))[0];
    const u16* SI = (const u16*)(ws + O_SI);
    const u16* qb = (const u16*)(ws + O_QB);
    const u16* kP = (const u16*)(ws + O_KP);
    const u16* kS = (const u16*)(ws + O_KS);
    const u16* vtP = (const u16*)(ws + O_VTP);
    const u16* vtS = (const u16*)(ws + O_VTS);
    u16* ob = (u16*)(ws + O_OB);
    int stage = 0, sidx = blockIdx.x;
    constexpr int SCAN_BASE = 100000, DONE = 1 << 30;
    for (;;) {
        if (threadIdx.x == 0) {
            int it;
            if (stage == 0) it = (sidx < 768) ? SCAN_BASE + sidx : -2;
            else {
                const int x = blockIdx.x & 7;
                const int i = (int)atomicAdd(ctr + 16 + x, 1u);
                if (i < 512) it = ((63 - (i >> 3)) << 6) | (x + 8 * (i & 7));
                else if (i < 528) it = 4096 + (x + 8 * (i - 512));
                else it = DONE;
            }
            *s_item = it;
        }
        __syncthreads();
        const int item = __builtin_amdgcn_readfirstlane(*s_item);
        __syncthreads();
        if (item == DONE) break;
        if (item == -2) {
            asm volatile("s_waitcnt vmcnt(0) lgkmcnt(0)" ::: "memory");
            cg::this_grid().sync();
            stage = 1;
            ln_pass(p);
            continue;
        }
        if (item >= SCAN_BASE) {
            sidx += gridDim.x;
            const int sc = item - SCAN_BASE;
            const u16* si; int nch; const float* s0; float* sout; int m0, h, half;
            if (sc < 256) {
                const int chain = sc >> 1;
                half = sc & 1; h = chain & 7;
                si = SI + (size_t)chain * 4096 * 384; nch = 256; s0 = nullptr;
                sout = p.out + OFF_WP + (size_t)chain * 4096; m0 = (chain >> 3) * 4096;
            } else {
                const int t2 = sc - 256, chain = t2 >> 1;
                half = t2 & 1; h = chain & 7;
                si = SI + ((size_t)128 * 4096 + (size_t)chain * 32) * 384; nch = 2; s0 = p.state_wkv + (size_t)chain * 4096;
                sout = p.out + OFF_WS + (size_t)chain * 4096; m0 = TP + (chain >> 3) * 32;
            }
            scan_item(p, si, nch, s0, sout, m0, h, half, smem);
        } else {
            const u16 *Q, *K, *Vt; u16* O; int nq, ldv, nkt, lastvalid;
            if (item < 4096) {
                const int c = item >> 6, bh = item & 63, b = bh >> 2, h = bh & 3;
                const size_t m0 = (size_t)b * 4096 + (size_t)c * 64;
                Q = qb + m0 * 512 + h * 128; nq = 64; K = kP + (size_t)b * 4096 * 512 + h * 128;
                Vt = vtP + ((size_t)b * 512 + h * 128) * 4096; ldv = 4096; nkt = c + 1; lastvalid = 64; O = ob + m0 * 512 + h * 128;
            } else {
                const int idx = item - 4096;
                const int b = idx >> 2, h = idx & 3;
                const size_t m0 = (size_t)TP + (size_t)b * 32;
                Q = qb + m0 * 512 + h * 128; nq = 32; K = kS + (size_t)b * LKS * 512 + h * 128;
                Vt = vtS + ((size_t)b * 512 + h * 128) * LKS; ldv = LKS; nkt = 17; lastvalid = 32; O = ob + m0 * 512 + h * 128;
            }
            attn_item(Q, nq, K, Vt, ldv, nkt, lastvalid, O, lam, p.subln, smem);
        }
    }
}

__device__ __forceinline__ void phase4(const Params& p, unsigned char* smem) {
    unsigned char* ws = p.ws;
    const u16* ya = (const u16*)(ws + O_YA);
    const u16* ob = (const u16*)(ws + O_OB);
    const u16* Wa = (const u16*)(ws + O_WOA);
    const u16* Wb = (const u16*)(ws + O_WOB);
    const u16* gate = (const u16*)p.out;
    u16* mix = (u16*)(ws + O_MIX);
    const int tid = threadIdx.x, lane = tid & 63, wid = tid >> 6, wm = wid >> 1, wn = wid & 1, l16 = lane & 15, g = lane >> 4;
    constexpr int NT = 8;
    for (int t = blockIdx.x; t < 520 * NT; t += gridDim.x) {
        int mtile, ntile;
        tile_map(t, NT, mtile, ntile);
        const int m0 = mtile * 128, n0 = ntile * 128;
        f32x4 acc[4][4], acc2[4][4];
        zero_acc(acc);
        zero_acc(acc2);
        gemm_loop(ya + (size_t)m0 * 512, 512, Wa + (size_t)n0 * 512, 512, 8, (u16*)smem, acc);
        gemm_loop(ob + (size_t)m0 * 512, 512, Wb + (size_t)n0 * 512, 512, 8, (u16*)smem, acc2);
#pragma unroll
        for (int mt = 0; mt < 4; ++mt) {
            const int m = m0 + wm * 64 + mt * 16 + l16;
#pragma unroll
            for (int nt = 0; nt < 4; ++nt) {
                const int n = n0 + wn * 64 + nt * 16 + g * 4;
                const uint2 ga = *(const uint2*)(gate + (size_t)m * 2048 + n);
                const uint2 gb = *(const uint2*)(gate + (size_t)m * 2048 + 1024 + n);
                const f32x4 a = acc[nt][mt], b = acc2[nt][mt];
                *(uint2*)(mix + (size_t)m * 1024 + n) =
                    pk4(bflo(ga.x) * a[0] + bflo(gb.x) * b[0], bfhi(ga.x) * a[1] + bfhi(gb.x) * b[1],
                        bflo(ga.y) * a[2] + bflo(gb.y) * b[2], bfhi(ga.y) * a[3] + bfhi(gb.y) * b[3]);
            }
        }
    }
}

__device__ __forceinline__ void gemm_rowss(const u16* A, int K, const u16* W, u16* outb, float* ssq, unsigned char* smem) {
    const int tid = threadIdx.x, lane = tid & 63, wid = tid >> 6, wm = wid >> 1, wn = wid & 1, l16 = lane & 15, g = lane >> 4;
    constexpr int NT = 8;
    for (int t = blockIdx.x; t < 520 * NT; t += gridDim.x) {
        int mtile, ntile;
        tile_map(t, NT, mtile, ntile);
        const int m0 = mtile * 128, n0 = ntile * 128;
        f32x4 acc[4][4];
        zero_acc(acc);
        gemm_loop(A + (size_t)m0 * K, K, W + (size_t)n0 * K, K, K / 64, (u16*)smem, acc);
#pragma unroll
        for (int mt = 0; mt < 4; ++mt) {
            const int m = m0 + wm * 64 + mt * 16 + l16;
#pragma unroll
            for (int nt = 0; nt < 4; ++nt) {
                const int n = n0 + wn * 64 + nt * 16 + g * 4;
                const f32x4 a = acc[nt][mt];
                *(uint2*)(outb + (size_t)m * 1024 + n) = pk4(a[0], a[1], a[2], a[3]);
            }
        }
    }
}

__device__ __forceinline__ float sum16(const float* q) {
    const float4 a = *(const float4*)q, b = *(const float4*)(q + 4), c = *(const float4*)(q + 8), d = *(const float4*)(q + 12);
    return ((a.x + a.y) + (a.z + a.w)) + ((b.x + b.y) + (b.z + b.w)) + (((c.x + c.y) + (c.z + c.w)) + ((d.x + d.y) + (d.z + d.w)));
}
__device__ __forceinline__ void phase6(const Params& p) {
    unsigned char* ws = p.ws;
    const u16* m2 = (const u16*)(ws + O_M2);
    u16* x1b = (u16*)(ws + O_X1B);
    float* rs3 = (float*)(ws + O_RS3);
    const int lane = threadIdx.x & 63, wid = threadIdx.x >> 6;
    for (int m = blockIdx.x * 4 + wid; m < T; m += gridDim.x * 4) {
        const float* xr = (m < TP) ? p.x_prompt + (size_t)m * 1024 : p.x_sample + (size_t)(m - TP) * 1024;
        uint2 mvv[4];
        float s2 = 0.f;
#pragma unroll
        for (int i = 0; i < 4; ++i) {
            mvv[i] = *(const uint2*)(m2 + (size_t)m * 1024 + i * 256 + lane * 4);
            const float a = bflo(mvv[i].x), b = bfhi(mvv[i].x), c = bflo(mvv[i].y), d = bfhi(mvv[i].y);
            s2 += a * a + b * b + c * c + d * d;
        }
        s2 = wave_sum(s2);
        const float rs = rsqrtf(s2 * (1.f / 1024.f) + EPS);
        float ss = 0.f;
#pragma unroll
        for (int i = 0; i < 4; ++i) {
            const int col = i * 256 + lane * 4;
            const float4 xv = *(const float4*)(xr + col);
            const uint2 mv = mvv[i];
            const float4 gp = *(const float4*)(p.n_mix_post + col);
            float4 r;
            r.x = xv.x + bflo(mv.x) * rs * gp.x;
            r.y = xv.y + bfhi(mv.x) * rs * gp.y;
            r.z = xv.z + bflo(mv.y) * rs * gp.z;
            r.w = xv.w + bfhi(mv.y) * rs * gp.w;
            ss += r.x * r.x + r.y * r.y + r.z * r.z + r.w * r.w;
            *(float4*)(p.out + (size_t)m * 1024 + col) = r;
            *(uint2*)(x1b + (size_t)m * 1024 + col) = pk4(r.x, r.y, r.z, r.w);
        }
        ss = wave_sum(ss);
        if (lane == 0) rs3[m] = rsqrtf(ss * (1.f / 1024.f) + EPS);
    }
}

__device__ __forceinline__ void phase7(const Params& p, unsigned char* smem) {
    unsigned char* ws = p.ws;
    const u16* x1b = (const u16*)(ws + O_X1B);
    const u16* W = (const u16*)(ws + O_WFI);
    const float* rs3 = (const float*)(ws + O_RS3);
    u16* hb = (u16*)(ws + O_HB);
    const int tid = threadIdx.x, lane = tid & 63, wid = tid >> 6, wm = wid >> 1, wn = wid & 1, l16 = lane & 15, g = lane >> 4;
    constexpr int NT = 44;
    for (int t = blockIdx.x; t < 520 * NT; t += gridDim.x) {
        int mtile, ntile;
        tile_map(t, NT, mtile, ntile);
        const int m0 = mtile * 128, n0 = ntile * 128;
        f32x4 acc[4][4];
        zero_acc(acc);
        gemm_loop(x1b + (size_t)m0 * 1024, 1024, W + (size_t)n0 * 1024, 1024, 16, (u16*)smem, acc);
#pragma unroll
        for (int mt = 0; mt < 4; ++mt) {
            const int m = m0 + wm * 64 + mt * 16 + l16;
            const float rs = rs3[m];
#pragma unroll
            for (int pr = 0; pr < 2; ++pr) {
                const f32x4 ug = acc[2 * pr][mt], uv = acc[2 * pr + 1][mt];
                const int j = ((n0 + wn * 64) >> 5) * 16 + pr * 16 + g * 4;
                float hv[4];
#pragma unroll
                for (int r = 0; r < 4; ++r) {
                    const float a = ug[r] * rs, b = uv[r] * rs;
                    hv[r] = a * sigmoidf_(a) * b;
                }
                *(uint2*)(hb + (size_t)m * 2816 + j) = pk4(hv[0], hv[1], hv[2], hv[3]);
            }
        }
    }
}

__device__ __forceinline__ void phase9(const Params& p) {
    unsigned char* ws = p.ws;
    const u16* fb = (const u16*)(ws + O_FB);
    const int lane = threadIdx.x & 63, wid = threadIdx.x >> 6;
    for (int m = blockIdx.x * 4 + wid; m < T; m += gridDim.x * 4) {
        uint2 fvv[4];
        float s2 = 0.f;
#pragma unroll
        for (int i = 0; i < 4; ++i) {
            fvv[i] = *(const uint2*)(fb + (size_t)m * 1024 + i * 256 + lane * 4);
            const float a = bflo(fvv[i].x), b = bfhi(fvv[i].x), c = bflo(fvv[i].y), d = bfhi(fvv[i].y);
            s2 += a * a + b * b + c * c + d * d;
        }
        s2 = wave_sum(s2);
        const float rs = rsqrtf(s2 * (1.f / 1024.f) + EPS);
#pragma unroll
        for (int i = 0; i < 4; ++i) {
            const int col = i * 256 + lane * 4;
            float4 r = *(const float4*)(p.out + (size_t)m * 1024 + col);
            const uint2 fv = fvv[i];
            const float4 gp = *(const float4*)(p.n_ffn_post + col);
            r.x += bflo(fv.x) * rs * gp.x;
            r.y += bfhi(fv.x) * rs * gp.y;
            r.z += bflo(fv.y) * rs * gp.z;
            r.w += bfhi(fv.y) * rs * gp.w;
            *(float4*)(p.out + (size_t)m * 1024 + col) = r;
        }
    }
}

__global__ void __launch_bounds__(256, 2) mega(Params p) {
    extern __shared__ __attribute__((aligned(16))) unsigned char smem[];
    cg::grid_group grid = cg::this_grid();
#define IN(k) (p.ph_lo <= (k) && (k) < p.ph_hi)
#define SEAM(k) if (IN(k) && IN((k) + 1)) { asm volatile("s_waitcnt vmcnt(0) lgkmcnt(0)" ::: "memory"); grid.sync(); }
    unsigned char* ws = p.ws;
    if (IN(0)) phase0(p, smem);
    SEAM(0)
    if (IN(1)) phase1(p, smem);
    SEAM(1)
    if (IN(2)) phase2(p, smem);
    SEAM(2)
    if (IN(3)) phase3(p, smem);
    SEAM(3)
    if (IN(5)) phase4(p, smem);
    SEAM(5)
    if (IN(6)) gemm_rowss((const u16*)(ws + O_MIX), 1024, (const u16*)(ws + O_WO), (u16*)(ws + O_M2), (float*)(ws + O_SS2), smem);
    SEAM(6)
    if (IN(7)) phase6(p);
    SEAM(7)
    if (IN(8)) phase7(p, smem);
    SEAM(8)
    if (IN(9)) gemm_rowss((const u16*)(ws + O_HB), 2816, (const u16*)(ws + O_WFO), (u16*)(ws + O_FB), (float*)(ws + O_SS4), smem);
    SEAM(9)
    if (IN(10)) phase9(p);
}

extern "C" void kernel_launch(void* const* d_in, const int* in_sizes, int n_in, void* d_out, int out_size, void* d_ws, size_t ws_size,
                              hipStream_t stream) {
    static int grid_blocks = 0;
    if (!grid_blocks) {
        int dev = 0, cus = 0, per_cu = 0;
        hipGetDevice(&dev);
        hipDeviceGetAttribute(&cus, hipDeviceAttributeMultiprocessorCount, dev);
        hipFuncSetAttribute((const void*)mega, hipFuncAttributeMaxDynamicSharedMemorySize, LDS_BYTES);
        hipOccupancyMaxActiveBlocksPerMultiprocessor(&per_cu, (const void*)mega, 256, LDS_BYTES);
        if (per_cu < 1) per_cu = 1;
        if (per_cu > 2) per_cu = 2;
        grid_blocks = cus * per_cu;
        if (ws_size < WS_END) fprintf(stderr, "kernel_launch: workspace too small: %zu < %zu\n", ws_size, (size_t)WS_END);
    }
    Params p{};
    const float** pp = (const float**)&p;
    for (int i = 0; i < 33; ++i) pp[i] = (const float*)d_in[i];
    p.out = (float*)d_out;
    p.ws = (unsigned char*)d_ws;
#ifndef MULTI_LAUNCH
    p.ph_lo = 0;
    p.ph_hi = 11;
    void* args[] = {&p};
    hipError_t e = hipLaunchCooperativeKernel((const void*)mega, dim3(grid_blocks), dim3(256), args, LDS_BYTES, stream);
    if (e != hipSuccess) fprintf(stderr, "cooperative launch failed: %s (grid %d)\n", hipGetErrorString(e), grid_blocks);
#else
    for (int k = 0; k < 11; ++k) {
        p.ph_lo = k;
        p.ph_hi = k + 1;
        hipLaunchKernelGGL(mega, dim3(grid_blocks), dim3(256), LDS_BYTES, stream, p);
    }
#endif
}
```

```cpp
#include <hip/hip_runtime.h>
#include <hip/hip_cooperative_groups.h>
#include <cstdio>
#include <cstdint>
namespace cg = cooperative_groups;

typedef unsigned short u16;
typedef __attribute__((ext_vector_type(8))) short bf16x8;
typedef __attribute__((ext_vector_type(4))) float f32x4;

constexpr int TP = 65536, TS = 1024, T = TP + TS;
constexpr int ACOLS = 1824;
constexpr int LKS = 1088;
constexpr int LDS_BYTES = 73728;
constexpr float EPS = 1e-6f;

constexpr size_t OFF_YS = 67108864ull, OFF_KP = 68157440ull, OFF_VP = 101711872ull, OFF_WP = 135266304ull,
                 OFF_SHP = 135790592ull, OFF_KS = 135819776ull, OFF_VS = 136344064ull, OFF_WS = 136868352ull,
                 OFF_SHS = 137916928ull;

constexpr size_t al(size_t x) { return (x + 255) & ~(size_t)255; }
constexpr size_t O_WIN = 0;
constexpr size_t O_WOA = O_WIN + al(5504ull * 1024 * 2);
constexpr size_t O_WOB = O_WOA + al(1024ull * 512 * 2);
constexpr size_t O_WO = O_WOB + al(1024ull * 512 * 2);
constexpr size_t O_WFI = O_WO + al(1024ull * 1024 * 2);
constexpr size_t O_WFO = O_WFI + al(5632ull * 1024 * 2);
constexpr size_t O_W2 = O_WFO + al(1024ull * 2816 * 2);
constexpr size_t O_A2 = O_W2 + al(512 * 64 * 2);
constexpr size_t O_G2 = O_A2 + al(512 * 64 * 2);
constexpr size_t O_RS1 = O_G2 + al(512 * 160 * 2);
constexpr size_t O_SS2 = O_RS1 + al((size_t)T * 4);
constexpr size_t O_SS4 = O_SS2 + al((size_t)T * 16 * 4);
constexpr size_t O_RS3 = O_SS4 + al((size_t)T * 16 * 4);
constexpr size_t O_RK = O_RS3 + al((size_t)T * 4);
constexpr size_t O_SCAL = O_RK + al((size_t)T * 8 * 16);
constexpr size_t O_REGA = O_SCAL + 256;
constexpr size_t O_CA = O_REGA;
constexpr size_t O_YA = O_REGA;
constexpr size_t O_OB = O_YA + al((size_t)T * 512 * 2);
constexpr size_t O_YRAW = O_OB + al((size_t)T * 512 * 2);
constexpr size_t O_HB = O_REGA;
constexpr size_t O_REGB = O_REGA + al((size_t)(T + 48) * 1824 * 2);
constexpr size_t O_QB = O_REGB;
constexpr size_t O_KP = O_QB + al((size_t)T * 512 * 2);
constexpr size_t O_KS = O_KP + al((size_t)TP * 512 * 2);
constexpr size_t O_VTP = O_KS + al(32ull * LKS * 512 * 2);
constexpr size_t O_VTS = O_VTP + al(16ull * 512 * 4096 * 2);
constexpr size_t O_REGC = O_VTS + al(32ull * 512 * LKS * 2);
constexpr size_t O_GATE = O_REGB;
static_assert(O_GATE + (size_t)T * 2048 * 2 <= O_REGC, "gate overlaps region C");
constexpr size_t O_SI = O_REGC;
constexpr size_t O_G = O_SI + al((size_t)T * 8 * 384 * 2);
constexpr size_t O_XB = O_REGC;
constexpr size_t O_MIX = O_REGC;
constexpr size_t O_M2 = O_MIX + al((size_t)T * 1024 * 2);
constexpr size_t O_X1B = O_M2 + al((size_t)T * 1024 * 2);
constexpr size_t O_FB = O_REGC;
constexpr size_t WS_END = O_G + al((size_t)T * 512 * 2);
static_assert(O_HB + (size_t)T * 2816 * 2 <= O_REGC, "hb overlaps region C");
static_assert(O_YRAW + (size_t)T * 512 * 2 <= O_REGB, "yraw overlaps region B");
static_assert(O_X1B + (size_t)T * 1024 * 2 <= WS_END, "x1b beyond end");
static_assert(WS_END <= 1073741824ull, "workspace too large");

struct Params {
    const float *x_prompt, *x_sample, *cache_k, *cache_v, *state_wkv, *state_shift;
    const float *n_mix_pre, *n_mix_post, *n_ffn_pre, *n_ffn_post, *w_in, *b_gate;
    const float *mu, *w0, *w2, *a0, *a2, *g2, *k_k, *k_a, *r_k, *ln_w, *ln_b;
    const float *lq1, *lk1, *lq2, *lk2, *subln, *w_out_a, *w_out_b, *w_o, *w_ffn_in, *w_ffn_out;
    float* out;
    unsigned char* ws;
    int ph_lo, ph_hi;
};

typedef float v2f_ __attribute__((ext_vector_type(2)));
typedef __bf16 bf2_ __attribute__((ext_vector_type(2)));
__device__ __forceinline__ unsigned pk2(float a, float b) {
    const v2f_ v = {a, b};
    const bf2_ r = __builtin_convertvector(v, bf2_);
    return __builtin_bit_cast(unsigned, r);
}
__device__ __forceinline__ u16 f2bf(float f) { return (u16)(pk2(f, 0.f) & 0xffffu); }
__device__ __forceinline__ float bflo(unsigned u) { return __uint_as_float(u << 16); }
__device__ __forceinline__ float bfhi(unsigned u) { return __uint_as_float(u & 0xffff0000u); }
__device__ __forceinline__ uint2 pk4(float a, float b, float c, float d) { return make_uint2(pk2(a, b), pk2(c, d)); }
__device__ __forceinline__ float sigmoidf_(float x) { return 1.f / (1.f + __expf(-x)); }

template <int CTRL>
__device__ __forceinline__ float dppf(float x) {
    return __int_as_float(__builtin_amdgcn_update_dpp(0, __float_as_int(x), CTRL, 0xF, 0xF, true));
}
__device__ __forceinline__ float red8(float x) {
    x += dppf<0xB1>(x);
    x += dppf<0x4E>(x);
    x += dppf<0x141>(x);
    return x;
}
__device__ __forceinline__ float red16(float x) {
    x = red8(x);
    x += dppf<0x140>(x);
    return x;
}
typedef unsigned u2_ __attribute__((ext_vector_type(2)));
__device__ __forceinline__ float red_g(float x) {
    u2_ r = __builtin_amdgcn_permlane16_swap(__float_as_uint(x), __float_as_uint(x), false, false);
    x = __uint_as_float(r[0]) + __uint_as_float(r[1]);
    r = __builtin_amdgcn_permlane32_swap(__float_as_uint(x), __float_as_uint(x), false, false);
    return __uint_as_float(r[0]) + __uint_as_float(r[1]);
}
__device__ __forceinline__ float max_g(float x) {
    u2_ r = __builtin_amdgcn_permlane16_swap(__float_as_uint(x), __float_as_uint(x), false, false);
    x = fmaxf(__uint_as_float(r[0]), __uint_as_float(r[1]));
    r = __builtin_amdgcn_permlane32_swap(__float_as_uint(x), __float_as_uint(x), false, false);
    return fmaxf(__uint_as_float(r[0]), __uint_as_float(r[1]));
}
__device__ __forceinline__ float wave_sum(float x) {
    x = red16(x);
    return red_g(x);
}
__device__ __forceinline__ bf16x8 as_frag(uint4 v) {
    union { uint4 u; bf16x8 f; } c;
    c.u = v;
    return c.f;
}
#define MFMA(a, b, c) __builtin_amdgcn_mfma_f32_16x16x32_bf16((a), (b), (c), 0, 0, 0)

constexpr int LDT = 72;
constexpr int STG = 128 * LDT;
__device__ __forceinline__ void gemm_loop(const u16* __restrict__ A, int lda, const u16* __restrict__ B, int ldb,
                                          int nkt, u16* smem, f32x4 (&acc)[4][4]) {
    const int tid = threadIdx.x, lane = tid & 63, wid = tid >> 6, wm = wid >> 1, wn = wid & 1, l16 = lane & 15, g = lane >> 4;
    const int lr = tid >> 3, lc = (tid & 7) * 8;
    u16* sA = smem;
    u16* sB = smem + 2 * STG;
    const u16* ap = A + (size_t)lr * lda + lc;
    const u16* bp = B + (size_t)lr * ldb + lc;
    uint4 ra0, ra1, ra2, ra3, rb0, rb1, rb2, rb3;
#define G_LOAD(ko)                                                   \
    ra0 = *(const uint4*)(ap + (ko));                                \
    ra1 = *(const uint4*)(ap + (size_t)32 * lda + (ko));             \
    ra2 = *(const uint4*)(ap + (size_t)64 * lda + (ko));             \
    ra3 = *(const uint4*)(ap + (size_t)96 * lda + (ko));             \
    rb0 = *(const uint4*)(bp + (ko));                                \
    rb1 = *(const uint4*)(bp + (size_t)32 * ldb + (ko));             \
    rb2 = *(const uint4*)(bp + (size_t)64 * ldb + (ko));             \
    rb3 = *(const uint4*)(bp + (size_t)96 * ldb + (ko));
#define G_STORE(bo)                                                  \
    *(uint4*)(sA + (bo) + (lr + 0) * LDT + lc) = ra0;                \
    *(uint4*)(sA + (bo) + (lr + 32) * LDT + lc) = ra1;               \
    *(uint4*)(sA + (bo) + (lr + 64) * LDT + lc) = ra2;               \
    *(uint4*)(sA + (bo) + (lr + 96) * LDT + lc) = ra3;               \
    *(uint4*)(sB + (bo) + (lr + 0) * LDT + lc) = rb0;                \
    *(uint4*)(sB + (bo) + (lr + 32) * LDT + lc) = rb1;               \
    *(uint4*)(sB + (bo) + (lr + 64) * LDT + lc) = rb2;               \
    *(uint4*)(sB + (bo) + (lr + 96) * LDT + lc) = rb3;
    G_LOAD(0)
    G_STORE(0)
    __syncthreads();
    for (int kt = 0; kt < nkt; ++kt) {
        const int buf = kt & 1;
        if (kt + 1 < nkt) { G_LOAD((kt + 1) * 64) }
        __builtin_amdgcn_sched_barrier(0);
        const u16* cA = sA + buf * STG + (wm * 64 + l16) * LDT + g * 8;
        const u16* cB = sB + buf * STG + (wn * 64 + l16) * LDT + g * 8;
#pragma unroll
        for (int ks = 0; ks < 2; ++ks) {
            bf16x8 xf[4], wf[4];
#pragma unroll
            for (int i = 0; i < 4; ++i) {
                xf[i] = *(const bf16x8*)(cA + i * 16 * LDT + ks * 32);
                wf[i] = *(const bf16x8*)(cB + i * 16 * LDT + ks * 32);
            }
#pragma unroll
            for (int nt = 0; nt < 4; ++nt)
#pragma unroll
                for (int mt = 0; mt < 4; ++mt) acc[nt][mt] = MFMA(wf[nt], xf[mt], acc[nt][mt]);
        }
        __builtin_amdgcn_sched_barrier(0);
        if (kt + 1 < nkt) { G_STORE((buf ^ 1) * STG) }
        __syncthreads();
    }
}
__device__ __forceinline__ void gemm_loop_xf32(const float* __restrict__ A, const u16* __restrict__ B, int ldb, int nkt, u16* smem,
                                               f32x4 (&acc)[4][4]) {
    const int tid = threadIdx.x, lane = tid & 63, wid = tid >> 6, wm = wid >> 1, wn = wid & 1, l16 = lane & 15, g = lane >> 4;
    const int lr = tid >> 3, lc = (tid & 7) * 8;
    u16* sA = smem;
    u16* sB = smem + 2 * STG;
    const float* ap = A + (size_t)lr * 1024 + lc;
    const u16* bp = B + (size_t)lr * ldb + lc;
    float4 fa0, fa1, fa2, fa3, fa4, fa5, fa6, fa7;
    uint4 rb0, rb1, rb2, rb3;
#define GX_LOAD(ko)                                                  \
    fa0 = *(const float4*)(ap + (ko));                               \
    fa1 = *(const float4*)(ap + (ko) + 4);                           \
    fa2 = *(const float4*)(ap + 32 * 1024 + (ko));                   \
    fa3 = *(const float4*)(ap + 32 * 1024 + (ko) + 4);               \
    fa4 = *(const float4*)(ap + 64 * 1024 + (ko));                   \
    fa5 = *(const float4*)(ap + 64 * 1024 + (ko) + 4);               \
    fa6 = *(const float4*)(ap + 96 * 1024 + (ko));                   \
    fa7 = *(const float4*)(ap + 96 * 1024 + (ko) + 4);               \
    rb0 = *(const uint4*)(bp + (ko));                                \
    rb1 = *(const uint4*)(bp + (size_t)32 * ldb + (ko));             \
    rb2 = *(const uint4*)(bp + (size_t)64 * ldb + (ko));             \
    rb3 = *(const uint4*)(bp + (size_t)96 * ldb + (ko));
#define PKF(a, b) make_uint4(pk2(a.x, a.y), pk2(a.z, a.w), pk2(b.x, b.y), pk2(b.z, b.w))
#define GX_STORE(bo)                                                 \
    *(uint4*)(sA + (bo) + (lr + 0) * LDT + lc) = PKF(fa0, fa1);      \
    *(uint4*)(sA + (bo) + (lr + 32) * LDT + lc) = PKF(fa2, fa3);     \
    *(uint4*)(sA + (bo) + (lr + 64) * LDT + lc) = PKF(fa4, fa5);     \
    *(uint4*)(sA + (bo) + (lr + 96) * LDT + lc) = PKF(fa6, fa7);     \
    *(uint4*)(sB + (bo) + (lr + 0) * LDT + lc) = rb0;                \
    *(uint4*)(sB + (bo) + (lr + 32) * LDT + lc) = rb1;               \
    *(uint4*)(sB + (bo) + (lr + 64) * LDT + lc) = rb2;               \
    *(uint4*)(sB + (bo) + (lr + 96) * LDT + lc) = rb3;
    GX_LOAD(0)
    GX_STORE(0)
    __syncthreads();
    for (int kt = 0; kt < nkt; ++kt) {
        const int buf = kt & 1;
        if (kt + 1 < nkt) { GX_LOAD((kt + 1) * 64) }
        __builtin_amdgcn_sched_barrier(0);
        const u16* cA = sA + buf * STG + (wm * 64 + l16) * LDT + g * 8;
        const u16* cB = sB + buf * STG + (wn * 64 + l16) * LDT + g * 8;
#pragma unroll
        for (int ks = 0; ks < 2; ++ks) {
            bf16x8 xf[4], wf[4];
#pragma unroll
            for (int i = 0; i < 4; ++i) {
                xf[i] = *(const bf16x8*)(cA + i * 16 * LDT + ks * 32);
                wf[i] = *(const bf16x8*)(cB + i * 16 * LDT + ks * 32);
            }
#pragma unroll
            for (int nt = 0; nt < 4; ++nt)
#pragma unroll
                for (int mt = 0; mt < 4; ++mt) acc[nt][mt] = MFMA(wf[nt], xf[mt], acc[nt][mt]);
        }
        __builtin_amdgcn_sched_barrier(0);
        if (kt + 1 < nkt) { GX_STORE((buf ^ 1) * STG) }
        __syncthreads();
    }
}
__device__ __forceinline__ void zero_acc(f32x4 (&acc)[4][4]) {
#pragma unroll
    for (int i = 0; i < 4; ++i)
#pragma unroll
        for (int j = 0; j < 4; ++j) acc[i][j] = (f32x4){0.f, 0.f, 0.f, 0.f};
}
__device__ __forceinline__ void tile_map(int t, int NT, int& mt, int& nt) {
    const int x = t & 7, u = t >> 3;
    const int gsz = 8 * NT;
    const int g = u / gsz;
    const int w = u - g * gsz;
    const int rows = (g < 8) ? 8 : 1;
    const int q = w / rows;
    mt = x * 65 + g * 8 + (w - q * rows);
    nt = q;
}

__device__ __forceinline__ void tr_tile(const float* __restrict__ in, int R, int C, int ldin, u16* __restrict__ out, int ldout,
                        const float* __restrict__ scale, int r0, int c0, int Cout, bool perm, float* tile) {
    const int tid = threadIdx.x;
    {
        const int tx = tid & 63, ty = tid >> 6;
        const int c = c0 + tx;
        for (int rr = ty; rr < 64; rr += 4) {
            const int r = r0 + rr;
            float v = 0.f;
            if (r < R && c < C) {
                v = in[(size_t)r * ldin + c];
                if (scale) v *= scale[r];
            }
            tile[rr * 65 + tx] = v;
        }
    }
    __syncthreads();
    {
        const int rch = (tid & 7) * 8;
#pragma unroll
        for (int pass = 0; pass < 2; ++pass) {
            const int cc = (tid >> 3) + pass * 32;
            const int c = c0 + cc;
            if (c < Cout && r0 + rch < R) {
                float v[8];
#pragma unroll
                for (int k = 0; k < 8; ++k) v[k] = tile[(rch + k) * 65 + cc];
                int orow = c;
                if (perm) {
                    const int type = c >= 2816 ? 1 : 0;
                    const int j = c - type * 2816;
                    orow = (j >> 4) * 32 + type * 16 + (j & 15);
                }
                uint4 o = make_uint4(pk2(v[0], v[1]), pk2(v[2], v[3]), pk2(v[4], v[5]), pk2(v[6], v[7]));
                *(uint4*)(out + (size_t)orow * ldout + r0 + rch) = o;
            }
        }
    }
    __syncthreads();
}

__device__ __forceinline__ void phase0(const Params& p, unsigned char* smem) {
    float* tile = (float*)smem;
    const int tid = threadIdx.x, lane = tid & 63, wid = tid >> 6;
    unsigned char* ws = p.ws;
    const int G = gridDim.x;
    for (int u = blockIdx.x; u < 8136; u += G) {
        const float* in;
        int R, C, Cout, ldout, tl;
        u16* out;
        const float* scale = nullptr;
        bool perm = false;
        if (u < 1376) { tl = u; in = p.w_in; R = 1024; C = 5408; Cout = 5504; out = (u16*)(ws + O_WIN); ldout = 1024; scale = p.n_mix_pre; }
        else if (u < 1504) { tl = u - 1376; in = p.w_out_a; R = 512; C = 1024; Cout = 1024; out = (u16*)(ws + O_WOA); ldout = 512; }
        else if (u < 1632) { tl = u - 1504; in = p.w_out_b; R = 512; C = 1024; Cout = 1024; out = (u16*)(ws + O_WOB); ldout = 512; }
        else if (u < 1888) { tl = u - 1632; in = p.w_o; R = 1024; C = 1024; Cout = 1024; out = (u16*)(ws + O_WO); ldout = 1024; }
        else if (u < 3296) { tl = u - 1888; in = p.w_ffn_in; R = 1024; C = 5632; Cout = 5632; out = (u16*)(ws + O_WFI); ldout = 1024; scale = p.n_ffn_pre; perm = true; }
        else if (u < 4000) { tl = u - 3296; in = p.w_ffn_out; R = 2816; C = 1024; Cout = 1024; out = (u16*)(ws + O_WFO); ldout = 2816; }
        else if (u < 4008) { tl = u - 4000; in = p.w2; R = 64; C = 512; Cout = 512; out = (u16*)(ws + O_W2); ldout = 64; }
        else if (u < 4016) { tl = u - 4008; in = p.a2; R = 64; C = 512; Cout = 512; out = (u16*)(ws + O_A2); ldout = 64; }
        else if (u < 4040) { tl = u - 4016; in = p.g2; R = 160; C = 512; Cout = 512; out = (u16*)(ws + O_G2); ldout = 160; }
        else {
            tl = u - 4040;
            const int b = tl >> 7;
            tl &= 127;
            in = p.cache_v + (size_t)b * 1024 * 512; R = 1024; C = 512; Cout = 512;
            out = (u16*)(ws + O_VTS) + (size_t)b * 512 * LKS; ldout = LKS;
        }
        const int ctiles = (Cout + 63) >> 6;
        const int rt = tl / ctiles, ct = tl - rt * ctiles;
        tr_tile(in, R, C, C, out, ldout, scale, rt * 64, ct * 64, Cout, perm, tile);
    }
    {
        u16* xb = (u16*)(ws + O_XB);
        float* rs1 = (float*)(ws + O_RS1);
        for (int m = blockIdx.x * 4 + wid; m < T; m += G * 4) {
            const float* xr = (m < TP) ? p.x_prompt + (size_t)m * 1024 : p.x_sample + (size_t)(m - TP) * 1024;
            float ss = 0.f;
#pragma unroll
            for (int i = 0; i < 4; ++i) {
                const float4 v = *(const float4*)(xr + i * 256 + lane * 4);
                ss += v.x * v.x + v.y * v.y + v.z * v.z + v.w * v.w;
                *(uint2*)(xb + (size_t)m * 1024 + i * 256 + lane * 4) = pk4(v.x, v.y, v.z, v.w);
            }
            ss = wave_sum(ss);
            if (lane == 0) rs1[m] = rsqrtf(ss * (1.f / 1024.f) + EPS);
        }
    }
    {
        u16* kS = (u16*)(ws + O_KS);
        const int n8 = 32 * 1024 * 64;
        for (int i = blockIdx.x * 256 + tid; i < n8; i += G * 256) {
            const int b = i >> 16, rem = i & 65535, key = rem >> 6, c8 = rem & 63;
            const float4 v0 = *(const float4*)(p.cache_k + (size_t)i * 8);
            const float4 v1 = *(const float4*)(p.cache_k + (size_t)i * 8 + 4);
            *(uint4*)(kS + ((size_t)b * LKS + key) * 512 + c8 * 8) =
                make_uint4(pk2(v0.x, v0.y), pk2(v0.z, v0.w), pk2(v1.x, v1.y), pk2(v1.z, v1.w));
        }
        for (int i = blockIdx.x * 256 + tid; i < 32 * 32 * 64; i += G * 256) {
            const int b = i >> 11, rem = i & 2047, row = rem >> 6, c8 = rem & 63;
            *(uint4*)(kS + ((size_t)b * LKS + 1056 + row) * 512 + c8 * 8) = make_uint4(0, 0, 0, 0);
        }
        u16* vtS = (u16*)(ws + O_VTS);
        for (int i = blockIdx.x * 256 + tid; i < 32 * 512 * 4; i += G * 256) {
            const int row = i >> 2, c8 = i & 3;
            *(uint4*)(vtS + (size_t)row * LKS + 1056 + c8 * 8) = make_uint4(0, 0, 0, 0);
        }
    }
    {
        u16* cA = (u16*)(ws + O_CA);
        for (int i = blockIdx.x * 256 + tid; i < 48 * ACOLS; i += G * 256) {
            const int s = i / ACOLS, c = i - s * ACOLS;
            float v = 0.f;
            size_t row;
            if (s < 16) row = (size_t)s * 4097;
            else { row = (size_t)16 * 4097 + (size_t)(s - 16) * 33; v = p.state_shift[(size_t)(s - 16) * ACOLS + c]; }
            cA[row * ACOLS + c] = f2bf(v);
        }
        if (blockIdx.x == 0 && tid == 0) {
            float d1 = 0.f, d2 = 0.f;
            for (int i = 0; i < 64; ++i) { d1 += p.lq1[i] * p.lk1[i]; d2 += p.lq2[i] * p.lk2[i]; }
            float* sc = (float*)(ws + O_SCAL);
            sc[0] = __expf(d1) - __expf(d2) + 0.2f;
            for (int i = 1; i < 32; ++i) ((unsigned*)sc)[i] = 0u;
        }
    }
}

__device__ __forceinline__ void phase1(const Params& p, unsigned char* smem) {
    unsigned char* ws = p.ws;
    const u16* xb = (const u16*)(ws + O_XB);
    const u16* W = (const u16*)(ws + O_WIN);
    const float* rs1 = (const float*)(ws + O_RS1);
    u16* cA = (u16*)(ws + O_CA);
    u16* qb = (u16*)(ws + O_QB);
    u16* kP = (u16*)(ws + O_KP);
    u16* kS = (u16*)(ws + O_KS);
    u16* vtP = (u16*)(ws + O_VTP);
    u16* vtS = (u16*)(ws + O_VTS);
    float* out = p.out;
    const int tid = threadIdx.x, lane = tid & 63, wid = tid >> 6, wm = wid >> 1, wn = wid & 1, l16 = lane & 15, g = lane >> 4;
    constexpr int NT = 43;
    u16* gate = (u16*)p.out;
    for (int t = blockIdx.x; t < 520 * NT; t += gridDim.x) {
        int mtile, ntile;
        tile_map(t, NT, mtile, ntile);
        const int m0 = mtile * 128, n0 = ntile * 128;
        f32x4 acc[4][4];
        zero_acc(acc);
        gemm_loop(xb + (size_t)m0 * 1024, 1024, W + (size_t)n0 * 1024, 1024, 16, (u16*)smem, acc);
#pragma unroll
        for (int mt = 0; mt < 4; ++mt) {
            const int m = m0 + wm * 64 + mt * 16 + l16;
            const float rs = rs1[m];
            const bool isP = m < TP;
            int seq, tt;
            if (isP) { seq = m >> 12; tt = m & 4095; }
            else { const int ms = m - TP; seq = 16 + (ms >> 5); tt = ms & 31; }
            const size_t carow = (size_t)m + seq + 1;
            const bool last = isP ? (tt == 4095) : (tt == 31);
#pragma unroll
            for (int nt = 0; nt < 4; ++nt) {
                const int n = n0 + wn * 64 + nt * 16 + g * 4;
                if (n >= 5408) continue;
                f32x4 v = acc[nt][mt];
                v[0] *= rs; v[1] *= rs; v[2] *= rs; v[3] *= rs;
                if (n < 1824) {
                    *(uint2*)(cA + carow * ACOLS + n) = pk4(v[0], v[1], v[2], v[3]);
                    if (last) {
                        float* so = isP ? out + OFF_SHP + (size_t)seq * ACOLS + n : out + OFF_SHS + (size_t)(seq - 16) * ACOLS + n;
                        *(float4*)so = make_float4(v[0], v[1], v[2], v[3]);
                    }
                } else if (n < 2336) {
                    constexpr float SCQ = 0.125f * 1.4426950408889634f;
                    *(uint2*)(qb + (size_t)m * 512 + (n - 1824)) = pk4(v[0] * SCQ, v[1] * SCQ, v[2] * SCQ, v[3] * SCQ);
                } else if (n < 2848) {
                    const int c = n - 2336;
                    if (isP) {
                        *(uint2*)(kP + (size_t)m * 512 + c) = pk4(v[0], v[1], v[2], v[3]);
                        *(float4*)(out + OFF_KP + (size_t)m * 512 + c) = make_float4(v[0], v[1], v[2], v[3]);
                    } else {
                        *(uint2*)(kS + ((size_t)(seq - 16) * LKS + 1024 + tt) * 512 + c) = pk4(v[0], v[1], v[2], v[3]);
                        *(float4*)(out + OFF_KS + (size_t)(m - TP) * 512 + c) = make_float4(v[0], v[1], v[2], v[3]);
                    }
                } else if (n < 3360) {
                    const int c = n - 2848;
                    if (isP) {
                        *(float4*)(out + OFF_VP + (size_t)m * 512 + c) = make_float4(v[0], v[1], v[2], v[3]);
                        u16* d = vtP + ((size_t)seq * 512 + c) * 4096 + tt;
                        d[0] = f2bf(v[0]); d[4096] = f2bf(v[1]); d[2 * 4096] = f2bf(v[2]); d[3 * 4096] = f2bf(v[3]);
                    } else {
                        *(float4*)(out + OFF_VS + (size_t)(m - TP) * 512 + c) = make_float4(v[0], v[1], v[2], v[3]);
                        u16* d = vtS + ((size_t)(seq - 16) * 512 + c) * LKS + 1024 + tt;
                        d[0] = f2bf(v[0]); d[LKS] = f2bf(v[1]); d[2 * LKS] = f2bf(v[2]); d[3 * LKS] = f2bf(v[3]);
                    }
                } else {
                    const int c = n - 3360;
                    const float4 bg = *(const float4*)(p.b_gate + c);
                    *(uint2*)(gate + (size_t)m * 2048 + c) =
                        pk4(sigmoidf_(v[0] + bg.x), sigmoidf_(v[1] + bg.y), sigmoidf_(v[2] + bg.z), sigmoidf_(v[3] + bg.w));
                }
            }
        }
    }
}

__device__ __forceinline__ void lerp8(const u16* cur, const u16* prv, const float* mu, int col, float (&xs)[8]) {
    const uint4 cu = *(const uint4*)(cur + col);
    const uint4 pv = *(const uint4*)(prv + col);
    const float4 m0 = *(const float4*)(mu + col);
    const float4 m1 = *(const float4*)(mu + col + 4);
    const unsigned cw[4] = {cu.x, cu.y, cu.z, cu.w}, pw[4] = {pv.x, pv.y, pv.z, pv.w};
    const float mm[8] = {m0.x, m0.y, m0.z, m0.w, m1.x, m1.y, m1.z, m1.w};
#pragma unroll
    for (int i = 0; i < 4; ++i) {
        const float c0 = bflo(cw[i]), c1 = bfhi(cw[i]), p0 = bflo(pw[i]), p1 = bfhi(pw[i]);
        xs[2 * i] = c0 + (p0 - c0) * mm[2 * i];
        xs[2 * i + 1] = c1 + (p1 - c1) * mm[2 * i + 1];
    }
}
__device__ __forceinline__ void lerp4(const u16* cur, const u16* prv, const float* mu, int col, float (&xs)[4]) {
    const uint2 cu = *(const uint2*)(cur + col);
    const uint2 pv = *(const uint2*)(prv + col);
    const float4 m0 = *(const float4*)(mu + col);
    float c0 = bflo(cu.x), c1 = bfhi(cu.x), c2 = bflo(cu.y), c3 = bfhi(cu.y);
    xs[0] = c0 + (bflo(pv.x) - c0) * m0.x;
    xs[1] = c1 + (bfhi(pv.x) - c1) * m0.y;
    xs[2] = c2 + (bflo(pv.y) - c2) * m0.z;
    xs[3] = c3 + (bfhi(pv.y) - c3) * m0.w;
}
__device__ __forceinline__ void lerp4w(const uint2 cu, const uint2 pv, const float* mu, int col, float (&xs)[4]) {
    const float4 m0 = *(const float4*)(mu + col);
    const float c0 = bflo(cu.x), c1 = bfhi(cu.x), c2 = bflo(cu.y), c3 = bfhi(cu.y);
    xs[0] = c0 + (bflo(pv.x) - c0) * m0.x;
    xs[1] = c1 + (bfhi(pv.x) - c1) * m0.y;
    xs[2] = c2 + (bflo(pv.y) - c2) * m0.z;
    xs[3] = c3 + (bfhi(pv.y) - c3) * m0.w;
}
__device__ __forceinline__ bf16x8 packfrag(const float (&v)[8]) {
    return as_frag(make_uint4(pk2(v[0], v[1]), pk2(v[2], v[3]), pk2(v[4], v[5]), pk2(v[6], v[7])));
}

__device__ __forceinline__ void phase2(const Params& p, unsigned char* smem) {
    unsigned char* ws = p.ws;
    const u16* cA = (const u16*)(ws + O_CA);
    const u16* w2t = (const u16*)(ws + O_W2);
    const u16* a2t = (const u16*)(ws + O_A2);
    const u16* g2t = (const u16*)(ws + O_G2);
    u16* SI = (u16*)(ws + O_SI);
    u16* Gb = (u16*)(ws + O_G);
    float4* rk4 = (float4*)(ws + O_RK);
    const int tid = threadIdx.x, lane = tid & 63, wid = tid >> 6, l16 = lane & 15, g = lane >> 4;
    float* sp = (float*)smem;
    for (int i = tid; i < 1824; i += 256) sp[i] = p.mu[i];
    for (int i = tid; i < 512; i += 256) {
        sp[1824 + i] = p.w0[i]; sp[2336 + i] = p.a0[i]; sp[2848 + i] = p.k_k[i]; sp[3360 + i] = p.k_a[i]; sp[3872 + i] = p.r_k[i];
    }
    __syncthreads();
    const int NU = (T / 64) / (int)gridDim.x * (int)gridDim.x;
    const int NW = NU + (T / 64 - NU) * 8;
    for (int uu = blockIdx.x; uu < NW; uu += gridDim.x) {
        int u, h_lo, h_hi;
        if (uu < NU) { u = uu; h_lo = 0; h_hi = 8; }
        else { const int v = uu - NU; u = NU + (v >> 3); h_lo = v & 7; h_hi = h_lo + 1; }
        const int mw = u * 64 + wid * 16;
        const int m = mw + l16;
        const bool isP = mw < TP;
        int seq, tt;
        if (isP) { seq = m >> 12; tt = m & 4095; }
        else { const int ms = m - TP; seq = 16 + (ms >> 5); tt = ms & 31; }
        const u16* cur = cA + ((size_t)m + seq + 1) * ACOLS;
        const u16* prv = cur - ACOLS;
        bf16x8 xw[2], xa[2], xg[5];
#pragma unroll
        for (int s = 0; s < 9; ++s) {
            float xs[8];
            lerp8(cur, prv, sp, 1536 + s * 32 + g * 8, xs);
            if (s < 2) {
#pragma unroll
                for (int i = 0; i < 8; ++i) xs[i] = 1.f - 2.f / (__expf(2.f * xs[i]) + 1.f);
                xw[s] = packfrag(xs);
            } else if (s < 4) {
                xa[s - 2] = packfrag(xs);
            } else {
#pragma unroll
                for (int i = 0; i < 8; ++i) xs[i] = sigmoidf_(xs[i]);
                xg[s - 4] = packfrag(xs);
            }
        }
        bf16x8 nw0, nw1, na0, na1;
        uint2 ncr, npr, nck, npk, ncv, npv;
#define P2_FETCH(hh, ntt)                                                          \
        {                                                                          \
            const int wr_ = (hh) * 64 + (ntt) * 16 + l16;                          \
            nw0 = *(const bf16x8*)(w2t + wr_ * 64 + g * 8);                        \
            nw1 = *(const bf16x8*)(w2t + wr_ * 64 + 32 + g * 8);                   \
            na0 = *(const bf16x8*)(a2t + wr_ * 64 + g * 8);                        \
            na1 = *(const bf16x8*)(a2t + wr_ * 64 + 32 + g * 8);                   \
            const int ch_ = (hh) * 64 + (ntt) * 16 + g * 4;                        \
            ncr = *(const uint2*)(cur + ch_);        npr = *(const uint2*)(prv + ch_);        \
            nck = *(const uint2*)(cur + 512 + ch_);  npk = *(const uint2*)(prv + 512 + ch_);  \
            ncv = *(const uint2*)(cur + 1024 + ch_); npv = *(const uint2*)(prv + 1024 + ch_); \
        }
        P2_FETCH(h_lo, 0)
        for (int h = h_lo; h < h_hi; ++h) {
            float kkr[16], av[16];
            float ssq = 0.f, rkacc = 0.f, bracc = 0.f, kracc = 0.f;
            const size_t sirow = isP ? ((size_t)(seq * 8 + h) * 4096 + tt) : ((size_t)128 * 4096 + (size_t)((seq - 16) * 8 + h) * 32 + tt);
            u16* sib = SI + sirow * 384;
#pragma unroll
            for (int nt = 0; nt < 4; ++nt) {
                const bf16x8 cw0 = nw0, cw1 = nw1, ca0 = na0, ca1 = na1;
                const uint2 ccr = ncr, cpr = npr, cck = nck, cpk = npk, ccv = ncv, cpv = npv;
                if (nt < 3) { P2_FETCH(h, nt + 1) } else if (h + 1 < h_hi) { P2_FETCH(h + 1, 0) }
                const u16* gw_ = g2t + (h * 64 + nt * 16 + l16) * 160 + g * 8;
                const bf16x8 cg0 = *(const bf16x8*)(gw_), cg1 = *(const bf16x8*)(gw_ + 32), cg2 = *(const bf16x8*)(gw_ + 64),
                             cg3 = *(const bf16x8*)(gw_ + 96), cg4 = *(const bf16x8*)(gw_ + 128);
                __builtin_amdgcn_sched_barrier(0);
                f32x4 accw = {0.f, 0.f, 0.f, 0.f}, acca = accw;
                accw = MFMA(cw0, xw[0], accw); accw = MFMA(cw1, xw[1], accw);
                acca = MFMA(ca0, xa[0], acca); acca = MFMA(ca1, xa[1], acca);
                const int ch = h * 64 + nt * 16 + g * 4;
                float xr[4], xk[4], xv[4];
                lerp4w(ccr, cpr, sp, ch, xr);
                lerp4w(cck, cpk, sp, 512 + ch, xk);
                lerp4w(ccv, cpv, sp, 1024 + ch, xv);
                const float4 w0 = *(const float4*)(sp + 1824 + ch), a0 = *(const float4*)(sp + 2336 + ch), kk4 = *(const float4*)(sp + 2848 + ch),
                             ka4 = *(const float4*)(sp + 3360 + ch), rk4 = *(const float4*)(sp + 3872 + ch);
                const float w0a[4] = {w0.x, w0.y, w0.z, w0.w}, a0a[4] = {a0.x, a0.y, a0.z, a0.w}, kka[4] = {kk4.x, kk4.y, kk4.z, kk4.w},
                            kaa[4] = {ka4.x, ka4.y, ka4.z, ka4.w}, rka[4] = {rk4.x, rk4.y, rk4.z, rk4.w};
                float ev[4], kp[4], dr[4];
#pragma unroll
                for (int r = 0; r < 4; ++r) {
                    const float z = -(w0a[r] + accw[r]);
                    const float sp = (z > 20.f) ? z : __logf(1.f + __expf(z));
                    ev[r] = __expf(-sp - 0.5f);
                    const float a = sigmoidf_(a0a[r] + acca[r]);
                    const float kraw = xk[r] * kka[r];
                    ssq += kraw * kraw;
                    kp[r] = xk[r] * (1.f + (a - 1.f) * kaa[r]);
                    rkacc += xr[r] * kp[r] * rka[r];
                    kracc += xr[r] * kp[r];
                    bracc += kraw * a * xr[r];
                    dr[r] = xr[r] * __expf(-ev[r]);
                    kkr[nt * 4 + r] = kraw;
                    av[nt * 4 + r] = a;
                }
                const int co = nt * 16 + g * 4;
                *(uint2*)(sib + 0 * 64 + co) = pk4(dr[0], dr[1], dr[2], dr[3]);
                *(uint2*)(sib + 1 * 64 + co) = pk4(ev[0], ev[1], ev[2], ev[3]);
                *(uint2*)(sib + 2 * 64 + co) = pk4(kp[0], kp[1], kp[2], kp[3]);
                *(uint2*)(sib + 3 * 64 + co) = pk4(xv[0], xv[1], xv[2], xv[3]);
                f32x4 accg = {0.f, 0.f, 0.f, 0.f};
                accg = MFMA(cg0, xg[0], accg); accg = MFMA(cg1, xg[1], accg); accg = MFMA(cg2, xg[2], accg);
                accg = MFMA(cg3, xg[3], accg); accg = MFMA(cg4, xg[4], accg);
                *(uint2*)(Gb + (size_t)m * 512 + ch) = pk4(accg[0], accg[1], accg[2], accg[3]);
            }
            ssq = red_g(ssq);
            rkacc = red_g(rkacc);
            bracc = red_g(bracc);
            kracc = red_g(kracc);
            const float inv = rsqrtf(fmaxf(ssq, 1e-24f));
#pragma unroll
            for (int nt = 0; nt < 4; ++nt) {
                const int co = nt * 16 + g * 4;
                float k0 = kkr[nt * 4 + 0] * inv, k1 = kkr[nt * 4 + 1] * inv, k2 = kkr[nt * 4 + 2] * inv, k3 = kkr[nt * 4 + 3] * inv;
                *(uint2*)(sib + 4 * 64 + co) = pk4(k0, k1, k2, k3);
                *(uint2*)(sib + 5 * 64 + co) = pk4(k0 * av[nt * 4 + 0], k1 * av[nt * 4 + 1], k2 * av[nt * 4 + 2], k3 * av[nt * 4 + 3]);
            }
            if (g == 0) rk4[(size_t)m * 8 + h] = make_float4(rkacc, bracc * inv, kracc, 0.f);
        }
    }
}

typedef float v2f __attribute__((ext_vector_type(2)));
__device__ __forceinline__ void scan_item(const Params& p, const u16* __restrict__ si, int nch, const float* __restrict__ s0, float* __restrict__ sout,
                          int m0, int h, int half, unsigned char* smem) {
    float* inb = (float*)smem;
    float* ybuf = (float*)(smem + 49152);
    float* scal = (float*)(smem + 53248);
    unsigned char* ws = p.ws;
    const float4* rk4 = (const float4*)(ws + O_RK);
    u16* yraw = (u16*)(ws + O_YRAW);
    const int tid = threadIdx.x;
    const int vp = tid >> 3, kq = tid & 7;
    const int row = half * 32 + vp;
    v2f S[4];
    if (s0) {
        const float4 a = *(const float4*)(s0 + row * 64 + kq * 8), b = *(const float4*)(s0 + row * 64 + kq * 8 + 4);
        S[0] = (v2f){a.x, a.y}; S[1] = (v2f){a.z, a.w}; S[2] = (v2f){b.x, b.y}; S[3] = (v2f){b.z, b.w};
    } else {
#pragma unroll
        for (int j = 0; j < 4; ++j) S[j] = (v2f){0.f, 0.f};
    }
    uint4 st0, st1, st2;
    float4 sq = make_float4(0.f, 0.f, 0.f, 0.f);
    st0 = *(const uint4*)(si + (0 * 256 + tid) * 8);
    st1 = *(const uint4*)(si + (1 * 256 + tid) * 8);
    st2 = *(const uint4*)(si + (2 * 256 + tid) * 8);
    if (tid < 16) sq = rk4[(m0 + tid) * 8 + h];
#define S_WRITE1(sv, i, buf)                                                                                          \
    {                                                                                                                 \
        const int idx = (i) * 256 + tid;                                                                              \
        const int vec = (idx % 48) >> 3;                                                                              \
        float v[8] = {bflo(sv.x), bfhi(sv.x), bflo(sv.y), bfhi(sv.y), bflo(sv.z), bfhi(sv.z), bflo(sv.w), bfhi(sv.w)}; \
        if (vec == 1) {                                                                                               \
            _Pragma("unroll") for (int k = 0; k < 8; ++k) v[k] = __expf(-v[k]);                                       \
        }                                                                                                             \
        float* d = inb + (buf) * 6144 + idx * 8;                                                                      \
        *(float4*)d = make_float4(v[0], v[1], v[2], v[3]);                                                            \
        *(float4*)(d + 4) = make_float4(v[4], v[5], v[6], v[7]);                                                      \
    }
#define stage_write(buf) S_WRITE1(st0, 0, buf) S_WRITE1(st1, 1, buf) S_WRITE1(st2, 2, buf) if (tid < 16) *(float4*)(scal + (buf) * 64 + tid * 4) = sq;
    stage_write(0)
    __syncthreads();
    for (int c = 0; c < nch; ++c) {
        const int buf = c & 1;
        if (c + 1 < nch) {
            const u16* sn = si + (c + 1) * 6144 + tid * 8;
            st0 = *(const uint4*)(sn);
            st1 = *(const uint4*)(sn + 2048);
            st2 = *(const uint4*)(sn + 4096);
            if (tid < 16) sq = rk4[(m0 + (c + 1) * 16 + tid) * 8 + h];
        }
        const float* cb = inb + buf * 6144;
        const float* cs = scal + buf * 64;
#pragma unroll 2
        for (int tt = 0; tt < 16; ++tt) {
            const float* base = cb + tt * 384;
            v2f kk[4], dr[4], dd[4], bb[4], kv[4];
#define LD8(dst, off)                                                      \
    {                                                                      \
        const float4 q0 = *(const float4*)(base + (off) + kq * 8);         \
        const float4 q1 = *(const float4*)(base + (off) + kq * 8 + 4);     \
        dst[0] = (v2f){q0.x, q0.y}; dst[1] = (v2f){q0.z, q0.w};            \
        dst[2] = (v2f){q1.x, q1.y}; dst[3] = (v2f){q1.z, q1.w};            \
    }
            LD8(kk, 256) LD8(dr, 0) LD8(dd, 64) LD8(bb, 320) LD8(kv, 128)
            const float vv = base[192 + row];
            const float2 brkr = *(const float2*)(cs + tt * 4 + 1);
            v2f a0 = S[0] * kk[0], a1 = S[1] * kk[1], q0 = S[0] * dr[0], q1 = S[1] * dr[1];
            a0 = __builtin_elementwise_fma(S[2], kk[2], a0);
            a1 = __builtin_elementwise_fma(S[3], kk[3], a1);
            q0 = __builtin_elementwise_fma(S[2], dr[2], q0);
            q1 = __builtin_elementwise_fma(S[3], dr[3], q1);
            a0 += a1;
            q0 += q1;
            const float sa = -red8(a0.x + a0.y);
            const float pp = red8(q0.x + q0.y);
            const float y = pp + sa * brkr.x + vv * brkr.y;
            if (kq == 0) ybuf[tt * 32 + vp] = y;
            const v2f sav = (v2f){sa, sa}, vvv = (v2f){vv, vv};
#pragma unroll
            for (int j = 0; j < 4; ++j) S[j] = __builtin_elementwise_fma(S[j], dd[j], __builtin_elementwise_fma(vvv, kv[j], sav * bb[j]));
        }
        __syncthreads();
        {
            const int tt = tid >> 4, e2 = (tid & 15) * 2;
            const float2 y2 = *(const float2*)(ybuf + tt * 32 + e2);
            *(unsigned*)(yraw + (m0 + c * 16 + tt) * 512 + h * 64 + half * 32 + e2) = pk2(y2.x, y2.y);
        }
        if (c + 1 < nch) { stage_write(buf ^ 1) }
        __syncthreads();
    }
    {
        float* d0 = sout + row * 64 + kq * 8;
        *(float4*)d0 = make_float4(S[0].x, S[0].y, S[1].x, S[1].y);
        *(float4*)(d0 + 4) = make_float4(S[2].x, S[2].y, S[3].x, S[3].y);
    }
}

__device__ __forceinline__ void ln_pass(const Params& p) {
    unsigned char* ws = p.ws;
    const u16* yraw = (const u16*)(ws + O_YRAW);
    const u16* Gb = (const u16*)(ws + O_G);
    const u16* SI = (const u16*)(ws + O_SI);
    const float4* rk4 = (const float4*)(ws + O_RK);
    u16* ya = (u16*)(ws + O_YA);
    const int tid = threadIdx.x, cq = (tid & 15) * 4;
    for (int q0 = blockIdx.x * 16; q0 < T * 8; q0 += gridDim.x * 16) {
        const int q = q0 + (tid >> 4);
        const int m = q >> 3, h = q & 7;
        const int e = m * 512 + h * 64 + cq;
        const uint2 yv = *(const uint2*)(yraw + e);
        const float y0 = bflo(yv.x), y1 = bfhi(yv.x), y2 = bflo(yv.y), y3 = bfhi(yv.y);
        const float mean = red16(y0 + y1 + y2 + y3) * (1.f / 64.f);
        const float d0 = y0 - mean, d1 = y1 - mean, d2 = y2 - mean, d3 = y3 - mean;
        const float var = red16(d0 * d0 + d1 * d1 + d2 * d2 + d3 * d3) * (1.f / 64.f);
        const float rstd = rsqrtf(var + 64e-5f);
        const float rkv = rk4[q].x;
        int sirow;
        if (m < TP) sirow = ((m >> 12) * 8 + h) * 4096 + (m & 4095);
        else { const int ms = m - TP; sirow = 128 * 4096 + ((ms >> 5) * 8 + h) * 32 + (ms & 31); }
        const uint2 vq = *(const uint2*)(SI + (size_t)sirow * 384 + 192 + cq);
        const uint2 gg = *(const uint2*)(Gb + e);
        const float4 lw = *(const float4*)(p.ln_w + h * 64 + cq), lb = *(const float4*)(p.ln_b + h * 64 + cq);
        const float o0 = (d0 * rstd * lw.x + lb.x + rkv * bflo(vq.x)) * bflo(gg.x);
        const float o1 = (d1 * rstd * lw.y + lb.y + rkv * bfhi(vq.x)) * bfhi(gg.x);
        const float o2 = (d2 * rstd * lw.z + lb.z + rkv * bflo(vq.y)) * bflo(gg.y);
        const float o3 = (d3 * rstd * lw.w + lb.w + rkv * bfhi(vq.y)) * bfhi(gg.y);
        *(uint2*)(ya + e) = pk4(o0, o1, o2, o3);
    }
}

constexpr int KLD = 136, VLD = 72;
__device__ __forceinline__ void attn_item(const u16* __restrict__ Q, int nq, const u16* __restrict__ K, const u16* __restrict__ Vt, int ldv, int nkt,
                          int lastvalid, u16* __restrict__ O, float lam, const float* __restrict__ subln, unsigned char* smem) {
    u16* sK = (u16*)smem;
    u16* sV = (u16*)(smem + 2 * 64 * KLD * 2);
    float* ex = (float*)smem;
    const int tid = threadIdx.x, lane = tid & 63, wid = tid >> 6, l16 = lane & 15, g = lane >> 4;
    const int n = wid >> 1, qh = wid & 1;
    const bool active = (qh * 32) < nq;
    bf16x8 qf[2][2];
#pragma unroll
    for (int qt = 0; qt < 2; ++qt)
#pragma unroll
        for (int s = 0; s < 2; ++s) {
            const int row = qh * 32 + qt * 16 + l16;
            uint4 v = make_uint4(0, 0, 0, 0);
            if (row < nq) v = *(const uint4*)(Q + (row * 512 + n * 64 + s * 32 + g * 8));
            qf[qt][s] = as_frag(v);
        }
    f32x4 o[2][8];
#pragma unroll
    for (int qt = 0; qt < 2; ++qt)
#pragma unroll
        for (int et = 0; et < 8; ++et) o[qt][et] = (f32x4){0.f, 0.f, 0.f, 0.f};
    float mrow[2] = {-1e30f, -1e30f}, lrow[2] = {0.f, 0.f};
    uint4 kr0, kr1, kr2, kr3, vr0, vr1, vr2, vr3;
    const int krow = tid >> 4, kch = (tid & 15) * 8;
    const int vrow = tid >> 3, vch = (tid & 7) * 8;
    const int ko_ = krow * 512 + kch;
    const int vo_ = vrow * ldv + vch;
#define A_LOAD(key0)                                                      \
    kr0 = *(const uint4*)(K + (ko_ + ((key0) + 0) * 512));                \
    kr1 = *(const uint4*)(K + (ko_ + ((key0) + 16) * 512));               \
    kr2 = *(const uint4*)(K + (ko_ + ((key0) + 32) * 512));               \
    kr3 = *(const uint4*)(K + (ko_ + ((key0) + 48) * 512));               \
    vr0 = *(const uint4*)(Vt + (vo_ + (key0)));                           \
    vr1 = *(const uint4*)(Vt + (vo_ + 32 * ldv + (key0)));                \
    vr2 = *(const uint4*)(Vt + (vo_ + 64 * ldv + (key0)));                \
    vr3 = *(const uint4*)(Vt + (vo_ + 96 * ldv + (key0)));
#define A_STORE(nb)                                                       \
    *(uint4*)(sK + (nb) * 64 * KLD + (krow + 0) * KLD + kch) = kr0;       \
    *(uint4*)(sK + (nb) * 64 * KLD + (krow + 16) * KLD + kch) = kr1;      \
    *(uint4*)(sK + (nb) * 64 * KLD + (krow + 32) * KLD + kch) = kr2;      \
    *(uint4*)(sK + (nb) * 64 * KLD + (krow + 48) * KLD + kch) = kr3;      \
    *(uint4*)(sV + (nb) * 128 * VLD + (vrow + 0) * VLD + vch) = vr0;      \
    *(uint4*)(sV + (nb) * 128 * VLD + (vrow + 32) * VLD + vch) = vr1;     \
    *(uint4*)(sV + (nb) * 128 * VLD + (vrow + 64) * VLD + vch) = vr2;     \
    *(uint4*)(sV + (nb) * 128 * VLD + (vrow + 96) * VLD + vch) = vr3;
    A_LOAD(0)
    A_STORE(0)
    __syncthreads();
    for (int kt = 0; kt < nkt; ++kt) {
        const int buf = kt & 1;
        if (kt + 1 < nkt) { A_LOAD((kt + 1) * 64) }
        __builtin_amdgcn_sched_barrier(0);
        if (active) {
            const int valid = (kt == nkt - 1) ? lastvalid : 64;
            const u16* cK = sK + buf * 64 * KLD + l16 * KLD + n * 64 + g * 8;
            const u16* cV = sV + buf * 128 * VLD + l16 * VLD + g * 4;
            f32x4 s[4][2];
#pragma unroll
            for (int k16 = 0; k16 < 4; ++k16) {
                const bf16x8 kf0 = *(const bf16x8*)(cK + k16 * 16 * KLD);
                const bf16x8 kf1 = *(const bf16x8*)(cK + k16 * 16 * KLD + 32);
#pragma unroll
                for (int qt = 0; qt < 2; ++qt) {
                    f32x4 z = {0.f, 0.f, 0.f, 0.f};
                    z = MFMA(kf0, qf[qt][0], z);
                    s[k16][qt] = MFMA(kf1, qf[qt][1], z);
                }
            }
            bf16x8 pf[2][2];
#pragma unroll
            for (int qt = 0; qt < 2; ++qt) {
                float mx = -1e30f;
                if (valid < 64) {
#pragma unroll
                    for (int k16 = 0; k16 < 4; ++k16)
#pragma unroll
                        for (int r = 0; r < 4; ++r) {
                            float v = s[k16][qt][r];
                            if (k16 * 16 >= valid) v = -1e30f;
                            s[k16][qt][r] = v;
                            mx = fmaxf(mx, v);
                        }
                } else {
#pragma unroll
                    for (int k16 = 0; k16 < 4; ++k16)
#pragma unroll
                        for (int r = 0; r < 4; ++r) {
                            const float v = s[k16][qt][r];
                            s[k16][qt][r] = v;
                            mx = fmaxf(mx, v);
                        }
                }
                mx = max_g(mx);
                const float mold = mrow[qt];
                const float mnew = fmaxf(mold, mx);
                mrow[qt] = mnew;
                if (__builtin_amdgcn_ballot_w64(mnew > mold) != 0ull) {
                    const float alpha = __builtin_amdgcn_exp2f(mold - mnew);
                    lrow[qt] *= alpha;
#pragma unroll
                    for (int et = 0; et < 8; ++et) {
                        o[qt][et][0] *= alpha; o[qt][et][1] *= alpha; o[qt][et][2] *= alpha; o[qt][et][3] *= alpha;
                    }
                }
                float psum = 0.f;
#pragma unroll
                for (int k16 = 0; k16 < 4; ++k16)
#pragma unroll
                    for (int r = 0; r < 4; ++r) {
                        const float pv = __builtin_amdgcn_exp2f(s[k16][qt][r] - mnew);
                        s[k16][qt][r] = pv;
                        psum += pv;
                    }
                lrow[qt] += psum;
#pragma unroll
                for (int kb = 0; kb < 2; ++kb)
                    pf[qt][kb] = as_frag(make_uint4(pk2(s[2 * kb][qt][0], s[2 * kb][qt][1]), pk2(s[2 * kb][qt][2], s[2 * kb][qt][3]),
                                                    pk2(s[2 * kb + 1][qt][0], s[2 * kb + 1][qt][1]), pk2(s[2 * kb + 1][qt][2], s[2 * kb + 1][qt][3])));
            }
#pragma unroll
            for (int et = 0; et < 8; ++et)
#pragma unroll
                for (int kb = 0; kb < 2; ++kb) {
                    const uint2 lo = *(const uint2*)(cV + et * 16 * VLD + kb * 32);
                    const uint2 hi = *(const uint2*)(cV + et * 16 * VLD + kb * 32 + 16);
                    const bf16x8 vf = as_frag(make_uint4(lo.x, lo.y, hi.x, hi.y));
#pragma unroll
                    for (int qt = 0; qt < 2; ++qt) o[qt][et] = MFMA(vf, pf[qt][kb], o[qt][et]);
                }
        }
        __builtin_amdgcn_sched_barrier(0);
        if (kt + 1 < nkt) { A_STORE(buf ^ 1) }
        __syncthreads();
    }
    float inv[2];
#pragma unroll
    for (int qt = 0; qt < 2; ++qt) {
        const float l = red_g(lrow[qt]);
        inv[qt] = 1.f / fmaxf(l, 1e-30f);
    }
    if (active && n == 1) {
#pragma unroll
        for (int qt = 0; qt < 2; ++qt)
#pragma unroll
            for (int et = 0; et < 8; ++et) {
                const f32x4 v = o[qt][et];
                *(float4*)(ex + (qh * 32 + qt * 16 + l16) * 132 + et * 16 + g * 4) =
                    make_float4(v[0] * inv[qt], v[1] * inv[qt], v[2] * inv[qt], v[3] * inv[qt]);
            }
    }
    __syncthreads();
    if (active && n == 0) {
#pragma unroll
        for (int qt = 0; qt < 2; ++qt) {
            const int row = qh * 32 + qt * 16 + l16;
            float ss = 0.f;
#pragma unroll
            for (int et = 0; et < 8; ++et) {
                const float4 o2 = *(const float4*)(ex + row * 132 + et * 16 + g * 4);
                f32x4 v = o[qt][et];
                v[0] = v[0] * inv[qt] - lam * o2.x;
                v[1] = v[1] * inv[qt] - lam * o2.y;
                v[2] = v[2] * inv[qt] - lam * o2.z;
                v[3] = v[3] * inv[qt] - lam * o2.w;
                o[qt][et] = v;
                ss += v[0] * v[0] + v[1] * v[1] + v[2] * v[2] + v[3] * v[3];
            }
            ss = red_g(ss);
            const float rn = rsqrtf(ss * (1.f / 128.f) + EPS) * 0.8f;
            if (row < nq) {
#pragma unroll
                for (int et = 0; et < 8; ++et) {
                    const float4 sl = *(const float4*)(subln + et * 16 + g * 4);
                    const f32x4 v = o[qt][et];
                    *(uint2*)(O + (row * 512 + et * 16 + g * 4)) = pk4(v[0] * rn * sl.x, v[1] * rn * sl.y, v[2] * rn * sl.z, v[3] * rn * sl.w);
                }
            }
        }
    }
    __syncthreads();
}

__device__ __forceinline__ void phase3(const Params& p, unsigned char* smem) {
    unsigned char* ws = p.ws;
    int* s_item = (int*)(smem + LDS_BYTES - 16);
    unsigned* ctr = (unsigned*)(ws + O_SCAL) + 1;
    const float lam = ((const float*)(ws + O_SCAL))[0];
    const u16* SI = (const u16*)(ws + O_SI);
    const u16* qb = (const u16*)(ws + O_QB);
    const u16* kP = (const u16*)(ws + O_KP);
    const u16* kS = (const u16*)(ws + O_KS);
    const u16* vtP = (const u16*)(ws + O_VTP);
    const u16* vtS = (const u16*)(ws + O_VTS);
    u16* ob = (u16*)(ws + O_OB);
    int stage = 0, sidx = blockIdx.x;
    constexpr int SCAN_BASE = 100000, DONE = 1 << 30;
    for (;;) {
        if (threadIdx.x == 0) {
            int it;
            if (stage == 0) it = (sidx < 768) ? SCAN_BASE + sidx : -2;
            else {
                const int x = blockIdx.x & 7;
                const int i = (int)atomicAdd(ctr + 16 + x, 1u);
                if (i < 512) it = ((63 - (i >> 3)) << 6) | (x + 8 * (i & 7));
                else if (i < 528) it = 4096 + (x + 8 * (i - 512));
                else it = DONE;
            }
            *s_item = it;
        }
        __syncthreads();
        const int item = __builtin_amdgcn_readfirstlane(*s_item);
        __syncthreads();
        if (item == DONE) break;
        if (item == -2) {
            asm volatile("s_waitcnt vmcnt(0) lgkmcnt(0)" ::: "memory");
            cg::this_grid().sync();
            stage = 1;
            ln_pass(p);
            continue;
        }
        if (item >= SCAN_BASE) {
            sidx += gridDim.x;
            const int sc = item - SCAN_BASE;
            const u16* si; int nch; const float* s0; float* sout; int m0, h, half;
            if (sc < 256) {
                const int chain = sc >> 1;
                half = sc & 1; h = chain & 7;
                si = SI + (size_t)chain * 4096 * 384; nch = 256; s0 = nullptr;
                sout = p.out + OFF_WP + (size_t)chain * 4096; m0 = (chain >> 3) * 4096;
            } else {
                const int t2 = sc - 256, chain = t2 >> 1;
                half = t2 & 1; h = chain & 7;
                si = SI + ((size_t)128 * 4096 + (size_t)chain * 32) * 384; nch = 2; s0 = p.state_wkv + (size_t)chain * 4096;
                sout = p.out + OFF_WS + (size_t)chain * 4096; m0 = TP + (chain >> 3) * 32;
            }
            scan_item(p, si, nch, s0, sout, m0, h, half, smem);
        } else {
            const u16 *Q, *K, *Vt; u16* O; int nq, ldv, nkt, lastvalid;
            if (item < 4096) {
                const int c = item >> 6, bh = item & 63, b = bh >> 2, h = bh & 3;
                const size_t m0 = (size_t)b * 4096 + (size_t)c * 64;
                Q = qb + m0 * 512 + h * 128; nq = 64; K = kP + (size_t)b * 4096 * 512 + h * 128;
                Vt = vtP + ((size_t)b * 512 + h * 128) * 4096; ldv = 4096; nkt = c + 1; lastvalid = 64; O = ob + m0 * 512 + h * 128;
            } else {
                const int idx = item - 4096;
                const int b = idx >> 2, h = idx & 3;
                const size_t m0 = (size_t)TP + (size_t)b * 32;
                Q = qb + m0 * 512 + h * 128; nq = 32; K = kS + (size_t)b * LKS * 512 + h * 128;
                Vt = vtS + ((size_t)b * 512 + h * 128) * LKS; ldv = LKS; nkt = 17; lastvalid = 32; O = ob + m0 * 512 + h * 128;
            }
            attn_item(Q, nq, K, Vt, ldv, nkt, lastvalid, O, lam, p.subln, smem);
        }
    }
}

__device__ __forceinline__ void phase4(const Params& p, unsigned char* smem) {
    unsigned char* ws = p.ws;
    const u16* ya = (const u16*)(ws + O_YA);
    const u16* ob = (const u16*)(ws + O_OB);
    const u16* Wa = (const u16*)(ws + O_WOA);
    const u16* Wb = (const u16*)(ws + O_WOB);
    const u16* gate = (const u16*)p.out;
    u16* mix = (u16*)(ws + O_MIX);
    const int tid = threadIdx.x, lane = tid & 63, wid = tid >> 6, wm = wid >> 1, wn = wid & 1, l16 = lane & 15, g = lane >> 4;
    constexpr int NT = 8;
    for (int t = blockIdx.x; t < 520 * NT; t += gridDim.x) {
        int mtile, ntile;
        tile_map(t, NT, mtile, ntile);
        const int m0 = mtile * 128, n0 = ntile * 128;
        f32x4 acc[4][4], acc2[4][4];
        zero_acc(acc);
        zero_acc(acc2);
        gemm_loop(ya + (size_t)m0 * 512, 512, Wa + (size_t)n0 * 512, 512, 8, (u16*)smem, acc);
        gemm_loop(ob + (size_t)m0 * 512, 512, Wb + (size_t)n0 * 512, 512, 8, (u16*)smem, acc2);
#pragma unroll
        for (int mt = 0; mt < 4; ++mt) {
            const int m = m0 + wm * 64 + mt * 16 + l16;
#pragma unroll
            for (int nt = 0; nt < 4; ++nt) {
                const int n = n0 + wn * 64 + nt * 16 + g * 4;
                const uint2 ga = *(const uint2*)(gate + (size_t)m * 2048 + n);
                const uint2 gb = *(const uint2*)(gate + (size_t)m * 2048 + 1024 + n);
                const f32x4 a = acc[nt][mt], b = acc2[nt][mt];
                *(uint2*)(mix + (size_t)m * 1024 + n) =
                    pk4(bflo(ga.x) * a[0] + bflo(gb.x) * b[0], bfhi(ga.x) * a[1] + bfhi(gb.x) * b[1],
                        bflo(ga.y) * a[2] + bflo(gb.y) * b[2], bfhi(ga.y) * a[3] + bfhi(gb.y) * b[3]);
            }
        }
    }
}

__device__ __forceinline__ void gemm_rowss(const u16* A, int K, const u16* W, u16* outb, float* ssq, unsigned char* smem) {
    const int tid = threadIdx.x, lane = tid & 63, wid = tid >> 6, wm = wid >> 1, wn = wid & 1, l16 = lane & 15, g = lane >> 4;
    constexpr int NT = 8;
    for (int t = blockIdx.x; t < 520 * NT; t += gridDim.x) {
        int mtile, ntile;
        tile_map(t, NT, mtile, ntile);
        const int m0 = mtile * 128, n0 = ntile * 128;
        f32x4 acc[4][4];
        zero_acc(acc);
        gemm_loop(A + (size_t)m0 * K, K, W + (size_t)n0 * K, K, K / 64, (u16*)smem, acc);
#pragma unroll
        for (int mt = 0; mt < 4; ++mt) {
            const int m = m0 + wm * 64 + mt * 16 + l16;
#pragma unroll
            for (int nt = 0; nt < 4; ++nt) {
                const int n = n0 + wn * 64 + nt * 16 + g * 4;
                const f32x4 a = acc[nt][mt];
                *(uint2*)(outb + (size_t)m * 1024 + n) = pk4(a[0], a[1], a[2], a[3]);
            }
        }
    }
}

__device__ __forceinline__ float sum16(const float* q) {
    const float4 a = *(const float4*)q, b = *(const float4*)(q + 4), c = *(const float4*)(q + 8), d = *(const float4*)(q + 12);
    return ((a.x + a.y) + (a.z + a.w)) + ((b.x + b.y) + (b.z + b.w)) + (((c.x + c.y) + (c.z + c.w)) + ((d.x + d.y) + (d.z + d.w)));
}
__device__ __forceinline__ void phase6(const Params& p) {
    unsigned char* ws = p.ws;
    const u16* m2 = (const u16*)(ws + O_M2);
    u16* x1b = (u16*)(ws + O_X1B);
    float* rs3 = (float*)(ws + O_RS3);
    const int lane = threadIdx.x & 63, wid = threadIdx.x >> 6;
    for (int m = blockIdx.x * 4 + wid; m < T; m += gridDim.x * 4) {
        const float* xr = (m < TP) ? p.x_prompt + (size_t)m * 1024 : p.x_sample + (size_t)(m - TP) * 1024;
        uint2 mvv[4];
        float s2 = 0.f;
#pragma unroll
        for (int i = 0; i < 4; ++i) {
            mvv[i] = *(const uint2*)(m2 + (size_t)m * 1024 + i * 256 + lane * 4);
            const float a = bflo(mvv[i].x), b = bfhi(mvv[i].x), c = bflo(mvv[i].y), d = bfhi(mvv[i].y);
            s2 += a * a + b * b + c * c + d * d;
        }
        s2 = wave_sum(s2);
        const float rs = rsqrtf(s2 * (1.f / 1024.f) + EPS);
        float ss = 0.f;
#pragma unroll
        for (int i = 0; i < 4; ++i) {
            const int col = i * 256 + lane * 4;
            const float4 xv = *(const float4*)(xr + col);
            const uint2 mv = mvv[i];
            const float4 gp = *(const float4*)(p.n_mix_post + col);
            float4 r;
            r.x = xv.x + bflo(mv.x) * rs * gp.x;
            r.y = xv.y + bfhi(mv.x) * rs * gp.y;
            r.z = xv.z + bflo(mv.y) * rs * gp.z;
            r.w = xv.w + bfhi(mv.y) * rs * gp.w;
            ss += r.x * r.x + r.y * r.y + r.z * r.z + r.w * r.w;
            *(float4*)(p.out + (size_t)m * 1024 + col) = r;
            *(uint2*)(x1b + (size_t)m * 1024 + col) = pk4(r.x, r.y, r.z, r.w);
        }
        ss = wave_sum(ss);
        if (lane == 0) rs3[m] = rsqrtf(ss * (1.f / 1024.f) + EPS);
    }
}

__device__ __forceinline__ void phase7(const Params& p, unsigned char* smem) {
    unsigned char* ws = p.ws;
    const u16* x1b = (const u16*)(ws + O_X1B);
    const u16* W = (const u16*)(ws + O_WFI);
    const float* rs3 = (const float*)(ws + O_RS3);
    u16* hb = (u16*)(ws + O_HB);
    const int tid = threadIdx.x, lane = tid & 63, wid = tid >> 6, wm = wid >> 1, wn = wid & 1, l16 = lane & 15, g = lane >> 4;
    constexpr int NT = 44;
    for (int t = blockIdx.x; t < 520 * NT; t += gridDim.x) {
        int mtile, ntile;
        tile_map(t, NT, mtile, ntile);
        const int m0 = mtile * 128, n0 = ntile * 128;
        f32x4 acc[4][4];
        zero_acc(acc);
        gemm_loop(x1b + (size_t)m0 * 1024, 1024, W + (size_t)n0 * 1024, 1024, 16, (u16*)smem, acc);
#pragma unroll
        for (int mt = 0; mt < 4; ++mt) {
            const int m = m0 + wm * 64 + mt * 16 + l16;
            const float rs = rs3[m];
#pragma unroll
            for (int pr = 0; pr < 2; ++pr) {
                const f32x4 ug = acc[2 * pr][mt], uv = acc[2 * pr + 1][mt];
                const int j = ((n0 + wn * 64) >> 5) * 16 + pr * 16 + g * 4;
                float hv[4];
#pragma unroll
                for (int r = 0; r < 4; ++r) {
                    const float a = ug[r] * rs, b = uv[r] * rs;
                    hv[r] = a * sigmoidf_(a) * b;
                }
                *(uint2*)(hb + (size_t)m * 2816 + j) = pk4(hv[0], hv[1], hv[2], hv[3]);
            }
        }
    }
}

__device__ __forceinline__ void phase9(const Params& p) {
    unsigned char* ws = p.ws;
    const u16* fb = (const u16*)(ws + O_FB);
    const int lane = threadIdx.x & 63, wid = threadIdx.x >> 6;
    for (int m = blockIdx.x * 4 + wid; m < T; m += gridDim.x * 4) {
        uint2 fvv[4];
        float s2 = 0.f;
#pragma unroll
        for (int i = 0; i < 4; ++i) {
            fvv[i] = *(const uint2*)(fb + (size_t)m * 1024 + i * 256 + lane * 4);
            const float a = bflo(fvv[i].x), b = bfhi(fvv[i].x), c = bflo(fvv[i].y), d = bfhi(fvv[i].y);
            s2 += a * a + b * b + c * c + d * d;
        }
        s2 = wave_sum(s2);
        const float rs = rsqrtf(s2 * (1.f / 1024.f) + EPS);
#pragma unroll
        for (int i = 0; i < 4; ++i) {
            const int col = i * 256 + lane * 4;
            float4 r = *(const float4*)(p.out + (size_t)m * 1024 + col);
            const uint2 fv = fvv[i];
            const float4 gp = *(const float4*)(p.n_ffn_post + col);
            r.x += bflo(fv.x) * rs * gp.x;
            r.y += bfhi(fv.x) * rs * gp.y;
            r.z += bflo(fv.y) * rs * gp.z;
            r.w += bfhi(fv.y) * rs * gp.w;
            *(float4*)(p.out + (size_t)m * 1024 + col) = r;
        }
    }
}

__global__ void __launch_bounds__(256, 2) mega(Params p) {
    extern __shared__ __attribute__((aligned(16))) unsigned char smem[];
    cg::grid_group grid = cg::this_grid();
#define IN(k) (p.ph_lo <= (k) && (k) < p.ph_hi)
#define SEAM(k) if (IN(k) && IN((k) + 1)) { asm volatile("s_waitcnt vmcnt(0) lgkmcnt(0)" ::: "memory"); grid.sync(); }
    unsigned char* ws = p.ws;
    if (IN(0)) phase0(p, smem);
    SEAM(0)
    if (IN(1)) phase1(p, smem);
    SEAM(1)
    if (IN(2)) phase2(p, smem);
    SEAM(2)
    if (IN(3)) phase3(p, smem);
    SEAM(3)
    if (IN(5)) phase4(p, smem);
    SEAM(5)
    if (IN(6)) gemm_rowss((const u16*)(ws + O_MIX), 1024, (const u16*)(ws + O_WO), (u16*)(ws + O_M2), (float*)(ws + O_SS2), smem);
    SEAM(6)
    if (IN(7)) phase6(p);
    SEAM(7)
    if (IN(8)) phase7(p, smem);
    SEAM(8)
    if (IN(9)) gemm_rowss((const u16*)(ws + O_HB), 2816, (const u16*)(ws + O_WFO), (u16*)(ws + O_FB), (float*)(ws + O_SS4), smem);
    SEAM(9)
    if (IN(10)) phase9(p);
}

extern "C" void kernel_launch(void* const* d_in, const int* in_sizes, int n_in, void* d_out, int out_size, void* d_ws, size_t ws_size,
                              hipStream_t stream) {
    static int grid_blocks = 0;
    if (!grid_blocks) {
        int dev = 0, cus = 0, per_cu = 0;
        hipGetDevice(&dev);
        hipDeviceGetAttribute(&cus, hipDeviceAttributeMultiprocessorCount, dev);
        hipFuncSetAttribute((const void*)mega, hipFuncAttributeMaxDynamicSharedMemorySize, LDS_BYTES);
        hipOccupancyMaxActiveBlocksPerMultiprocessor(&per_cu, (const void*)mega, 256, LDS_BYTES);
        if (per_cu < 1) per_cu = 1;
        if (per_cu > 2) per_cu = 2;
        grid_blocks = cus * per_cu;
        if (ws_size < WS_END) fprintf(stderr, "kernel_launch: workspace too small: %zu < %zu\n", ws_size, (size_t)WS_END);
    }
    Params p{};
    const float** pp = (const float**)&p;
    for (int i = 0; i < 33; ++i) pp[i] = (const float*)d_in[i];
    p.out = (float*)d_out;
    p.ws = (unsigned char*)d_ws;
#ifndef MULTI_LAUNCH
    p.ph_lo = 0;
    p.ph_hi = 11;
    void* args[] = {&p};
    hipError_t e = hipLaunchCooperativeKernel((const void*)mega, dim3(grid_blocks), dim3(256), args, LDS_BYTES, stream);
    if (e != hipSuccess) fprintf(stderr, "cooperative launch failed: %s (grid %d)\n", hipGetErrorString(e), grid_blocks);
#else
    for (int k = 0; k < 11; ++k) {
        p.ph_lo = k;
        p.ph_hi = k + 1;
        hipLaunchKernelGGL(mega, dim3(grid_blocks), dim3(256), LDS_BYTES, stream, p);
    }
#endif
}
```
